# Optimizing an MI355X kernel written in HIP

```python
import math
import jax
import jax.numpy as jnp
from jax import lax
import numpy as np

D_MODEL = 2048
BATCH = 8
SEQ = 2048
DEPTH = 2

CTX_LEN = 256
GRID_W = 64
MIX = D_MODEL
NORM_EPS = 1e-6

RW_HEAD = 64
RW_W = MIX // 4
RW_HEADS = RW_W // RW_HEAD
RW_DECAY_RANK = 64
RW_AICL_RANK = 64
RW_GATE_RANK = 128
RW_GN_EPS = 64e-5
RW_SPLITS = (RW_W, 2 * RW_W, 3 * RW_W, 3 * RW_W + RW_DECAY_RANK, 3 * RW_W + RW_DECAY_RANK + RW_AICL_RANK)
RW_COLS = 3 * RW_W + RW_DECAY_RANK + RW_AICL_RANK + RW_GATE_RANK

MB_HEAD = 64
MB_W = MIX // 2
MB_HEADS = MB_W // MB_HEAD
MB_GROUPS = 2
MB_STATE = 128
MB_CONV = 3
MB_CHUNK = 128
MB_NORM_EPS = 1e-5
MB_CONV_CH = MB_W + 2 * MB_GROUPS * MB_STATE
MB_COLS = MB_W + MB_CONV_CH + 2 * MB_HEADS

DA_QK = 64
DA_V = 2 * DA_QK
DA_W = MIX - RW_W - MB_W
DA_HEADS = DA_W // DA_V
DA_QK_COLS = DA_HEADS * 2 * DA_QK
DA_COLS = 2 * DA_QK_COLS + DA_W
DA_SUBLN_EPS = 1e-5
Q_BLOCK = 128
ROPE_THETA = 10000.0
ROPE_PAIRS = DA_QK // 4

IN_COLS = RW_COLS + MB_COLS + DA_COLS

FFN_DENSE = 256 * ((8 * D_MODEL // 3 + 255) // 256)
N_EXPERTS = 8
TOP_K = 2
FFN_EXPERT = 7 * D_MODEL // 2
N_DENSE = (DEPTH + 1) // 2
N_MOE = DEPTH // 2

kernel_name = 'hybrid_rwkv7_mamba2_diffattn_moe_dit'


def rmsnorm(x, w, eps=NORM_EPS):
    xf = x.astype(jnp.float32)
    y = xf * lax.rsqrt(jnp.mean(jnp.square(xf), axis=-1, keepdims=True) + eps)
    return (y * w.astype(jnp.float32)).astype(x.dtype)


def ada_split(cvec, w, b):
    return jnp.split(jnp.matmul(jax.nn.silu(cvec), w) + b, 6, axis=-1)


def centred_shift(u, mu):
    prev = jnp.pad(u, ((0, 0), (1, 0), (0, 0)))[:, :-1]
    nxt = jnp.pad(u, ((0, 0), (0, 1), (0, 0)))[:, 1:]
    return u + mu[0] * (prev - u) + mu[1] * (nxt - u)


def dwconv_centred(u, w, b):
    k = w.shape[0]
    y = lax.conv_general_dilated(u, w[:, None, :].astype(u.dtype), window_strides=(1,),
                                 padding=[(k // 2, k // 2)],
                                 dimension_numbers=('NWC', 'WIO', 'NWC'),
                                 feature_group_count=u.shape[-1])
    return y + b


def flip_seq(t):
    return jnp.flip(t, axis=1)


def rwkv7_features(u, mu, w0, w_up, a0, a_up, g_up, k_k, k_a):
    bsz, L, _ = u.shape
    f32 = jnp.float32
    heads = lambda t: t.reshape(bsz, L, RW_HEADS, RW_HEAD).astype(f32)
    r, k, v, xw, xa, xg = jnp.split(centred_shift(u, mu), RW_SPLITS, axis=-1)
    tw = jnp.tanh(xw)
    logw_f = -jax.nn.softplus(-(w0[0] + tw @ w_up[0])) - 0.5
    logw_b = -jax.nn.softplus(-(w0[1] + tw @ w_up[1])) - 0.5
    decay_f = jnp.exp(-jnp.exp(heads(logw_f)))
    decay_b = jnp.exp(-jnp.exp(heads(logw_b)))
    a = jax.nn.sigmoid(a0 + xa @ a_up)
    g = jax.nn.sigmoid(xg) @ g_up
    kk = heads(k * k_k)
    kk = kk / jnp.maximum(jnp.sqrt(jnp.sum(kk * kk, axis=-1, keepdims=True)), 1e-12)
    k = k * (1 + (a - 1) * k_a)
    b = kk * heads(a)
    return heads(r), heads(k), heads(v), kk, b, decay_f, decay_b, g


def rwkv7_scan(r, w, k, v, kk, b, s0):
    def step(S, inp):
        rt, wt, kt, vt, kkt, bt = inp
        sa = jnp.einsum('bhij,bhj->bhi', S, -kkt)
        S = S * wt[:, :, None, :] + sa[..., None] * bt[:, :, None, :] + vt[..., None] * kt[:, :, None, :]
        return S, jnp.einsum('bhij,bhj->bhi', S, rt)
    seq = tuple(jnp.swapaxes(t, 0, 1) for t in (r, w, k, v, kk, b))
    s_final, y = lax.scan(step, s0, seq)
    return jnp.swapaxes(y, 0, 1), s_final


def rwkv7_bidir(f, s0_fwd, s0_bwd):
    r, k, v, kk, b, w_fwd, w_bwd, _ = f
    y_f, s_f = rwkv7_scan(r, w_fwd, k, v, kk, b, s0_fwd)
    y_b, s_b = rwkv7_scan(flip_seq(r), flip_seq(w_bwd), flip_seq(k), flip_seq(v),
                          flip_seq(kk), flip_seq(b), s0_bwd)
    return y_f + flip_seq(y_b), s_f, s_b


def rwkv7_output(y, f, r_k, ln_w, ln_b, dtype):
    r, k, v, _, _, _, _, g = f
    bsz, L = y.shape[:2]
    mu = jnp.mean(y, axis=-1, keepdims=True)
    var = jnp.mean(jnp.square(y - mu), axis=-1, keepdims=True)
    yn = ((y - mu) * lax.rsqrt(var + RW_GN_EPS)).reshape(bsz, L, RW_W) * ln_w + ln_b
    bonus = (jnp.sum(r * k * r_k, axis=-1, keepdims=True) * v).reshape(bsz, L, RW_W)
    return ((yn + bonus) * g).astype(dtype)


def rwkv7_mixer(u_lat, u_ctx, mu, w0, w_up, a0, a_up, g_up, k_k, k_a, r_k, ln_w, ln_b, need_ctx):
    f_lat = rwkv7_features(u_lat, mu, w0, w_up, a0, a_up, g_up, k_k, k_a)
    f_ctx = rwkv7_features(u_ctx, mu, w0, w_up, a0, a_up, g_up, k_k, k_a)
    zero = jnp.zeros((u_lat.shape[0], RW_HEADS, RW_HEAD, RW_HEAD), jnp.float32)
    y_ctx, s_f, s_b = rwkv7_bidir(f_ctx, zero, zero)
    y_lat, _, _ = rwkv7_bidir(f_lat, s_f, s_b)
    out_lat = rwkv7_output(y_lat, f_lat, r_k, ln_w, ln_b, u_lat.dtype)
    out_ctx = rwkv7_output(y_ctx, f_ctx, r_k, ln_w, ln_b, u_ctx.dtype) if need_ctx else None
    return out_lat, out_ctx


def segsum(a):
    T = a.shape[-1]
    cs = jnp.cumsum(a, axis=-1)
    diff = cs[..., :, None] - cs[..., None, :]
    return jnp.where(jnp.tril(jnp.ones((T, T), dtype=bool)), diff, -jnp.inf)


def ssd_chunked(xs, dt, A, bm, cm, s0):
    f32 = jnp.float32
    bsz, L, H, P = xs.shape
    G, N = bm.shape[2], bm.shape[3]
    E = H // G
    Q = MB_CHUNK
    nc = L // Q
    xdt = (xs.astype(f32) * dt[..., None]).reshape(bsz, nc, Q, G, E, P)
    a = (dt * A).reshape(bsz, nc, Q, G, E).transpose(0, 3, 4, 1, 2)
    a_cs = jnp.cumsum(a, axis=-1)
    bc = bm.astype(f32).reshape(bsz, nc, Q, G, N)
    cc = cm.astype(f32).reshape(bsz, nc, Q, G, N)
    lmat = jnp.exp(segsum(a))
    cb = jnp.einsum('bclgn,bcsgn->bgcls', cc, bc)
    y_diag = jnp.einsum('bgcls,bgecls,bcsgep->bclgep', cb, lmat, xdt)
    decay_states = jnp.exp(a_cs[..., -1:] - a_cs)
    states = jnp.einsum('bclgn,bgecl,bclgep->bcgepn', bc, decay_states, xdt)
    states = jnp.concatenate([s0.astype(f32).reshape(bsz, 1, G, E, P, N), states], axis=1)
    chunk_a = jnp.pad(a_cs[..., -1], ((0, 0), (0, 0), (0, 0), (1, 0)))
    decay_chunk = jnp.exp(segsum(chunk_a))
    new_states = jnp.einsum('bgezc,bcgepn->bzgepn', decay_chunk, states)
    states_in, final = new_states[:, :-1], new_states[:, -1]
    y_off = jnp.einsum('bclgn,bcgepn,bgecl->bclgep', cc, states_in, jnp.exp(a_cs))
    return (y_diag + y_off).reshape(bsz, L, H, P), final.reshape(bsz, H, P, N)


def mamba2_features(u, conv_w, conv_b, dt_bias):
    bsz, L, _ = u.shape
    z, xbc, dt = jnp.split(u, (MB_W, MB_W + MB_CONV_CH), axis=-1)
    xbc = jax.nn.silu(dwconv_centred(xbc, conv_w, conv_b))
    xs, bm, cm = jnp.split(xbc, (MB_W, MB_W + MB_GROUPS * MB_STATE), axis=-1)
    dt = dt.astype(jnp.float32)
    dt_f = jax.nn.softplus(dt[..., :MB_HEADS] + dt_bias[0].astype(jnp.float32))
    dt_b = jax.nn.softplus(dt[..., MB_HEADS:] + dt_bias[1].astype(jnp.float32))
    return (z, xs.reshape(bsz, L, MB_HEADS, MB_HEAD),
            bm.reshape(bsz, L, MB_GROUPS, MB_STATE), cm.reshape(bsz, L, MB_GROUPS, MB_STATE), dt_f, dt_b)


def mamba2_bidir(f, a_f, a_b, s0_f, s0_b):
    _, xs, bm, cm, dt_f, dt_b = f
    y_f, s_f = ssd_chunked(xs, dt_f, a_f, bm, cm, s0_f)
    y_b, s_b = ssd_chunked(flip_seq(xs), flip_seq(dt_b), a_b, flip_seq(bm), flip_seq(cm), s0_b)
    return y_f + flip_seq(y_b), s_f, s_b


def mamba2_output(y, f, d_skip, norm_w, dtype):
    z, xs = f[0], f[1]
    bsz, L = y.shape[:2]
    y = (y + d_skip.astype(jnp.float32)[:, None] * xs.astype(jnp.float32)).reshape(bsz, L, MB_W)
    y = y * jax.nn.silu(z.astype(jnp.float32))
    yg = y.reshape(bsz, L, MB_GROUPS, MB_W // MB_GROUPS)
    yg = yg * lax.rsqrt(jnp.mean(jnp.square(yg), axis=-1, keepdims=True) + MB_NORM_EPS)
    return (yg.reshape(bsz, L, MB_W) * norm_w).astype(dtype)


def mamba2_mixer(u_lat, u_ctx, conv_w, conv_b, dt_bias, a_log, d_skip, norm_w, need_ctx):
    f_lat = mamba2_features(u_lat, conv_w, conv_b, dt_bias)
    f_ctx = mamba2_features(u_ctx, conv_w, conv_b, dt_bias)
    a_f = -jnp.exp(a_log[0].astype(jnp.float32))
    a_b = -jnp.exp(a_log[1].astype(jnp.float32))
    zero = jnp.zeros((u_lat.shape[0], MB_HEADS, MB_HEAD, MB_STATE), jnp.float32)
    y_ctx, s_f, s_b = mamba2_bidir(f_ctx, a_f, a_b, zero, zero)
    y_lat, _, _ = mamba2_bidir(f_lat, a_f, a_b, s_f, s_b)
    out_lat = mamba2_output(y_lat, f_lat, d_skip, norm_w, u_lat.dtype)
    out_ctx = mamba2_output(y_ctx, f_ctx, d_skip, norm_w, u_ctx.dtype) if need_ctx else None
    return out_lat, out_ctx


def axial_angles(L):
    rows = L // GRID_W
    row = jnp.repeat(jnp.arange(rows, dtype=jnp.float32), GRID_W)
    col = jnp.tile(jnp.arange(GRID_W, dtype=jnp.float32), rows)
    inv = ROPE_THETA ** (-jnp.arange(ROPE_PAIRS, dtype=jnp.float32) / ROPE_PAIRS)
    return row[:, None] * inv, col[:, None] * inv


def axial_rope(t, ang_row, ang_col):
    def rot(u, ang):
        cos = jnp.cos(ang)[None, :, None, None, :]
        sin = jnp.sin(ang)[None, :, None, None, :]
        u1, u2 = jnp.split(u.astype(jnp.float32), 2, axis=-1)
        return jnp.concatenate([u1 * cos - u2 * sin, u2 * cos + u1 * sin], axis=-1)
    t_row, t_col = jnp.split(t, 2, axis=-1)
    return jnp.concatenate([rot(t_row, ang_row), rot(t_col, ang_col)], axis=-1).astype(t.dtype)


def diff_attend(q, k, v, lam):
    s = jnp.einsum('bqhcd,bkhcd->bhcqk', q, k).astype(jnp.float32) * (DA_QK ** -0.5)
    p = jax.nn.softmax(s, axis=-1)
    w = p[:, :, 0] - lam * p[:, :, 1]
    return jnp.einsum('bhqk,bkhe->bqhe', w.astype(v.dtype), v)


def diff_attn_mixer(u_lat, u_ctx, lam_p, subln_w, lam_init, need_ctx):
    def split_heads(u):
        bsz, L, _ = u.shape
        q, k, v = jnp.split(u, (DA_QK_COLS, 2 * DA_QK_COLS), axis=-1)
        return (q.reshape(bsz, L, DA_HEADS, 2, DA_QK), k.reshape(bsz, L, DA_HEADS, 2, DA_QK),
                v.reshape(bsz, L, DA_HEADS, DA_V))
    q_lat, k_lat, v_lat = split_heads(u_lat)
    q_ctx, k_ctx, v_ctx = split_heads(u_ctx)
    bsz, L = u_lat.shape[:2]
    ang_row, ang_col = axial_angles(L)
    q_lat = axial_rope(q_lat, ang_row, ang_col)
    k_lat = axial_rope(k_lat, ang_row, ang_col)
    lp = lam_p.astype(jnp.float32)
    lam = jnp.exp(jnp.sum(lp[0] * lp[1])) - jnp.exp(jnp.sum(lp[2] * lp[3])) + lam_init
    k_all = jnp.concatenate([k_ctx, k_lat], axis=1)
    v_all = jnp.concatenate([v_ctx, v_lat], axis=1)
    nb = L // Q_BLOCK
    q_blocks = jnp.swapaxes(q_lat.reshape(bsz, nb, Q_BLOCK, DA_HEADS, 2, DA_QK), 0, 1)
    o_blocks = lax.map(lambda qb: diff_attend(qb, k_all, v_all, lam), q_blocks)
    o_lat = jnp.swapaxes(o_blocks, 0, 1).reshape(bsz, L, DA_HEADS, DA_V)

    def finish(o):
        o = rmsnorm(o, subln_w, DA_SUBLN_EPS) * (1.0 - lam_init)
        return o.reshape(o.shape[0], o.shape[1], DA_W)
    out_ctx = finish(diff_attend(q_ctx, k_ctx, v_ctx, lam)) if need_ctx else None
    return finish(o_lat), out_ctx


def swiglu(h, w_gate, w_up, w_down):
    return jnp.matmul(jax.nn.silu(h @ w_gate) * (h @ w_up), w_down)


def moe_swiglu(h, router, w_gate, w_up, w_down):
    shp = h.shape
    t = h.reshape(-1, shp[-1])
    logits = (t @ router).astype(jnp.float32)
    top_val, top_idx = lax.top_k(logits, TOP_K)
    top_w = jax.nn.softmax(top_val, axis=-1)
    combine = jnp.einsum('tk,tke->te', top_w,
                         jax.nn.one_hot(top_idx, N_EXPERTS, dtype=jnp.float32)).astype(h.dtype)
    out = jnp.zeros_like(t)
    for e in range(N_EXPERTS):
        out = out + combine[:, e:e + 1] * swiglu(t, w_gate[e], w_up[e], w_down[e])
    return out.reshape(shp)


def setup_inputs(seed: int = 0) -> dict:
    key = jax.random.key(seed)
    ks = iter(jax.random.split(key, 48))
    f32 = jnp.float32
    D = D_MODEL

    def nrm(shape, scale):
        return jax.random.normal(next(ks), shape, f32) * scale

    def gain(shape):
        return 1.0 + nrm(shape, 0.05)

    def unif(shape, lo, hi):
        return jax.random.uniform(next(ks), shape, f32, lo, hi)

    x = nrm((BATCH, SEQ, D), 1.0)
    c = nrm((BATCH, D), 1.0)
    ctx = nrm((BATCH, CTX_LEN, D), 1.0)
    c_ctx = nrm((D,), 1.0)
    mod_w = nrm((DEPTH, D, 6 * D), 0.5 * D ** -0.5)
    mod_b = nrm((DEPTH, 6 * D), 0.02)
    norm_mix_pre = gain((DEPTH, D))
    norm_mix_post = gain((DEPTH, D))
    norm_ffn_pre = gain((DEPTH, D))
    norm_ffn_post = gain((DEPTH, D))
    w_in = nrm((DEPTH, D, IN_COLS), D ** -0.5)
    w_out = nrm((DEPTH, MIX, D), MIX ** -0.5)
    rw_mu = unif((DEPTH, 2, RW_COLS), 0.0, 0.5)
    rw_w0 = unif((DEPTH, 2, RW_W), -6.0, 0.0)
    rw_w_up = nrm((DEPTH, 2, RW_DECAY_RANK, RW_W), 0.1)
    rw_a0 = nrm((DEPTH, RW_W), 0.1)
    rw_a_up = nrm((DEPTH, RW_AICL_RANK, RW_W), 0.1)
    rw_g_up = nrm((DEPTH, RW_GATE_RANK, RW_W), RW_GATE_RANK ** -0.5)
    rw_k_k = 0.85 + nrm((DEPTH, RW_W), 0.05)
    rw_k_a = gain((DEPTH, RW_W))
    rw_r_k = nrm((DEPTH, RW_HEADS, RW_HEAD), 0.1)
    rw_ln_w = gain((DEPTH, RW_W))
    rw_ln_b = nrm((DEPTH, RW_W), 0.02)
    mb_conv_w = nrm((DEPTH, MB_CONV, MB_CONV_CH), MB_CONV ** -0.5)
    mb_conv_b = nrm((DEPTH, MB_CONV_CH), 0.02)
    dt0 = jnp.exp(unif((DEPTH, 2, MB_HEADS), math.log(1e-3), math.log(1e-1)))
    mb_dt_bias = dt0 + jnp.log(-jnp.expm1(-dt0))
    mb_A_log = jnp.log(unif((DEPTH, 2, MB_HEADS), 1.0, 16.0))
    mb_D = gain((DEPTH, MB_HEADS))
    mb_norm_w = gain((DEPTH, MB_W))
    da_lambda = nrm((DEPTH, 4, DA_QK), 0.1)
    da_subln = gain((DEPTH, DA_V))
    ffn_w_gate = nrm((N_DENSE, D, FFN_DENSE), D ** -0.5)
    ffn_w_up = nrm((N_DENSE, D, FFN_DENSE), D ** -0.5)
    ffn_w_down = nrm((N_DENSE, FFN_DENSE, D), FFN_DENSE ** -0.5)
    moe_router = nrm((N_MOE, D, N_EXPERTS), D ** -0.5)
    moe_w_gate = nrm((N_MOE, N_EXPERTS, D, FFN_EXPERT), D ** -0.5)
    moe_w_up = nrm((N_MOE, N_EXPERTS, D, FFN_EXPERT), D ** -0.5)
    moe_w_down = nrm((N_MOE, N_EXPERTS, FFN_EXPERT, D), FFN_EXPERT ** -0.5)
    return {'x': x, 'c': c, 'ctx': ctx, 'c_ctx': c_ctx, 'mod_w': mod_w, 'mod_b': mod_b,
            'norm_mix_pre': norm_mix_pre, 'norm_mix_post': norm_mix_post,
            'norm_ffn_pre': norm_ffn_pre, 'norm_ffn_post': norm_ffn_post,
            'w_in': w_in, 'w_out': w_out,
            'rw_mu': rw_mu, 'rw_w0': rw_w0, 'rw_w_up': rw_w_up, 'rw_a0': rw_a0, 'rw_a_up': rw_a_up,
            'rw_g_up': rw_g_up, 'rw_k_k': rw_k_k, 'rw_k_a': rw_k_a, 'rw_r_k': rw_r_k,
            'rw_ln_w': rw_ln_w, 'rw_ln_b': rw_ln_b,
            'mb_conv_w': mb_conv_w, 'mb_conv_b': mb_conv_b, 'mb_dt_bias': mb_dt_bias,
            'mb_A_log': mb_A_log, 'mb_D': mb_D, 'mb_norm_w': mb_norm_w,
            'da_lambda': da_lambda, 'da_subln': da_subln,
            'ffn_w_gate': ffn_w_gate, 'ffn_w_up': ffn_w_up, 'ffn_w_down': ffn_w_down,
            'moe_router': moe_router, 'moe_w_gate': moe_w_gate, 'moe_w_up': moe_w_up,
            'moe_w_down': moe_w_down}


def reference(x, c, ctx, c_ctx, mod_w, mod_b, norm_mix_pre, norm_mix_post, norm_ffn_pre, norm_ffn_post,
              w_in, w_out, rw_mu, rw_w0, rw_w_up, rw_a0, rw_a_up, rw_g_up, rw_k_k, rw_k_a, rw_r_k,
              rw_ln_w, rw_ln_b, mb_conv_w, mb_conv_b, mb_dt_bias, mb_A_log, mb_D, mb_norm_w,
              da_lambda, da_subln, ffn_w_gate, ffn_w_up, ffn_w_down,
              moe_router, moe_w_gate, moe_w_up, moe_w_down):
    xc = ctx
    for i in range(DEPTH):
        need_ctx = i < DEPTH - 1
        lam_init = 0.8 - 0.6 * math.exp(-0.3 * i)
        sm, scm, gm, sf, scf, gf = [m[:, None, :] for m in ada_split(c, mod_w[i], mod_b[i])]
        csm, cscm, cgm, csf, cscf, cgf = ada_split(c_ctx, mod_w[i], mod_b[i])

        h = rmsnorm(x, norm_mix_pre[i]) * (1 + scm) + sm
        hc = rmsnorm(xc, norm_mix_pre[i]) * (1 + cscm) + csm
        u = h @ w_in[i]
        uc = hc @ w_in[i]
        u_rw, u_mb, u_da = jnp.split(u, (RW_COLS, RW_COLS + MB_COLS), axis=-1)
        uc_rw, uc_mb, uc_da = jnp.split(uc, (RW_COLS, RW_COLS + MB_COLS), axis=-1)
        o_rw, oc_rw = rwkv7_mixer(u_rw, uc_rw, rw_mu[i], rw_w0[i], rw_w_up[i], rw_a0[i], rw_a_up[i],
                                  rw_g_up[i], rw_k_k[i], rw_k_a[i], rw_r_k[i], rw_ln_w[i], rw_ln_b[i],
                                  need_ctx)
        o_mb, oc_mb = mamba2_mixer(u_mb, uc_mb, mb_conv_w[i], mb_conv_b[i], mb_dt_bias[i], mb_A_log[i],
                                   mb_D[i], mb_norm_w[i], need_ctx)
        o_da, oc_da = diff_attn_mixer(u_da, uc_da, da_lambda[i], da_subln[i], lam_init, need_ctx)
        mix = jnp.concatenate([o_rw, o_mb, o_da], axis=-1) @ w_out[i]
        x = x + gm * rmsnorm(mix, norm_mix_post[i])
        if need_ctx:
            mix_c = jnp.concatenate([oc_rw, oc_mb, oc_da], axis=-1) @ w_out[i]
            xc = xc + cgm * rmsnorm(mix_c, norm_mix_post[i])

        if i % 2 == 0:
            j = i // 2
            ffn = lambda t: swiglu(t, ffn_w_gate[j], ffn_w_up[j], ffn_w_down[j])
        else:
            j = i // 2
            ffn = lambda t: moe_swiglu(t, moe_router[j], moe_w_gate[j], moe_w_up[j], moe_w_down[j])
        h = rmsnorm(x, norm_ffn_pre[i]) * (1 + scf) + sf
        x = x + gf * rmsnorm(ffn(h), norm_ffn_post[i])
        if need_ctx:
            hc = rmsnorm(xc, norm_ffn_pre[i]) * (1 + cscf) + csf
            xc = xc + cgf * rmsnorm(ffn(hc), norm_ffn_post[i])
    return x
```

```cpp
#include <hip/hip_runtime.h>
#include <cstdio>
#include <cstdint>

#ifndef MK_PER_PHASE
#define MK_PER_PHASE 1
#endif

#define GAS __attribute__((address_space(1)))
#define LAS __attribute__((address_space(3)))
typedef GAS unsigned gu32;
typedef GAS unsigned long long gu64;

__device__ __forceinline__ int opq(int x) { asm volatile("" : "+v"(x)); return x; }
template <class T> __device__ __forceinline__ T* opqp(T* p) { asm volatile("" : "+s"(p)); return p; }
__device__ __forceinline__ int opqs(int x) { asm volatile("" : "+s"(x)); return x; }

__device__ __forceinline__ int lane_v() { int l; asm volatile("v_mbcnt_lo_u32_b32 %0, -1, 0\n\tv_mbcnt_hi_u32_b32 %0, -1, %0" : "=v"(l)); return l; }

namespace pg8 {
#define PG8_LAS __attribute__((address_space(3)))
typedef unsigned short bf16_t;
typedef short bf16x8 __attribute__((ext_vector_type(8)));
typedef float f32x4 __attribute__((ext_vector_type(4)));
typedef unsigned u32x4 __attribute__((ext_vector_type(4)));
constexpr int BM = 256, BK = 64, HALF = 128, HTB = HALF * BK * 2  , STAGE_BYTES = 8 * HTB, NXCD = 8, WGM = 8;

__host__ __device__ __forceinline__ int lds_byte(int r, int c) { const int st = (r >> 4) * 2 + (c >> 5), rr = r & 15, cc = c & 31, ob = rr * 64 + cc * 2; return st * 1024 + (ob ^ (((ob >> 9) & 1) << 5)); }
__host__ __device__ __forceinline__ void stage_rc(int b, int& R, int& C) { const int st = b / 1024, sb = b % 1024, swz = sb ^ (((sb >> 9) & 1) << 5); R = (st >> 1) * 16 + swz / 64; C = (st & 1) * 32 + (swz % 64) / 2; }
__host__ __device__ __forceinline__ int perm32(int rho) { const int n = rho >> 4, i = rho & 15; return 8 * (i >> 2) + 4 * n + (i & 3); }

struct Unit { int pm, pn; };
struct Gemm { const bf16_t* A; const bf16_t* Bt; int M, N, K; };

struct StaticOrder {
    int nM, nN, nwg, G, c;
    __host__ __device__ void init(int M, int N, int G_, int c_) { nM = M / BM; nN = N / BM; nwg = nM * nN; G = G_; c = c_; }
    __host__ __device__ bool next(int i, Unit& u) const {
        const long L = (long)i * G + c; if (L >= nwg) return false;
        int wgid = (int)L; { const int q = nwg / NXCD, r = nwg % NXCD, xcd = wgid % NXCD, off = wgid / NXCD; wgid = (xcd < r ? xcd * (q + 1) : r * (q + 1) + (xcd - r) * q) + off; }
        const int nig = WGM * nN, gid = wgid / nig, fm = gid * WGM, gsz = (nM - fm) < WGM ? (nM - fm) : WGM;
        u.pm = fm + ((wgid % nig) % gsz); u.pn = (wgid % nig) / gsz; return true;
    }
    __device__ __forceinline__ void a_ready(const Unit&) const {}
    __device__ __forceinline__ void done(const Unit&) const {}
};
__device__ __forceinline__ unsigned cvt_pk_bf16(float lo, float hi) { unsigned r; asm volatile("v_cvt_pk_bf16_f32 %0, %1, %2" : "=v"(r) : "v"(lo), "v"(hi)); return r; }
struct EpiF32 {
    static constexpr bool PERM = false, AFTER_DRAIN = false;
    float* C; int ldc; const float* bias;
    __device__ __forceinline__ void operator()(const f32x4 (&acc)[2][2][4][2], const Unit& u, int wr, int wc, int fr, int fq) const {
        const int row0 = u.pm * BM + wr * 64 + fr, col0 = u.pn * BM + wc * 32 + 4 * fq;
        f32x4 bv[2][2];
#pragma unroll
        for (int bj = 0; bj < 2; ++bj)
#pragma unroll
            for (int n = 0; n < 2; ++n) bv[bj][n] = bias ? *(const f32x4*)(bias + col0 + bj * HALF + n * 16) : (f32x4){0.f, 0.f, 0.f, 0.f};
#pragma unroll
        for (int ai = 0; ai < 2; ++ai)
#pragma unroll
            for (int m = 0; m < 4; ++m) { float* rowp = C + (size_t)(row0 + ai * HALF + m * 16) * ldc + col0;
#pragma unroll
                for (int bj = 0; bj < 2; ++bj)
#pragma unroll
                    for (int n = 0; n < 2; ++n) *(f32x4*)(rowp + bj * HALF + n * 16) = acc[ai][bj][m][n] + bv[bj][n]; }
    }
};

__device__ __forceinline__ float fsilu(float x) { return x * __builtin_amdgcn_rcpf(1.0f + __expf(-x)); }
__device__ __forceinline__ float fsigm(float x) { return __builtin_amdgcn_rcpf(1.0f + __expf(-x)); }

struct MoeOrder {
    const PG8_LAS int* tab; int nN, G, c;
    __device__ __forceinline__ bool next(int i, Unit& u) const {
        long L = (long)i * G + c;
#pragma unroll
        for (int e = 0; e < 8; ++e) { const int te = tab[e]; const long n = (long)te * nN; if (L < n) { u.pn = e * nN + (int)(L / te); u.pm = tab[8 + e] + (int)(L % te); return true; } L -= n; }
        return false;
    }
    __device__ __forceinline__ void a_ready(const Unit&) const {}
    __device__ __forceinline__ void done(const Unit&) const {}
};

struct EpiBf16P {
    static constexpr bool PERM = true, AFTER_DRAIN = false;
    bf16_t* O; int ldc; int nN;
    __device__ __forceinline__ void operator()(const f32x4 (&acc)[2][2][4][2], const Unit& u, int wr, int wc, int fr, int fq) const {
        const int row0 = u.pm * BM + wr * 64 + fr; const int pnr = nN ? (u.pn % nN) : u.pn; const int col0 = pnr * BM + wc * 32 + 8 * fq;
#pragma unroll
        for (int ai = 0; ai < 2; ++ai)
#pragma unroll
            for (int m = 0; m < 4; ++m) { bf16_t* rowp = O + (size_t)(row0 + ai * HALF + m * 16) * ldc + col0;
#pragma unroll
                for (int bj = 0; bj < 2; ++bj) { const f32x4 v0 = acc[ai][bj][m][0], v1 = acc[ai][bj][m][1];
                    u32x4 w; w.x = cvt_pk_bf16(v0[0], v0[1]); w.y = cvt_pk_bf16(v0[2], v0[3]); w.z = cvt_pk_bf16(v1[0], v1[1]); w.w = cvt_pk_bf16(v1[2], v1[3]);
                    *(u32x4*)(rowp + bj * HALF) = w; } }
    }
};

struct EpiSwiGLU {
    static constexpr bool PERM = true, AFTER_DRAIN = false;
    bf16_t* O; int ldc; int nN;
    __device__ __forceinline__ void operator()(const f32x4 (&acc)[2][2][4][2], const Unit& u, int wr, int wc, int fr, int fq) const {
        const int row0 = u.pm * BM + wr * 64 + fr; const int pnr = nN ? (u.pn % nN) : u.pn; const int col0 = pnr * HALF + wc * 32 + 8 * fq;
#pragma unroll
        for (int ai = 0; ai < 2; ++ai)
#pragma unroll
            for (int m = 0; m < 4; ++m) { bf16_t* rowp = O + (size_t)(row0 + ai * HALF + m * 16) * ldc + col0;
                const f32x4 g0 = acc[ai][0][m][0], g1 = acc[ai][0][m][1], u0 = acc[ai][1][m][0], u1 = acc[ai][1][m][1];
                f32x4 v0, v1;
#pragma unroll
                for (int j = 0; j < 4; ++j) { v0[j] = fsilu(g0[j]) * u0[j]; v1[j] = fsilu(g1[j]) * u1[j]; }
                u32x4 w; w.x = cvt_pk_bf16(v0[0], v0[1]); w.y = cvt_pk_bf16(v0[2], v0[3]); w.z = cvt_pk_bf16(v1[0], v1[1]); w.w = cvt_pk_bf16(v1[2], v1[3]);
                *(u32x4*)rowp = w; }
    }
};


template <class Epi, class Sched, bool STAMP = false>
__device__ __forceinline__ void gemm_phase(PG8_LAS unsigned char* lds, const Gemm g, const Sched& S, const Epi& E, unsigned long long* stamps, const int tid_in) {
    const int tid = opq(tid_in), wid = __builtin_amdgcn_readfirstlane(tid >> 6), lane = tid & 63, wr = wid >> 2, wc = wid & 3, fr = lane & 15, fq = lane >> 4;
    const int K = g.K, nt = K / BK;
    int ts_lo = 0, ts_hi = 0, nts = 0; const unsigned long long rt_entry = STAMP ? (unsigned long long)wall_clock64() : 0ull;
#define PG8_STAMP() do { if (STAMP && wid == 0 && nts < 64) { const unsigned long long _c = (unsigned long long)clock64(); \
        ts_lo = (lane == nts) ? (int)(unsigned)_c : ts_lo; ts_hi = (lane == nts) ? (int)(unsigned)(_c >> 32) : ts_hi; ++nts; } } while (0)
    PG8_STAMP();
    unsigned voffA[2], voffB[2];
#pragma unroll
    for (int i = 0; i < 2; ++i) { int R, C; stage_rc(tid * 16 + i * 8192, R, C); const int Rb = Epi::PERM ? ((R & ~31) + perm32(R & 31)) : R;
        voffA[i] = (unsigned)(R * K + C) * 2u; voffB[i] = (unsigned)(Rb * K + C) * 2u; }
    const size_t kstep = (size_t)(BK * 2);
    const size_t hstep = (size_t)HALF * K * 2;
    const size_t tstep = 2 * hstep;
    const unsigned ldsw = (unsigned)wid * 1024u;
    const int aoff = lds_byte(wr * 64 + fr, fq * 8), boff = lds_byte(wc * 32 + fr, fq * 8);
#define PG8_SA(b, h) (((b) * 2 + (h)) * HTB)
#define PG8_SB(b, h) ((4 + (b) * 2 + (h)) * HTB)
#define PG8_STAGE(bufoff, gbase, voff) do { _Pragma("unroll") for (int _i = 0; _i < 2; ++_i) \
        __builtin_amdgcn_global_load_lds((const unsigned*)((const char*)(gbase) + (voff)[_i]), (PG8_LAS unsigned*)(lds + (bufoff) + ldsw + _i * 8192), 16, 0, 0); } while (0)
#define PG8_LDA(dst, b, h) do { _Pragma("unroll") for (int m = 0; m < 4; ++m) _Pragma("unroll") for (int k = 0; k < 2; ++k) dst[m][k] = *(const PG8_LAS bf16x8*)(lds + PG8_SA(b, h) + aoff + m * 2048 + k * 1024); } while (0)
#define PG8_LDB(dst, b, h) do { _Pragma("unroll") for (int n = 0; n < 2; ++n) _Pragma("unroll") for (int k = 0; k < 2; ++k) dst[n][k] = *(const PG8_LAS bf16x8*)(lds + PG8_SB(b, h) + boff + n * 2048 + k * 1024); } while (0)
#define PG8_MMA(ai, bj, At, Bt) do { __builtin_amdgcn_s_setprio(1); _Pragma("unroll") for (int m = 0; m < 4; ++m) _Pragma("unroll") for (int n = 0; n < 2; ++n) _Pragma("unroll") for (int k = 0; k < 2; ++k) \
        acc[ai][bj][m][n] = __builtin_amdgcn_mfma_f32_16x16x32_bf16(Bt[n][k], At[m][k], acc[ai][bj][m][n], 0, 0, 0); __builtin_amdgcn_s_setprio(0); } while (0)
#define PG8_WAIT_V(n) asm volatile("s_waitcnt vmcnt(" #n ")" ::: "memory")
#define PG8_WAIT_L(n) asm volatile("s_waitcnt lgkmcnt(" #n ")" ::: "memory")
#define PG8_BAR __builtin_amdgcn_s_barrier()
#define PG8_SCHED __builtin_amdgcn_sched_barrier(0)
    Unit cur, nxt; int ui = 0;
    if (!S.next(0, cur)) return;
    f32x4 acc[2][2][4][2];
#pragma unroll
    for (int a = 0; a < 2; ++a)
#pragma unroll
        for (int b = 0; b < 2; ++b)
#pragma unroll
            for (int m = 0; m < 4; ++m)
#pragma unroll
                for (int n = 0; n < 2; ++n) acc[a][b][m][n] = (f32x4){0.f, 0.f, 0.f, 0.f};
    bf16x8 At[4][2], B0[2][2], B1[2][2];
    const char* cA = (const char*)g.A + (size_t)cur.pm * tstep; const char* cB = (const char*)g.Bt + (size_t)cur.pn * tstep;
    S.a_ready(cur);
    PG8_STAGE(PG8_SB(0, 0), cB, voffB); PG8_STAGE(PG8_SA(0, 0), cA, voffA); PG8_STAGE(PG8_SB(0, 1), cB + hstep, voffB); PG8_STAGE(PG8_SA(0, 1), cA + hstep, voffA);
    if (wr == 1) PG8_BAR;
    PG8_WAIT_V(4); PG8_BAR;
    PG8_STAGE(PG8_SB(1, 0), cB + kstep, voffB); PG8_STAGE(PG8_SA(1, 0), cA + kstep, voffA); PG8_STAGE(PG8_SB(1, 1), cB + hstep + kstep, voffB);
    PG8_WAIT_V(6); PG8_BAR;
    PG8_STAMP();
    for (;;) {
        const bool has_next = S.next(ui + 1, nxt);
        const char* nA = has_next ? (const char*)g.A + (size_t)nxt.pm * tstep : cA; const char* nB = has_next ? (const char*)g.Bt + (size_t)nxt.pn * tstep : cB;
        for (int t = 0; t < nt; t += 2) {
            const bool last = (t == nt - 2);
            const char* a1 = cA + (size_t)(t + 1) * kstep;
            const char* a2 = last ? nA : cA + (size_t)(t + 2) * kstep; const char* b2 = last ? nB : cB + (size_t)(t + 2) * kstep;
            const char* a3 = a2 + kstep; const char* b3 = b2 + kstep;
            if (last && has_next) S.a_ready(nxt);
            PG8_LDB(B0, 0, 0); PG8_SCHED; PG8_LDA(At, 0, 0); PG8_STAGE(PG8_SA(1, 1), a1 + hstep, voffA);
            PG8_WAIT_L(8); PG8_BAR; PG8_WAIT_L(0); PG8_MMA(0, 0, At, B0); PG8_BAR; PG8_SCHED;
            PG8_LDB(B1, 0, 1); PG8_STAGE(PG8_SB(0, 0), b2, voffB);
            PG8_BAR; PG8_WAIT_L(0); PG8_MMA(0, 1, At, B1); PG8_BAR;
            PG8_LDA(At, 0, 1); PG8_STAGE(PG8_SA(0, 0), a2, voffA);
            PG8_BAR; PG8_WAIT_L(0); PG8_MMA(1, 0, At, B0); PG8_BAR; PG8_SCHED;
            PG8_STAGE(PG8_SB(0, 1), b2 + hstep, voffB);
            PG8_WAIT_V(6); PG8_BAR; PG8_MMA(1, 1, At, B1); PG8_BAR;
            PG8_LDB(B0, 1, 0); PG8_SCHED; PG8_LDA(At, 1, 0); PG8_STAGE(PG8_SA(0, 1), a2 + hstep, voffA);
            PG8_WAIT_L(8); PG8_BAR; PG8_WAIT_L(0); PG8_MMA(0, 0, At, B0); PG8_BAR; PG8_SCHED;
            PG8_LDB(B1, 1, 1); PG8_STAGE(PG8_SB(1, 0), b3, voffB);
            PG8_BAR; PG8_WAIT_L(0); PG8_MMA(0, 1, At, B1); PG8_BAR;
            PG8_LDA(At, 1, 1); PG8_STAGE(PG8_SA(1, 0), a3, voffA);
            PG8_BAR; PG8_WAIT_L(0); PG8_MMA(1, 0, At, B0); PG8_BAR; PG8_SCHED;
            PG8_STAGE(PG8_SB(1, 1), b3 + hstep, voffB);
            PG8_WAIT_V(6); PG8_BAR; PG8_MMA(1, 1, At, B1); PG8_BAR;
        }
        PG8_STAMP();
        if constexpr (!Epi::AFTER_DRAIN) { E(acc, cur, wr, wc, fr, fq); S.done(cur); }
        PG8_STAMP();
        if (!has_next) break;
#pragma unroll
        for (int a = 0; a < 2; ++a)
#pragma unroll
            for (int b = 0; b < 2; ++b)
#pragma unroll
                for (int m = 0; m < 4; ++m)
#pragma unroll
                    for (int n = 0; n < 2; ++n) acc[a][b][m][n] = (f32x4){0.f, 0.f, 0.f, 0.f};
        cur = nxt; cA = nA; cB = nB; ++ui;
    }
    PG8_WAIT_V(0);
    if (wr == 0) PG8_BAR;
    PG8_BAR;
    if constexpr (Epi::AFTER_DRAIN) { E.fused(acc, cur, wr, wc, fr, fq, lds, wid, lane); S.done(cur); }
    PG8_STAMP();
    if (STAMP && wid == 0) { stamps[lane] = lane < nts ? (((unsigned long long)(unsigned)ts_hi << 32) | (unsigned)ts_lo) : 0ull;
        if (lane == 62) stamps[62] = rt_entry; if (lane == 63) stamps[63] = (unsigned long long)wall_clock64(); }
#undef PG8_STAMP
#undef PG8_SA
#undef PG8_SB
#undef PG8_STAGE
#undef PG8_LDA
#undef PG8_LDB
#undef PG8_MMA
#undef PG8_WAIT_V
#undef PG8_WAIT_L
#undef PG8_BAR
#undef PG8_SCHED
}
}
#define RLX_AGENT __ATOMIC_RELAXED, __HIP_MEMORY_SCOPE_AGENT
#define XB_TMO      128
#define XB_XCNT(j)  (256  + 64 * (j))
#define XB_XSUB(j)  (1280 + 64 * (j))
#define XB_XGEN(j)  (2304 + 64 * (j))
#define XB_TOP      3328
#define XB_TOPGEN   3392
#define XCD_BAR_WORDS 3456
#define XB_SPIN_CAP (1u << 18)

__device__ __forceinline__ unsigned xb_ld(unsigned* p)              { return __hip_atomic_load(p, __ATOMIC_RELAXED, __HIP_MEMORY_SCOPE_AGENT); }
__device__ __forceinline__ unsigned xb_add(unsigned* p, unsigned v) { return __hip_atomic_fetch_add(p, v, __ATOMIC_RELAXED, __HIP_MEMORY_SCOPE_AGENT); }
__device__ __forceinline__ unsigned xb_xcc_id() { return (unsigned)__builtin_amdgcn_s_getreg((3 << 11) | 20) & 0xFu; }
#define XB_SPIN(cond, bar) do { unsigned _sp = 0; while (cond) { __builtin_amdgcn_s_sleep(1); \
    if ((++_sp & 255u) == 0u) { if (xb_ld(&(bar)[XB_TMO])) break; if (_sp > XB_SPIN_CAP) { atomicAdd(&(bar)[XB_TMO], 1u); break; } } } } while (0)

struct XcdBarrier {
    unsigned* bar; unsigned x; int wv;
    volatile LAS unsigned* st;
};

__device__ __forceinline__ XcdBarrier xcd_barrier_post(unsigned* bar, volatile LAS unsigned* st) {
    XcdBarrier b; b.bar = bar; b.x = xb_xcc_id(); b.st = st; b.wv = __builtin_amdgcn_readfirstlane((int)threadIdx.x >> 6);
    if (threadIdx.x == 0) (void)xb_add(&bar[XB_XCNT(b.x)], 1u);
    return b;
}
__device__ __forceinline__ void xcd_barrier_complete(unsigned* bar, unsigned x, unsigned& nloc, unsigned& nx) {
    const unsigned G = gridDim.x * gridDim.y * gridDim.z;
    unsigned sum, cnt, mine, sp = 0u;
    for (;;) {
        sum = 0u; cnt = 0u; mine = 0u;
#pragma unroll
        for (unsigned j = 0; j < 16; ++j) { const unsigned c = xb_ld(&bar[XB_XCNT(j)]); sum += c; cnt += (c > 0u) ? 1u : 0u; mine = (j == x) ? c : mine; }
        if (sum == G) break;
        __builtin_amdgcn_s_sleep(1);
        if ((++sp & 255u) == 0u) { if (xb_ld(&bar[XB_TMO])) break; if (sp > XB_SPIN_CAP) { atomicAdd(&bar[XB_TMO], 1u); break; } }
    }
    nloc = mine > 0u ? mine : 1u; nx = cnt > 0u ? cnt : 1u;
}

__device__ __forceinline__ void xcd_barrier(const XcdBarrier& b) {
    asm volatile("s_waitcnt vmcnt(0)" ::: "memory");
    __syncthreads();
    if (((b.wv << 6) | lane_v()) == 0) {
        unsigned* bar = b.bar;
        __builtin_amdgcn_s_waitcnt(0);
        unsigned nloc = b.st[0], nx = b.st[1];
        if (nloc == 0u) { xcd_barrier_complete(bar, b.x, nloc, nx); b.st[0] = nloc; b.st[1] = nx; }
        const unsigned old = xb_add(&bar[XB_XSUB(b.x)], 1u);
        const unsigned gen = old / nloc;
        if (old + 1u == (gen + 1u) * nloc) {
            __builtin_amdgcn_fence(__ATOMIC_RELEASE, "agent");
            asm volatile("s_waitcnt vmcnt(0)" ::: "memory");
            const unsigned og = xb_add(&bar[XB_TOP], 1u);
            const unsigned tg = og / nx;
            if (og + 1u == (tg + 1u) * nx) xb_add(&bar[XB_TOPGEN], 1u);
            else XB_SPIN(xb_ld(&bar[XB_TOPGEN]) == tg, bar);
            __builtin_amdgcn_fence(__ATOMIC_ACQUIRE, "agent");
            xb_add(&bar[XB_XGEN(b.x)], 1u);
            asm volatile("s_waitcnt vmcnt(0)" ::: "memory");
        } else {
            XB_SPIN(xb_ld(&bar[XB_XGEN(b.x)]) == gen, bar);
            __builtin_amdgcn_fence(__ATOMIC_ACQUIRE, "agent");
            asm volatile("s_waitcnt vmcnt(0)" ::: "memory");
        }
    }
    __syncthreads();
}

typedef unsigned short bf16;
using pg8::bf16x8; using pg8::f32x4; using pg8::u32x4;
typedef unsigned u32x2 __attribute__((ext_vector_type(2)));
constexpr int NT = 512, NW = 8;
constexpr int DM = 2048, NB = 8, SEQ = 2048, CTXL = 256;
constexpr int MLAT = NB * SEQ, MCTX = NB * CTXL, MTOT = MLAT + MCTX;
constexpr int NIN = 5920, NINP = 6144;
constexpr int C_RW_R = 0, C_RW_K = 512, C_RW_V = 1024, C_RW_XW = 1536;
constexpr int C_MB_Z = 1792, C_MB_XBC = 2816, C_MB_DT = 4352;
constexpr int C_DA_Q = 4384, C_DA_V = 5408;
constexpr int FF = 5632, FE = 7168, NE = 8;
constexpr int MOE_ROWS = 34816;
constexpr int LDS_STAGE = 131072, LDS_MISC = 1024, LDS_BYTES = LDS_STAGE + LDS_MISC;

constexpr size_t MiB = 1048576;
constexpr size_t WS_CTL   = 0;
constexpr size_t CTL_BYTES = 65536;
constexpr size_t CW_BAR = 0, CW_CNT = 4096  ;
constexpr size_t WS_ADA   = 1 * MiB;
constexpr size_t WS_ROPE  = 2 * MiB;
constexpr size_t WS_TOK   = 3 * MiB;
constexpr size_t WS_WIN   = 4 * MiB;
constexpr size_t WS_WOUT  = WS_WIN  + 48 * MiB;
constexpr size_t WS_WSM   = WS_WOUT + 16 * MiB;
constexpr size_t WS_WGU   = WS_WSM  + 2 * MiB;
constexpr size_t WS_WD    = WS_WGU  + 44 * MiB;
constexpr size_t WS_MGU   = WS_WD   + 22 * MiB;
constexpr size_t WS_MD    = WS_MGU  + 448 * MiB;
constexpr size_t WS_XC    = WS_MD   + 224 * MiB;
constexpr size_t WS_HA    = WS_XC   + 16 * MiB;
constexpr size_t WS_U     = WS_HA   + 72 * MiB;
constexpr size_t WS_MIX   = WS_U    + 216 * MiB;
constexpr size_t WS_BIG   = WS_MIX  + 144 * MiB;
constexpr size_t WS_END   = WS_BIG  + 476 * MiB;
constexpr size_t WS_ASM   = WS_BIG;
constexpr size_t WS_XBC   = WS_ASM  + 9 * MiB;
constexpr size_t WS_DT    = WS_XBC  + 54 * MiB;
constexpr size_t WS_QK    = WS_DT   + 5 * MiB;
constexpr size_t WS_RW5   = WS_QK   + 36 * MiB;
constexpr size_t WS_YR    = WS_RW5  + 90 * MiB;
constexpr size_t WS_YM    = WS_YR   + 72 * MiB;
static_assert(WS_YM + 144 * MiB <= WS_END, "mixer intermediates overflow BIG");
static_assert((size_t)MOE_ROWS * FE * 2 <= 476 * MiB && (size_t)MOE_ROWS * DM * 2 <= 144 * MiB, "moe buffers");

struct Args { const float* in[38]; float* out; unsigned char* ws; int ph_lo, ph_hi; };
struct Ctx { unsigned char* ws; int wv; };

constexpr int LDS_PTRS = LDS_STAGE + 128;
__device__ __forceinline__ const float* ldin(int k) {
    extern __shared__ __attribute__((aligned(16))) unsigned char lds_dyn[];
    const int base = opqs((int)(unsigned)(unsigned long long)(LAS unsigned char*)lds_dyn);
    const LAS unsigned* p = (const LAS unsigned*)(unsigned long long)(unsigned)(base + LDS_PTRS + 8 * k);
    const unsigned lo = __builtin_amdgcn_readfirstlane(p[0]), hi = __builtin_amdgcn_readfirstlane(p[1]);
    return (const float*)(((unsigned long long)hi << 32) | (unsigned long long)lo);
}
__device__ __forceinline__ float bf2f(unsigned short b) { return __uint_as_float(((unsigned)b) << 16); }
__device__ __forceinline__ unsigned f2bf(float f) { unsigned u = __float_as_uint(f); return (u + 0x7fffu + ((u >> 16) & 1u)) >> 16; }
__device__ __forceinline__ unsigned pk2(float lo, float hi) { return f2bf(lo) | (f2bf(hi) << 16); }
__device__ __forceinline__ void unpack8(const uint4 w, float (&f)[8]) {
    f[0] = __uint_as_float(w.x << 16); f[1] = __uint_as_float(w.x & 0xffff0000u); f[2] = __uint_as_float(w.y << 16); f[3] = __uint_as_float(w.y & 0xffff0000u);
    f[4] = __uint_as_float(w.z << 16); f[5] = __uint_as_float(w.z & 0xffff0000u); f[6] = __uint_as_float(w.w << 16); f[7] = __uint_as_float(w.w & 0xffff0000u); }
__device__ __forceinline__ uint4 pack8(const float (&f)[8]) { uint4 w; w.x = pk2(f[0], f[1]); w.y = pk2(f[2], f[3]); w.z = pk2(f[4], f[5]); w.w = pk2(f[6], f[7]); return w; }
__device__ __forceinline__ void unpack4(const uint2 w, float (&f)[4]) {
    f[0] = __uint_as_float(w.x << 16); f[1] = __uint_as_float(w.x & 0xffff0000u); f[2] = __uint_as_float(w.y << 16); f[3] = __uint_as_float(w.y & 0xffff0000u); }
template <int CTRL> __device__ __forceinline__ float dppf(float v) { return __int_as_float(__builtin_amdgcn_update_dpp(0, __float_as_int(v), CTRL, 0xf, 0xf, false)); }
__device__ __forceinline__ float red8(float v)  { v += dppf<0xB1>(v); v += dppf<0x4E>(v); v += dppf<0x141>(v); return v; }
__device__ __forceinline__ float red16(float v) { v += dppf<0xB1>(v); v += dppf<0x4E>(v); v += dppf<0x141>(v); v += dppf<0x140>(v); return v; }
__device__ __forceinline__ float swz16(float v) { return __int_as_float(__builtin_amdgcn_ds_swizzle(__float_as_int(v), 0x401F)); }
__device__ __forceinline__ float red32(float v) { v = red16(v); v += swz16(v); return v; }
__device__ __forceinline__ float wsum(float v) { v = red32(v); return __int_as_float(__builtin_amdgcn_readlane(__float_as_int(v), 0)) + __int_as_float(__builtin_amdgcn_readlane(__float_as_int(v), 32)); }
__device__ __forceinline__ float shx32(float v, int lane) { return __int_as_float(__builtin_amdgcn_ds_bpermute((lane ^ 32) << 2, __float_as_int(v))); }
__device__ __forceinline__ float fsilu(float x) { return pg8::fsilu(x); }
__device__ __forceinline__ float fsigm(float x) { return pg8::fsigm(x); }
__device__ __forceinline__ float softplusf(float x) { return fmaxf(x, 0.f) + log1pf(__expf(-fabsf(x))); }


__device__ __forceinline__ void cvt_tile(const float* __restrict__ src, int ld, int ncols_valid, bf16* __restrict__ dst, int K, int k0, int n0, int mode, LAS float* tile, const int tid) {
    const int tx = tid & 63, ty = tid >> 6;
    const int n = n0 + tx;
#pragma unroll
    for (int r = 0; r < 8; ++r) { const int k = ty * 8 + r; tile[k * 65 + tx] = (n < ncols_valid) ? src[(size_t)(k0 + k) * ld + n] : 0.f; }
    __syncthreads();
    const int kp = tid & 31, nr = tid >> 5;
#pragma unroll
    for (int j = 0; j < 4; ++j) { const int nl = nr + 16 * j, nn = n0 + nl;
        const int drow = mode == 0 ? nn : ((nn >> 7) * 256 + (nn & 127) + (mode == 2 ? 128 : 0));
        *(unsigned*)(dst + (size_t)drow * K + k0 + 2 * kp) = pk2(tile[(2 * kp) * 65 + nl], tile[(2 * kp + 1) * 65 + nl]); }
    __syncthreads();
}
__device__ __forceinline__ void cvt_job(const float* src, int ld, int ncols_valid, int ncols_total, bf16* dst, int K, int mode, LAS float* tile, int bid, int G, const int tid) {
    const int ntn = ncols_total >> 6, ntk = K >> 6, nt = ntn * ntk;
    for (int t = bid; t < nt; t += G) { const int tn = t % ntn, tk = t / ntn; cvt_tile(src, ld, ncols_valid, dst, K, tk * 64, tn * 64, mode, tile, tid); }
}

__device__ __forceinline__ void p0_prologue(const Ctx& a, LAS unsigned char* lds, int bid, int G) {
    unsigned char* ws = opqp(a.ws); const int tid = ((a.wv << 6) | lane_v());
    LAS float* tile = (LAS float*)lds;
    for (int l = 0; l < 2; ++l) {
        cvt_job(ldin(10) + (size_t)l * DM * NIN, NIN, NIN, NINP, (bf16*)(ws + WS_WIN) + (size_t)l * NINP * DM, DM, 0, tile, bid, G, tid);
        cvt_job(ldin(11) + (size_t)l * DM * DM, DM, DM, DM, (bf16*)(ws + WS_WOUT) + (size_t)l * DM * DM, DM, 0, tile, bid, G, tid);
    }
    cvt_job(ldin(31), FF, FF, FF, (bf16*)(ws + WS_WGU), DM, 1, tile, bid, G, tid);
    cvt_job(ldin(32), FF, FF, FF, (bf16*)(ws + WS_WGU), DM, 2, tile, bid, G, tid);
    cvt_job(ldin(33), DM, DM, DM, (bf16*)(ws + WS_WD), FF, 0, tile, bid, G, tid);
    for (int e = 0; e < NE; ++e) {
        cvt_job(ldin(35) + (size_t)e * DM * FE, FE, FE, FE, (bf16*)(ws + WS_MGU) + (size_t)e * 2 * FE * DM, DM, 1, tile, bid, G, tid);
        cvt_job(ldin(36) + (size_t)e * DM * FE, FE, FE, FE, (bf16*)(ws + WS_MGU) + (size_t)e * 2 * FE * DM, DM, 2, tile, bid, G, tid);
        cvt_job(ldin(37) + (size_t)e * FE * DM, DM, DM, DM, (bf16*)(ws + WS_MD) + (size_t)e * DM * FE, FE, 0, tile, bid, G, tid);
    }
    {
        bf16* wsm = (bf16*)(ws + WS_WSM);
        for (size_t i = (size_t)bid * NT + tid; i < (size_t)2 * 2048 * 256; i += (size_t)G * NT) {
            const int l = (int)(i >> 19), n = (int)((i >> 8) & 2047), k = (int)(i & 255); float v = 0.f;
            if (n < 1024) { if (k < 64) v = ldin(14)[(((size_t)l * 2 + (n >> 9)) * 64 + k) * 512 + (n & 511)]; }
            else if (n < 1536) { if (k >= 64 && k < 128) v = ldin(16)[((size_t)l * 64 + (k - 64)) * 512 + (n - 1024)]; }
            else { if (k >= 128) v = ldin(17)[((size_t)l * 128 + (k - 128)) * 512 + (n - 1536)]; }
            wsm[i] = (bf16)f2bf(v);
        }
    }
    {
        float* rope = (float*)(ws + WS_ROPE);
        for (int i = bid * NT + tid; i < SEQ * 32; i += G * NT) {
            const int t = i >> 5, j = i & 31, half = j >> 4, f = j & 15;
            const float pos = (float)(half ? (t & 63) : (t >> 6));
            const float inv = powf(10000.0f, -(float)f / 16.0f);
            const float ang = pos * inv;
            double ad = (double)ang; const double twopi = 6.283185307179586476925; ad -= twopi * floor(ad / twopi);
            const float ar = (float)ad;
            rope[t * 64 + half * 32 + f] = cosf(ar); rope[t * 64 + half * 32 + 16 + f] = sinf(ar);
        }
    }
    {
        LAS float* sil = (LAS float*)lds;
        LAS float* red = sil + 9 * 2048;
        __syncthreads();
        for (int i = tid; i < 9 * 2048; i += NT) { const float v = i < 8 * 2048 ? ldin(1)[i] : ldin(3)[i - 8 * 2048]; sil[i] = v / (1.0f + __expf(-v)); }
        __syncthreads();
        float* ada = (float*)(ws + WS_ADA);
        for (int it = bid; it < 2 * 96; it += G) {
            const int l = it / 96, col0 = (it % 96) * 128; const int cn = tid & 127, kg = tid >> 7;
            const float* w = ldin(4) + (size_t)l * DM * 12288 + col0 + cn;
            float acc[9];
#pragma unroll
            for (int v = 0; v < 9; ++v) acc[v] = 0.f;
            for (int k = kg * 512; k < kg * 512 + 512; ++k) { const float wv = w[(size_t)k * 12288];
#pragma unroll
                for (int v = 0; v < 9; ++v) acc[v] += sil[v * 2048 + k] * wv; }
#pragma unroll
            for (int v = 0; v < 9; ++v) red[(kg * 9 + v) * 128 + cn] = acc[v];
            __syncthreads();
            if (kg == 0) {
                const float bb = ldin(5)[(size_t)l * 12288 + col0 + cn];
#pragma unroll
                for (int v = 0; v < 9; ++v) ada[((size_t)l * 9 + v) * 12288 + col0 + cn] = red[v * 128 + cn] + red[(9 + v) * 128 + cn] + red[(18 + v) * 128 + cn] + red[(27 + v) * 128 + cn] + bb;
            }
            __syncthreads();
        }
    }
}


__device__ __forceinline__ void ld_row(const float* p, int lane, float (&x)[32]) {
#pragma unroll
    for (int i = 0; i < 8; ++i) { const float4 v = *(const float4*)(p + i * 256 + lane * 4); x[i * 4] = v.x; x[i * 4 + 1] = v.y; x[i * 4 + 2] = v.z; x[i * 4 + 3] = v.w; }
}
__device__ __forceinline__ void st_row(float* p, int lane, const float (&x)[32]) {
#pragma unroll
    for (int i = 0; i < 8; ++i) *(float4*)(p + i * 256 + lane * 4) = make_float4(x[i * 4], x[i * 4 + 1], x[i * 4 + 2], x[i * 4 + 3]);
}
__device__ __forceinline__ float sumsq(const float (&x)[32]) { float s = 0.f;
#pragma unroll
    for (int i = 0; i < 32; ++i) s += x[i] * x[i];
    return wsum(s); }

template <int TMODE, int HMODE>
__device__ __forceinline__ void thin_phase(const Ctx& a, LAS unsigned char* lds, int bid, int G, int M,
                           const float* xlat, const float* xctx, float* olat, float* octx,
                           const float* T, const float* postw, int lg, int kg,
                           const float* prew, int lm, int ksc, int ksh) {
    unsigned char* ws = opqp(a.ws); const int tid = ((a.wv << 6) | lane_v()), lane = tid & 63, wid = tid >> 6;
    const float* ada = (const float*)(ws + WS_ADA);
    bf16* HA = (bf16*)(ws + WS_HA);
    LAS float* rt = (LAS float*)lds;
    if (HMODE == 2) { __syncthreads(); for (int i = tid; i < DM * NE; i += NT) rt[i] = ldin(34)[i]; __syncthreads(); }
    for (int r = bid * NW + wid; r < M; r += G * NW) {
        const int vec = r < MLAT ? r / SEQ : 8;
        const float* xs = r < MLAT ? xlat + (size_t)r * DM : xctx + (size_t)(r - MLAT) * DM;
        float x[32]; ld_row(xs, lane, x);
        if (TMODE != 0) {
            float t[32];
            if (TMODE == 1) ld_row(T + (size_t)r * DM, lane, t);
            else {
                const unsigned* tok = (const unsigned*)(ws + WS_TOK) + (size_t)r * 8;
                const float w1 = __uint_as_float(tok[4]), w2 = __uint_as_float(tok[5]); const unsigned d1 = tok[6], d2 = tok[7];
                const bf16* y1 = (const bf16*)(ws + WS_MIX) + (size_t)d1 * DM; const bf16* y2 = (const bf16*)(ws + WS_MIX) + (size_t)d2 * DM;
#pragma unroll
                for (int i = 0; i < 8; ++i) { const uint2 p1 = *(const uint2*)(y1 + i * 256 + lane * 4), p2 = *(const uint2*)(y2 + i * 256 + lane * 4);
                    float f1[4], f2[4]; unpack4(p1, f1); unpack4(p2, f2);
#pragma unroll
                    for (int j = 0; j < 4; ++j) t[i * 4 + j] = w1 * f1[j] + w2 * f2[j]; }
            }
            const float rs = rsqrtf(sumsq(t) * (1.0f / DM) + 1e-6f);
            float pw[32], gg[32]; ld_row(postw, lane, pw); ld_row(ada + ((size_t)lg * 9 + vec) * 12288 + kg * DM, lane, gg);
#pragma unroll
            for (int i = 0; i < 32; ++i) x[i] += gg[i] * (t[i] * rs * pw[i]);
            float* xd = r < MLAT ? olat + (size_t)r * DM : octx + (size_t)(r - MLAT) * DM;
            st_row(xd, lane, x);
        }
        if (HMODE != 0) {
            const float rs = rsqrtf(sumsq(x) * (1.0f / DM) + 1e-6f);
            float pw[32], sc[32], sh[32]; ld_row(prew, lane, pw);
            ld_row(ada + ((size_t)lm * 9 + vec) * 12288 + ksc * DM, lane, sc); ld_row(ada + ((size_t)lm * 9 + vec) * 12288 + ksh * DM, lane, sh);
            float h[32];
#pragma unroll
            for (int i = 0; i < 32; ++i) h[i] = x[i] * rs * pw[i] * (1.0f + sc[i]) + sh[i];
            bf16* hd = HA + (size_t)r * DM;
#pragma unroll
            for (int i = 0; i < 8; ++i) { uint2 p; p.x = pk2(h[i * 4], h[i * 4 + 1]); p.y = pk2(h[i * 4 + 2], h[i * 4 + 3]); *(uint2*)(hd + i * 256 + lane * 4) = p; }
            if (HMODE == 2) {
                float lg8[8];
#pragma unroll
                for (int e = 0; e < 8; ++e) lg8[e] = 0.f;
#pragma unroll 1
                for (int i = 0; i < 8; ++i) {
                    float hv4[4];
#pragma unroll
                    for (int j = 0; j < 4; ++j) hv4[j] = 0.f;
#pragma unroll
                    for (int ii = 0; ii < 8; ++ii) if (ii == i) { hv4[0] = h[ii * 4]; hv4[1] = h[ii * 4 + 1]; hv4[2] = h[ii * 4 + 2]; hv4[3] = h[ii * 4 + 3]; }
#pragma unroll
                    for (int j = 0; j < 4; ++j) { const int c = i * 256 + lane * 4 + j; const f32x4 r0 = *(const LAS f32x4*)(rt + c * 8), r1 = *(const LAS f32x4*)(rt + c * 8 + 4); const float hv = hv4[j];
                        lg8[0] += hv * r0[0]; lg8[1] += hv * r0[1]; lg8[2] += hv * r0[2]; lg8[3] += hv * r0[3]; lg8[4] += hv * r1[0]; lg8[5] += hv * r1[1]; lg8[6] += hv * r1[2]; lg8[7] += hv * r1[3]; }
                }
#pragma unroll
                for (int e = 0; e < 8; ++e) lg8[e] = wsum(lg8[e]);
                if (lane == 0) {
                    int e1 = 0; float v1 = lg8[0];
#pragma unroll
                    for (int e = 1; e < 8; ++e) if (lg8[e] > v1) { v1 = lg8[e]; e1 = e; }
                    int e2 = -1; float v2 = -3.0e38f;
#pragma unroll
                    for (int e = 0; e < 8; ++e) if (e != e1 && lg8[e] > v2) { v2 = lg8[e]; e2 = e; }
                    const float ex = __expf(v2 - v1); const float w1 = 1.0f / (1.0f + ex), w2 = ex / (1.0f + ex);
                    unsigned* cnt = (unsigned*)(ws + WS_CTL) + CW_CNT;
                    const unsigned p1 = atomicAdd(cnt + e1 * 64, 1u), p2 = atomicAdd(cnt + e2 * 64, 1u);
                    unsigned* tok = (unsigned*)(ws + WS_TOK) + (size_t)r * 8;
                    tok[0] = (unsigned)e1; tok[1] = (unsigned)e2; tok[2] = p1; tok[3] = p2; tok[4] = __float_as_uint(w1); tok[5] = __float_as_uint(w2);
                }
            }
        }
    }
}

__device__ __forceinline__ void moe_gather(const Ctx& a, int bid, int G) {
    unsigned char* ws = opqp(a.ws); const int tid = ((a.wv << 6) | lane_v()), lane = tid & 63, wid = tid >> 6;
    const unsigned* cnt = (const unsigned*)(ws + WS_CTL) + CW_CNT;
    const bf16* HA = (const bf16*)(ws + WS_HA); bf16* AG = (bf16*)(ws + WS_U);
    for (int r = bid * NW + wid; r < MLAT; r += G * NW) {
        unsigned* tok = (unsigned*)(ws + WS_TOK) + (size_t)r * 8;
        const int e1 = (int)tok[0], e2 = (int)tok[1]; const unsigned p1 = tok[2], p2 = tok[3];
        unsigned run = 0, s1 = 0, s2 = 0;
#pragma unroll
        for (int e = 0; e < 8; ++e) { const unsigned t = (cnt[e * 64] + 255u) >> 8; if (e == e1) s1 = run; if (e == e2) s2 = run; run += t; }
        const unsigned d1 = s1 * 256u + p1, d2 = s2 * 256u + p2;
        const uint4* src = (const uint4*)(HA + (size_t)r * DM); uint4* q1 = (uint4*)(AG + (size_t)d1 * DM); uint4* q2 = (uint4*)(AG + (size_t)d2 * DM);
#pragma unroll
        for (int i = 0; i < 4; ++i) { const uint4 v = src[i * 64 + lane]; q1[i * 64 + lane] = v; q2[i * 64 + lane] = v; }
        if (lane == 0) { tok[6] = d1; tok[7] = d2; }
    }
    unsigned run = 0;
    for (int e = 0; e < 8; ++e) { const unsigned c = cnt[e * 64], t = (c + 255u) >> 8; const unsigned lo = run * 256u + c, hi = (run + t) * 256u; run += t;
        for (unsigned r = lo + bid * NW + wid; r < hi; r += G * NW) { uint4* q = (uint4*)(AG + (size_t)r * DM);
#pragma unroll
            for (int i = 0; i < 4; ++i) q[i * 64 + lane] = make_uint4(0u, 0u, 0u, 0u); } }
}


__device__ __forceinline__ uint4 ldg16(const bf16* p) { return *(const uint4*)p; }
__device__ __forceinline__ uint4 zero16() { return make_uint4(0u, 0u, 0u, 0u); }

__device__ __forceinline__ void feat_a(const Ctx& a, int l, int bid, int G) {
    unsigned char* ws = opqp(a.ws); const int tid = ((a.wv << 6) | lane_v()), lane = tid & 63, wid = tid >> 6;
    const bf16* U = (const bf16*)(ws + WS_U); bf16* ASM = (bf16*)(ws + WS_ASM); bf16* XBC = (bf16*)(ws + WS_XBC); bf16* QK = (bf16*)(ws + WS_QK);
    float* DT = (float*)(ws + WS_DT); const float* rope = (const float*)(ws + WS_ROPE);
    const float* mu = ldin(12) + (size_t)l * 2 * 1792; const float* cw = ldin(23) + (size_t)l * 3 * 1536; const float* cb = ldin(24) + (size_t)l * 1536;
    const float* dtb = ldin(25) + l * 32; const float* alog = ldin(26) + l * 32;
    for (int r = bid * NW + wid; r < MTOT; r += G * NW) {
        const bool lat = r < MLAT; const int t = lat ? (r & (SEQ - 1)) : ((r - MLAT) & (CTXL - 1)); const int L = lat ? SEQ : CTXL;
        const bool hp = t > 0, hn = t < L - 1;
        const bf16* up = U + (size_t)r * NINP;
        if (lane < 32) {
            const int c = C_RW_XW + lane * 8; float u[8], p[8], n[8], o[8];
            unpack8(ldg16(up + c), u); unpack8(hp ? ldg16(up - NINP + c) : zero16(), p); unpack8(hn ? ldg16(up + NINP + c) : zero16(), n);
#pragma unroll
            for (int e = 0; e < 8; ++e) { const float s = u[e] + mu[c + e] * (p[e] - u[e]) + mu[1792 + c + e] * (n[e] - u[e]); const int k = lane * 8 + e;
                o[e] = k < 64 ? (1.0f - 2.0f / (__expf(2.0f * s) + 1.0f)) : (k < 128 ? s : fsigm(s)); }
            *(uint4*)(ASM + (size_t)r * 256 + lane * 8) = pack8(o);
        }
#pragma unroll
        for (int it = 0; it < 3; ++it) {
            const int cc = (it * 64 + lane) * 8, c = C_MB_XBC + cc; float u[8], p[8], n[8], o[8];
            unpack8(ldg16(up + c), u); unpack8(hp ? ldg16(up - NINP + c) : zero16(), p); unpack8(hn ? ldg16(up + NINP + c) : zero16(), n);
#pragma unroll
            for (int e = 0; e < 8; ++e) o[e] = fsilu(cw[cc + e] * p[e] + cw[1536 + cc + e] * u[e] + cw[3072 + cc + e] * n[e] + cb[cc + e]);
            *(uint4*)(XBC + (size_t)r * 1536 + cc) = pack8(o);
        }
        if (lane < 32) {
            const float raw = bf2f(up[C_MB_DT + lane]); const float dtv = softplusf(raw + dtb[lane]); const float A = -__expf(alog[lane]);
            DT[(size_t)r * 64 + lane] = dtv; DT[(size_t)r * 64 + 32 + lane] = dtv * A;
        }
        {
            const int blk = lane >> 1, sub = lane & 1, c1 = C_DA_Q + blk * 32 + sub * 8; float u1[8], u2[8], o1[8], o2[8];
            unpack8(ldg16(up + c1), u1); unpack8(ldg16(up + c1 + 16), u2);
            const int half = blk & 1; const float scale = blk < 16 ? 0.125f * 1.44269504f : 1.0f;
#pragma unroll
            for (int e = 0; e < 8; ++e) {
                float cs = 1.0f, sn = 0.0f;
                if (lat) { cs = rope[t * 64 + half * 32 + sub * 8 + e]; sn = rope[t * 64 + half * 32 + 16 + sub * 8 + e]; }
                o1[e] = (u1[e] * cs - u2[e] * sn) * scale; o2[e] = (u2[e] * cs + u1[e] * sn) * scale; }
            *(uint4*)(QK + (size_t)r * 1024 + blk * 32 + sub * 8) = pack8(o1); *(uint4*)(QK + (size_t)r * 1024 + blk * 32 + 16 + sub * 8) = pack8(o2);
        }
    }
}

__device__ __forceinline__ void feat_b(const Ctx& a, int l, int bid, int G) {
    unsigned char* ws = opqp(a.ws); const int tid = ((a.wv << 6) | lane_v()), lane = tid & 63, wid = tid >> 6;
    const bf16* U = (const bf16*)(ws + WS_U); const float* F = (const float*)(ws + WS_MIX); bf16* R5 = (bf16*)(ws + WS_RW5);
    const float* mu = ldin(12) + (size_t)l * 2 * 1792; const float* k_k = ldin(18) + l * 512; const float* k_a = ldin(19) + l * 512; const float* a0 = ldin(15) + l * 512;
    for (int r = bid * NW + wid; r < MTOT; r += G * NW) {
        const bool lat = r < MLAT; const int t = lat ? (r & (SEQ - 1)) : ((r - MLAT) & (CTXL - 1)); const int L = lat ? SEQ : CTXL;
        const bool hp = t > 0, hn = t < L - 1;
        const bf16* up = U + (size_t)r * NINP; const int c = lane * 8;
        float s[3][8];
#pragma unroll
        for (int q = 0; q < 3; ++q) { const int col = q * 512 + c; float u[8], p[8], n[8];
            unpack8(ldg16(up + col), u); unpack8(hp ? ldg16(up - NINP + col) : zero16(), p); unpack8(hn ? ldg16(up + NINP + col) : zero16(), n);
#pragma unroll
            for (int e = 0; e < 8; ++e) s[q][e] = u[e] + mu[col + e] * (p[e] - u[e]) + mu[1792 + col + e] * (n[e] - u[e]); }
        float av[8]; { const float4 q0 = *(const float4*)(F + (size_t)r * 2048 + 1024 + c), a1 = *(const float4*)(F + (size_t)r * 2048 + 1024 + c + 4);
            av[0] = q0.x; av[1] = q0.y; av[2] = q0.z; av[3] = q0.w; av[4] = a1.x; av[5] = a1.y; av[6] = a1.z; av[7] = a1.w; }
#pragma unroll
        for (int e = 0; e < 8; ++e) av[e] = fsigm(av[e] + a0[c + e]);
        float kkv[8], k2[8], bv[8]; float ss = 0.f;
#pragma unroll
        for (int e = 0; e < 8; ++e) { kkv[e] = s[1][e] * k_k[c + e]; ss += kkv[e] * kkv[e]; }
        ss = red8(ss); const float inv = 1.0f / fmaxf(sqrtf(ss), 1e-12f);
#pragma unroll
        for (int e = 0; e < 8; ++e) { kkv[e] *= inv; k2[e] = s[1][e] * (1.0f + (av[e] - 1.0f) * k_a[c + e]); bv[e] = kkv[e] * av[e]; }
        const size_t o = (size_t)r * 512 + c, st = (size_t)MTOT * 512;
        *(uint4*)(R5 + o) = pack8(s[0]); *(uint4*)(R5 + st + o) = pack8(k2); *(uint4*)(R5 + 2 * st + o) = pack8(s[2]); *(uint4*)(R5 + 3 * st + o) = pack8(kkv); *(uint4*)(R5 + 4 * st + o) = pack8(bv);
    }
}

__device__ __forceinline__ void mix_out(const Ctx& a, int l, int M, int bid, int G) {
    unsigned char* ws = opqp(a.ws); const int tid = ((a.wv << 6) | lane_v()), lane = tid & 63, wid = tid >> 6;
    const bf16* U = (const bf16*)(ws + WS_U); const float* F = (const float*)(ws + WS_MIX); const bf16* R5 = (const bf16*)(ws + WS_RW5); const bf16* XBC = (const bf16*)(ws + WS_XBC);
    const float* YR = (const float*)(ws + WS_YR); const float* YM = (const float*)(ws + WS_YM); bf16* A2 = (bf16*)(ws + WS_HA);
    const float* r_k = ldin(20) + l * 512; const float* ln_w = ldin(21) + l * 512; const float* ln_b = ldin(22) + l * 512;
    const float* Dsk = ldin(27) + l * 16; const float* nw = ldin(28) + l * 1024;
    for (int r = bid * NW + wid; r < M; r += G * NW) {
        {
            const int c = lane * 8; const size_t o = (size_t)r * 512 + c, st = (size_t)MTOT * 512;
            float y[8];
            { const float4 f0 = *(const float4*)(YR + o), f1 = *(const float4*)(YR + o + 4), b0 = *(const float4*)(YR + st + o), b1 = *(const float4*)(YR + st + o + 4);
              y[0] = f0.x + b0.x; y[1] = f0.y + b0.y; y[2] = f0.z + b0.z; y[3] = f0.w + b0.w; y[4] = f1.x + b1.x; y[5] = f1.y + b1.y; y[6] = f1.z + b1.z; y[7] = f1.w + b1.w; }
            float sm = 0.f;
#pragma unroll
            for (int e = 0; e < 8; ++e) sm += y[e];
            const float mean = red8(sm) * (1.0f / 64.0f); float sv = 0.f;
#pragma unroll
            for (int e = 0; e < 8; ++e) { y[e] -= mean; sv += y[e] * y[e]; }
            const float rs = rsqrtf(red8(sv) * (1.0f / 64.0f) + 64e-5f);
            float rr[8], kk[8], vv[8]; unpack8(ldg16(R5 + o), rr); unpack8(ldg16(R5 + st + o), kk); unpack8(ldg16(R5 + 2 * st + o), vv);
            float dot = 0.f;
#pragma unroll
            for (int e = 0; e < 8; ++e) dot += rr[e] * kk[e] * r_k[c + e];
            dot = red8(dot);
            const float4 g0 = *(const float4*)(F + (size_t)r * 2048 + 1536 + c), g1 = *(const float4*)(F + (size_t)r * 2048 + 1536 + c + 4);
            const float g[8] = {g0.x, g0.y, g0.z, g0.w, g1.x, g1.y, g1.z, g1.w}; float ov[8];
#pragma unroll
            for (int e = 0; e < 8; ++e) ov[e] = (y[e] * rs * ln_w[c + e] + ln_b[c + e] + dot * vv[e]) * g[e];
            *(uint4*)(A2 + (size_t)r * DM + c) = pack8(ov);
        }
        {
            const int m0 = lane * 16, hh = m0 >> 6; const float dsk = Dsk[hh]; float y[16]; float ss = 0.f;
#pragma unroll
            for (int q = 0; q < 2; ++q) { const int m = m0 + q * 8; const size_t o = (size_t)r * 1024 + m, st = (size_t)MTOT * 1024;
                const float4 f0 = *(const float4*)(YM + o), f1 = *(const float4*)(YM + o + 4), b0 = *(const float4*)(YM + st + o), b1 = *(const float4*)(YM + st + o + 4);
                const float ys[8] = {f0.x + b0.x, f0.y + b0.y, f0.z + b0.z, f0.w + b0.w, f1.x + b1.x, f1.y + b1.y, f1.z + b1.z, f1.w + b1.w};
                float xs[8], z[8]; unpack8(ldg16(XBC + (size_t)r * 1536 + m), xs); unpack8(ldg16(U + (size_t)r * NINP + C_MB_Z + m), z);
#pragma unroll
                for (int e = 0; e < 8; ++e) { const float v = (ys[e] + dsk * xs[e]) * fsilu(z[e]); y[q * 8 + e] = v; ss += v * v; } }
            ss = red32(ss);
            const float rs = rsqrtf(ss * (1.0f / 512.0f) + 1e-5f);
#pragma unroll
            for (int q = 0; q < 2; ++q) { const int m = m0 + q * 8; float ov[8];
#pragma unroll
                for (int e = 0; e < 8; ++e) ov[e] = y[q * 8 + e] * rs * nw[m + e];
                *(uint4*)(A2 + (size_t)r * DM + 512 + m) = pack8(ov); }
        }
    }
}


__device__ __forceinline__ int chain_row(int s, int b, int dir) {
    if (s < CTXL) return MLAT + b * CTXL + (dir ? (CTXL - 1 - s) : s);
    const int t = s - CTXL; return b * SEQ + (dir ? (SEQ - 1 - t) : t);
}
constexpr int CH_STEPS = CTXL + SEQ, CH_T = 32, CH_NC = CH_STEPS / CH_T;

constexpr int RW_LD = 352;
__device__ __forceinline__ void rwkv_chain(const Ctx& a, LAS unsigned char* lds, int l, int item) {
    unsigned char* ws = opqp(a.ws); const int tid = ((a.wv << 6) | lane_v());
    const int half = item & 1, dir = (item >> 1) & 1, h = (item >> 2) & 7, b = item >> 5;
    const int il = tid >> 4, js = tid & 15, j0 = js * 4;
    const bf16* R5 = (const bf16*)(ws + WS_RW5); const float* F = (const float*)(ws + WS_MIX); float* Y = (float*)(ws + WS_YR) + (size_t)dir * MTOT * 512;
    const size_t st = (size_t)MTOT * 512;
    LAS float* buf = (LAS float*)lds;
    const int ls = tid >> 4, lp = tid & 15;
    float S0 = 0.f, S1 = 0.f, S2 = 0.f, S3 = 0.f;
    float4 wreg; uint2 kkr, br, kr, rr, vr;
    const float4 w0r = *(const float4*)(ldin(13) + l * 1024 + dir * 512 + h * 64 + lp * 4);
#define RW_LOAD(c) do { const int row_ = chain_row((c) * CH_T + ls, b, dir); const size_t o_ = (size_t)row_ * 512 + h * 64 + lp * 4; \
        wreg = *(const float4*)(F + (size_t)row_ * 2048 + dir * 512 + h * 64 + lp * 4); \
        rr = *(const uint2*)(R5 + o_); kr = *(const uint2*)(R5 + st + o_); kkr = *(const uint2*)(R5 + 3 * st + o_); br = *(const uint2*)(R5 + 4 * st + o_); \
        vr = make_uint2(0u, 0u); if (lp < 8) vr = *(const uint2*)(R5 + 2 * st + (size_t)row_ * 512 + h * 64 + half * 32 + lp * 4); } while (0)
#define RW_STORE(c) do { LAS float* q_ = buf + (((c) & 1) * CH_T + ls) * RW_LD; float f_[4]; \
        unpack4(kkr, f_); *(LAS f32x4*)(q_ + lp * 4) = (f32x4){f_[0], f_[1], f_[2], f_[3]}; \
        unpack4(br, f_);  *(LAS f32x4*)(q_ + 64 + lp * 4) = (f32x4){f_[0], f_[1], f_[2], f_[3]}; \
        *(LAS f32x4*)(q_ + 128 + lp * 4) = (f32x4){__expf(-0.60653066f * fsigm(wreg.x + w0r.x)), __expf(-0.60653066f * fsigm(wreg.y + w0r.y)), __expf(-0.60653066f * fsigm(wreg.z + w0r.z)), __expf(-0.60653066f * fsigm(wreg.w + w0r.w))}; \
        unpack4(kr, f_);  *(LAS f32x4*)(q_ + 192 + lp * 4) = (f32x4){f_[0], f_[1], f_[2], f_[3]}; \
        unpack4(rr, f_);  *(LAS f32x4*)(q_ + 256 + lp * 4) = (f32x4){f_[0], f_[1], f_[2], f_[3]}; \
        if (lp < 8) { unpack4(vr, f_); *(LAS f32x4*)(q_ + 320 + lp * 4) = (f32x4){f_[0], f_[1], f_[2], f_[3]}; } } while (0)
    __syncthreads();
    RW_LOAD(0); RW_STORE(0);
    __syncthreads();
    for (int c = 0; c < CH_NC; ++c) {
        if (c + 1 < CH_NC) RW_LOAD(c + 1);
        const LAS float* cb = buf + ((c & 1) * CH_T) * RW_LD;
        for (int s = 0; s < CH_T; ++s) {
            const LAS float* q = cb + s * RW_LD;
            const f32x4 kk4 = *(const LAS f32x4*)(q + j0), b4 = *(const LAS f32x4*)(q + 64 + j0), w4 = *(const LAS f32x4*)(q + 128 + j0), k4 = *(const LAS f32x4*)(q + 192 + j0), r4 = *(const LAS f32x4*)(q + 256 + j0);
            const float v = q[320 + il];
            const float sa = -red16(S0 * kk4[0] + S1 * kk4[1] + S2 * kk4[2] + S3 * kk4[3]);
            S0 = S0 * w4[0] + sa * b4[0] + v * k4[0]; S1 = S1 * w4[1] + sa * b4[1] + v * k4[1]; S2 = S2 * w4[2] + sa * b4[2] + v * k4[2]; S3 = S3 * w4[3] + sa * b4[3] + v * k4[3];
            const float y = red16(S0 * r4[0] + S1 * r4[1] + S2 * r4[2] + S3 * r4[3]);
            if (js == 0) { const int row = chain_row(c * CH_T + s, b, dir); Y[(size_t)row * 512 + h * 64 + half * 32 + il] = y; }
        }
        if (c + 1 < CH_NC) RW_STORE(c + 1);
        __syncthreads();
    }
#undef RW_LOAD
#undef RW_STORE
}

constexpr int MB_LD = 328;
__device__ __forceinline__ void mamba_chain(const Ctx& a, LAS unsigned char* lds, int item) {
    unsigned char* ws = opqp(a.ws); const int tid = ((a.wv << 6) | lane_v());
    const int dir = item & 1, h = (item >> 1) & 15, b = item >> 5, g = h >> 3;
    const int p = tid >> 3, ns = tid & 7, n0 = ns * 16;
    const bf16* XBC = (const bf16*)(ws + WS_XBC); const float* DT = (const float*)(ws + WS_DT); float* Y = (float*)(ws + WS_YM) + (size_t)dir * MTOT * 1024;
    LAS float* buf = (LAS float*)lds;
    const int ls = tid >> 4, lp = tid & 15;
    float H[16];
#pragma unroll
    for (int i = 0; i < 16; ++i) H[i] = 0.f;
    uint4 Breg, Creg, xreg; float sreg;
#define MB_LOAD(c) do { const int row_ = chain_row((c) * CH_T + ls, b, dir); const bf16* xr_ = XBC + (size_t)row_ * 1536; \
        Breg = *(const uint4*)(xr_ + 1024 + g * 128 + lp * 8); Creg = *(const uint4*)(xr_ + 1280 + g * 128 + lp * 8); \
        xreg = make_uint4(0u, 0u, 0u, 0u); if (lp < 8) xreg = *(const uint4*)(xr_ + h * 64 + lp * 8); \
        sreg = 0.f; if (lp == 8) sreg = DT[(size_t)row_ * 64 + dir * 16 + h]; if (lp == 9) sreg = DT[(size_t)row_ * 64 + 32 + dir * 16 + h]; } while (0)
#define MB_STORE(c) do { LAS float* q_ = buf + (((c) & 1) * CH_T + ls) * MB_LD; float f_[8]; \
        unpack8(Breg, f_); *(LAS f32x4*)(q_ + lp * 8) = (f32x4){f_[0], f_[1], f_[2], f_[3]}; *(LAS f32x4*)(q_ + lp * 8 + 4) = (f32x4){f_[4], f_[5], f_[6], f_[7]}; \
        unpack8(Creg, f_); *(LAS f32x4*)(q_ + 128 + lp * 8) = (f32x4){f_[0], f_[1], f_[2], f_[3]}; *(LAS f32x4*)(q_ + 128 + lp * 8 + 4) = (f32x4){f_[4], f_[5], f_[6], f_[7]}; \
        if (lp < 8) { unpack8(xreg, f_); *(LAS f32x4*)(q_ + 256 + lp * 8) = (f32x4){f_[0], f_[1], f_[2], f_[3]}; *(LAS f32x4*)(q_ + 256 + lp * 8 + 4) = (f32x4){f_[4], f_[5], f_[6], f_[7]}; } \
        if (lp == 8) q_[321] = sreg; if (lp == 9) q_[320] = __expf(sreg); } while (0)
    __syncthreads();
    MB_LOAD(0); MB_STORE(0);
    __syncthreads();
    for (int c = 0; c < CH_NC; ++c) {
        if (c + 1 < CH_NC) MB_LOAD(c + 1);
        const LAS float* cb = buf + ((c & 1) * CH_T) * MB_LD;
        for (int s = 0; s < CH_T; ++s) {
            const LAS float* q = cb + s * MB_LD;
            const float ea = q[320], dtx = q[321] * q[256 + p];
            float y = 0.f;
#pragma unroll
            for (int i4 = 0; i4 < 4; ++i4) { const f32x4 B4 = *(const LAS f32x4*)(q + n0 + i4 * 4), C4 = *(const LAS f32x4*)(q + 128 + n0 + i4 * 4);
#pragma unroll
                for (int j = 0; j < 4; ++j) { H[i4 * 4 + j] = ea * H[i4 * 4 + j] + dtx * B4[j]; y += H[i4 * 4 + j] * C4[j]; } }
            y = red8(y);
            if (ns == 0) { const int row = chain_row(c * CH_T + s, b, dir); Y[(size_t)row * 1024 + h * 64 + p] = y; }
        }
        if (c + 1 < CH_NC) MB_STORE(c + 1);
        __syncthreads();
    }
#undef MB_LOAD
#undef MB_STORE
}

constexpr int AT_KP = 136, AT_VP = 72;
__device__ __forceinline__ void attn_item(const Ctx& a, LAS unsigned char* lds, int l, int b, int h, int qt, bool ctxq, float lam, float post) {
    unsigned char* ws = opqp(a.ws); const int tid = ((a.wv << 6) | lane_v()), lane = tid & 63, wid = tid >> 6, fr = lane & 15, fq = lane >> 4;
    const bf16* QK = (const bf16*)(ws + WS_QK); const bf16* U = (const bf16*)(ws + WS_U); bf16* A2 = (bf16*)(ws + WS_HA);
    LAS bf16* Ks = (LAS bf16*)lds; LAS bf16* Vt = Ks + 64 * AT_KP;
    const int qrow = (ctxq ? MLAT + b * CTXL : b * SEQ) + qt * 128 + wid * 16 + fr;
    const int nkt = ctxq ? 4 : 36;
    bf16x8 qf[2][2];
#pragma unroll
    for (int c = 0; c < 2; ++c)
#pragma unroll
        for (int ks = 0; ks < 2; ++ks) qf[c][ks] = *(const bf16x8*)(QK + (size_t)qrow * 1024 + h * 128 + c * 64 + ks * 32 + fq * 8);
    f32x4 O[2][8];
#pragma unroll
    for (int c = 0; c < 2; ++c)
#pragma unroll
        for (int d = 0; d < 8; ++d) O[c][d] = (f32x4){0.f, 0.f, 0.f, 0.f};
    float mrun[2] = {-3.0e38f, -3.0e38f}, lrun[2] = {0.f, 0.f};
    uint4 kreg[2], vreg[2];
#define AT_LOAD(kt) do { const int kr0_ = ((kt) < 4 ? MLAT + b * CTXL + (kt) * 64 : b * SEQ + ((kt) - 4) * 64); \
        _Pragma("unroll") for (int j_ = 0; j_ < 2; ++j_) { const int id_ = tid + j_ * NT, key_ = id_ >> 4, part_ = id_ & 15; \
            kreg[j_] = *(const uint4*)(QK + (size_t)(kr0_ + key_) * 1024 + 512 + h * 128 + part_ * 8); \
            vreg[j_] = *(const uint4*)(U + (size_t)(kr0_ + key_) * NINP + C_DA_V + h * 128 + part_ * 8); } } while (0)
#define AT_STORE() do { _Pragma("unroll") for (int j_ = 0; j_ < 2; ++j_) { const int id_ = tid + j_ * NT, key_ = id_ >> 4, part_ = id_ & 15; \
            *(LAS u32x4*)(Ks + key_ * AT_KP + part_ * 8) = (u32x4){kreg[j_].x, kreg[j_].y, kreg[j_].z, kreg[j_].w}; \
            const unsigned w_[4] = {vreg[j_].x, vreg[j_].y, vreg[j_].z, vreg[j_].w}; \
            _Pragma("unroll") for (int e_ = 0; e_ < 4; ++e_) { Vt[(part_ * 8 + 2 * e_) * AT_VP + key_] = (bf16)(w_[e_] & 0xffffu); Vt[(part_ * 8 + 2 * e_ + 1) * AT_VP + key_] = (bf16)(w_[e_] >> 16); } } } while (0)
    AT_LOAD(0);
    for (int kt = 0; kt < nkt; ++kt) {
        __syncthreads();
        AT_STORE();
        __syncthreads();
        if (kt + 1 < nkt) AT_LOAD(kt + 1);
        f32x4 S[2][4];
#pragma unroll
        for (int c = 0; c < 2; ++c)
#pragma unroll
            for (int sb = 0; sb < 4; ++sb) { f32x4 acc = (f32x4){0.f, 0.f, 0.f, 0.f};
#pragma unroll
                for (int ks = 0; ks < 2; ++ks) { const bf16x8 kf = *(const LAS bf16x8*)(Ks + (sb * 16 + fr) * AT_KP + c * 64 + ks * 32 + fq * 8);
                    acc = __builtin_amdgcn_mfma_f32_16x16x32_bf16(kf, qf[c][ks], acc, 0, 0, 0); }
                S[c][sb] = acc; }
        bf16x8 pf[2][2];
#pragma unroll
        for (int c = 0; c < 2; ++c) {
            float mx = S[c][0][0];
#pragma unroll
            for (int sb = 0; sb < 4; ++sb)
#pragma unroll
                for (int e = 0; e < 4; ++e) mx = fmaxf(mx, S[c][sb][e]);
            mx = fmaxf(mx, swz16(mx)); mx = fmaxf(mx, shx32(mx, lane));
            const float mnew = fmaxf(mrun[c], mx), alpha = exp2f(mrun[c] - mnew); mrun[c] = mnew;
            float ps = 0.f;
#pragma unroll
            for (int sb = 0; sb < 4; ++sb)
#pragma unroll
                for (int e = 0; e < 4; ++e) { const float pv = exp2f(S[c][sb][e] - mnew); S[c][sb][e] = pv; ps += pv; }
            lrun[c] = lrun[c] * alpha + ps;
#pragma unroll
            for (int d = 0; d < 8; ++d) O[c][d] *= alpha;
#pragma unroll
            for (int kc = 0; kc < 2; ++kc) { u32x4 w; w.x = pk2(S[c][2 * kc][0], S[c][2 * kc][1]); w.y = pk2(S[c][2 * kc][2], S[c][2 * kc][3]); w.z = pk2(S[c][2 * kc + 1][0], S[c][2 * kc + 1][1]); w.w = pk2(S[c][2 * kc + 1][2], S[c][2 * kc + 1][3]);
                pf[c][kc] = __builtin_bit_cast(bf16x8, w); }
        }
#pragma unroll
        for (int kc = 0; kc < 2; ++kc)
#pragma unroll
            for (int d = 0; d < 8; ++d) {
                const LAS bf16* vp = Vt + (d * 16 + fr) * AT_VP + kc * 32 + 4 * fq;
                const u32x2 lo = *(const LAS u32x2*)vp, hi = *(const LAS u32x2*)(vp + 16);
                u32x4 w; w.x = lo.x; w.y = lo.y; w.z = hi.x; w.w = hi.y; const bf16x8 vf = __builtin_bit_cast(bf16x8, w);
                O[0][d] = __builtin_amdgcn_mfma_f32_16x16x32_bf16(vf, pf[0][kc], O[0][d], 0, 0, 0);
                O[1][d] = __builtin_amdgcn_mfma_f32_16x16x32_bf16(vf, pf[1][kc], O[1][d], 0, 0, 0);
            }
    }
#undef AT_LOAD
#undef AT_STORE
    float l0 = lrun[0], l1 = lrun[1];
    l0 += swz16(l0); l0 += shx32(l0, lane); l1 += swz16(l1); l1 += shx32(l1, lane);
    const float i0 = 1.0f / l0, i1 = lam / l1;
    float ss = 0.f;
#pragma unroll
    for (int d = 0; d < 8; ++d)
#pragma unroll
        for (int e = 0; e < 4; ++e) { const float o = O[0][d][e] * i0 - O[1][d][e] * i1; O[0][d][e] = o; ss += o * o; }
    ss += swz16(ss); ss += shx32(ss, lane);
    const float rs = rsqrtf(ss * (1.0f / 128.0f) + 1e-5f) * post;
    const float* sw = ldin(30) + l * 128;
#pragma unroll
    for (int d = 0; d < 8; ++d) { const int dc = d * 16 + 4 * fq; const float4 w4 = *(const float4*)(sw + dc);
        uint2 pk; pk.x = pk2(O[0][d][0] * rs * w4.x, O[0][d][1] * rs * w4.y); pk.y = pk2(O[0][d][2] * rs * w4.z, O[0][d][3] * rs * w4.w);
        *(uint2*)(A2 + (size_t)qrow * DM + 1536 + h * 128 + dc) = pk; }
}

__device__ __forceinline__ void p6_mixers(const Ctx& a, LAS unsigned char* lds, int l, int bid, int G) {
    for (int it = bid; it < 256; it += G) rwkv_chain(a, lds, l, it);
    for (int it = bid; it < 256; it += G) mamba_chain(a, lds, it);
    const float* lp = ldin(29) + l * 256; float s01 = 0.f, s23 = 0.f;
    for (int i = 0; i < 64; ++i) { s01 += lp[i] * lp[64 + i]; s23 += lp[128 + i] * lp[192 + i]; }
    const float lam_init = l == 0 ? 0.2f : (0.8f - 0.6f * 0.74081822068f);
    const float lam = expf(s01) - expf(s23) + lam_init, post = 1.0f - lam_init;
    __syncthreads();
    for (int it = bid; it < 512; it += G) { const int qt = it & 15, h = (it >> 4) & 3, b = it >> 6; attn_item(a, lds, l, b, h, qt, false, lam, post); }
    if (l == 0) for (int it = bid; it < 64; it += G) { const int qt = it & 1, h = (it >> 1) & 3, b = it >> 3; attn_item(a, lds, l, b, h, qt, true, lam, post); }
}


constexpr int N_PHASES = 25;
__global__ void __launch_bounds__(NT, 2) fwd(Args args) {
    extern __shared__ __attribute__((aligned(16))) unsigned char lds_dyn[];
    LAS unsigned char* lds = (LAS unsigned char*)lds_dyn;
    volatile LAS unsigned* MISC = (volatile LAS unsigned*)(lds + LDS_STAGE);
    const int wv = __builtin_amdgcn_readfirstlane((int)threadIdx.x >> 6);
    const int tid = (wv << 6) | lane_v(), bid = blockIdx.x, G = gridDim.x;
    unsigned char* ws = args.ws;
    const Ctx cx{ws, wv};
    for (int u = tid; u < LDS_MISC / 4; u += NT) MISC[u] = 0u;
    __syncthreads();
    if (tid == 0) {
#pragma unroll
        for (int i = 0; i < 38; ++i) *(LAS unsigned long long*)(lds + LDS_PTRS + 8 * i) = (unsigned long long)args.in[i];
    }
    __syncthreads();
#if MK_PER_PHASE
#define GRID_BAR() do { } while (0)
#else
    XcdBarrier bar = xcd_barrier_post((unsigned*)(ws + WS_CTL) + CW_BAR, MISC);
#define GRID_BAR() do { XcdBarrier b_ = bar; b_.bar = opqp(b_.bar); b_.x = (unsigned)opqs((int)b_.x); xcd_barrier(b_); } while (0)
#endif
    const int lo = args.ph_lo, hi = args.ph_hi;
#define IN(k) (opqs(lo) <= (k) && (k) < opqs(hi))
#define SEAM(k) do { if (IN((k) + 1)) GRID_BAR(); } while (0)

#define XS (args.out)
#define XC ((float*)(wsq + WS_XC))
#define HA ((bf16*)(wsq + WS_HA))
#define Ub ((bf16*)(wsq + WS_U))
#define MIX ((float*)(wsq + WS_MIX))
#define HID ((bf16*)(wsq + WS_BIG))
#define PH_LOCALS unsigned char* const wsq = opqp(ws); const int bidq = opqs(bid), Gq = opqs(G); (void)wsq; (void)bidq; (void)Gq

    if (IN(0)) { PH_LOCALS; p0_prologue(cx, lds,  bidq, Gq); SEAM(0); }
    if (IN(1)) { PH_LOCALS;
        thin_phase<0, 1>(cx, lds,  bidq, Gq, MTOT, ldin(0), ldin(2), nullptr, nullptr, nullptr, nullptr, 0, 0, ldin(6), 0, 1, 0);
        SEAM(1);
    }
    for (int l = 0; l < 2; ++l) {
        const int pb = 2 + 11 * l;
        const int Mo = l == 0 ? MTOT : MLAT;
        if (IN(pb + 0)) { PH_LOCALS;
            pg8::Gemm g{HA, (const bf16*)(wsq + WS_WIN) + (size_t)l * NINP * DM, MTOT, NINP, DM}; pg8::StaticOrder S; S.init(MTOT, NINP, Gq, bidq);
            pg8::EpiBf16P E{Ub, NINP, 0};
            pg8::gemm_phase<pg8::EpiBf16P, pg8::StaticOrder>(lds, g, S, E, nullptr, (wv << 6) | lane_v());
            SEAM(pb + 0);
        }
        if (IN(pb + 1)) { PH_LOCALS; feat_a(cx, l,  bidq, Gq); SEAM(pb + 1); }
        if (IN(pb + 2)) { PH_LOCALS;
            pg8::Gemm g{(const bf16*)(wsq + WS_ASM), (const bf16*)(wsq + WS_WSM) + (size_t)l * 2048 * 256, MTOT, 2048, 256}; pg8::StaticOrder S; S.init(MTOT, 2048, Gq, bidq);
            pg8::EpiF32 E{MIX, 2048, nullptr};
            pg8::gemm_phase<pg8::EpiF32, pg8::StaticOrder>(lds, g, S, E, nullptr, (wv << 6) | lane_v());
            SEAM(pb + 2);
        }
        if (IN(pb + 3)) { PH_LOCALS; feat_b(cx, l,  bidq, Gq); SEAM(pb + 3); }
        if (IN(pb + 4)) { PH_LOCALS; p6_mixers(cx, lds, l,  bidq, Gq); SEAM(pb + 4); }
        if (IN(pb + 5)) { PH_LOCALS; mix_out(cx, l, Mo,  bidq, Gq); SEAM(pb + 5); }
        if (IN(pb + 6)) { PH_LOCALS;
            pg8::Gemm g{HA, (const bf16*)(wsq + WS_WOUT) + (size_t)l * DM * DM, Mo, DM, DM}; pg8::StaticOrder S; S.init(Mo, DM, Gq, bidq);
            pg8::EpiF32 E{MIX, DM, nullptr};
            pg8::gemm_phase<pg8::EpiF32, pg8::StaticOrder>(lds, g, S, E, nullptr, (wv << 6) | lane_v());
            SEAM(pb + 6);
        }
        if (l == 0) {
            if (IN(pb + 7)) { PH_LOCALS;
                thin_phase<1, 1>(cx, lds,  bidq, Gq, MTOT, ldin(0), ldin(2), XS, XC, MIX, ldin(7), 0, 2, ldin(8), 0, 4, 3);
                SEAM(pb + 7);
            }
            if (IN(pb + 8)) { PH_LOCALS;
                pg8::Gemm g{HA, (const bf16*)(wsq + WS_WGU), MTOT, 2 * FF, DM}; pg8::StaticOrder S; S.init(MTOT, 2 * FF, Gq, bidq);
                pg8::EpiSwiGLU E{HID, FF, 0};
                pg8::gemm_phase<pg8::EpiSwiGLU, pg8::StaticOrder>(lds, g, S, E, nullptr, (wv << 6) | lane_v());
                SEAM(pb + 8);
            }
            if (IN(pb + 9)) { PH_LOCALS;
                pg8::Gemm g{HID, (const bf16*)(wsq + WS_WD), MTOT, DM, FF}; pg8::StaticOrder S; S.init(MTOT, DM, Gq, bidq);
                pg8::EpiF32 E{MIX, DM, nullptr};
                pg8::gemm_phase<pg8::EpiF32, pg8::StaticOrder>(lds, g, S, E, nullptr, (wv << 6) | lane_v());
                SEAM(pb + 9);
            }
            if (IN(pb + 10)) { PH_LOCALS;
                thin_phase<1, 1>(cx, lds,  bidq, Gq, MTOT, XS, XC, XS, XC, MIX, ldin(9), 0, 5, ldin(6) + DM, 1, 1, 0);
                SEAM(pb + 10);
            }
        } else {
            if (IN(pb + 7)) { PH_LOCALS;
                thin_phase<1, 2>(cx, lds,  bidq, Gq, MLAT, XS, XC, XS, XC, MIX, ldin(7) + DM, 1, 2, ldin(8) + DM, 1, 4, 3);
                SEAM(pb + 7);
            }
            if (IN(pb + 8)) { PH_LOCALS; moe_gather(cx,  bidq, Gq); SEAM(pb + 8); }
            if (IN(pb + 9) || IN(pb + 10)) { PH_LOCALS;
                if (((wv << 6) | lane_v()) == 0) { const unsigned* cnt = (const unsigned*)(wsq + WS_CTL) + CW_CNT; int run = 0;
                    for (int e = 0; e < 8; ++e) { const int t = (int)((cnt[e * 64] + 255u) >> 8); MISC[16 + e] = (unsigned)t; MISC[24 + e] = (unsigned)run; run += t; } }
                __syncthreads();
            }
            if (IN(pb + 9)) { PH_LOCALS;
                pg8::Gemm g{(const bf16*)(wsq + WS_U), (const bf16*)(wsq + WS_MGU), MOE_ROWS, 2 * FE, DM};
                pg8::MoeOrder S{(const LAS int*)(lds + LDS_STAGE + 64), (2 * FE) / 256, Gq, bidq};
                pg8::EpiSwiGLU E{HID, FE, (2 * FE) / 256};
                pg8::gemm_phase<pg8::EpiSwiGLU, pg8::MoeOrder>(lds, g, S, E, nullptr, (wv << 6) | lane_v());
                SEAM(pb + 9);
            }
            if (IN(pb + 10)) { PH_LOCALS;
                pg8::Gemm g{HID, (const bf16*)(wsq + WS_MD), MOE_ROWS, DM, FE};
                pg8::MoeOrder S{(const LAS int*)(lds + LDS_STAGE + 64), DM / 256, Gq, bidq};
                pg8::EpiBf16P E{(bf16*)(wsq + WS_MIX), DM, DM / 256};
                pg8::gemm_phase<pg8::EpiBf16P, pg8::MoeOrder>(lds, g, S, E, nullptr, (wv << 6) | lane_v());
                SEAM(pb + 10);
            }
            if (IN(pb + 11)) { PH_LOCALS;
                thin_phase<2, 0>(cx, lds,  bidq, Gq, MLAT, XS, XC, XS, XC, nullptr, ldin(9) + DM, 1, 5, nullptr, 0, 0, 0);
            }
        }
    }
#undef IN
#undef SEAM
}

extern "C" void kernel_launch(void* const* d_in, const int* in_sizes, int n_in, void* d_out, int out_size, void* d_ws, size_t ws_size, hipStream_t stream) {
    static int grid = 0;
    if (grid == 0) {
        if (n_in != 38 || out_size != MLAT * DM || ws_size < WS_END) { fprintf(stderr, "kernel_launch: unexpected shapes (n_in %d out %d ws %zu need %zu)\n", n_in, out_size, ws_size, (size_t)WS_END); grid = -1; return; }
        int dev = 0, cus = 0, per_cu = 0;
        if (hipGetDevice(&dev) != hipSuccess || hipDeviceGetAttribute(&cus, hipDeviceAttributeMultiprocessorCount, dev) != hipSuccess) { grid = -1; return; }
        if (hipFuncSetAttribute((const void*)fwd, hipFuncAttributeMaxDynamicSharedMemorySize, LDS_BYTES) != hipSuccess) { fprintf(stderr, "kernel_launch: hipFuncSetAttribute failed\n"); grid = -1; return; }
        if (hipOccupancyMaxActiveBlocksPerMultiprocessor(&per_cu, (const void*)fwd, NT, LDS_BYTES) != hipSuccess || per_cu < 1) { fprintf(stderr, "kernel_launch: occupancy query says %d\n", per_cu); per_cu = 1; }
        (void)hipGetLastError();
        grid = cus;
    }
    if (grid < 0) return;
    if (hipMemsetAsync((char*)d_ws + WS_CTL, 0, CTL_BYTES, stream) != hipSuccess) return;
    Args a{};
    for (int i = 0; i < 38; ++i) a.in[i] = (const float*)d_in[i];
    a.out = (float*)d_out; a.ws = (unsigned char*)d_ws;
#if MK_PER_PHASE
    for (int p = 0; p < N_PHASES; ++p) { a.ph_lo = p; a.ph_hi = p + 1; hipLaunchKernelGGL(fwd, dim3(grid), dim3(NT), LDS_BYTES, stream, a); }
#else
    a.ph_lo = 0; a.ph_hi = N_PHASES; hipLaunchKernelGGL(fwd, dim3(grid), dim3(NT), LDS_BYTES, stream, a);
#endif
}
```

```cpp
#include <hip/hip_runtime.h>
#include <cstdio>
#include <cstdint>

#ifndef MK_PER_PHASE
#define MK_PER_PHASE 0
#endif

#define GAS __attribute__((address_space(1)))
#define LAS __attribute__((address_space(3)))
typedef GAS unsigned gu32;
typedef GAS unsigned long long gu64;

__device__ __forceinline__ int opq(int x) { asm volatile("" : "+v"(x)); return x; }
template <class T> __device__ __forceinline__ T* opqp(T* p) { int z = 0; asm volatile("" : "+s"(z)); return (T*)((unsigned char*)p + z); }
__device__ __forceinline__ int opqs(int x) { asm volatile("" : "+s"(x)); return x; }

__device__ __forceinline__ int lane_v() { int l; asm volatile("v_mbcnt_lo_u32_b32 %0, -1, 0\n\tv_mbcnt_hi_u32_b32 %0, -1, %0" : "=v"(l)); return l; }

namespace pg8 {
#define PG8_LAS __attribute__((address_space(3)))
typedef unsigned short bf16_t;
typedef short bf16x8 __attribute__((ext_vector_type(8)));
typedef float f32x4 __attribute__((ext_vector_type(4)));
typedef unsigned u32x4 __attribute__((ext_vector_type(4)));
typedef int i32x4 __attribute__((ext_vector_type(4)));
typedef int i32x8 __attribute__((ext_vector_type(8)));
constexpr int BM = 256, BK = 64, HALF = 128, HTB = HALF * BK * 2  , STAGE_BYTES = 8 * HTB, NXCD = 8, WGM = 8;

__host__ __device__ __forceinline__ int lds_byte(int r, int c) { const int st = (r >> 4) * 2 + (c >> 5), rr = r & 15, cc = c & 31, ob = rr * 64 + cc * 2; return st * 1024 + (ob ^ (((ob >> 9) & 1) << 5)); }
__host__ __device__ __forceinline__ void stage_rc(int b, int& R, int& C) { const int st = b / 1024, sb = b % 1024, swz = sb ^ (((sb >> 9) & 1) << 5); R = (st >> 1) * 16 + swz / 64; C = (st & 1) * 32 + (swz % 64) / 2; }
__host__ __device__ __forceinline__ int perm32(int rho) { const int n = rho >> 4, i = rho & 15; return 8 * (i >> 2) + 4 * n + (i & 3); }

struct Unit { int pm, pn; };
struct Gemm { const bf16_t* A; const bf16_t* Bt; int M, N, K; };

struct StaticOrder {
    int nM, nN, nwg, G, c;
    __host__ __device__ void init(int M, int N, int G_, int c_) { nM = M / BM; nN = N / BM; nwg = nM * nN; G = G_; c = c_; }
    __host__ __device__ bool next(int i, Unit& u) const {
        const long L = (long)i * G + c; if (L >= nwg) return false;
        int wgid = (int)L; { const int q = nwg / NXCD, r = nwg % NXCD, xcd = wgid % NXCD, off = wgid / NXCD; wgid = (xcd < r ? xcd * (q + 1) : r * (q + 1) + (xcd - r) * q) + off; }
        const int nig = WGM * nN, gid = wgid / nig, fm = gid * WGM, gsz = (nM - fm) < WGM ? (nM - fm) : WGM;
        u.pm = fm + ((wgid % nig) % gsz); u.pn = (wgid % nig) / gsz; return true;
    }
    __device__ __forceinline__ void a_ready(const Unit&) const {}
    __device__ __forceinline__ void done(const Unit&) const {}
};
__device__ __forceinline__ unsigned cvt_pk_bf16(float lo, float hi) { unsigned r; asm volatile("v_cvt_pk_bf16_f32 %0, %1, %2" : "=v"(r) : "v"(lo), "v"(hi)); return r; }
struct EpiF32 {
    static constexpr bool PERM = false, AFTER_DRAIN = false;
    float* C; int ldc; const float* bias;
    __device__ __forceinline__ void operator()(const f32x4 (&acc)[2][2][4][2], const Unit& u, int wr, int wc, int fr, int fq) const {
        const int row0 = u.pm * BM + wr * 64 + fr, col0 = u.pn * BM + wc * 32 + 4 * fq;
        f32x4 bv[2][2];
#pragma unroll
        for (int bj = 0; bj < 2; ++bj)
#pragma unroll
            for (int n = 0; n < 2; ++n) bv[bj][n] = bias ? *(const f32x4*)(bias + col0 + bj * HALF + n * 16) : (f32x4){0.f, 0.f, 0.f, 0.f};
#pragma unroll
        for (int ai = 0; ai < 2; ++ai)
#pragma unroll
            for (int m = 0; m < 4; ++m) { float* rowp = C + (size_t)(row0 + ai * HALF + m * 16) * ldc + col0;
#pragma unroll
                for (int bj = 0; bj < 2; ++bj)
#pragma unroll
                    for (int n = 0; n < 2; ++n) *(f32x4*)(rowp + bj * HALF + n * 16) = acc[ai][bj][m][n] + bv[bj][n]; }
    }
};

__device__ __forceinline__ float fsilu(float x) { return x * __builtin_amdgcn_rcpf(1.0f + __expf(-x)); }
__device__ __forceinline__ float fsigm(float x) { return __builtin_amdgcn_rcpf(1.0f + __expf(-x)); }

struct MoeOrder {
    const PG8_LAS int* tab; int nN, G, c;
    __device__ __forceinline__ bool next(int i, Unit& u) const {
        long L = (long)i * G + c;
#pragma unroll
        for (int e = 0; e < 8; ++e) { const int te = tab[e]; const long n = (long)te * nN; if (L < n) { u.pn = e * nN + (int)(L / te); u.pm = tab[8 + e] + (int)(L % te); return true; } L -= n; }
        return false;
    }
    __device__ __forceinline__ void a_ready(const Unit&) const {}
    __device__ __forceinline__ void done(const Unit&) const {}
};

struct EpiBf16P {
    static constexpr bool PERM = true, AFTER_DRAIN = false;
    bf16_t* O; int ldc; int nN; float scale;
    __device__ __forceinline__ void operator()(const f32x4 (&acc)[2][2][4][2], const Unit& u, int wr, int wc, int fr, int fq) const {
        const int row0 = u.pm * BM + wr * 64 + fr; const int pnr = nN ? (u.pn % nN) : u.pn; const int col0 = pnr * BM + wc * 32 + 8 * fq;
#pragma unroll
        for (int ai = 0; ai < 2; ++ai)
#pragma unroll
            for (int m = 0; m < 4; ++m) { bf16_t* rowp = O + (size_t)(row0 + ai * HALF + m * 16) * ldc + col0;
#pragma unroll
                for (int bj = 0; bj < 2; ++bj) { const f32x4 v0 = acc[ai][bj][m][0] * scale, v1 = acc[ai][bj][m][1] * scale;
                    u32x4 w; w.x = cvt_pk_bf16(v0[0], v0[1]); w.y = cvt_pk_bf16(v0[2], v0[3]); w.z = cvt_pk_bf16(v1[0], v1[1]); w.w = cvt_pk_bf16(v1[2], v1[3]);
                    *(u32x4*)(rowp + bj * HALF) = w; } }
    }
};

struct EpiSwiGLU {
    static constexpr bool PERM = true, AFTER_DRAIN = false;
    bf16_t* O; int ldc; int nN;
    __device__ __forceinline__ void operator()(const f32x4 (&acc)[2][2][4][2], const Unit& u, int wr, int wc, int fr, int fq) const {
        const int row0 = u.pm * BM + wr * 64 + fr; const int pnr = nN ? (u.pn % nN) : u.pn; const int col0 = pnr * HALF + wc * 32 + 8 * fq;
#pragma unroll
        for (int ai = 0; ai < 2; ++ai)
#pragma unroll
            for (int m = 0; m < 4; ++m) { bf16_t* rowp = O + (size_t)(row0 + ai * HALF + m * 16) * ldc + col0;
                const f32x4 g0 = acc[ai][0][m][0], g1 = acc[ai][0][m][1], u0 = acc[ai][1][m][0], u1 = acc[ai][1][m][1];
                f32x4 v0, v1;
#pragma unroll
                for (int j = 0; j < 4; ++j) { v0[j] = fsilu(g0[j]) * u0[j]; v1[j] = fsilu(g1[j]) * u1[j]; }
                u32x4 w; w.x = cvt_pk_bf16(v0[0], v0[1]); w.y = cvt_pk_bf16(v0[2], v0[3]); w.z = cvt_pk_bf16(v1[0], v1[1]); w.w = cvt_pk_bf16(v1[2], v1[3]);
                *(u32x4*)rowp = w; }
    }
};


__device__ __forceinline__ float clamp8(float x) { return fminf(fmaxf(x, -448.0f), 448.0f); }
__device__ __forceinline__ unsigned pk_fp8x4(float a, float b, float c, float d) { int w = __builtin_amdgcn_cvt_pk_fp8_f32(clamp8(a), clamp8(b), 0, false); w = __builtin_amdgcn_cvt_pk_fp8_f32(clamp8(c), clamp8(d), w, true); return (unsigned)w; }
struct EpiSwiGLU8 {
    static constexpr bool PERM = true, AFTER_DRAIN = false;
    unsigned char* O; int ldc; int nN; float sin, sout;
    __device__ __forceinline__ void operator()(const f32x4 (&acc)[2][2][4][2], const Unit& u, int wr, int wc, int fr, int fq) const {
        const int row0 = u.pm * BM + wr * 64 + fr; const int pnr = nN ? (u.pn % nN) : u.pn; const int col0 = pnr * HALF + wc * 32 + 8 * fq;
#pragma unroll
        for (int ai = 0; ai < 2; ++ai)
#pragma unroll
            for (int m = 0; m < 4; ++m) { unsigned char* rowp = O + (size_t)(row0 + ai * HALF + m * 16) * ldc + col0;
                const f32x4 g0 = acc[ai][0][m][0] * sin, g1 = acc[ai][0][m][1] * sin, u0 = acc[ai][1][m][0] * (sin * sout), u1 = acc[ai][1][m][1] * (sin * sout);
                f32x4 v0, v1;
#pragma unroll
                for (int j = 0; j < 4; ++j) { v0[j] = fsilu(g0[j]) * u0[j]; v1[j] = fsilu(g1[j]) * u1[j]; }
                uint2 w; w.x = pk_fp8x4(v0[0], v0[1], v0[2], v0[3]); w.y = pk_fp8x4(v1[0], v1[1], v1[2], v1[3]);
                *(uint2*)rowp = w; }
    }
};


struct EpiF32S {
    static constexpr bool PERM = false, AFTER_DRAIN = false;
    float* C; int ldc; float scale;
    __device__ __forceinline__ void operator()(const f32x4 (&acc)[2][2][4][2], const Unit& u, int wr, int wc, int fr, int fq) const {
        const int row0 = u.pm * BM + wr * 64 + fr, col0 = u.pn * BM + wc * 32 + 4 * fq;
#pragma unroll
        for (int ai = 0; ai < 2; ++ai)
#pragma unroll
            for (int m = 0; m < 4; ++m) { float* rowp = C + (size_t)(row0 + ai * HALF + m * 16) * ldc + col0;
#pragma unroll
                for (int bj = 0; bj < 2; ++bj)
#pragma unroll
                    for (int n = 0; n < 2; ++n) *(f32x4*)(rowp + bj * HALF + n * 16) = acc[ai][bj][m][n] * scale; }
    }
};

template <class Epi, class Sched, bool STAMP = false, bool F8 = false>
__device__ __forceinline__ void gemm_phase(PG8_LAS unsigned char* lds, const Gemm g, const Sched& S, const Epi& E, unsigned long long* stamps, const int tid_in) {
    const int tid = opq(tid_in), wid = __builtin_amdgcn_readfirstlane(tid >> 6), lane = tid & 63, wr = wid >> 2, wc = wid & 3, fr = lane & 15, fq = lane >> 4;
    const int K = g.K, nt = K / BK;
    int ts_lo = 0, ts_hi = 0, nts = 0; const unsigned long long rt_entry = STAMP ? (unsigned long long)wall_clock64() : 0ull;
#define PG8_STAMP() do { if (STAMP && wid == 0 && nts < 64) { const unsigned long long _c = (unsigned long long)clock64(); \
        ts_lo = (lane == nts) ? (int)(unsigned)_c : ts_lo; ts_hi = (lane == nts) ? (int)(unsigned)(_c >> 32) : ts_hi; ++nts; } } while (0)
    PG8_STAMP();
    unsigned voffA[2], voffB[2];
#pragma unroll
    for (int i = 0; i < 2; ++i) { int R, C; stage_rc(tid * 16 + i * 8192, R, C); const int Rb = Epi::PERM ? ((R & ~31) + perm32(R & 31)) : R;
        voffA[i] = (unsigned)(R * K + C) * 2u; voffB[i] = (unsigned)(Rb * K + C) * 2u; }
    const size_t kstep = (size_t)(BK * 2);
    const size_t qstep = (size_t)64 * K * 2;
    const size_t hstep = (size_t)HALF * K * 2;
    const size_t tstep = 2 * hstep;
    const unsigned ldsw = (unsigned)wid * 1024u;
    const int aoff = lds_byte(wr * 64 + fr, fq * 8), boff = lds_byte(wc * 32 + fr, fq * 8);
#define PG8_SA(b, h) (((b) * 2 + (h)) * HTB)
#define PG8_SB(b, h) ((4 + (b) * 2 + (h)) * HTB)
#define PG8_STAGE(bufoff, gbase, voff) do { _Pragma("unroll") for (int _i = 0; _i < 2; ++_i) \
        __builtin_amdgcn_global_load_lds((const unsigned*)((const char*)(gbase) + (size_t)_i * qstep + (voff)[0]), (PG8_LAS unsigned*)(lds + (bufoff) + ldsw + _i * 8192), 16, 0, 0); } while (0)
#define PG8_LDA(dst, b, h) do { _Pragma("unroll") for (int m = 0; m < 4; ++m) { if constexpr (F8) { const i32x4 lo_ = *(const PG8_LAS i32x4*)(lds + PG8_SA(b, h) + aoff + m * 2048), hi_ = *(const PG8_LAS i32x4*)(lds + PG8_SA(b, h) + aoff + m * 2048 + 1024); \
            dst##8[m] = __builtin_shufflevector(lo_, hi_, 0, 1, 2, 3, 4, 5, 6, 7); } else { _Pragma("unroll") for (int k = 0; k < 2; ++k) dst[m][k] = *(const PG8_LAS bf16x8*)(lds + PG8_SA(b, h) + aoff + m * 2048 + k * 1024); } } } while (0)
#define PG8_LDB(dst, b, h) do { _Pragma("unroll") for (int n = 0; n < 2; ++n) { if constexpr (F8) { const i32x4 lo_ = *(const PG8_LAS i32x4*)(lds + PG8_SB(b, h) + boff + n * 2048), hi_ = *(const PG8_LAS i32x4*)(lds + PG8_SB(b, h) + boff + n * 2048 + 1024); \
            dst##8[n] = __builtin_shufflevector(lo_, hi_, 0, 1, 2, 3, 4, 5, 6, 7); } else { _Pragma("unroll") for (int k = 0; k < 2; ++k) dst[n][k] = *(const PG8_LAS bf16x8*)(lds + PG8_SB(b, h) + boff + n * 2048 + k * 1024); } } } while (0)
#define PG8_MMA(ai, bj, At, Bt) do { __builtin_amdgcn_s_setprio(1); _Pragma("unroll") for (int m = 0; m < 4; ++m) _Pragma("unroll") for (int n = 0; n < 2; ++n) { \
        if constexpr (F8) {   \
            asm volatile("v_mfma_scale_f32_16x16x128_f8f6f4 %0, %1, %2, %0, %3, %3 op_sel_hi:[0,0,0]" : "+v"(acc[ai][bj][m][n]) : "v"(Bt##8[n]), "v"(At##8[m]), "v"(f8scale)); } \
        else { _Pragma("unroll") for (int k = 0; k < 2; ++k) acc[ai][bj][m][n] = __builtin_amdgcn_mfma_f32_16x16x32_bf16(Bt[n][k], At[m][k], acc[ai][bj][m][n], 0, 0, 0); } } \
        __builtin_amdgcn_s_setprio(0); } while (0)
#define PG8_WAIT_V(n) asm volatile("s_waitcnt vmcnt(" #n ")" ::: "memory")
#define PG8_WAIT_L(n) asm volatile("s_waitcnt lgkmcnt(" #n ")" ::: "memory")
#define PG8_BAR __builtin_amdgcn_s_barrier()
#define PG8_SCHED __builtin_amdgcn_sched_barrier(0)
    float zf_ = 0.f; asm volatile("" : "+v"(zf_));
    Unit cur, nxt; int ui = 0;
    if (!S.next(0, cur)) return;
    f32x4 acc[2][2][4][2];
#pragma unroll
    for (int a = 0; a < 2; ++a)
#pragma unroll
        for (int b = 0; b < 2; ++b)
#pragma unroll
            for (int m = 0; m < 4; ++m)
#pragma unroll
                for (int n = 0; n < 2; ++n) acc[a][b][m][n] = (f32x4){zf_, zf_, zf_, zf_};
    int f8scale = 0x7F7F7F7F; asm volatile("" : "+v"(f8scale));
    bf16x8 At[4][2], B0[2][2], B1[2][2]; i32x8 At8[4], B08[2], B18[2]; (void)At; (void)B0; (void)B1; (void)At8; (void)B08; (void)B18;
    const char* cA = (const char*)g.A + (size_t)cur.pm * tstep; const char* cB = (const char*)g.Bt + (size_t)cur.pn * tstep;
    S.a_ready(cur);
    PG8_STAGE(PG8_SB(0, 0), cB, voffB); PG8_STAGE(PG8_SA(0, 0), cA, voffA); PG8_STAGE(PG8_SB(0, 1), cB + hstep, voffB); PG8_STAGE(PG8_SA(0, 1), cA + hstep, voffA);
    if (wr == 1) PG8_BAR;
    PG8_WAIT_V(4); PG8_BAR;
    PG8_STAGE(PG8_SB(1, 0), cB + kstep, voffB); PG8_STAGE(PG8_SA(1, 0), cA + kstep, voffA); PG8_STAGE(PG8_SB(1, 1), cB + hstep + kstep, voffB);
    PG8_WAIT_V(6); PG8_BAR;
    PG8_STAMP();
    for (;;) {
        const bool has_next = S.next(ui + 1, nxt);
        const char* nA = has_next ? (const char*)g.A + (size_t)nxt.pm * tstep : cA; const char* nB = has_next ? (const char*)g.Bt + (size_t)nxt.pn * tstep : cB;
        for (int t = 0; t < nt; t += 2) {
            const bool last = (t == nt - 2);
            const char* a1 = cA + (size_t)(t + 1) * kstep;
            const char* a2 = last ? nA : cA + (size_t)(t + 2) * kstep; const char* b2 = last ? nB : cB + (size_t)(t + 2) * kstep;
            const char* a3 = a2 + kstep; const char* b3 = b2 + kstep;
            if (last && has_next) S.a_ready(nxt);
            PG8_LDB(B0, 0, 0); PG8_SCHED; PG8_LDA(At, 0, 0); PG8_STAGE(PG8_SA(1, 1), a1 + hstep, voffA);
            PG8_WAIT_L(8); PG8_BAR; PG8_WAIT_L(0); PG8_MMA(0, 0, At, B0); PG8_BAR; PG8_SCHED;
            PG8_LDB(B1, 0, 1); PG8_STAGE(PG8_SB(0, 0), b2, voffB);
            PG8_BAR; PG8_WAIT_L(0); PG8_MMA(0, 1, At, B1); PG8_BAR;
            PG8_LDA(At, 0, 1); PG8_STAGE(PG8_SA(0, 0), a2, voffA);
            PG8_BAR; PG8_WAIT_L(0); PG8_MMA(1, 0, At, B0); PG8_BAR; PG8_SCHED;
            PG8_STAGE(PG8_SB(0, 1), b2 + hstep, voffB);
            PG8_WAIT_V(6); PG8_BAR; PG8_MMA(1, 1, At, B1); PG8_BAR;
            PG8_LDB(B0, 1, 0); PG8_SCHED; PG8_LDA(At, 1, 0); PG8_STAGE(PG8_SA(0, 1), a2 + hstep, voffA);
            PG8_WAIT_L(8); PG8_BAR; PG8_WAIT_L(0); PG8_MMA(0, 0, At, B0); PG8_BAR; PG8_SCHED;
            PG8_LDB(B1, 1, 1); PG8_STAGE(PG8_SB(1, 0), b3, voffB);
            PG8_BAR; PG8_WAIT_L(0); PG8_MMA(0, 1, At, B1); PG8_BAR;
            PG8_LDA(At, 1, 1); PG8_STAGE(PG8_SA(1, 0), a3, voffA);
            PG8_BAR; PG8_WAIT_L(0); PG8_MMA(1, 0, At, B0); PG8_BAR; PG8_SCHED;
            PG8_STAGE(PG8_SB(1, 1), b3 + hstep, voffB);
            PG8_WAIT_V(6); PG8_BAR; PG8_MMA(1, 1, At, B1); PG8_BAR;
        }
        PG8_STAMP();
        if constexpr (F8) { asm volatile("s_nop 15\n\ts_nop 15" ::: "memory"); }
        if constexpr (!Epi::AFTER_DRAIN) { E(acc, cur, wr, wc, fr, fq); S.done(cur); }
        PG8_STAMP();
        if (!has_next) break;
#pragma unroll
        for (int a = 0; a < 2; ++a)
#pragma unroll
            for (int b = 0; b < 2; ++b)
#pragma unroll
                for (int m = 0; m < 4; ++m)
#pragma unroll
                    for (int n = 0; n < 2; ++n) acc[a][b][m][n] = (f32x4){zf_, zf_, zf_, zf_};
        cur = nxt; cA = nA; cB = nB; ++ui;
    }
    PG8_WAIT_V(0);
    if (wr == 0) PG8_BAR;
    PG8_BAR;
    if constexpr (Epi::AFTER_DRAIN) { E.fused(acc, cur, wr, wc, fr, fq, lds, wid, lane); S.done(cur); }
    PG8_STAMP();
    if (STAMP && wid == 0) { stamps[lane] = lane < nts ? (((unsigned long long)(unsigned)ts_hi << 32) | (unsigned)ts_lo) : 0ull;
        if (lane == 62) stamps[62] = rt_entry; if (lane == 63) stamps[63] = (unsigned long long)wall_clock64(); }
#undef PG8_STAMP
#undef PG8_SA
#undef PG8_SB
#undef PG8_STAGE
#undef PG8_LDA
#undef PG8_LDB
#undef PG8_MMA
#undef PG8_WAIT_V
#undef PG8_WAIT_L
#undef PG8_BAR
#undef PG8_SCHED
}
}
#define RLX_AGENT __ATOMIC_RELAXED, __HIP_MEMORY_SCOPE_AGENT
#define XB_TMO      128
#define XB_XCNT(j)  (256  + 64 * (j))
#define XB_XSUB(j)  (1280 + 64 * (j))
#define XB_XGEN(j)  (2304 + 64 * (j))
#define XB_TOP      3328
#define XB_TOPGEN   3392
#define XCD_BAR_WORDS 3456
#define XB_SPIN_CAP (1u << 18)

__device__ __forceinline__ unsigned xb_ld(unsigned* p)              { return __hip_atomic_load(p, __ATOMIC_RELAXED, __HIP_MEMORY_SCOPE_AGENT); }
__device__ __forceinline__ unsigned xb_add(unsigned* p, unsigned v) { return __hip_atomic_fetch_add(p, v, __ATOMIC_RELAXED, __HIP_MEMORY_SCOPE_AGENT); }
__device__ __forceinline__ unsigned xb_xcc_id() { return (unsigned)__builtin_amdgcn_s_getreg((3 << 11) | 20) & 0xFu; }
#define XB_SPIN(cond, bar) do { unsigned _sp = 0; while (cond) { __builtin_amdgcn_s_sleep(1); \
    if ((++_sp & 255u) == 0u) { if (xb_ld(&(bar)[XB_TMO])) break; if (_sp > XB_SPIN_CAP) { atomicAdd(&(bar)[XB_TMO], 1u); break; } } } } while (0)

struct XcdBarrier {
    unsigned* bar; unsigned x; int wv;
    volatile LAS unsigned* st;
};

__device__ __forceinline__ XcdBarrier xcd_barrier_post(unsigned* bar, volatile LAS unsigned* st) {
    XcdBarrier b; b.bar = bar; b.x = xb_xcc_id(); b.st = st; b.wv = __builtin_amdgcn_readfirstlane((int)threadIdx.x >> 6);
    if (threadIdx.x == 0) (void)xb_add(&bar[XB_XCNT(b.x)], 1u);
    return b;
}
__device__ __forceinline__ void xcd_barrier_complete(unsigned* bar, unsigned x, unsigned& nloc, unsigned& nx) {
    const unsigned G = gridDim.x * gridDim.y * gridDim.z;
    unsigned sum, cnt, mine, sp = 0u;
    for (;;) {
        sum = 0u; cnt = 0u; mine = 0u;
#pragma unroll
        for (unsigned j = 0; j < 16; ++j) { const unsigned c = xb_ld(&bar[XB_XCNT(j)]); sum += c; cnt += (c > 0u) ? 1u : 0u; mine = (j == x) ? c : mine; }
        if (sum == G) break;
        __builtin_amdgcn_s_sleep(1);
        if ((++sp & 255u) == 0u) { if (xb_ld(&bar[XB_TMO])) break; if (sp > XB_SPIN_CAP) { atomicAdd(&bar[XB_TMO], 1u); break; } }
    }
    nloc = mine > 0u ? mine : 1u; nx = cnt > 0u ? cnt : 1u;
}

__device__ __forceinline__ void xcd_barrier(const XcdBarrier& b) {
    asm volatile("s_waitcnt vmcnt(0)" ::: "memory");
    __syncthreads();
    if (((b.wv << 6) | lane_v()) == 0) {
        unsigned* bar = b.bar;
        __builtin_amdgcn_s_waitcnt(0);
        unsigned nloc = b.st[0], nx = b.st[1];
        if (nloc == 0u) { xcd_barrier_complete(bar, b.x, nloc, nx); b.st[0] = nloc; b.st[1] = nx; }
        const unsigned old = xb_add(&bar[XB_XSUB(b.x)], 1u);
        const unsigned gen = old / nloc;
        if (old + 1u == (gen + 1u) * nloc) {
            __builtin_amdgcn_fence(__ATOMIC_RELEASE, "agent");
            asm volatile("s_waitcnt vmcnt(0)" ::: "memory");
            const unsigned og = xb_add(&bar[XB_TOP], 1u);
            const unsigned tg = og / nx;
            if (og + 1u == (tg + 1u) * nx) xb_add(&bar[XB_TOPGEN], 1u);
            else XB_SPIN(xb_ld(&bar[XB_TOPGEN]) == tg, bar);
            __builtin_amdgcn_fence(__ATOMIC_ACQUIRE, "agent");
            xb_add(&bar[XB_XGEN(b.x)], 1u);
            asm volatile("s_waitcnt vmcnt(0)" ::: "memory");
        } else {
            XB_SPIN(xb_ld(&bar[XB_XGEN(b.x)]) == gen, bar);
            __builtin_amdgcn_fence(__ATOMIC_ACQUIRE, "agent");
            asm volatile("s_waitcnt vmcnt(0)" ::: "memory");
        }
    }
    __syncthreads();
}

typedef unsigned short bf16;
using pg8::bf16x8; using pg8::f32x4; using pg8::u32x4;
typedef unsigned u32x2 __attribute__((ext_vector_type(2)));
constexpr int NT = 512, NW = 8;
constexpr int DM = 2048, NB = 8, SEQ = 2048, CTXL = 256;
constexpr int MLAT = NB * SEQ, MCTX = NB * CTXL, MTOT = MLAT + MCTX;
constexpr int NIN = 5920, NINP = 6144;
constexpr int C_RW_R = 0, C_RW_K = 512, C_RW_V = 1024, C_RW_XW = 1536;
constexpr int C_MB_Z = 1792, C_MB_XBC = 2816, C_MB_DT = 4352;
constexpr int C_DA_Q = 4384, C_DA_V = 5408;
constexpr int FF = 5632, FE = 7168, NE = 8;
constexpr int MOE_ROWS = 34816;
constexpr int LDS_STAGE = 131072, LDS_MISC = 1024, LDS_BYTES = LDS_STAGE + LDS_MISC;

#ifndef MOE_FP8
#define MOE_FP8 1
#endif
#ifndef DENSE_FP8
#define DENSE_FP8 0
#endif
constexpr float MOE_SGU = 32.0f, MOE_SD = 64.0f, MOE_SH = 4.0f;
constexpr size_t MiB = 1048576;
constexpr size_t WS_CTL   = 0;
constexpr size_t CTL_BYTES = 65536;
constexpr size_t CW_BAR = 0, CW_CNT = 4096  , CW_Q = 8192  , CW_BG = 8704  , CW_DONE = 9216  ;
constexpr size_t WS_ADA   = 1 * MiB;
constexpr size_t WS_ROPE  = 2 * MiB;
constexpr size_t WS_TOK   = 3 * MiB;
constexpr size_t WS_WIN   = 4 * MiB;
constexpr size_t WS_WOUT  = WS_WIN  + 48 * MiB;
constexpr size_t WS_WSM   = WS_WOUT + 16 * MiB;
constexpr size_t WS_WGU   = WS_WSM  + 2 * MiB;
constexpr size_t WS_WD    = WS_WGU  + 44 * MiB;
constexpr size_t WS_MGU   = WS_WD   + 22 * MiB;
constexpr size_t WS_MD    = WS_MGU  + 448 * MiB;
constexpr size_t WS_XC    = WS_MD   + 224 * MiB;
constexpr size_t WS_HA    = WS_XC   + 16 * MiB;
constexpr size_t WS_U     = WS_HA   + 72 * MiB;
constexpr size_t WS_MIX   = WS_U    + 216 * MiB;
constexpr size_t WS_BIG   = WS_MIX  + 144 * MiB;
constexpr size_t WS_XSB   = WS_BIG  + 476 * MiB;
constexpr size_t WS_END   = WS_XSB  + 64 * MiB;
constexpr size_t WS_ASM   = WS_BIG;
constexpr size_t WS_XBC   = WS_ASM  + 9 * MiB;
constexpr size_t WS_DT    = WS_XBC  + 54 * MiB;
constexpr size_t WS_QK    = WS_DT   + 5 * MiB;
constexpr size_t WS_RW5   = WS_QK   + 36 * MiB;
constexpr size_t WS_YR    = WS_RW5  + 90 * MiB;
constexpr size_t WS_YM    = WS_YR   + 72 * MiB;
constexpr size_t WS_ST    = WS_YM   + 72 * MiB;
constexpr size_t WS_AC    = WS_ST   + 72 * MiB;
static_assert(WS_AC + 1 * MiB <= WS_END, "mixer intermediates overflow BIG");
static_assert((size_t)MOE_ROWS * FE * 2 <= 476 * MiB && (size_t)MOE_ROWS * DM * 2 <= 144 * MiB, "moe buffers");

struct Args { const float* in[38]; float* out; unsigned char* ws; int ph_lo, ph_hi, sub, pad; };
struct Ctx { unsigned char* ws; int wv; int sub; };

constexpr int LDS_PTRS = LDS_STAGE + 128;
__device__ __forceinline__ const float* ldin(int k) {
    extern __shared__ __attribute__((aligned(16))) unsigned char lds_dyn[];
    const int base = opqs((int)(unsigned)(unsigned long long)(LAS unsigned char*)lds_dyn);
    const LAS unsigned* p = (const LAS unsigned*)(unsigned long long)(unsigned)(base + LDS_PTRS + 8 * k);
    const unsigned lo = __builtin_amdgcn_readfirstlane(p[0]), hi = __builtin_amdgcn_readfirstlane(p[1]);
    return (const float*)(const GAS float*)(((unsigned long long)hi << 32) | (unsigned long long)lo);
}
__device__ __forceinline__ float bf2f(unsigned short b) { return __uint_as_float(((unsigned)b) << 16); }
typedef float f32x2_t __attribute__((ext_vector_type(2)));
typedef __bf16 bf16x2_t __attribute__((ext_vector_type(2)));
__device__ __forceinline__ unsigned pk2(float lo, float hi) { const f32x2_t v = {lo, hi}; return __builtin_bit_cast(unsigned, __builtin_convertvector(v, bf16x2_t)); }
__device__ __forceinline__ unsigned f2bf(float f) { return pk2(f, f) & 0xffffu; }
__device__ __forceinline__ void unpack8(const uint4 w, float (&f)[8]) {
    f[0] = __uint_as_float(w.x << 16); f[1] = __uint_as_float(w.x & 0xffff0000u); f[2] = __uint_as_float(w.y << 16); f[3] = __uint_as_float(w.y & 0xffff0000u);
    f[4] = __uint_as_float(w.z << 16); f[5] = __uint_as_float(w.z & 0xffff0000u); f[6] = __uint_as_float(w.w << 16); f[7] = __uint_as_float(w.w & 0xffff0000u); }
__device__ __forceinline__ uint4 pack8(const float (&f)[8]) { uint4 w; w.x = pk2(f[0], f[1]); w.y = pk2(f[2], f[3]); w.z = pk2(f[4], f[5]); w.w = pk2(f[6], f[7]); return w; }
__device__ __forceinline__ void unpack4(const uint2 w, float (&f)[4]) {
    f[0] = __uint_as_float(w.x << 16); f[1] = __uint_as_float(w.x & 0xffff0000u); f[2] = __uint_as_float(w.y << 16); f[3] = __uint_as_float(w.y & 0xffff0000u); }
template <int CTRL> __device__ __forceinline__ float dppf(float v) { return __int_as_float(__builtin_amdgcn_update_dpp(0, __float_as_int(v), CTRL, 0xf, 0xf, false)); }
__device__ __forceinline__ float red8(float v)  { v += dppf<0xB1>(v); v += dppf<0x4E>(v); v += dppf<0x141>(v); return v; }
__device__ __forceinline__ float red16(float v) { v += dppf<0xB1>(v); v += dppf<0x4E>(v); v += dppf<0x141>(v); v += dppf<0x140>(v); return v; }
__device__ __forceinline__ float swz16(float v) { return __int_as_float(__builtin_amdgcn_ds_swizzle(__float_as_int(v), 0x401F)); }
__device__ __forceinline__ float red32(float v) { v = red16(v); v += swz16(v); return v; }
__device__ __forceinline__ float wsum(float v) { v = red32(v); return __int_as_float(__builtin_amdgcn_readlane(__float_as_int(v), 0)) + __int_as_float(__builtin_amdgcn_readlane(__float_as_int(v), 32)); }
__device__ __forceinline__ float shx32(float v, int lane) { return __int_as_float(__builtin_amdgcn_ds_bpermute((lane ^ 32) << 2, __float_as_int(v))); }
__device__ __forceinline__ float fsilu(float x) { return pg8::fsilu(x); }
__device__ __forceinline__ float fsigm(float x) { return pg8::fsigm(x); }
__device__ __forceinline__ float softplusf(float x) { return fmaxf(x, 0.f) + log1pf(__expf(-fabsf(x))); }


template <bool F8>
__device__ __forceinline__ void cvt_job_t(const float* __restrict__ src, int ld, int ncols_valid, int ncols_total, void* __restrict__ dstv, int K, int mode, float scale, LAS float* tile, int bid, int G, const int tid, int t_end = 0x7fffffff) {
    const int ntn = ncols_total >> 6, ntk = K >> 7; const int nt = (ntn * ntk) < t_end ? (ntn * ntk) : t_end;
    const int lk = tid >> 4, lc = (tid & 15) * 4;
    constexpr int TP = 65;
    float4 r[4]; int buf = 0;
    const float4 z4 = make_float4(0.f, 0.f, 0.f, 0.f);
#define CVT_LOAD(t_, dst_) do { const int tn_ = (t_) % ntn, tk_ = (t_) / ntn; const int n_ = tn_ * 64 + lc; const float* p_ = src + (size_t)(tk_ * 128 + lk) * ld + n_; \
        _Pragma("unroll") for (int i_ = 0; i_ < 4; ++i_) dst_[i_] = (n_ < ncols_valid) ? *(const float4*)(p_ + (size_t)(32 * i_) * ld) : z4; } while (0)
    int t = bid;
    if (t < nt) CVT_LOAD(t, r);
    __syncthreads();
    for (; t < nt; t += G) {
        float4 nx[4] = {z4, z4, z4, z4};
        if (t + G < nt) CVT_LOAD(t + G, nx);
        LAS float* tl = tile + buf * (128 * TP);
#pragma unroll
        for (int i = 0; i < 4; ++i) { LAS float* q = tl + (lk + 32 * i) * TP + lc; q[0] = r[i].x; q[1] = r[i].y; q[2] = r[i].z; q[3] = r[i].w; }
        __syncthreads();
        const int tn = t % ntn, tk = t / ntn, k0 = tk * 128, nb = tn * 64;
        const int kq = tid & 7, nl = tid >> 3, nn = nb + nl;
        const int drow = mode == 0 ? nn : ((nn >> 7) * 256 + (nn & 127) + (mode == 2 ? 128 : 0));
        const LAS float* c = tl + (kq * 16) * TP + nl;
        if (F8) {
            uint4 w;
            w.x = pg8::pk_fp8x4(c[0 * TP] * scale, c[1 * TP] * scale, c[2 * TP] * scale, c[3 * TP] * scale); w.y = pg8::pk_fp8x4(c[4 * TP] * scale, c[5 * TP] * scale, c[6 * TP] * scale, c[7 * TP] * scale);
            w.z = pg8::pk_fp8x4(c[8 * TP] * scale, c[9 * TP] * scale, c[10 * TP] * scale, c[11 * TP] * scale); w.w = pg8::pk_fp8x4(c[12 * TP] * scale, c[13 * TP] * scale, c[14 * TP] * scale, c[15 * TP] * scale);
            *(uint4*)((unsigned char*)dstv + (size_t)drow * K + k0 + kq * 16) = w;
        } else {
            uint4 w0, w1;
            w0.x = pk2(c[0 * TP], c[1 * TP]); w0.y = pk2(c[2 * TP], c[3 * TP]); w0.z = pk2(c[4 * TP], c[5 * TP]); w0.w = pk2(c[6 * TP], c[7 * TP]);
            w1.x = pk2(c[8 * TP], c[9 * TP]); w1.y = pk2(c[10 * TP], c[11 * TP]); w1.z = pk2(c[12 * TP], c[13 * TP]); w1.w = pk2(c[14 * TP], c[15 * TP]);
            uint4* q = (uint4*)((bf16*)dstv + (size_t)drow * K + k0 + kq * 16); q[0] = w0; q[1] = w1;
        }
#pragma unroll
        for (int i = 0; i < 4; ++i) r[i] = nx[i];
        buf ^= 1;
    }
#undef CVT_LOAD
}
__device__ __forceinline__ void cvt_job_f8(const float* __restrict__ src, int ld, int ncols, unsigned char* __restrict__ dst, int K, int mode, float scale, LAS unsigned char* tile, int t_begin, int t_end, const int tid) {
    const int ntn = ncols >> 6;
    const int q = tid >> 4, i4 = tid & 15;
    constexpr int TP = 144;
    float4 r[4]; int buf = 0;
#define CVT8_LOAD(t_, dst_) do { const int tn_ = (t_) % ntn, tk_ = (t_) / ntn; const float* p_ = src + (size_t)(tk_ * 128 + 4 * q) * ld + tn_ * 64 + 4 * i4; \
        _Pragma("unroll") for (int j_ = 0; j_ < 4; ++j_) dst_[j_] = *(const float4*)(p_ + (size_t)j_ * ld); } while (0)
    int t = t_begin;
    if (t < t_end) CVT8_LOAD(t, r);
    __syncthreads();
    for (; t < t_end; ++t) {
        float4 nx[4];
#pragma unroll
        for (int j = 0; j < 4; ++j) nx[j] = r[j];
        if (t + 1 < t_end) CVT8_LOAD(t + 1, nx);
        unsigned w[4];
#pragma unroll
        for (int j = 0; j < 4; ++j) w[j] = pg8::pk_fp8x4(r[j].x * scale, r[j].y * scale, r[j].z * scale, r[j].w * scale);
        const unsigned a_lo = __builtin_amdgcn_perm(w[1], w[0], 0x05010400u), a_hi = __builtin_amdgcn_perm(w[1], w[0], 0x07030602u);
        const unsigned b_lo = __builtin_amdgcn_perm(w[3], w[2], 0x05010400u), b_hi = __builtin_amdgcn_perm(w[3], w[2], 0x07030602u);
        unsigned o[4];
        o[0] = __builtin_amdgcn_perm(b_lo, a_lo, 0x05040100u); o[1] = __builtin_amdgcn_perm(b_lo, a_lo, 0x07060302u);
        o[2] = __builtin_amdgcn_perm(b_hi, a_hi, 0x05040100u); o[3] = __builtin_amdgcn_perm(b_hi, a_hi, 0x07060302u);
        LAS unsigned char* tl = tile + buf * (64 * TP);
        const int cw = ((q >> 2) ^ (i4 & 7)) * 16 + (q & 3) * 4;
#pragma unroll
        for (int m = 0; m < 4; ++m) *(LAS unsigned*)(tl + (4 * i4 + m) * TP + cw) = o[m];
        __syncthreads();
        const int tn = t % ntn, tk = t / ntn, k0 = tk * 128, nb = tn * 64;
        const int kq = tid & 7, nl = tid >> 3, nn = nb + nl;
        const int drow = mode == 0 ? nn : ((nn >> 7) * 256 + (nn & 127) + (mode == 2 ? 128 : 0));
        const u32x4 v = *(const LAS u32x4*)(tl + nl * TP + ((kq ^ ((nl >> 2) & 7)) * 16));
        *(uint4*)(dst + (size_t)drow * K + k0 + kq * 16) = make_uint4(v.x, v.y, v.z, v.w);
#pragma unroll
        for (int j = 0; j < 4; ++j) r[j] = nx[j];
        buf ^= 1;
    }
#undef CVT8_LOAD
}
__device__ __forceinline__ void cvt_job8(const float* src, int ld, int ncols, unsigned char* dst, int K, int mode, float scale, LAS float* tile, int bid, int G, const int tid) { cvt_job_t<true>(src, ld, ncols, ncols, dst, K, mode, scale, tile, bid, G, tid); }
__device__ __forceinline__ void cvt_job(const float* src, int ld, int ncols_valid, int ncols_total, bf16* dst, int K, int mode, LAS float* tile, int bid, int G, const int tid) { cvt_job_t<false>(src, ld, ncols_valid, ncols_total, dst, K, mode, 1.0f, tile, bid, G, tid); }

__device__ __forceinline__ void p0_prologue(const Ctx& a, LAS unsigned char* lds, int bid, int G) {
    unsigned char* ws = opqp(a.ws); const int tid = ((a.wv << 6) | lane_v());
    LAS float* tile = (LAS float*)lds;
    for (int l = 0; l < 2; ++l) {
        cvt_job(ldin(10) + (size_t)l * DM * NIN, NIN, NIN, NINP, (bf16*)(ws + WS_WIN) + (size_t)l * NINP * DM, DM, 0, tile, bid, G, tid);
        cvt_job(ldin(11) + (size_t)l * DM * DM, DM, DM, DM, (bf16*)(ws + WS_WOUT) + (size_t)l * DM * DM, DM, 0, tile, bid, G, tid);
    }
#if DENSE_FP8
    cvt_job8(ldin(31), FF, FF, ws + WS_WGU, DM, 1, MOE_SGU, tile, bid, G, tid);
    cvt_job8(ldin(32), FF, FF, ws + WS_WGU, DM, 2, MOE_SGU, tile, bid, G, tid);
    cvt_job8(ldin(33), DM, DM, ws + WS_WD, FF, 0, MOE_SD, tile, bid, G, tid);
#else
    cvt_job(ldin(31), FF, FF, FF, (bf16*)(ws + WS_WGU), DM, 1, tile, bid, G, tid);
    cvt_job(ldin(32), FF, FF, FF, (bf16*)(ws + WS_WGU), DM, 2, tile, bid, G, tid);
    cvt_job(ldin(33), DM, DM, DM, (bf16*)(ws + WS_WD), FF, 0, tile, bid, G, tid);
#endif
#if !MOE_FP8
    for (int e = 0; e < NE; ++e) {
        cvt_job(ldin(35) + (size_t)e * DM * FE, FE, FE, FE, (bf16*)(ws + WS_MGU) + (size_t)e * 2 * FE * DM, DM, 1, tile, bid, G, tid);
        cvt_job(ldin(36) + (size_t)e * DM * FE, FE, FE, FE, (bf16*)(ws + WS_MGU) + (size_t)e * 2 * FE * DM, DM, 2, tile, bid, G, tid);
        cvt_job(ldin(37) + (size_t)e * FE * DM, DM, DM, DM, (bf16*)(ws + WS_MD) + (size_t)e * DM * FE, FE, 0, tile, bid, G, tid);
    }
#endif
    {
        bf16* wsm = (bf16*)(ws + WS_WSM);
        for (size_t i = (size_t)bid * NT + tid; i < (size_t)2 * 2048 * 256; i += (size_t)G * NT) {
            const int l = (int)(i >> 19), n = (int)((i >> 8) & 2047), k = (int)(i & 255); float v = 0.f;
            if (n < 1024) { if (k < 64) v = ldin(14)[(((size_t)l * 2 + (n >> 9)) * 64 + k) * 512 + (n & 511)]; }
            else if (n < 1536) { if (k >= 64 && k < 128) v = ldin(16)[((size_t)l * 64 + (k - 64)) * 512 + (n - 1024)]; }
            else { if (k >= 128) v = ldin(17)[((size_t)l * 128 + (k - 128)) * 512 + (n - 1536)]; }
            wsm[i] = (bf16)f2bf(v);
        }
    }
    {
        float* rope = (float*)(ws + WS_ROPE);
        for (int i = bid * NT + tid; i < SEQ * 32; i += G * NT) {
            const int t = i >> 5, j = i & 31, half = j >> 4, f = j & 15;
            const float pos = (float)(half ? (t & 63) : (t >> 6));
            const float inv = powf(10000.0f, -(float)f / 16.0f);
            const float ang = pos * inv;
            double ad = (double)ang; const double twopi = 6.283185307179586476925; ad -= twopi * floor(ad / twopi);
            const float ar = (float)ad;
            rope[t * 64 + half * 32 + f] = cosf(ar); rope[t * 64 + half * 32 + 16 + f] = sinf(ar);
        }
    }
    {
        LAS float* sil = (LAS float*)lds;
        LAS float* red = sil + 9 * 2048;
        __syncthreads();
        for (int i = tid; i < 9 * 2048; i += NT) { const float v = i < 8 * 2048 ? ldin(1)[i] : ldin(3)[i - 8 * 2048]; sil[i] = v / (1.0f + __expf(-v)); }
        __syncthreads();
        float* ada = (float*)(ws + WS_ADA);
        for (int it = bid; it < 2 * 96; it += G) {
            const int l = it / 96, col0 = (it % 96) * 128; const int cn = tid & 127, kg = tid >> 7;
            const float* w = ldin(4) + (size_t)l * DM * 12288 + col0 + cn;
            float acc[9];
#pragma unroll
            for (int v = 0; v < 9; ++v) acc[v] = 0.f;
            for (int k = kg * 512; k < kg * 512 + 512; ++k) { const float wv = w[(size_t)k * 12288];
#pragma unroll
                for (int v = 0; v < 9; ++v) acc[v] += sil[v * 2048 + k] * wv; }
#pragma unroll
            for (int v = 0; v < 9; ++v) red[(kg * 9 + v) * 128 + cn] = acc[v];
            __syncthreads();
            if (kg == 0) {
                const float bb = ldin(5)[(size_t)l * 12288 + col0 + cn];
#pragma unroll
                for (int v = 0; v < 9; ++v) ada[((size_t)l * 9 + v) * 12288 + col0 + cn] = red[v * 128 + cn] + red[(9 + v) * 128 + cn] + red[(18 + v) * 128 + cn] + red[(27 + v) * 128 + cn] + bb;
            }
            __syncthreads();
        }
    }
}


constexpr int BG_TPJ = 1792, BG_NT = 24 * BG_TPJ, BG_B = 8;
__device__ __forceinline__ void bg_convert(const Ctx& a, LAS unsigned char* lds, unsigned* until_done, int G) {
#if MOE_FP8
    unsigned char* ws = opqp(a.ws); const int tid = ((a.wv << 6) | lane_v());
    unsigned* ctr = (unsigned*)(ws + WS_CTL) + CW_BG; volatile LAS unsigned* slot = (volatile LAS unsigned*)(lds + LDS_STAGE + 8);
    LAS float* tile = (LAS float*)lds;
    for (;;) {
        __syncthreads();
        if (tid == 0) { unsigned v = 0xffffffffu;
            if (!until_done || __hip_atomic_load(until_done, __ATOMIC_RELAXED, __HIP_MEMORY_SCOPE_AGENT) < (unsigned)G) v = __hip_atomic_fetch_add(ctr, (unsigned)BG_B, __ATOMIC_RELAXED, __HIP_MEMORY_SCOPE_AGENT);
            *slot = v; }
        __syncthreads();
        const unsigned t0 = *slot;
        if (t0 >= (unsigned)BG_NT) break;
        const int job = (int)t0 / BG_TPJ, tl = (int)t0 % BG_TPJ; const int e = job / 3, kind = job % 3;
        if (kind < 2) cvt_job_f8(ldin(35 + kind) + (size_t)e * DM * FE, FE, FE, ws + WS_MGU + (size_t)e * 2 * FE * DM, DM, 1 + kind, MOE_SGU, (LAS unsigned char*)lds, tl, tl + BG_B, tid);
        else cvt_job_f8(ldin(37) + (size_t)e * FE * DM, DM, DM, ws + WS_MD + (size_t)e * DM * FE, FE, 0, MOE_SD, (LAS unsigned char*)lds, tl, tl + BG_B, tid);
    }
    __syncthreads();
#endif
}
__device__ __forceinline__ void bg_tail(const Ctx& a, LAS unsigned char* lds, int slotid, int G) {
#if MOE_FP8
    unsigned char* ws = opqp(a.ws); const int tid = ((a.wv << 6) | lane_v());
    unsigned* done = (unsigned*)(ws + WS_CTL) + CW_DONE + slotid * 64;
    __syncthreads();
    if (tid == 0) (void)__hip_atomic_fetch_add(done, 1u, __ATOMIC_RELAXED, __HIP_MEMORY_SCOPE_AGENT);
    bg_convert(a, lds, done, G);
#endif
}

__device__ __forceinline__ void ld_row(const float* p, int lane, float (&x)[32]) {
#pragma unroll
    for (int i = 0; i < 8; ++i) { const float4 v = *(const float4*)(p + i * 256 + lane * 4); x[i * 4] = v.x; x[i * 4 + 1] = v.y; x[i * 4 + 2] = v.z; x[i * 4 + 3] = v.w; }
}
__device__ __forceinline__ void st_row(float* p, int lane, const float (&x)[32]) {
#pragma unroll
    for (int i = 0; i < 8; ++i) *(float4*)(p + i * 256 + lane * 4) = make_float4(x[i * 4], x[i * 4 + 1], x[i * 4 + 2], x[i * 4 + 3]);
}
__device__ __forceinline__ float sumsq(const float (&x)[32]) { float s = 0.f;
#pragma unroll
    for (int i = 0; i < 32; ++i) s += x[i] * x[i];
    return wsum(s); }

template <int TMODE, int HMODE, int XIN = 0, int XOUT = 0>
__device__ __forceinline__ void thin_phase(const Ctx& a, LAS unsigned char* lds, int bid, int G, int M,
                           const float* xlat, const float* xctx, float* olat, float* octx,
                           const float* T, const float* postw, int lg, int kg,
                           const float* prew, int lm, int ksc, int ksh) {
    unsigned char* ws = opqp(a.ws); const int tid = ((a.wv << 6) | lane_v()), lane = tid & 63, wid = tid >> 6;
    const float* ada = (const float*)(ws + WS_ADA);
    bf16* HA = (bf16*)(ws + WS_HA);
    LAS float* rt = (LAS float*)lds;
    if (HMODE == 2) { __syncthreads(); for (int i = tid; i < DM * NE; i += NT) rt[i] = ldin(34)[i]; __syncthreads(); }
    for (int r = bid * NW + wid; r < M; r += G * NW) {
        const int vec = r < MLAT ? r / SEQ : 8;
        float x[32];
        if (XIN == 1 && r < MLAT) { const bf16* xb = (const bf16*)xlat + (size_t)r * DM;
#pragma unroll
            for (int i = 0; i < 8; ++i) { const uint2 p1 = *(const uint2*)(xb + i * 256 + lane * 4); float f1[4]; unpack4(p1, f1); x[i * 4] = f1[0]; x[i * 4 + 1] = f1[1]; x[i * 4 + 2] = f1[2]; x[i * 4 + 3] = f1[3]; } }
        else { const float* xs = r < MLAT ? xlat + (size_t)r * DM : xctx + (size_t)(r - MLAT) * DM; ld_row(xs, lane, x); }
        if (TMODE != 0) {
            float t[32];
            if (TMODE == 1) { const bf16* tb = (const bf16*)T + (size_t)r * DM;
#pragma unroll
                for (int i = 0; i < 8; ++i) { const uint2 p1 = *(const uint2*)(tb + i * 256 + lane * 4); float f1[4]; unpack4(p1, f1); t[i * 4] = f1[0]; t[i * 4 + 1] = f1[1]; t[i * 4 + 2] = f1[2]; t[i * 4 + 3] = f1[3]; } }
            else {
                const unsigned* tok = (const unsigned*)(ws + WS_TOK) + (size_t)r * 8;
                const float w1 = __uint_as_float(tok[4]), w2 = __uint_as_float(tok[5]); const unsigned d1 = tok[6], d2 = tok[7];
                const bf16* y1 = (const bf16*)(ws + WS_MIX) + (size_t)d1 * DM; const bf16* y2 = (const bf16*)(ws + WS_MIX) + (size_t)d2 * DM;
#pragma unroll
                for (int i = 0; i < 8; ++i) { const uint2 p1 = *(const uint2*)(y1 + i * 256 + lane * 4), p2 = *(const uint2*)(y2 + i * 256 + lane * 4);
                    float f1[4], f2[4]; unpack4(p1, f1); unpack4(p2, f2);
#pragma unroll
                    for (int j = 0; j < 4; ++j) t[i * 4 + j] = w1 * f1[j] + w2 * f2[j]; }
            }
            const float rs = rsqrtf(sumsq(t) * (1.0f / DM) + 1e-6f);
            float pw[32], gg[32]; ld_row(postw, lane, pw); ld_row(ada + ((size_t)lg * 9 + vec) * 12288 + kg * DM, lane, gg);
#pragma unroll
            for (int i = 0; i < 32; ++i) x[i] += gg[i] * (t[i] * rs * pw[i]);
            if (XOUT == 1 && r < MLAT) { bf16* xd = (bf16*)olat + (size_t)r * DM;
#pragma unroll
                for (int i = 0; i < 8; ++i) { uint2 p; p.x = pk2(x[i * 4], x[i * 4 + 1]); p.y = pk2(x[i * 4 + 2], x[i * 4 + 3]); *(uint2*)(xd + i * 256 + lane * 4) = p; } }
            else { float* xd = r < MLAT ? olat + (size_t)r * DM : octx + (size_t)(r - MLAT) * DM; st_row(xd, lane, x); }
        }
        if (HMODE != 0) {
            const float rs = rsqrtf(sumsq(x) * (1.0f / DM) + 1e-6f);
            float pw[32], sc[32], sh[32]; ld_row(prew, lane, pw);
            ld_row(ada + ((size_t)lm * 9 + vec) * 12288 + ksc * DM, lane, sc); ld_row(ada + ((size_t)lm * 9 + vec) * 12288 + ksh * DM, lane, sh);
            float h[32];
#pragma unroll
            for (int i = 0; i < 32; ++i) h[i] = x[i] * rs * pw[i] * (1.0f + sc[i]) + sh[i];
            if ((HMODE == 2 && MOE_FP8) || HMODE == 3) { unsigned char* hd8 = (unsigned char*)HA + (size_t)r * DM;
#pragma unroll
                for (int i = 0; i < 8; ++i) *(unsigned*)(hd8 + i * 256 + lane * 4) = pg8::pk_fp8x4(h[i * 4], h[i * 4 + 1], h[i * 4 + 2], h[i * 4 + 3]); }
            else { bf16* hd = HA + (size_t)r * DM;
#pragma unroll
                for (int i = 0; i < 8; ++i) { uint2 p; p.x = pk2(h[i * 4], h[i * 4 + 1]); p.y = pk2(h[i * 4 + 2], h[i * 4 + 3]); *(uint2*)(hd + i * 256 + lane * 4) = p; } }
            if (HMODE == 2) {
                float lg8[8];
#pragma unroll
                for (int e = 0; e < 8; ++e) lg8[e] = 0.f;
#pragma unroll 1
                for (int i = 0; i < 8; ++i) {
                    float hv4[4];
#pragma unroll
                    for (int j = 0; j < 4; ++j) hv4[j] = 0.f;
#pragma unroll
                    for (int ii = 0; ii < 8; ++ii) if (ii == i) { hv4[0] = h[ii * 4]; hv4[1] = h[ii * 4 + 1]; hv4[2] = h[ii * 4 + 2]; hv4[3] = h[ii * 4 + 3]; }
#pragma unroll
                    for (int j = 0; j < 4; ++j) { const int c = i * 256 + lane * 4 + j; const f32x4 r0 = *(const LAS f32x4*)(rt + c * 8), r1 = *(const LAS f32x4*)(rt + c * 8 + 4); const float hv = hv4[j];
                        lg8[0] += hv * r0[0]; lg8[1] += hv * r0[1]; lg8[2] += hv * r0[2]; lg8[3] += hv * r0[3]; lg8[4] += hv * r1[0]; lg8[5] += hv * r1[1]; lg8[6] += hv * r1[2]; lg8[7] += hv * r1[3]; }
                }
#pragma unroll
                for (int e = 0; e < 8; ++e) lg8[e] = wsum(lg8[e]);
                if (lane == 0) {
                    int e1 = 0; float v1 = lg8[0];
#pragma unroll
                    for (int e = 1; e < 8; ++e) if (lg8[e] > v1) { v1 = lg8[e]; e1 = e; }
                    int e2 = -1; float v2 = -3.0e38f;
#pragma unroll
                    for (int e = 0; e < 8; ++e) if (e != e1 && lg8[e] > v2) { v2 = lg8[e]; e2 = e; }
                    const float ex = __expf(v2 - v1); const float w1 = 1.0f / (1.0f + ex), w2 = ex / (1.0f + ex);
                    unsigned* cnt = (unsigned*)(ws + WS_CTL) + CW_CNT;
                    const unsigned p1 = atomicAdd(cnt + e1 * 64, 1u), p2 = atomicAdd(cnt + e2 * 64, 1u);
                    unsigned* tok = (unsigned*)(ws + WS_TOK) + (size_t)r * 8;
                    tok[0] = (unsigned)e1; tok[1] = (unsigned)e2; tok[2] = p1; tok[3] = p2; tok[4] = __float_as_uint(w1); tok[5] = __float_as_uint(w2);
                }
            }
        }
    }
}

__device__ __forceinline__ void moe_gather(const Ctx& a, int bid, int G) {
    unsigned char* ws = opqp(a.ws); const int tid = ((a.wv << 6) | lane_v()), lane = tid & 63, wid = tid >> 6;
    const unsigned* cnt = (const unsigned*)(ws + WS_CTL) + CW_CNT;
    const bf16* HA = (const bf16*)(ws + WS_HA); bf16* AG = (bf16*)(ws + WS_U);
    for (int r = bid * NW + wid; r < MLAT; r += G * NW) {
        unsigned* tok = (unsigned*)(ws + WS_TOK) + (size_t)r * 8;
        const int e1 = (int)tok[0], e2 = (int)tok[1]; const unsigned p1 = tok[2], p2 = tok[3];
        unsigned run = 0, s1 = 0, s2 = 0;
#pragma unroll
        for (int e = 0; e < 8; ++e) { const unsigned t = (cnt[e * 64] + 255u) >> 8; if (e == e1) s1 = run; if (e == e2) s2 = run; run += t; }
        const unsigned d1 = s1 * 256u + p1, d2 = s2 * 256u + p2;
#if MOE_FP8
        const uint4* src = (const uint4*)((const unsigned char*)HA + (size_t)r * DM); uint4* q1 = (uint4*)((unsigned char*)AG + (size_t)d1 * DM); uint4* q2 = (uint4*)((unsigned char*)AG + (size_t)d2 * DM);
#pragma unroll
        for (int i = 0; i < 2; ++i) { const uint4 v = src[i * 64 + lane]; q1[i * 64 + lane] = v; q2[i * 64 + lane] = v; }
#else
        const uint4* src = (const uint4*)(HA + (size_t)r * DM); uint4* q1 = (uint4*)(AG + (size_t)d1 * DM); uint4* q2 = (uint4*)(AG + (size_t)d2 * DM);
#pragma unroll
        for (int i = 0; i < 4; ++i) { const uint4 v = src[i * 64 + lane]; q1[i * 64 + lane] = v; q2[i * 64 + lane] = v; }
#endif
        if (lane == 0) { tok[6] = d1; tok[7] = d2; }
    }
    unsigned zq = 0u; asm volatile("" : "+v"(zq));
    unsigned run = 0;
    for (int e = 0; e < 8; ++e) { const unsigned c = cnt[e * 64], t = (c + 255u) >> 8; const unsigned lo = run * 256u + c, hi = (run + t) * 256u; run += t;
        for (unsigned r = lo + bid * NW + wid; r < hi; r += G * NW) { uint4* q = (uint4*)((unsigned char*)AG + (size_t)r * DM * (MOE_FP8 ? 1 : 2));
#pragma unroll
            for (int i = 0; i < (MOE_FP8 ? 2 : 4); ++i) q[i * 64 + lane] = make_uint4(zq, zq, zq, zq); } }
}


__device__ __forceinline__ uint4 ldg16(const bf16* p) { return *(const uint4*)p; }
__device__ __forceinline__ uint4 zero16() { return make_uint4(0u, 0u, 0u, 0u); }

__device__ __forceinline__ void feat_a(const Ctx& a, int l, int bid, int G) {
    unsigned char* ws = opqp(a.ws); const int tid = ((a.wv << 6) | lane_v()), lane = tid & 63, wid = tid >> 6;
    const bf16* U = (const bf16*)(ws + WS_U); bf16* ASM = (bf16*)(ws + WS_ASM); bf16* XBC = (bf16*)(ws + WS_XBC); bf16* QK = (bf16*)(ws + WS_QK);
    float* DT = (float*)(ws + WS_DT); const float* rope = (const float*)(ws + WS_ROPE);
    const float* mu = ldin(12) + (size_t)l * 2 * 1792; const float* cw = ldin(23) + (size_t)l * 3 * 1536; const float* cb = ldin(24) + (size_t)l * 1536;
    const float* dtb = ldin(25) + l * 32; const float* alog = ldin(26) + l * 32;
    for (int r = bid * NW + wid; r < MTOT; r += G * NW) {
        const bool lat = r < MLAT; const int t = lat ? (r & (SEQ - 1)) : ((r - MLAT) & (CTXL - 1)); const int L = lat ? SEQ : CTXL;
        const bool hp = t > 0, hn = t < L - 1;
        const bf16* up = U + (size_t)r * NINP;
        if (lane < 32) {
            const int c = C_RW_XW + lane * 8; float u[8], p[8], n[8], o[8];
            unpack8(ldg16(up + c), u); unpack8(hp ? ldg16(up - NINP + c) : zero16(), p); unpack8(hn ? ldg16(up + NINP + c) : zero16(), n);
#pragma unroll
            for (int e = 0; e < 8; ++e) { const float s = u[e] + mu[c + e] * (p[e] - u[e]) + mu[1792 + c + e] * (n[e] - u[e]); const int k = lane * 8 + e;
                o[e] = k < 64 ? (1.0f - 2.0f / (__expf(2.0f * s) + 1.0f)) : (k < 128 ? s : fsigm(s)); }
            *(uint4*)(ASM + (size_t)r * 256 + lane * 8) = pack8(o);
        }
#pragma unroll
        for (int it = 0; it < 3; ++it) {
            const int cc = (it * 64 + lane) * 8, c = C_MB_XBC + cc; float u[8], p[8], n[8], o[8];
            unpack8(ldg16(up + c), u); unpack8(hp ? ldg16(up - NINP + c) : zero16(), p); unpack8(hn ? ldg16(up + NINP + c) : zero16(), n);
#pragma unroll
            for (int e = 0; e < 8; ++e) o[e] = fsilu(cw[cc + e] * p[e] + cw[1536 + cc + e] * u[e] + cw[3072 + cc + e] * n[e] + cb[cc + e]);
            *(uint4*)(XBC + (size_t)r * 1536 + cc) = pack8(o);
        }
        if (lane < 32) {
            const float raw = bf2f(up[C_MB_DT + lane]); const float dtv = softplusf(raw + dtb[lane]); const float A = -__expf(alog[lane]);
            DT[(size_t)r * 64 + lane] = dtv; DT[(size_t)r * 64 + 32 + lane] = dtv * A;
        }
        {
            const int blk = lane >> 1, sub = lane & 1, c1 = C_DA_Q + blk * 32 + sub * 8; float u1[8], u2[8], o1[8], o2[8];
            unpack8(ldg16(up + c1), u1); unpack8(ldg16(up + c1 + 16), u2);
            const int half = blk & 1; const float scale = blk < 16 ? 0.125f * 1.44269504f : 1.0f;
#pragma unroll
            for (int e = 0; e < 8; ++e) {
                float cs = 1.0f, sn = 0.0f;
                if (lat) { cs = rope[t * 64 + half * 32 + sub * 8 + e]; sn = rope[t * 64 + half * 32 + 16 + sub * 8 + e]; }
                o1[e] = (u1[e] * cs - u2[e] * sn) * scale; o2[e] = (u2[e] * cs + u1[e] * sn) * scale; }
            *(uint4*)(QK + (size_t)r * 1024 + blk * 32 + sub * 8) = pack8(o1); *(uint4*)(QK + (size_t)r * 1024 + blk * 32 + 16 + sub * 8) = pack8(o2);
        }
    }
}

__device__ __forceinline__ void feat_b(const Ctx& a, int l, int bid, int G) {
    unsigned char* ws = opqp(a.ws); const int tid = ((a.wv << 6) | lane_v()), lane = tid & 63, wid = tid >> 6;
    const bf16* U = (const bf16*)(ws + WS_U); const float* F = (const float*)(ws + WS_MIX); bf16* R5 = (bf16*)(ws + WS_RW5);
    const float* mu = ldin(12) + (size_t)l * 2 * 1792; const float* k_k = ldin(18) + l * 512; const float* k_a = ldin(19) + l * 512; const float* a0 = ldin(15) + l * 512;
    for (int r = bid * NW + wid; r < MTOT; r += G * NW) {
        const bool lat = r < MLAT; const int t = lat ? (r & (SEQ - 1)) : ((r - MLAT) & (CTXL - 1)); const int L = lat ? SEQ : CTXL;
        const bool hp = t > 0, hn = t < L - 1;
        const bf16* up = U + (size_t)r * NINP; const int c = lane * 8;
        float s[3][8];
#pragma unroll
        for (int q = 0; q < 3; ++q) { const int col = q * 512 + c; float u[8], p[8], n[8];
            unpack8(ldg16(up + col), u); unpack8(hp ? ldg16(up - NINP + col) : zero16(), p); unpack8(hn ? ldg16(up + NINP + col) : zero16(), n);
#pragma unroll
            for (int e = 0; e < 8; ++e) s[q][e] = u[e] + mu[col + e] * (p[e] - u[e]) + mu[1792 + col + e] * (n[e] - u[e]); }
        float av[8]; { const float4 q0 = *(const float4*)(F + (size_t)r * 2048 + 1024 + c), a1 = *(const float4*)(F + (size_t)r * 2048 + 1024 + c + 4);
            av[0] = q0.x; av[1] = q0.y; av[2] = q0.z; av[3] = q0.w; av[4] = a1.x; av[5] = a1.y; av[6] = a1.z; av[7] = a1.w; }
#pragma unroll
        for (int e = 0; e < 8; ++e) av[e] = fsigm(av[e] + a0[c + e]);
        float kkv[8], k2[8], bv[8]; float ss = 0.f;
#pragma unroll
        for (int e = 0; e < 8; ++e) { kkv[e] = s[1][e] * k_k[c + e]; ss += kkv[e] * kkv[e]; }
        ss = red8(ss); const float inv = 1.0f / fmaxf(sqrtf(ss), 1e-12f);
#pragma unroll
        for (int e = 0; e < 8; ++e) { kkv[e] *= inv; k2[e] = s[1][e] * (1.0f + (av[e] - 1.0f) * k_a[c + e]); bv[e] = kkv[e] * av[e]; }
        const size_t o = (size_t)r * 512 + c, st = (size_t)MTOT * 512;
        *(uint4*)(R5 + o) = pack8(s[0]); *(uint4*)(R5 + st + o) = pack8(k2); *(uint4*)(R5 + 2 * st + o) = pack8(s[2]); *(uint4*)(R5 + 3 * st + o) = pack8(kkv); *(uint4*)(R5 + 4 * st + o) = pack8(bv);
    }
}

__device__ __forceinline__ void mix_out(const Ctx& a, int l, int M, int bid, int G) {
    unsigned char* ws = opqp(a.ws); const int tid = ((a.wv << 6) | lane_v()), lane = tid & 63, wid = tid >> 6;
    const bf16* U = (const bf16*)(ws + WS_U); const bf16* F = (const bf16*)(ws + WS_MIX); const bf16* R5 = (const bf16*)(ws + WS_RW5); const bf16* XBC = (const bf16*)(ws + WS_XBC);
    const bf16* YR = (const bf16*)(ws + WS_YR); const bf16* YM = (const bf16*)(ws + WS_YM); bf16* A2 = (bf16*)(ws + WS_HA);
    const float* r_k = ldin(20) + l * 512; const float* ln_w = ldin(21) + l * 512; const float* ln_b = ldin(22) + l * 512;
    const float* Dsk = ldin(27) + l * 16; const float* nw = ldin(28) + l * 1024;
    for (int r = bid * NW + wid; r < M; r += G * NW) {
        {
            const int c = lane * 8; const size_t o = (size_t)r * 512 + c, st = (size_t)MTOT * 512;
            float y[8];
            { float yf[8], yb[8]; unpack8(ldg16(YR + o), yf); unpack8(ldg16(YR + st + o), yb);
#pragma unroll
              for (int e = 0; e < 8; ++e) y[e] = yf[e] + yb[e]; }
            float sm = 0.f;
#pragma unroll
            for (int e = 0; e < 8; ++e) sm += y[e];
            const float mean = red8(sm) * (1.0f / 64.0f); float sv = 0.f;
#pragma unroll
            for (int e = 0; e < 8; ++e) { y[e] -= mean; sv += y[e] * y[e]; }
            const float rs = rsqrtf(red8(sv) * (1.0f / 64.0f) + 64e-5f);
            float rr[8], kk[8], vv[8]; unpack8(ldg16(R5 + o), rr); unpack8(ldg16(R5 + st + o), kk); unpack8(ldg16(R5 + 2 * st + o), vv);
            float dot = 0.f;
#pragma unroll
            for (int e = 0; e < 8; ++e) dot += rr[e] * kk[e] * r_k[c + e];
            dot = red8(dot);
            float g[8]; unpack8(ldg16(F + (size_t)r * 2048 + 1536 + c), g); float ov[8];
#pragma unroll
            for (int e = 0; e < 8; ++e) ov[e] = (y[e] * rs * ln_w[c + e] + ln_b[c + e] + dot * vv[e]) * g[e];
            *(uint4*)(A2 + (size_t)r * DM + c) = pack8(ov);
        }
        {
            const int m0 = lane * 16, hh = m0 >> 6; const float dsk = Dsk[hh]; float y[16]; float ss = 0.f;
#pragma unroll
            for (int q = 0; q < 2; ++q) { const int m = m0 + q * 8; const size_t o = (size_t)r * 1024 + m;
                float ys[8]; unpack8(ldg16(YM + o), ys);
                float xs[8], z[8]; unpack8(ldg16(XBC + (size_t)r * 1536 + m), xs); unpack8(ldg16(U + (size_t)r * NINP + C_MB_Z + m), z);
#pragma unroll
                for (int e = 0; e < 8; ++e) { const float v = (ys[e] + dsk * xs[e]) * fsilu(z[e]); y[q * 8 + e] = v; ss += v * v; } }
            ss = red32(ss);
            const float rs = rsqrtf(ss * (1.0f / 512.0f) + 1e-5f);
#pragma unroll
            for (int q = 0; q < 2; ++q) { const int m = m0 + q * 8; float ov[8];
#pragma unroll
                for (int e = 0; e < 8; ++e) ov[e] = y[q * 8 + e] * rs * nw[m + e];
                *(uint4*)(A2 + (size_t)r * DM + 512 + m) = pack8(ov); }
        }
    }
}

__device__ __forceinline__ int chain_row(int s, int b, int dir) {
    if (s < CTXL) return MLAT + b * CTXL + (dir ? (CTXL - 1 - s) : s);
    const int t = s - CTXL; return b * SEQ + (dir ? (SEQ - 1 - t) : t);
}
constexpr int CH_STEPS = CTXL + SEQ, CH_T = 32, CH_NC = CH_STEPS / CH_T;


typedef short s16x4 __attribute__((ext_vector_type(4)));
constexpr int MB_NCH = 18;
__device__ __forceinline__ int mb_row0(int b, int cc) { return cc < 2 ? MLAT + b * CTXL + cc * 128 : b * SEQ + (cc - 2) * 128; }
__device__ __forceinline__ bf16x8 trfrag(const LAS bf16* pA, const LAS bf16* pB) {
    const s16x4 v0 = __builtin_amdgcn_ds_read_tr16_b64_v4i16((LAS s16x4*)pA), v1 = __builtin_amdgcn_ds_read_tr16_b64_v4i16((LAS s16x4*)pB);
    return __builtin_shufflevector(v0, v1, 0, 1, 2, 3, 4, 5, 6, 7);
}
constexpr int MB_PB = 144, MB_PX = 72;
constexpr int MB_OFF_C = 0, MB_OFF_B = 36864, MB_OFF_X = 73728  , MB_OFF_V = 110592  ;

__device__ __forceinline__ void mb_vectors(const float* DT, int row0, int g, LAS float* tmp, LAS float* vec, int tid) {
    for (int i = tid; i < 128 * 16; i += NT) { const int l = i >> 4, q4 = i & 15; *(LAS f32x4*)(tmp + l * 64 + q4 * 4) = *(const f32x4*)(DT + (size_t)(row0 + l) * 64 + q4 * 4); }
    __syncthreads();
    LAS float* tot = tmp + 128 * 64;
    const int seq = tid >> 5, j = tid & 31, hh = seq & 7, dir = seq >> 3;
    float v[4], run = 0.f;
#pragma unroll
    for (int e = 0; e < 4; ++e) { const int l = dir ? 127 - (4 * j + e) : 4 * j + e; run += tmp[l * 64 + 32 + dir * 16 + g * 8 + hh]; v[e] = run; }
    tot[seq * 32 + j] = run;
    __syncthreads();
    float off = 0.f;
    for (int q = 0; q < 32; ++q) { const float tq = tot[seq * 32 + q]; off += q < j ? tq : 0.f; }
#pragma unroll
    for (int e = 0; e < 4; ++e) { const int l = dir ? 127 - (4 * j + e) : 4 * j + e; vec[dir * 1024 + hh * 128 + l] = v[e] + off; }
    __syncthreads();
    for (int i = tid; i < 2048; i += NT) { const int d2 = i >> 10, h2 = (i >> 7) & 7, l = i & 127; const int ref = d2 ? (l & ~15) : (l | 15);
        vec[2048 + i] = __expf(fmaxf(vec[d2 * 1024 + h2 * 128 + ref] - vec[d2 * 1024 + h2 * 128 + l], -80.f)) * tmp[l * 64 + d2 * 16 + g * 8 + h2]; }
    __syncthreads();
}

__device__ __forceinline__ void mamba_m1(const Ctx& a, LAS unsigned char* lds, int item) {
    unsigned char* ws = opqp(a.ws); const int tid = ((a.wv << 6) | lane_v()), lane = tid & 63, wid = tid >> 6, fr = lane & 15, fq = lane >> 4, q4 = (lane & 15) >> 2, p4 = lane & 3;
    const int g = item & 1, cc = (item >> 1) % MB_NCH, b = (item >> 1) / MB_NCH; const int row0 = mb_row0(b, cc);
    const bf16* XBC = (const bf16*)(ws + WS_XBC); const float* DT = (const float*)(ws + WS_DT); bf16* ST = (bf16*)(ws + WS_ST); float* AC = (float*)(ws + WS_AC);
    LAS bf16* Bs = (LAS bf16*)(lds + MB_OFF_B); LAS float* vec = (LAS float*)(lds + MB_OFF_V);
    __syncthreads();
    mb_vectors(DT, row0, g, (LAS float*)(lds + MB_OFF_C), vec, tid);
    if (tid < 16) { const int hh = tid & 7, dir = tid >> 3; AC[((size_t)(b * MB_NCH + cc) * 16 + g * 8 + hh) * 2 + dir] = dir ? vec[1024 + hh * 128] : vec[hh * 128 + 127]; }
    for (int i = tid; i < 2048; i += NT) { const int l = i >> 4, ch = i & 15; *(LAS u32x4*)(Bs + l * MB_PB + ch * 8) = *(const u32x4*)(XBC + (size_t)(row0 + l) * 1536 + 1024 + g * 128 + ch * 8); }
    uint4 xq[2];
#pragma unroll
    for (int j = 0; j < 2; ++j) { const int id = tid + j * NT; xq[j] = *(const uint4*)(XBC + (size_t)(row0 + (id >> 3)) * 1536 + (g * 8) * 64 + (id & 7) * 8); }
    for (int hh = 0; hh < 8; ++hh) {
        const int h = g * 8 + hh;
        LAS bf16* Yf = (LAS bf16*)(lds + ((hh & 1) ? MB_OFF_X : MB_OFF_C)); LAS bf16* Yb = Yf + 128 * MB_PX;
        const float tf = vec[hh * 128 + 127];
        uint4 xc[2] = {xq[0], xq[1]};
        if (hh + 1 < 8) {
#pragma unroll
            for (int j = 0; j < 2; ++j) { const int id = tid + j * NT; xq[j] = *(const uint4*)(XBC + (size_t)(row0 + (id >> 3)) * 1536 + (h + 1) * 64 + (id & 7) * 8); } }
#pragma unroll
        for (int j = 0; j < 2; ++j) { const int id = tid + j * NT, l = id >> 3, ch = id & 7; float x8[8], of[8], ob[8];
            unpack8(xc[j], x8);
            const float sf = __expf(tf - vec[hh * 128 + (l | 15)]) * vec[2048 + hh * 128 + l], sb = __expf(vec[1024 + hh * 128] - vec[1024 + hh * 128 + (l & ~15)]) * vec[3072 + hh * 128 + l];
#pragma unroll
            for (int e = 0; e < 8; ++e) { of[e] = x8[e] * sf; ob[e] = x8[e] * sb; }
            const uint4 pf = pack8(of), pb = pack8(ob);
            *(LAS u32x4*)(Yf + l * MB_PX + ch * 8) = (u32x4){pf.x, pf.y, pf.z, pf.w}; *(LAS u32x4*)(Yb + l * MB_PX + ch * 8) = (u32x4){pb.x, pb.y, pb.z, pb.w}; }
        __syncthreads();
        const int pt = wid & 3, nh = wid >> 2;
#pragma unroll
        for (int dir = 0; dir < 2; ++dir) { const LAS bf16* Xd = dir ? Yb : Yf;
            bf16x8 yf4[4];
#pragma unroll
            for (int ks = 0; ks < 4; ++ks) { const LAS bf16* pa = Xd + (ks * 32 + 8 * fq + q4) * MB_PX + pt * 16 + 4 * p4; yf4[ks] = trfrag(pa, pa + 4 * MB_PX); }
#pragma unroll
            for (int ns = 0; ns < 4; ++ns) { f32x4 acc = (f32x4){0.f, 0.f, 0.f, 0.f};
#pragma unroll
                for (int ks = 0; ks < 4; ++ks) { const LAS bf16* pa = Bs + (ks * 32 + 8 * fq + q4) * MB_PB + (nh * 4 + ns) * 16 + 4 * p4;
                    acc = __builtin_amdgcn_mfma_f32_16x16x32_bf16(trfrag(pa, pa + 4 * MB_PB), yf4[ks], acc, 0, 0, 0); }
                uint2 pk; pk.x = pk2(acc[0], acc[1]); pk.y = pk2(acc[2], acc[3]);
                *(uint2*)(ST + ((((size_t)(b * MB_NCH + cc) * 16 + h) * 2 + dir) * 64 + pt * 16 + fr) * 128 + (nh * 4 + ns) * 16 + 4 * fq) = pk; } }
    }
}

__device__ __forceinline__ void mamba_m2(const Ctx& a, int item) {
    unsigned char* ws = opqp(a.ws); const int tid = ((a.wv << 6) | lane_v());
    const int dir = item & 1, h = (item >> 1) & 15, b = item >> 5;
    bf16* ST = (bf16*)(ws + WS_ST); const float* AC = (const float*)(ws + WS_AC);
    float H[16];
#pragma unroll
    for (int i = 0; i < 16; ++i) H[i] = 0.f;
#define M2_CC(st_) (dir == 0 ? (st_) : ((st_) < 2 ? 1 - (st_) : 19 - (st_)))
#define M2_PTR(st_) (ST + ((((size_t)(b * MB_NCH + M2_CC(st_)) * 16 + h) * 2 + dir) * 64) * 128 + tid * 16)
    uint4 s0 = *(const uint4*)M2_PTR(0), s1 = *(const uint4*)(M2_PTR(0) + 8); float la = AC[((size_t)(b * MB_NCH + M2_CC(0)) * 16 + h) * 2 + dir];
    for (int st = 0; st < MB_NCH; ++st) {
        bf16* p = M2_PTR(st);
        const int sn = st + 1 < MB_NCH ? st + 1 : st;
        const uint4 n0 = *(const uint4*)M2_PTR(sn), n1 = *(const uint4*)(M2_PTR(sn) + 8); const float ln = AC[((size_t)(b * MB_NCH + M2_CC(sn)) * 16 + h) * 2 + dir];
        float f0[8], f1[8]; unpack8(s0, f0); unpack8(s1, f1);
        const float ea = __expf(la);
        float o0[8], o1[8];
#pragma unroll
        for (int e = 0; e < 8; ++e) { o0[e] = H[e]; o1[e] = H[8 + e]; H[e] = ea * H[e] + f0[e]; H[8 + e] = ea * H[8 + e] + f1[e]; }
        *(uint4*)p = pack8(o0); *(uint4*)(p + 8) = pack8(o1);
        s0 = n0; s1 = n1; la = ln;
    }
#undef M2_CC
#undef M2_PTR
}

__device__ __forceinline__ void mamba_m3(const Ctx& a, LAS unsigned char* lds, int b, int cc, int g) {
    unsigned char* ws = opqp(a.ws); const int tid = ((a.wv << 6) | lane_v()), lane = tid & 63, wid = tid >> 6, fr = lane & 15, fq = lane >> 4, q4 = (lane & 15) >> 2, p4 = lane & 3;
    const int row0 = mb_row0(b, cc);
    const bf16* XBC = (const bf16*)(ws + WS_XBC); const float* DT = (const float*)(ws + WS_DT); const bf16* ST = (const bf16*)(ws + WS_ST); bf16* YM = (bf16*)(ws + WS_YM);
    LAS bf16* Cs = (LAS bf16*)(lds + MB_OFF_C); LAS bf16* Bs = (LAS bf16*)(lds + MB_OFF_B); LAS float* vec = (LAS float*)(lds + MB_OFF_V);
    __syncthreads();
    mb_vectors(DT, row0, g, (LAS float*)(lds + MB_OFF_C), vec, tid);
    for (int i = tid; i < 2048; i += NT) { const int l = i >> 4, ch = i & 15; const bf16* src = XBC + (size_t)(row0 + l) * 1536 + g * 128 + ch * 8;
        *(LAS u32x4*)(Bs + l * MB_PB + ch * 8) = *(const u32x4*)(src + 1024); *(LAS u32x4*)(Cs + l * MB_PB + ch * 8) = *(const u32x4*)(src + 1280); }
    uint4 xr[2];
#define M3_XLOAD(hh_) do { _Pragma("unroll") for (int j_ = 0; j_ < 2; ++j_) { const int id_ = tid + j_ * NT; xr[j_] = *(const uint4*)(XBC + (size_t)(row0 + (id_ >> 3)) * 1536 + (g * 8 + (hh_)) * 64 + (id_ & 7) * 8); } } while (0)
#define M3_XSTORE(hh_) do { LAS bf16* X_ = (LAS bf16*)(lds + MB_OFF_X) + ((hh_) & 1) * 128 * MB_PX; _Pragma("unroll") for (int j_ = 0; j_ < 2; ++j_) { const int id_ = tid + j_ * NT; \
        *(LAS u32x4*)(X_ + (id_ >> 3) * MB_PX + (id_ & 7) * 8) = (u32x4){xr[j_].x, xr[j_].y, xr[j_].z, xr[j_].w}; } } while (0)
    M3_XLOAD(0); M3_XSTORE(0);
    __syncthreads();
    const int l0 = wid * 16;
    bf16x8 cf[4];
#pragma unroll
    for (int ks = 0; ks < 4; ++ks) cf[ks] = *(const LAS bf16x8*)(Cs + (l0 + fr) * MB_PB + ks * 32 + fq * 8);
    f32x4 CB[8];
#pragma unroll
    for (int sb = 0; sb < 8; ++sb) { f32x4 acc = (f32x4){0.f, 0.f, 0.f, 0.f};
#pragma unroll
        for (int ks = 0; ks < 4; ++ks) acc = __builtin_amdgcn_mfma_f32_16x16x32_bf16(*(const LAS bf16x8*)(Bs + (sb * 16 + fr) * MB_PB + ks * 32 + fq * 8), cf[ks], acc, 0, 0, 0);
        CB[sb] = acc; }
    bf16x8 hs0[8], hs1[8];
#define M3_HLOAD(SET_, hh_, pt_) do { const bf16* Hf_ = ST + ((((size_t)(b * MB_NCH + cc) * 16 + g * 8 + (hh_)) * 2 + 0) * 64) * 128 + (size_t)((pt_) * 16 + fr) * 128 + fq * 8; \
        _Pragma("unroll") for (int ks_ = 0; ks_ < 4; ++ks_) { SET_[ks_] = *(const bf16x8*)(Hf_ + ks_ * 32); SET_[4 + ks_] = *(const bf16x8*)(Hf_ + 64 * 128 + ks_ * 32); } } while (0)
    M3_HLOAD(hs0, 0, 0);
    float mfd[4], mbd[4];
#pragma unroll
    for (int e = 0; e < 4; ++e) { const int dd = 4 * fq + e - fr; mfd[e] = dd <= 0 ? 1.f : 0.f; mbd[e] = dd >= 0 ? 1.f : 0.f; }
    const int nhh = (a.sub & 16) ? 0 : ((a.sub & 8) ? 1 : 8);
    for (int hh = 0; hh < nhh; ++hh) {
        const int h = g * 8 + hh;
        if (hh + 1 < 8) M3_XLOAD(hh + 1);
        const LAS bf16* X = (const LAS bf16*)(lds + MB_OFF_X) + (hh & 1) * 128 * MB_PX;
        const LAS float* vf = vec + hh * 128; const LAS float* vb = vec + 1024 + hh * 128; const LAS float* cF = vec + 2048 + hh * 128; const LAS float* cB = vec + 3072 + hh * 128;
        const float afl = vf[l0 + fr], abl = vb[l0 + fr];
        bf16x8 wf[4];
#pragma unroll
        for (int kc = 0; kc < 4; ++kc) { float wv[8];
#pragma unroll
            for (int hs = 0; hs < 2; ++hs) { const int sb = 2 * kc + hs, s0 = sb * 16 + 4 * fq;
                float rf = 0.f, rb = 0.f;
                if (sb <= wid) rf = __expf(fminf(afl - vf[sb * 16 + 15], 80.f));
                if (sb >= wid) rb = __expf(fminf(abl - vb[sb * 16], 80.f));
                const f32x4 c_f = *(const LAS f32x4*)(cF + s0), c_b = *(const LAS f32x4*)(cB + s0);
#pragma unroll
                for (int e = 0; e < 4; ++e) { float m;
                    if (sb < wid) m = rf * c_f[e]; else if (sb > wid) m = rb * c_b[e]; else m = rf * c_f[e] * mfd[e] + rb * c_b[e] * mbd[e];
                    wv[hs * 4 + e] = CB[sb][e] * m; } }
            u32x4 w; w.x = pk2(wv[0], wv[1]); w.y = pk2(wv[2], wv[3]); w.z = pk2(wv[4], wv[5]); w.w = pk2(wv[6], wv[7]); wf[kc] = __builtin_bit_cast(bf16x8, w); }
        const float ef = __expf(afl), eb = __expf(abl);
#define M3_STEP(SET_, NXT_, pt_, hn_, ptn_, do_load_) do { \
            if (do_load_) M3_HLOAD(NXT_, hn_, ptn_); \
            f32x4 yd = (f32x4){0.f, 0.f, 0.f, 0.f}, y1 = yd, y2 = yd; \
            _Pragma("unroll") for (int kc = 0; kc < 4; ++kc) { const LAS bf16* pa = X + (kc * 32 + 4 * fq + q4) * MB_PX + (pt_) * 16 + 4 * p4; \
                yd = __builtin_amdgcn_mfma_f32_16x16x32_bf16(trfrag(pa, pa + 16 * MB_PX), wf[kc], yd, 0, 0, 0); } \
            _Pragma("unroll") for (int ks = 0; ks < 4; ++ks) { y1 = __builtin_amdgcn_mfma_f32_16x16x32_bf16(SET_[ks], cf[ks], y1, 0, 0, 0); y2 = __builtin_amdgcn_mfma_f32_16x16x32_bf16(SET_[4 + ks], cf[ks], y2, 0, 0, 0); } \
            f32x4 o; \
            _Pragma("unroll") for (int e = 0; e < 4; ++e) o[e] = yd[e] + ef * y1[e] + eb * y2[e]; \
            { uint2 pk; pk.x = pk2(o[0], o[1]); pk.y = pk2(o[2], o[3]); *(uint2*)(YM + (size_t)(row0 + l0 + fr) * 1024 + h * 64 + (pt_) * 16 + 4 * fq) = pk; } } while (0)
        M3_STEP(hs0, hs1, 0, hh, 1, true);
        M3_STEP(hs1, hs0, 1, hh, 2, true);
        M3_STEP(hs0, hs1, 2, hh, 3, true);
        M3_STEP(hs1, hs0, 3, hh + 1, 0, hh + 1 < 8);
#undef M3_STEP
        if (hh + 1 < 8) { M3_XSTORE(hh + 1); }
        __syncthreads();
    }
#undef M3_XLOAD
#undef M3_XSTORE
#undef M3_HLOAD
}


constexpr int RC_NCH = CH_STEPS / 16;
constexpr int RC_UNITS = 128 * RC_NCH;
constexpr int RC_TP = 72;
constexpr int RC_WAVE_LDS = 5 * 16 * RC_TP * 2 + 16 * 17 * 4 + 16 * 24 * 2;
constexpr int RC_CT_FLOATS = 6 * 512 + 3 * 512;
static_assert(8 * RC_WAVE_LDS + RC_CT_FLOATS * 4 <= LDS_STAGE, "rwkv R1 LDS");
__device__ __forceinline__ void rc_consts(LAS unsigned char* lds, int l, int tid) {
    LAS float* CT = (LAS float*)(lds + 8 * RC_WAVE_LDS);
    const float* mu = ldin(12) + (size_t)l * 2 * 1792; const float* a0 = ldin(15) + l * 512; const float* k_k = ldin(18) + l * 512; const float* k_a = ldin(19) + l * 512;
    for (int i = tid; i < 1536; i += NT) { CT[i] = mu[i]; CT[1536 + i] = mu[1792 + i]; }
    for (int i = tid; i < 512; i += NT) { CT[3072 + i] = a0[i]; CT[3584 + i] = k_k[i]; CT[4096 + i] = k_a[i]; }
    __syncthreads();
}
constexpr size_t RC_REC = 16 * 64 + 16 * 64 + 16 * 64 + 64 * 32 + 16 * 64;
constexpr size_t WS_RC1 = WS_MGU + 224 * MiB;
constexpr size_t WS_RC2 = WS_MD + 112 * MiB;
static_assert(MOE_FP8 == 1 && (size_t)RC_UNITS * RC_REC * 2 <= 224 * MiB && (size_t)RC_UNITS * (4096 + 256) <= 112 * MiB, "rwkv chunk records");

__device__ __forceinline__ bf16x8 pack_lo4(const f32x4 v) { u32x4 w; w.x = pk2(v[0], v[1]); w.y = pk2(v[2], v[3]); w.z = 0u; w.w = 0u; return __builtin_bit_cast(bf16x8, w); }

__device__ __forceinline__ void rwkv_r1(const Ctx& a, LAS unsigned char* lds, int l, int unit) {
    unsigned char* ws = opqp(a.ws); const int tid = ((a.wv << 6) | lane_v()), lane = tid & 63, wid = tid >> 6, fr = lane & 15, fq = lane >> 4, q4 = (lane & 15) >> 2, p4 = lane & 3;
    const int chain = unit / RC_NCH, c = unit % RC_NCH; const int dir = chain & 1, h = (chain >> 1) & 7, b = chain >> 4;
    const bf16* R5 = (const bf16*)(ws + WS_RW5); const bf16* F = (const bf16*)(ws + WS_MIX); const size_t st = (size_t)MTOT * 512;
    bf16* rec = (bf16*)(ws + WS_RC1) + (size_t)unit * RC_REC; float* Ycg = (float*)(ws + WS_RC2) + (size_t)unit * 1024; float* PCg = (float*)(ws + WS_RC2) + (size_t)RC_UNITS * 1024 + (size_t)unit * 64;
    LAS bf16* tA = (LAS bf16*)(lds + wid * RC_WAVE_LDS); LAS bf16* tR = tA + 16 * RC_TP; LAS bf16* tB = tR + 16 * RC_TP; LAS bf16* tK = tB + 16 * RC_TP; LAS bf16* tV = tK + 16 * RC_TP;
    LAS float* L1s = (LAS float*)(tV + 16 * RC_TP); LAS bf16* Ts = (LAS bf16*)(L1s + 16 * 17);
    {   const int t = lane >> 2, part = lane & 3; const int row = chain_row(c * 16 + t, b, dir);
        const bool lat = row < MLAT; const int pos = lat ? (row & (SEQ - 1)) : ((row - MLAT) & (CTXL - 1)); const bool hp = pos > 0, hn = pos < (lat ? SEQ : CTXL) - 1;
        const bf16* U = (const bf16*)(ws + WS_U); const bf16* up = U + (size_t)row * NINP + h * 64 + part * 16; const int ch = h * 64 + part * 16;
        const LAS float* CT = (const LAS float*)(lds + 8 * RC_WAVE_LDS);
        float sv[3][16];
#pragma unroll
        for (int q = 0; q < 3; ++q)
#pragma unroll
            for (int hf = 0; hf < 2; ++hf) { float u[8], p[8], n[8];
                unpack8(*(const uint4*)(up + q * 512 + hf * 8), u); unpack8(hp ? *(const uint4*)(up - NINP + q * 512 + hf * 8) : make_uint4(0u, 0u, 0u, 0u), p); unpack8(hn ? *(const uint4*)(up + NINP + q * 512 + hf * 8) : make_uint4(0u, 0u, 0u, 0u), n);
#pragma unroll
                for (int e = 0; e < 8; ++e) { const int cc = ch + hf * 8 + e; sv[q][hf * 8 + e] = u[e] + CT[q * 512 + cc] * (p[e] - u[e]) + CT[1536 + q * 512 + cc] * (n[e] - u[e]); } }
        float av[16];
#pragma unroll
        for (int hf = 0; hf < 2; ++hf) { float f[8]; unpack8(*(const uint4*)(F + (size_t)row * 2048 + 1024 + ch + hf * 8), f);
#pragma unroll
            for (int e = 0; e < 8; ++e) av[hf * 8 + e] = fsigm(f[e] + CT[3072 + ch + hf * 8 + e]); }
        float kkv[16], k2[16], bv[16], ss = 0.f;
#pragma unroll
        for (int e = 0; e < 16; ++e) { kkv[e] = sv[1][e] * CT[3584 + ch + e]; ss += kkv[e] * kkv[e]; }
        ss += dppf<0xB1>(ss); ss += dppf<0x4E>(ss);
        const float inv = 1.0f / fmaxf(sqrtf(ss), 1e-12f);
#pragma unroll
        for (int e = 0; e < 16; ++e) { kkv[e] *= inv; k2[e] = sv[1][e] * (1.0f + (av[e] - 1.0f) * CT[4096 + ch + e]); bv[e] = kkv[e] * av[e]; }
        const int lo = t * RC_TP + part * 16;
#define RC_PUT(T_, A_) do { *(LAS u32x4*)(T_ + lo) = (u32x4){pk2(A_[0], A_[1]), pk2(A_[2], A_[3]), pk2(A_[4], A_[5]), pk2(A_[6], A_[7])}; \
            *(LAS u32x4*)(T_ + lo + 8) = (u32x4){pk2(A_[8], A_[9]), pk2(A_[10], A_[11]), pk2(A_[12], A_[13]), pk2(A_[14], A_[15])}; } while (0)
        RC_PUT(tR, sv[0]); RC_PUT(tK, k2); RC_PUT(tV, sv[2]); RC_PUT(tA, kkv); RC_PUT(tB, bv);
#undef RC_PUT
        if (dir == 0) {
            bf16* R5w = (bf16*)(ws + WS_RW5); const size_t o = (size_t)row * 512 + ch;
            *(u32x4*)(R5w + o) = *(const LAS u32x4*)(tR + lo); *(u32x4*)(R5w + o + 8) = *(const LAS u32x4*)(tR + lo + 8);
            *(u32x4*)(R5w + st + o) = *(const LAS u32x4*)(tK + lo); *(u32x4*)(R5w + st + o + 8) = *(const LAS u32x4*)(tK + lo + 8);
            *(u32x4*)(R5w + 2 * st + o) = *(const LAS u32x4*)(tV + lo); *(u32x4*)(R5w + 2 * st + o + 8) = *(const LAS u32x4*)(tV + lo + 8); }
    }
    const int j = lane; const float w0j = ldin(13)[l * 1024 + dir * 512 + h * 64 + j];
    float wraw[16];
#pragma unroll
    for (int t = 0; t < 16; ++t) wraw[t] = bf2f(F[(size_t)chain_row(c * 16 + t, b, dir) * 2048 + dir * 512 + h * 64 + j]);
    __builtin_amdgcn_sched_barrier(0);
    float Lc = 0.f, Pprev = 1.0f, Lct[16], bq[16], kq[16];
#pragma unroll
    for (int t = 0; t < 16; ++t) {
        const float rv = bf2f(tR[t * RC_TP + j]), kv = bf2f(tK[t * RC_TP + j]), kkv = bf2f(tA[t * RC_TP + j]), bv = bf2f(tB[t * RC_TP + j]);
        const float lw = (-0.60653066f * 1.44269504f) * fsigm(wraw[t] + w0j);
        const float Pm1 = Pprev; Lc += lw; const float P = __builtin_amdgcn_exp2f(Lc), iP = __builtin_amdgcn_rcpf(P); Pprev = P;
        Lct[t] = Lc; bq[t] = bv; kq[t] = kv;
        tA[t * RC_TP + j] = (bf16)f2bf(-kkv * Pm1); tR[t * RC_TP + j] = (bf16)f2bf(rv * P); tB[t * RC_TP + j] = (bf16)f2bf(bv * iP); tK[t * RC_TP + j] = (bf16)f2bf(kv * iP);
    }
    PCg[j] = Pprev;
    {   unsigned vw[8];
#pragma unroll
        for (int t2 = 0; t2 < 8; ++t2) vw[t2] = (unsigned)tV[(2 * t2) * RC_TP + j] | ((unsigned)tV[(2 * t2 + 1) * RC_TP + j] << 16);
        *(uint4*)(rec + 5120 + (size_t)j * 16) = make_uint4(vw[0], vw[1], vw[2], vw[3]); *(uint4*)(rec + 5120 + (size_t)j * 16 + 8) = make_uint4(vw[4], vw[5], vw[6], vw[7]); }
    {   bf16* BK = rec + 3072 + (size_t)j * 32;
#pragma unroll
        for (int g = 0; g < 4; ++g) { float o8[8];
#pragma unroll
            for (int e = 0; e < 4; ++e) { const float d = __builtin_amdgcn_exp2f(Lc - Lct[4 * g + e]); o8[e] = bq[4 * g + e] * d; o8[4 + e] = kq[4 * g + e] * d; }
            *(uint4*)(BK + g * 8) = pack8(o8); } }
    f32x4 L1 = (f32x4){0.f, 0.f, 0.f, 0.f}, L2 = L1, M1 = L1, M2 = L1;
#pragma unroll
    for (int ks = 0; ks < 2; ++ks) {
        const bf16x8 ya = *(const LAS bf16x8*)(tA + fr * RC_TP + ks * 32 + fq * 8), yr = *(const LAS bf16x8*)(tR + fr * RC_TP + ks * 32 + fq * 8);
        const bf16x8 xb = *(const LAS bf16x8*)(tB + fr * RC_TP + ks * 32 + fq * 8), xk = *(const LAS bf16x8*)(tK + fr * RC_TP + ks * 32 + fq * 8);
        L1 = __builtin_amdgcn_mfma_f32_16x16x32_bf16(xb, ya, L1, 0, 0, 0); L2 = __builtin_amdgcn_mfma_f32_16x16x32_bf16(xk, ya, L2, 0, 0, 0);
        M1 = __builtin_amdgcn_mfma_f32_16x16x32_bf16(xb, yr, M1, 0, 0, 0); M2 = __builtin_amdgcn_mfma_f32_16x16x32_bf16(xk, yr, M2, 0, 0, 0);
    }
#pragma unroll
    for (int e = 0; e < 4; ++e) { const int s = 4 * fq + e, t = fr;
        if (!(s < t)) { L1[e] = 0.f; L2[e] = 0.f; } if (!(s <= t)) { M1[e] = 0.f; M2[e] = 0.f; }
        }
    {   const int cc = lane & 15; float Tc[16];
#pragma unroll
        for (int t = 0; t < 16; ++t) { float acc = (t == cc) ? 1.f : 0.f;
#pragma unroll
            for (int s = 0; s < t; ++s) { const float lts = __int_as_float(__builtin_amdgcn_readlane(__float_as_int(L1[s & 3]), 16 * (s >> 2) + t)); acc += lts * Tc[s]; }
            Tc[t] = acc; }
        if (lane < 16) {
#pragma unroll
            for (int t = 0; t < 16; ++t) Ts[t * 24 + cc] = (bf16)f2bf(Tc[t]); } }
    const bf16x8 Top = __builtin_bit_cast(bf16x8, (u32x4){((const LAS unsigned*)(Ts + fr * 24 + 4 * fq))[0], ((const LAS unsigned*)(Ts + fr * 24 + 4 * fq))[1], 0u, 0u});
    const bf16x8 L2op = pack_lo4(L2), M1op = pack_lo4(M1), M2op = pack_lo4(M2);
#pragma unroll
    for (int kt = 0; kt < 4; ++kt) { const LAS bf16* pa = tA + (4 * fq + q4) * RC_TP + kt * 16 + 4 * p4;
        const f32x4 ta = __builtin_amdgcn_mfma_f32_16x16x32_bf16(trfrag(pa, pa), Top, (f32x4){0.f, 0.f, 0.f, 0.f}, 0, 0, 0);
        uint2 pk; pk.x = pk2(ta[0], ta[1]); pk.y = pk2(ta[2], ta[3]);
        *(uint2*)(rec + fr * 64 + 32 * (kt >> 1) + 8 * fq + 4 * (kt & 1)) = pk;
        *(LAS u32x2*)(tB + fr * RC_TP + kt * 16 + 4 * fq) = (u32x2){pk.x, pk.y}; }
#pragma unroll
    for (int vt = 0; vt < 4; ++vt) { const LAS bf16* pa = tV + (4 * fq + q4) * RC_TP + vt * 16 + 4 * p4;
        const f32x4 x = __builtin_amdgcn_mfma_f32_16x16x32_bf16(trfrag(pa, pa), L2op, (f32x4){0.f, 0.f, 0.f, 0.f}, 0, 0, 0);
        *(LAS u32x2*)(tK + fr * RC_TP + vt * 16 + 4 * fq) = (u32x2){pk2(x[0], x[1]), pk2(x[2], x[3])}; }
#pragma unroll
    for (int kt = 0; kt < 4; ++kt) { const LAS bf16* pa = tB + (4 * fq + q4) * RC_TP + kt * 16 + 4 * p4;
        const u32x2 r2 = *(const LAS u32x2*)(tR + fr * RC_TP + kt * 16 + 4 * fq);
        f32x4 ra = (f32x4){__uint_as_float(r2.x << 16), __uint_as_float(r2.x & 0xffff0000u), __uint_as_float(r2.y << 16), __uint_as_float(r2.y & 0xffff0000u)};
        ra = __builtin_amdgcn_mfma_f32_16x16x32_bf16(trfrag(pa, pa), M1op, ra, 0, 0, 0);
        uint2 pk; pk.x = pk2(ra[0], ra[1]); pk.y = pk2(ra[2], ra[3]);
        *(uint2*)(rec + 1024 + fr * 64 + 32 * (kt >> 1) + 8 * fq + 4 * (kt & 1)) = pk; }
#pragma unroll
    for (int vt = 0; vt < 4; ++vt) { const LAS bf16* pa = tK + (4 * fq + q4) * RC_TP + vt * 16 + 4 * p4;
        const f32x4 x = __builtin_amdgcn_mfma_f32_16x16x32_bf16(trfrag(pa, pa), Top, (f32x4){0.f, 0.f, 0.f, 0.f}, 0, 0, 0);
        uint2 pk; pk.x = pk2(x[0], x[1]); pk.y = pk2(x[2], x[3]);
#pragma unroll
        for (int e = 0; e < 4; ++e) rec[2048 + (size_t)(vt * 16 + 4 * fq + e) * 16 + fr] = (bf16)f2bf(x[e]);
        *(LAS u32x2*)(tA + fr * RC_TP + vt * 16 + 4 * fq) = (u32x2){pk.x, pk.y}; }
#pragma unroll
    for (int vt = 0; vt < 4; ++vt) { const LAS bf16* pg = tA + (4 * fq + q4) * RC_TP + vt * 16 + 4 * p4; const LAS bf16* pv = tV + (4 * fq + q4) * RC_TP + vt * 16 + 4 * p4;
        f32x4 x = __builtin_amdgcn_mfma_f32_16x16x32_bf16(trfrag(pg, pg), M1op, (f32x4){0.f, 0.f, 0.f, 0.f}, 0, 0, 0);
        x = __builtin_amdgcn_mfma_f32_16x16x32_bf16(trfrag(pv, pv), M2op, x, 0, 0, 0);
#pragma unroll
        for (int e = 0; e < 4; ++e) Ycg[(size_t)(vt * 16 + 4 * fq + e) * 16 + fr] = x[e]; }
}

constexpr int R2_NV = 2;
__device__ __forceinline__ void rwkv_r2(const Ctx& a, int l, int item) {
    unsigned char* ws = opqp(a.ws); const int tid = ((a.wv << 6) | lane_v()), lane = tid & 63, wid = tid >> 6, fr = lane & 15, fq = lane >> 4;
    const int chain = 4 * item + (wid >> 1), v0 = 32 * (wid & 1); const int dir = chain & 1, h = (chain >> 1) & 7, b = chain >> 4;
    bf16* Y = (bf16*)(ws + WS_YR) + (size_t)dir * MTOT * 512;
    f32x4 S[R2_NV][4];
#pragma unroll
    for (int vg = 0; vg < R2_NV; ++vg)
#pragma unroll
        for (int kt = 0; kt < 4; ++kt) S[vg][kt] = (f32x4){0.f, 0.f, 0.f, 0.f};
    struct Rec { bf16x8 taf[2], raf[2], bkf[4]; f32x4 pc[4]; uint2 g2[R2_NV], v2[R2_NV]; f32x4 yc[R2_NV]; int r0; };
    Rec cur, nxt;
#define R2_LOAD(R_, c_) do { const size_t unit_ = (size_t)chain * RC_NCH + (c_); \
        const bf16* rec_ = (const bf16*)(ws + WS_RC1) + unit_ * RC_REC; const float* Ycg_ = (const float*)(ws + WS_RC2) + unit_ * 1024; const float* PCg_ = (const float*)(ws + WS_RC2) + (size_t)RC_UNITS * 1024 + unit_ * 64; \
        _Pragma("unroll") for (int jj = 0; jj < 2; ++jj) { R_.taf[jj] = *(const bf16x8*)(rec_ + fr * 64 + jj * 32 + fq * 8); R_.raf[jj] = *(const bf16x8*)(rec_ + 1024 + fr * 64 + jj * 32 + fq * 8); } \
        _Pragma("unroll") for (int kt = 0; kt < 4; ++kt) { R_.bkf[kt] = *(const bf16x8*)(rec_ + 3072 + (size_t)(kt * 16 + fr) * 32 + fq * 8); R_.pc[kt] = *(const f32x4*)(PCg_ + kt * 16 + 4 * fq); } \
        _Pragma("unroll") for (int vg = 0; vg < R2_NV; ++vg) { const size_t vo_ = (size_t)(v0 + 16 * vg + fr) * 16 + 4 * fq; \
            R_.g2[vg] = *(const uint2*)(rec_ + 2048 + vo_); R_.v2[vg] = *(const uint2*)(rec_ + 5120 + vo_); R_.yc[vg] = *(const f32x4*)(Ycg_ + vo_); } \
        const int s0_ = (c_) * 16; const int inc_ = s0_ < CTXL ? 1 : 0; const int t0_ = s0_ - (inc_ ? 0 : CTXL), L_ = inc_ ? CTXL : SEQ, base_ = inc_ ? MLAT + b * CTXL : b * SEQ; \
        R_.r0 = base_ + (dir ? L_ - 1 - t0_ : t0_); } while (0)
#define R2_STEP(R_, c_) do { _Pragma("unroll") for (int vg = 0; vg < R2_NV; ++vg) { \
        bf16x8 sb[2]; \
        _Pragma("unroll") for (int jj = 0; jj < 2; ++jj) { u32x4 w; w.x = pk2(S[vg][2 * jj][0], S[vg][2 * jj][1]); w.y = pk2(S[vg][2 * jj][2], S[vg][2 * jj][3]); w.z = pk2(S[vg][2 * jj + 1][0], S[vg][2 * jj + 1][1]); w.w = pk2(S[vg][2 * jj + 1][2], S[vg][2 * jj + 1][3]); sb[jj] = __builtin_bit_cast(bf16x8, w); } \
        f32x4 xt = (f32x4){0.f, 0.f, 0.f, 0.f}, yt = xt; \
        _Pragma("unroll") for (int jj = 0; jj < 2; ++jj) { xt = __builtin_amdgcn_mfma_f32_16x16x32_bf16(R_.taf[jj], sb[jj], xt, 0, 0, 0); yt = __builtin_amdgcn_mfma_f32_16x16x32_bf16(R_.raf[jj], sb[jj], yt, 0, 0, 0); }     \
        _Pragma("unroll") for (int e = 0; e < 4; ++e) Y[(size_t)(R_.r0 + (dir ? -(4 * fq + e) : (4 * fq + e))) * 512 + h * 64 + v0 + 16 * vg + fr] = (bf16)f2bf(yt[e] + R_.yc[vg][e]); \
        float g4_[4]; unpack4(R_.g2[vg], g4_); \
        u32x4 w; w.x = pk2(xt[0] + g4_[0], xt[1] + g4_[1]); w.y = pk2(xt[2] + g4_[2], xt[3] + g4_[3]); w.z = R_.v2[vg].x; w.w = R_.v2[vg].y; \
        const bf16x8 yop = __builtin_bit_cast(bf16x8, w);                    \
        _Pragma("unroll") for (int kt = 0; kt < 4; ++kt) { S[vg][kt] = S[vg][kt] * R_.pc[kt]; S[vg][kt] = __builtin_amdgcn_mfma_f32_16x16x32_bf16(R_.bkf[kt], yop, S[vg][kt], 0, 0, 0); } } } while (0)
#define R2_CL(x_) ((x_) < RC_NCH ? (x_) : RC_NCH - 1)
    R2_LOAD(cur, 0);
    for (int c = 0; c < RC_NCH; c += 2) {
        R2_LOAD(nxt, R2_CL(c + 1)); R2_STEP(cur, c);
        R2_LOAD(cur, R2_CL(c + 2)); R2_STEP(nxt, c + 1);
    }
#undef R2_STEP
#undef R2_CL
#undef R2_LOAD
}

constexpr int RW_LD = 384;
constexpr int RW_YOFF = 2 * CH_T * RW_LD;
__device__ __forceinline__ void rwkv_chain(const Ctx& a, LAS unsigned char* lds, int l, int item) {
    unsigned char* ws = opqp(a.ws); const int tid = ((a.wv << 6) | lane_v());
    const int dir = item & 1, h = (item >> 1) & 7, b = item >> 4;
    const int rp = tid >> 4, js = tid & 15, j0 = js * 4; const bool odd = js & 1;
    const bf16* R5 = (const bf16*)(ws + WS_RW5); const float* F = (const float*)(ws + WS_MIX); float* Y = (float*)(ws + WS_YR) + (size_t)dir * MTOT * 512;
    const size_t st = (size_t)MTOT * 512;
    LAS float* buf = (LAS float*)lds;
    const int ls = tid >> 4, lp = tid & 15;
    typedef float f32x2 __attribute__((ext_vector_type(2)));
    f32x2 S00 = {0.f, 0.f}, S01 = {0.f, 0.f}, S10 = {0.f, 0.f}, S11 = {0.f, 0.f};
    float4 wreg; uint2 kkr, br, kr, rr, vr;
    const float4 w0r = *(const float4*)(ldin(13) + l * 1024 + dir * 512 + h * 64 + lp * 4);
#define RW_LOAD(c) do { const int row_ = chain_row((c) * CH_T + ls, b, dir); const size_t o_ = (size_t)row_ * 512 + h * 64 + lp * 4; \
        wreg = *(const float4*)(F + (size_t)row_ * 2048 + dir * 512 + h * 64 + lp * 4); \
        rr = *(const uint2*)(R5 + o_); kr = *(const uint2*)(R5 + st + o_); vr = *(const uint2*)(R5 + 2 * st + o_); kkr = *(const uint2*)(R5 + 3 * st + o_); br = *(const uint2*)(R5 + 4 * st + o_); } while (0)
#define RW_STORE(c) do { LAS float* q_ = buf + (((c) & 1) * CH_T + ls) * RW_LD; float f_[4]; \
        unpack4(kkr, f_); *(LAS f32x4*)(q_ + lp * 4) = (f32x4){f_[0], f_[1], f_[2], f_[3]}; \
        unpack4(br, f_);  *(LAS f32x4*)(q_ + 64 + lp * 4) = (f32x4){f_[0], f_[1], f_[2], f_[3]}; \
        *(LAS f32x4*)(q_ + 128 + lp * 4) = (f32x4){__expf(-0.60653066f * fsigm(wreg.x + w0r.x)), __expf(-0.60653066f * fsigm(wreg.y + w0r.y)), __expf(-0.60653066f * fsigm(wreg.z + w0r.z)), __expf(-0.60653066f * fsigm(wreg.w + w0r.w))}; \
        unpack4(kr, f_);  *(LAS f32x4*)(q_ + 192 + lp * 4) = (f32x4){f_[0], f_[1], f_[2], f_[3]}; \
        unpack4(rr, f_);  *(LAS f32x4*)(q_ + 256 + lp * 4) = (f32x4){f_[0], f_[1], f_[2], f_[3]}; \
        unpack4(vr, f_);  *(LAS f32x4*)(q_ + 320 + lp * 4) = (f32x4){f_[0], f_[1], f_[2], f_[3]}; } while (0)
    __syncthreads();
    RW_LOAD(0); RW_STORE(0);
    __syncthreads();
    for (int c = 0; c < CH_NC; ++c) {
        if (c + 1 < CH_NC) RW_LOAD(c + 1);
        if (c > 0) {
            const int row = chain_row((c - 1) * CH_T + ls, b, dir);
            *(f32x4*)(Y + (size_t)row * 512 + h * 64 + lp * 4) = *(const LAS f32x4*)(buf + RW_YOFF + (((c - 1) & 1) * CH_T + ls) * 64 + lp * 4);
        }
        const LAS float* cb = buf + ((c & 1) * CH_T) * RW_LD; LAS float* yb = buf + RW_YOFF + ((c & 1) * CH_T) * 64;
#pragma unroll 2
        for (int s = 0; s < CH_T; ++s) {
            const LAS float* q = cb + s * RW_LD;
            const f32x4 kk4 = *(const LAS f32x4*)(q + j0), b4 = *(const LAS f32x4*)(q + 64 + j0), w4 = *(const LAS f32x4*)(q + 128 + j0), k4 = *(const LAS f32x4*)(q + 192 + j0), r4 = *(const LAS f32x4*)(q + 256 + j0);
            const f32x2 v2 = *(const LAS f32x2*)(q + 320 + 2 * rp);
            const f32x2 kkA = {kk4[0], kk4[1]}, kkB = {kk4[2], kk4[3]}, bA = {b4[0], b4[1]}, bB = {b4[2], b4[3]}, wA = {w4[0], w4[1]}, wB = {w4[2], w4[3]}, kA = {k4[0], k4[1]}, kB = {k4[2], k4[3]}, rA = {r4[0], r4[1]}, rB = {r4[2], r4[3]};
            f32x2 t0 = S00 * kkA + S01 * kkB, t1 = S10 * kkA + S11 * kkB;
            const float sa0 = -red16(t0[0] + t0[1]), sa1 = -red16(t1[0] + t1[1]);
            S00 = S00 * wA + (bA * sa0 + kA * v2[0]); S01 = S01 * wB + (bB * sa0 + kB * v2[0]);
            S10 = S10 * wA + (bA * sa1 + kA * v2[1]); S11 = S11 * wB + (bB * sa1 + kB * v2[1]);
            t0 = S00 * rA + S01 * rB; t1 = S10 * rA + S11 * rB;
            const float p0 = t0[0] + t0[1], p1 = t1[0] + t1[1];
            float ym = odd ? p1 : p0; const float yo = odd ? p0 : p1;
            ym += dppf<0xB1>(yo); ym += dppf<0x4E>(ym); ym += dppf<0x124>(ym); ym += dppf<0x128>(ym);
            if (js < 2) yb[s * 64 + 2 * rp + js] = ym;
        }
        if (c + 1 < CH_NC) RW_STORE(c + 1);
        __syncthreads();
    }
    { const int row = chain_row((CH_NC - 1) * CH_T + ls, b, dir);
      *(f32x4*)(Y + (size_t)row * 512 + h * 64 + lp * 4) = *(const LAS f32x4*)(buf + RW_YOFF + (((CH_NC - 1) & 1) * CH_T + ls) * 64 + lp * 4); }
#undef RW_LOAD
#undef RW_STORE
}

constexpr int AT_KP = 136, AT_VP = 144;
constexpr int AT_KB = 64 * AT_KP * 2, AT_VB = 64 * AT_VP * 2, AT_BUF = AT_KB + AT_VB;
__device__ __forceinline__ void attn_item(const Ctx& a, LAS unsigned char* lds, int l, int b, int h, int qt, bool ctxq, float lam, float post) {
    unsigned char* ws = opqp(a.ws); const int tid = ((a.wv << 6) | lane_v()), lane = tid & 63, wid = tid >> 6, fr = lane & 15, fq = lane >> 4, q4 = (lane & 15) >> 2, p4 = lane & 3;
    const bf16* QK = (const bf16*)(ws + WS_QK); const bf16* U = (const bf16*)(ws + WS_U); bf16* A2 = (bf16*)(ws + WS_HA);
    const int qrow = (ctxq ? MLAT + b * CTXL : b * SEQ) + qt * 128 + wid * 16 + fr;
    const int nkt = ctxq ? 4 : 36;
    bf16x8 qf[2][2];
#pragma unroll
    for (int c = 0; c < 2; ++c)
#pragma unroll
        for (int ks = 0; ks < 2; ++ks) qf[c][ks] = *(const bf16x8*)(QK + (size_t)qrow * 1024 + h * 128 + c * 64 + ks * 32 + fq * 8);
    f32x4 O[2][8];
#pragma unroll
    for (int c = 0; c < 2; ++c)
#pragma unroll
        for (int d = 0; d < 8; ++d) O[c][d] = (f32x4){0.f, 0.f, 0.f, 0.f};
    float mrun[2] = {-3.0e38f, -3.0e38f}, lrun[2] = {0.f, 0.f};
    uint4 kreg[2], vreg[2];
#define AT_LOAD(kt) do { const int kr0_ = ((kt) < 4 ? MLAT + b * CTXL + (kt) * 64 : b * SEQ + ((kt) - 4) * 64); \
        _Pragma("unroll") for (int j_ = 0; j_ < 2; ++j_) { const int id_ = tid + j_ * NT, key_ = id_ >> 4, part_ = id_ & 15; \
            kreg[j_] = *(const uint4*)(QK + (size_t)(kr0_ + key_) * 1024 + 512 + h * 128 + part_ * 8); \
            vreg[j_] = *(const uint4*)(U + (size_t)(kr0_ + key_) * NINP + C_DA_V + h * 128 + part_ * 8); } } while (0)
#define AT_STORE(kt) do { LAS bf16* Ks_ = (LAS bf16*)(lds + ((kt) & 1) * AT_BUF); LAS bf16* Vs_ = (LAS bf16*)(lds + ((kt) & 1) * AT_BUF + AT_KB); \
        _Pragma("unroll") for (int j_ = 0; j_ < 2; ++j_) { const int id_ = tid + j_ * NT, key_ = id_ >> 4, part_ = id_ & 15; \
            *(LAS u32x4*)(Ks_ + key_ * AT_KP + part_ * 8) = (u32x4){kreg[j_].x, kreg[j_].y, kreg[j_].z, kreg[j_].w}; \
            *(LAS u32x4*)(Vs_ + key_ * AT_VP + part_ * 8) = (u32x4){vreg[j_].x, vreg[j_].y, vreg[j_].z, vreg[j_].w}; } } while (0)
    __syncthreads();
    AT_LOAD(0); AT_STORE(0);
    __syncthreads();
    for (int kt = 0; kt < nkt; ++kt) {
        if (kt + 1 < nkt) AT_LOAD(kt + 1);
        const LAS bf16* Ks = (const LAS bf16*)(lds + (kt & 1) * AT_BUF); const LAS bf16* Vs = (const LAS bf16*)(lds + (kt & 1) * AT_BUF + AT_KB);
        f32x4 S[2][4];
#pragma unroll
        for (int c = 0; c < 2; ++c)
#pragma unroll
            for (int sb = 0; sb < 4; ++sb) { f32x4 acc = (f32x4){0.f, 0.f, 0.f, 0.f};
#pragma unroll
                for (int ks = 0; ks < 2; ++ks) { const bf16x8 kf = *(const LAS bf16x8*)(Ks + (sb * 16 + fr) * AT_KP + c * 64 + ks * 32 + fq * 8);
                    acc = __builtin_amdgcn_mfma_f32_16x16x32_bf16(kf, qf[c][ks], acc, 0, 0, 0); }
                S[c][sb] = acc; }
        bf16x8 pf[2][2];
#pragma unroll
        for (int c = 0; c < 2; ++c) {
            float mx = S[c][0][0];
#pragma unroll
            for (int sb = 0; sb < 4; ++sb)
#pragma unroll
                for (int e = 0; e < 4; ++e) mx = fmaxf(mx, S[c][sb][e]);
            mx = fmaxf(mx, swz16(mx)); mx = fmaxf(mx, shx32(mx, lane));
            const float mnew = fmaxf(mrun[c], mx), alpha = __builtin_amdgcn_exp2f(mrun[c] - mnew); mrun[c] = mnew;
            float ps = 0.f;
#pragma unroll
            for (int sb = 0; sb < 4; ++sb)
#pragma unroll
                for (int e = 0; e < 4; ++e) { const float pv = __builtin_amdgcn_exp2f(S[c][sb][e] - mnew); S[c][sb][e] = pv; ps += pv; }
            lrun[c] = lrun[c] * alpha + ps;
#pragma unroll
            for (int d = 0; d < 8; ++d) O[c][d] *= alpha;
#pragma unroll
            for (int kc = 0; kc < 2; ++kc) { u32x4 w; w.x = pk2(S[c][2 * kc][0], S[c][2 * kc][1]); w.y = pk2(S[c][2 * kc][2], S[c][2 * kc][3]); w.z = pk2(S[c][2 * kc + 1][0], S[c][2 * kc + 1][1]); w.w = pk2(S[c][2 * kc + 1][2], S[c][2 * kc + 1][3]);
                pf[c][kc] = __builtin_bit_cast(bf16x8, w); }
        }
#pragma unroll
        for (int kc = 0; kc < 2; ++kc)
#pragma unroll
            for (int d = 0; d < 8; ++d) {
                const LAS bf16* pa = Vs + (kc * 32 + 4 * fq + q4) * AT_VP + d * 16 + 4 * p4;
                const bf16x8 vf = trfrag(pa, pa + 16 * AT_VP);
                O[0][d] = __builtin_amdgcn_mfma_f32_16x16x32_bf16(vf, pf[0][kc], O[0][d], 0, 0, 0);
                O[1][d] = __builtin_amdgcn_mfma_f32_16x16x32_bf16(vf, pf[1][kc], O[1][d], 0, 0, 0);
            }
        if (kt + 1 < nkt) AT_STORE(kt + 1);
        __syncthreads();
    }
#undef AT_LOAD
#undef AT_STORE
    float l0 = lrun[0], l1 = lrun[1];
    l0 += swz16(l0); l0 += shx32(l0, lane); l1 += swz16(l1); l1 += shx32(l1, lane);
    const float i0 = 1.0f / l0, i1 = lam / l1;
    float ss = 0.f;
#pragma unroll
    for (int d = 0; d < 8; ++d)
#pragma unroll
        for (int e = 0; e < 4; ++e) { const float o = O[0][d][e] * i0 - O[1][d][e] * i1; O[0][d][e] = o; ss += o * o; }
    ss += swz16(ss); ss += shx32(ss, lane);
    const float rs = rsqrtf(ss * (1.0f / 128.0f) + 1e-5f) * post;
    const float* sw = ldin(30) + l * 128;
#pragma unroll
    for (int d = 0; d < 8; ++d) { const int dc = d * 16 + 4 * fq; const float4 w4 = *(const float4*)(sw + dc);
        uint2 pk; pk.x = pk2(O[0][d][0] * rs * w4.x, O[0][d][1] * rs * w4.y); pk.y = pk2(O[0][d][2] * rs * w4.z, O[0][d][3] * rs * w4.w);
        *(uint2*)(A2 + (size_t)qrow * DM + 1536 + h * 128 + dc) = pk; }
}

__device__ __forceinline__ int q_pull(unsigned* ctr, volatile LAS unsigned* slot, int tid) {
    __syncthreads();
    if (tid == 0) *slot = __hip_atomic_fetch_add(ctr, 1u, __ATOMIC_RELAXED, __HIP_MEMORY_SCOPE_AGENT);
    __syncthreads();
    return (int)*slot;
}
__device__ __forceinline__ void p6_mixers(const Ctx& a, LAS unsigned char* lds, int l, int bid, int G) {
    unsigned char* ws = opqp(a.ws); const int tid = ((a.wv << 6) | lane_v());
    volatile LAS unsigned* slot = (volatile LAS unsigned*)(lds + LDS_STAGE + 8);
    unsigned* qm = (unsigned*)(ws + WS_CTL) + CW_Q + (l * 2 + 0) * 64; unsigned* qa = (unsigned*)(ws + WS_CTL) + CW_Q + (l * 2 + 1) * 64;
    if (a.sub & 1) for (int it = bid; it < 32; it += G) rwkv_r2(a, l, it);
    if (a.sub & 4) {
    const float* lp = ldin(29) + l * 256; float s01 = 0.f, s23 = 0.f;
    for (int i = 0; i < 64; ++i) { s01 += lp[i] * lp[64 + i]; s23 += lp[128 + i] * lp[192 + i]; }
    const float lam_init = l == 0 ? 0.2f : (0.8f - 0.6f * 0.74081822068f);
    const float lam = expf(s01) - expf(s23) + lam_init, post = 1.0f - lam_init;
    const int nat = l == 0 ? 576 : 512;
    for (;;) { const int it = q_pull(qa, slot, tid); if (it >= nat) break;
        if (it < 512) { const int qt = it & 15, h = (it >> 4) & 3, b = it >> 6; attn_item(a, lds, l, b, h, qt, false, lam, post); }
        else { const int i2 = it - 512; const int qt = i2 & 1, h = (i2 >> 1) & 3, b = i2 >> 3; attn_item(a, lds, l, b, h, qt, true, lam, post); } }
    }
    if (a.sub & 2) { const int nit = l == 0 ? 8 * MB_NCH * 2 : 8 * 16 * 2;
        for (;;) { const int it = q_pull(qm, slot, tid); if (it >= nit) break;
            const int g = it & 1; int cc, b; if (l == 0) { cc = (it >> 1) % MB_NCH; b = (it >> 1) / MB_NCH; } else { cc = 2 + ((it >> 1) & 15); b = it >> 5; } mamba_m3(a, lds, b, cc, g); } }
}


constexpr int N_PHASES = 27;
__global__ void __launch_bounds__(NT, 2) fwd(Args args) {
    extern __shared__ __attribute__((aligned(16))) unsigned char lds_dyn[];
    LAS unsigned char* lds = (LAS unsigned char*)lds_dyn;
    volatile LAS unsigned* MISC = (volatile LAS unsigned*)(lds + LDS_STAGE);
    const int wv = __builtin_amdgcn_readfirstlane((int)threadIdx.x >> 6);
    const int tid = (wv << 6) | lane_v(), bid = blockIdx.x, G = gridDim.x;
    unsigned char* ws = args.ws;
    const Ctx cx{ws, wv, args.sub};
    for (int u = tid; u < LDS_MISC / 4; u += NT) MISC[u] = 0u;
    __syncthreads();
    if (tid == 0) {
#pragma unroll
        for (int i = 0; i < 38; ++i) *(LAS unsigned long long*)(lds + LDS_PTRS + 8 * i) = (unsigned long long)args.in[i];
    }
    __syncthreads();
#if MK_PER_PHASE
#define GRID_BAR() do { } while (0)
#else
    XcdBarrier bar = xcd_barrier_post((unsigned*)(ws + WS_CTL) + CW_BAR, MISC);
#define GRID_BAR() do { XcdBarrier b_ = bar; b_.bar = opqp(b_.bar); b_.x = (unsigned)opqs((int)b_.x); xcd_barrier(b_); } while (0)
#endif
    const int lo = args.ph_lo, hi = args.ph_hi;
#define IN(k) (opqs(lo) <= (k) && (k) < opqs(hi))
#define SEAM(k) do { if (IN((k) + 1)) GRID_BAR(); } while (0)

#define XS (args.out)
#define XSB ((float*)(wsq + WS_XSB))
#define XC ((float*)(wsq + WS_XC))
#define HA ((bf16*)(wsq + WS_HA))
#define Ub ((bf16*)(wsq + WS_U))
#define MIX ((float*)(wsq + WS_MIX))
#define HID ((bf16*)(wsq + WS_BIG))
#define PH_LOCALS unsigned char* const wsq = opqp(ws); const int bidq = opqs(bid), Gq = opqs(G); (void)wsq; (void)bidq; (void)Gq

    if (IN(0)) { PH_LOCALS; if (args.sub & 64) bg_convert(cx, lds, nullptr, Gq); else p0_prologue(cx, lds,  bidq, Gq); SEAM(0); }
    if (IN(1)) { PH_LOCALS;
        thin_phase<0, 1>(cx, lds,  bidq, Gq, MTOT, ldin(0), ldin(2), nullptr, nullptr, nullptr, nullptr, 0, 0, ldin(6), 0, 1, 0);
        SEAM(1);
    }
    for (int l = 0; l < 2; ++l) {
        const int pb = 2 + 12 * l;
        const int Mo = l == 0 ? MTOT : MLAT;
        if (IN(pb + 0)) { PH_LOCALS;
            pg8::Gemm g{HA, (const bf16*)(wsq + WS_WIN) + (size_t)l * NINP * DM, MTOT, NINP, DM}; pg8::StaticOrder S; S.init(MTOT, NINP, Gq, bidq);
            pg8::EpiBf16P E{Ub, NINP, 0, 1.0f};
            pg8::gemm_phase<pg8::EpiBf16P, pg8::StaticOrder>(lds, g, S, E, nullptr, (wv << 6) | lane_v());
            bg_tail(cx, lds, l * 8 + 0, Gq);
            SEAM(pb + 0);
        }
        if (IN(pb + 1)) { PH_LOCALS; feat_a(cx, l,  bidq, Gq); SEAM(pb + 1); }
        if (IN(pb + 2)) { PH_LOCALS;
            pg8::Gemm g{(const bf16*)(wsq + WS_ASM), (const bf16*)(wsq + WS_WSM) + (size_t)l * 2048 * 256, MTOT, 2048, 256}; pg8::StaticOrder S; S.init(MTOT, 2048, Gq, bidq);
            pg8::EpiBf16P E{(bf16*)MIX, 2048, 0, 1.0f};
            pg8::gemm_phase<pg8::EpiBf16P, pg8::StaticOrder>(lds, g, S, E, nullptr, (wv << 6) | lane_v());
            for (int it = bidq; it < 8 * MB_NCH * 2; it += Gq) mamba_m1(cx, lds, it);
            bg_tail(cx, lds, l * 8 + 1, Gq);
            SEAM(pb + 2);
        }
        if (IN(pb + 4)) { PH_LOCALS; for (int it = bidq; it < 256; it += Gq) mamba_m2(cx, it);
            rc_consts(lds, l, (wv << 6) | lane_v());
            for (int u = bidq * NW + wv; u < RC_UNITS; u += Gq * NW) rwkv_r1(cx, lds, l, u); SEAM(pb + 4); }
        if (IN(pb + 5)) { PH_LOCALS; p6_mixers(cx, lds, l,  bidq, Gq); if (!(args.sub & 32)) bg_tail(cx, lds, l * 8 + 5, Gq); SEAM(pb + 5); }
        if (IN(pb + 6)) { PH_LOCALS; mix_out(cx, l, Mo,  bidq, Gq); SEAM(pb + 6); }
        if (IN(pb + 7)) { PH_LOCALS;
            pg8::Gemm g{HA, (const bf16*)(wsq + WS_WOUT) + (size_t)l * DM * DM, Mo, DM, DM}; pg8::StaticOrder S; S.init(Mo, DM, Gq, bidq);
            pg8::EpiBf16P E{(bf16*)MIX, DM, 0, 1.0f};
            pg8::gemm_phase<pg8::EpiBf16P, pg8::StaticOrder>(lds, g, S, E, nullptr, (wv << 6) | lane_v());
            bg_tail(cx, lds, l * 8 + 2, Gq);
            SEAM(pb + 7);
        }
        if (l == 0) {
            if (IN(pb + 8)) { PH_LOCALS;
                thin_phase<1, DENSE_FP8 ? 3 : 1, 0, 1>(cx, lds,  bidq, Gq, MTOT, ldin(0), ldin(2), XSB, XC, MIX, ldin(7), 0, 2, ldin(8), 0, 4, 3);
                SEAM(pb + 8);
            }
            if (IN(pb + 9)) { PH_LOCALS;
                pg8::StaticOrder S; S.init(MTOT, 2 * FF, Gq, bidq);
#if DENSE_FP8
                pg8::Gemm g{HA, (const bf16*)(wsq + WS_WGU), MTOT, 2 * FF, DM / 2};
                pg8::EpiSwiGLU8 E{(unsigned char*)(wsq + WS_BIG), FF, 0, 1.0f / MOE_SGU, MOE_SH};
                pg8::gemm_phase<pg8::EpiSwiGLU8, pg8::StaticOrder, false, true>(lds, g, S, E, nullptr, (wv << 6) | lane_v());
#else
                pg8::Gemm g{HA, (const bf16*)(wsq + WS_WGU), MTOT, 2 * FF, DM};
                pg8::EpiSwiGLU E{HID, FF, 0};
                pg8::gemm_phase<pg8::EpiSwiGLU, pg8::StaticOrder>(lds, g, S, E, nullptr, (wv << 6) | lane_v());
#endif
                bg_tail(cx, lds, 3, Gq);
                SEAM(pb + 9);
            }
            if (IN(pb + 10)) { PH_LOCALS;
                pg8::StaticOrder S; S.init(MTOT, DM, Gq, bidq);
#if DENSE_FP8
                pg8::Gemm g{HID, (const bf16*)(wsq + WS_WD), MTOT, DM, FF / 2};
                pg8::EpiBf16P E{(bf16*)MIX, DM, 0, 1.0f / (MOE_SD * MOE_SH)};
                pg8::gemm_phase<pg8::EpiBf16P, pg8::StaticOrder, false, true>(lds, g, S, E, nullptr, (wv << 6) | lane_v());
#else
                pg8::Gemm g{HID, (const bf16*)(wsq + WS_WD), MTOT, DM, FF};
                pg8::EpiBf16P E{(bf16*)MIX, DM, 0, 1.0f};
                pg8::gemm_phase<pg8::EpiBf16P, pg8::StaticOrder>(lds, g, S, E, nullptr, (wv << 6) | lane_v());
#endif
                bg_tail(cx, lds, 4, Gq);
                SEAM(pb + 10);
            }
            if (IN(pb + 11)) { PH_LOCALS;
                thin_phase<1, 1, 1, 1>(cx, lds,  bidq, Gq, MTOT, XSB, XC, XSB, XC, MIX, ldin(9), 0, 5, ldin(6) + DM, 1, 1, 0);
                SEAM(pb + 11);
            }
        } else {
            if (IN(pb + 8)) { PH_LOCALS;
                thin_phase<1, 2, 1, 1>(cx, lds,  bidq, Gq, MLAT, XSB, XC, XSB, XC, MIX, ldin(7) + DM, 1, 2, ldin(8) + DM, 1, 4, 3);
                SEAM(pb + 8);
            }
            if (IN(pb + 9)) { PH_LOCALS; moe_gather(cx,  bidq, Gq); bg_convert(cx, lds, nullptr, Gq); SEAM(pb + 9); }
            if (IN(pb + 10) || IN(pb + 11)) { PH_LOCALS;
                if (((wv << 6) | lane_v()) == 0) { const unsigned* cnt = (const unsigned*)(wsq + WS_CTL) + CW_CNT; int run = 0;
                    for (int e = 0; e < 8; ++e) { const int t = (int)((cnt[e * 64] + 255u) >> 8); MISC[16 + e] = (unsigned)t; MISC[24 + e] = (unsigned)run; run += t; } }
                __syncthreads();
            }
            if (IN(pb + 10)) { PH_LOCALS;
                pg8::MoeOrder S{(const LAS int*)(lds + LDS_STAGE + 64), (2 * FE) / 256, Gq, bidq};
#if MOE_FP8
                pg8::Gemm g{(const bf16*)(wsq + WS_U), (const bf16*)(wsq + WS_MGU), MOE_ROWS, 2 * FE, DM / 2};
                pg8::EpiSwiGLU8 E{(unsigned char*)(wsq + WS_BIG), FE, (2 * FE) / 256, 1.0f / MOE_SGU, MOE_SH};
                pg8::gemm_phase<pg8::EpiSwiGLU8, pg8::MoeOrder, false, true>(lds, g, S, E, nullptr, (wv << 6) | lane_v());
#else
                pg8::Gemm g{(const bf16*)(wsq + WS_U), (const bf16*)(wsq + WS_MGU), MOE_ROWS, 2 * FE, DM};
                pg8::EpiSwiGLU E{HID, FE, (2 * FE) / 256};
                pg8::gemm_phase<pg8::EpiSwiGLU, pg8::MoeOrder>(lds, g, S, E, nullptr, (wv << 6) | lane_v());
#endif
                SEAM(pb + 10);
            }
            if (IN(pb + 11)) { PH_LOCALS;
                pg8::MoeOrder S{(const LAS int*)(lds + LDS_STAGE + 64), DM / 256, Gq, bidq};
#if MOE_FP8
                pg8::Gemm g{HID, (const bf16*)(wsq + WS_MD), MOE_ROWS, DM, FE / 2};
                pg8::EpiBf16P E{(bf16*)(wsq + WS_MIX), DM, DM / 256, 1.0f / (MOE_SD * MOE_SH)};
                pg8::gemm_phase<pg8::EpiBf16P, pg8::MoeOrder, false, true>(lds, g, S, E, nullptr, (wv << 6) | lane_v());
#else
                pg8::Gemm g{HID, (const bf16*)(wsq + WS_MD), MOE_ROWS, DM, FE};
                pg8::EpiBf16P E{(bf16*)(wsq + WS_MIX), DM, DM / 256, 1.0f};
                pg8::gemm_phase<pg8::EpiBf16P, pg8::MoeOrder>(lds, g, S, E, nullptr, (wv << 6) | lane_v());
#endif
                SEAM(pb + 11);
            }
            if (IN(pb + 12)) { PH_LOCALS;
                thin_phase<2, 0, 1, 0>(cx, lds,  bidq, Gq, MLAT, XSB, XC, XS, XC, nullptr, ldin(9) + DM, 1, 5, nullptr, 0, 0, 0);
            }
        }
    }
#undef IN
#undef SEAM
}

extern "C" void kernel_launch(void* const* d_in, const int* in_sizes, int n_in, void* d_out, int out_size, void* d_ws, size_t ws_size, hipStream_t stream) {
    static int grid = 0;
    if (grid == 0) {
        if (n_in != 38 || out_size != MLAT * DM || ws_size < WS_END) { fprintf(stderr, "kernel_launch: unexpected shapes (n_in %d out %d ws %zu need %zu)\n", n_in, out_size, ws_size, (size_t)WS_END); grid = -1; return; }
        int dev = 0, cus = 0, per_cu = 0;
        if (hipGetDevice(&dev) != hipSuccess || hipDeviceGetAttribute(&cus, hipDeviceAttributeMultiprocessorCount, dev) != hipSuccess) { grid = -1; return; }
        if (hipFuncSetAttribute((const void*)fwd, hipFuncAttributeMaxDynamicSharedMemorySize, LDS_BYTES) != hipSuccess) { fprintf(stderr, "kernel_launch: hipFuncSetAttribute failed\n"); grid = -1; return; }
        if (hipOccupancyMaxActiveBlocksPerMultiprocessor(&per_cu, (const void*)fwd, NT, LDS_BYTES) != hipSuccess || per_cu < 1) { fprintf(stderr, "kernel_launch: occupancy query says %d\n", per_cu); per_cu = 1; }
        (void)hipGetLastError();
        grid = cus;
    }
    if (grid < 0) return;
    if (hipMemsetAsync((char*)d_ws + WS_CTL, 0, CTL_BYTES, stream) != hipSuccess) return;
    Args a{};
    for (int i = 0; i < 38; ++i) a.in[i] = (const float*)d_in[i];
    a.out = (float*)d_out; a.ws = (unsigned char*)d_ws; a.sub = 7;
#if MK_PER_PHASE
#ifndef PROBE_SUB
#define PROBE_SUB 7
#endif
#ifndef PROBE_MASK
#define PROBE_MASK 0u
#endif
#ifndef PROBE_SPLIT
#define PROBE_SPLIT 0
#endif
#ifndef PROBE_REP
#define PROBE_REP 1
#endif
    for (int p = 0; p < N_PHASES; ++p) { a.ph_lo = p; a.ph_hi = p + 1;
        if (PROBE_SPLIT && (p == 7 || p == 19)) {
            a.sub = 1; hipLaunchKernelGGL(fwd, dim3(grid), dim3(NT), LDS_BYTES, stream, a);
            if (PROBE_SPLIT == 1) { a.sub = 2; hipLaunchKernelGGL(fwd, dim3(grid), dim3(NT), LDS_BYTES, stream, a); a.sub = 4; hipLaunchKernelGGL(fwd, dim3(grid), dim3(NT), LDS_BYTES, stream, a); }
            else if (PROBE_SPLIT == 2) { a.sub = 6; hipLaunchKernelGGL(fwd, dim3(grid), dim3(NT), LDS_BYTES, stream, a); }
            else { a.sub = 2; hipLaunchKernelGGL(fwd, dim3(grid), dim3(NT), LDS_BYTES, stream, a); a.sub = 5; hipLaunchKernelGGL(fwd, dim3(grid), dim3(NT), LDS_BYTES, stream, a); }
            a.sub = 7; continue; }
        if ((PROBE_MASK >> p) & 1u) { a.sub = PROBE_SUB;
            for (int rep = 0; rep < PROBE_REP; ++rep) { if (rep) (void)hipMemsetAsync((char*)d_ws + WS_CTL + CW_BG * 4, 0, 256, stream); hipLaunchKernelGGL(fwd, dim3(grid), dim3(NT), LDS_BYTES, stream, a); }
            a.sub = 7;
            (void)hipMemsetAsync((char*)d_ws + WS_CTL + CW_Q * 4, 0, 4 * 256, stream); }
        hipLaunchKernelGGL(fwd, dim3(grid), dim3(NT), LDS_BYTES, stream, a); }
#else
    a.ph_lo = 0; a.ph_hi = N_PHASES; hipLaunchKernelGGL(fwd, dim3(grid), dim3(NT), LDS_BYTES, stream, a);
#endif
}
```

```cpp
#include <hip/hip_runtime.h>
#include <cstdio>
#include <cstdint>

#ifndef MK_PER_PHASE
#define MK_PER_PHASE 0
#endif

#define GAS __attribute__((address_space(1)))
#define LAS __attribute__((address_space(3)))
typedef GAS unsigned gu32;
typedef GAS unsigned long long gu64;

__device__ __forceinline__ int opq(int x) { asm volatile("" : "+v"(x)); return x; }
template <class T> __device__ __forceinline__ T* opqp(T* p) { int z = 0; asm volatile("" : "+s"(z)); return (T*)((unsigned char*)p + z); }
__device__ __forceinline__ int opqs(int x) { asm volatile("" : "+s"(x)); return x; }

__device__ __forceinline__ int lane_v() { int l; asm volatile("v_mbcnt_lo_u32_b32 %0, -1, 0\n\tv_mbcnt_hi_u32_b32 %0, -1, %0" : "=v"(l)); return l; }

namespace pg8 {
#define PG8_LAS __attribute__((address_space(3)))
typedef unsigned short bf16_t;
typedef short bf16x8 __attribute__((ext_vector_type(8)));
typedef float f32x4 __attribute__((ext_vector_type(4)));
typedef unsigned u32x4 __attribute__((ext_vector_type(4)));
typedef int i32x4 __attribute__((ext_vector_type(4)));
typedef int i32x8 __attribute__((ext_vector_type(8)));
constexpr int BM = 256, BK = 64, HALF = 128, HTB = HALF * BK * 2  , STAGE_BYTES = 8 * HTB, NXCD = 8, WGM = 8;

__host__ __device__ __forceinline__ int lds_byte(int r, int c) { const int st = (r >> 4) * 2 + (c >> 5), rr = r & 15, cc = c & 31, ob = rr * 64 + cc * 2; return st * 1024 + (ob ^ (((ob >> 9) & 1) << 5)); }
__host__ __device__ __forceinline__ void stage_rc(int b, int& R, int& C) { const int st = b / 1024, sb = b % 1024, swz = sb ^ (((sb >> 9) & 1) << 5); R = (st >> 1) * 16 + swz / 64; C = (st & 1) * 32 + (swz % 64) / 2; }
__host__ __device__ __forceinline__ int perm32(int rho) { const int n = rho >> 4, i = rho & 15; return 8 * (i >> 2) + 4 * n + (i & 3); }

struct Unit { int pm, pn; };
struct Gemm { const bf16_t* A; const bf16_t* Bt; int M, N, K; };

struct StaticOrder {
    int nM, nN, nwg, G, c;
    __host__ __device__ void init(int M, int N, int G_, int c_) { nM = M / BM; nN = N / BM; nwg = nM * nN; G = G_; c = c_; }
    __host__ __device__ bool next(int i, Unit& u) const {
        const long L = (long)i * G + c; if (L >= nwg) return false;
        int wgid = (int)L; { const int q = nwg / NXCD, r = nwg % NXCD, xcd = wgid % NXCD, off = wgid / NXCD; wgid = (xcd < r ? xcd * (q + 1) : r * (q + 1) + (xcd - r) * q) + off; }
        const int nig = WGM * nN, gid = wgid / nig, fm = gid * WGM, gsz = (nM - fm) < WGM ? (nM - fm) : WGM;
        u.pm = fm + ((wgid % nig) % gsz); u.pn = (wgid % nig) / gsz; return true;
    }
    __device__ __forceinline__ void a_ready(const Unit&) const {}
    __device__ __forceinline__ void done(const Unit&) const {}
};
__device__ __forceinline__ unsigned cvt_pk_bf16(float lo, float hi) { unsigned r; asm volatile("v_cvt_pk_bf16_f32 %0, %1, %2" : "=v"(r) : "v"(lo), "v"(hi)); return r; }
struct EpiF32 {
    static constexpr bool PERM = false, AFTER_DRAIN = false;
    float* C; int ldc; const float* bias;
    __device__ __forceinline__ void operator()(const f32x4 (&acc)[2][2][4][2], const Unit& u, int wr, int wc, int fr, int fq) const {
        const int row0 = u.pm * BM + wr * 64 + fr, col0 = u.pn * BM + wc * 32 + 4 * fq;
        f32x4 bv[2][2];
#pragma unroll
        for (int bj = 0; bj < 2; ++bj)
#pragma unroll
            for (int n = 0; n < 2; ++n) bv[bj][n] = bias ? *(const f32x4*)(bias + col0 + bj * HALF + n * 16) : (f32x4){0.f, 0.f, 0.f, 0.f};
#pragma unroll
        for (int ai = 0; ai < 2; ++ai)
#pragma unroll
            for (int m = 0; m < 4; ++m) { float* rowp = C + (size_t)(row0 + ai * HALF + m * 16) * ldc + col0;
#pragma unroll
                for (int bj = 0; bj < 2; ++bj)
#pragma unroll
                    for (int n = 0; n < 2; ++n) *(f32x4*)(rowp + bj * HALF + n * 16) = acc[ai][bj][m][n] + bv[bj][n]; }
    }
};

__device__ __forceinline__ float fsilu(float x) { return x * __builtin_amdgcn_rcpf(1.0f + __expf(-x)); }
__device__ __forceinline__ float fsigm(float x) { return __builtin_amdgcn_rcpf(1.0f + __expf(-x)); }

struct MoeOrder {
    const PG8_LAS int* tab; int nN, G, c;
    __device__ __forceinline__ bool next(int i, Unit& u) const {
        long L = (long)i * G + c;
#pragma unroll
        for (int e = 0; e < 8; ++e) { const int te = tab[e]; const long n = (long)te * nN; if (L < n) { u.pn = e * nN + (int)(L / te); u.pm = tab[8 + e] + (int)(L % te); return true; } L -= n; }
        return false;
    }
    __device__ __forceinline__ void a_ready(const Unit&) const {}
    __device__ __forceinline__ void done(const Unit&) const {}
};

struct EpiBf16P {
    static constexpr bool PERM = true, AFTER_DRAIN = false;
    bf16_t* O; int ldc; int nN; float scale;
    __device__ __forceinline__ void operator()(const f32x4 (&acc)[2][2][4][2], const Unit& u, int wr, int wc, int fr, int fq) const {
        const int row0 = u.pm * BM + wr * 64 + fr; const int pnr = nN ? (u.pn % nN) : u.pn; const int col0 = pnr * BM + wc * 32 + 8 * fq;
#pragma unroll
        for (int ai = 0; ai < 2; ++ai)
#pragma unroll
            for (int m = 0; m < 4; ++m) { bf16_t* rowp = O + (size_t)(row0 + ai * HALF + m * 16) * ldc + col0;
#pragma unroll
                for (int bj = 0; bj < 2; ++bj) { const f32x4 v0 = acc[ai][bj][m][0] * scale, v1 = acc[ai][bj][m][1] * scale;
                    u32x4 w; w.x = cvt_pk_bf16(v0[0], v0[1]); w.y = cvt_pk_bf16(v0[2], v0[3]); w.z = cvt_pk_bf16(v1[0], v1[1]); w.w = cvt_pk_bf16(v1[2], v1[3]);
                    *(u32x4*)(rowp + bj * HALF) = w; } }
    }
};

struct EpiSwiGLU {
    static constexpr bool PERM = true, AFTER_DRAIN = false;
    bf16_t* O; int ldc; int nN;
    __device__ __forceinline__ void operator()(const f32x4 (&acc)[2][2][4][2], const Unit& u, int wr, int wc, int fr, int fq) const {
        const int row0 = u.pm * BM + wr * 64 + fr; const int pnr = nN ? (u.pn % nN) : u.pn; const int col0 = pnr * HALF + wc * 32 + 8 * fq;
#pragma unroll
        for (int ai = 0; ai < 2; ++ai)
#pragma unroll
            for (int m = 0; m < 4; ++m) { bf16_t* rowp = O + (size_t)(row0 + ai * HALF + m * 16) * ldc + col0;
                const f32x4 g0 = acc[ai][0][m][0], g1 = acc[ai][0][m][1], u0 = acc[ai][1][m][0], u1 = acc[ai][1][m][1];
                f32x4 v0, v1;
#pragma unroll
                for (int j = 0; j < 4; ++j) { v0[j] = fsilu(g0[j]) * u0[j]; v1[j] = fsilu(g1[j]) * u1[j]; }
                u32x4 w; w.x = cvt_pk_bf16(v0[0], v0[1]); w.y = cvt_pk_bf16(v0[2], v0[3]); w.z = cvt_pk_bf16(v1[0], v1[1]); w.w = cvt_pk_bf16(v1[2], v1[3]);
                *(u32x4*)rowp = w; }
    }
};


__device__ __forceinline__ float clamp8(float x) { return fminf(fmaxf(x, -448.0f), 448.0f); }
__device__ __forceinline__ unsigned pk_fp8x4(float a, float b, float c, float d) { int w = __builtin_amdgcn_cvt_pk_fp8_f32(clamp8(a), clamp8(b), 0, false); w = __builtin_amdgcn_cvt_pk_fp8_f32(clamp8(c), clamp8(d), w, true); return (unsigned)w; }
struct EpiSwiGLUS {
    static constexpr bool PERM = true, AFTER_DRAIN = false;
    bf16_t* O; int ldc; int nN; float sin;
    __device__ __forceinline__ void operator()(const f32x4 (&acc)[2][2][4][2], const Unit& u, int wr, int wc, int fr, int fq) const {
        const int row0 = u.pm * BM + wr * 64 + fr; const int pnr = nN ? (u.pn % nN) : u.pn; const int col0 = pnr * HALF + wc * 32 + 8 * fq;
#pragma unroll
        for (int ai = 0; ai < 2; ++ai)
#pragma unroll
            for (int m = 0; m < 4; ++m) { bf16_t* rowp = O + (size_t)(row0 + ai * HALF + m * 16) * ldc + col0;
                const f32x4 g0 = acc[ai][0][m][0] * sin, g1 = acc[ai][0][m][1] * sin, u0 = acc[ai][1][m][0] * sin, u1 = acc[ai][1][m][1] * sin;
                f32x4 v0, v1;
#pragma unroll
                for (int j = 0; j < 4; ++j) { v0[j] = fsilu(g0[j]) * u0[j]; v1[j] = fsilu(g1[j]) * u1[j]; }
                u32x4 w; w.x = cvt_pk_bf16(v0[0], v0[1]); w.y = cvt_pk_bf16(v0[2], v0[3]); w.z = cvt_pk_bf16(v1[0], v1[1]); w.w = cvt_pk_bf16(v1[2], v1[3]);
                *(u32x4*)rowp = w; }
    }
};


struct EpiSwiGLU8 {
    static constexpr bool PERM = true, AFTER_DRAIN = false;
    unsigned char* O; int ldc; int nN; float sin, sout;
    __device__ __forceinline__ void operator()(const f32x4 (&acc)[2][2][4][2], const Unit& u, int wr, int wc, int fr, int fq) const {
        const int row0 = u.pm * BM + wr * 64 + fr; const int pnr = nN ? (u.pn % nN) : u.pn; const int col0 = pnr * HALF + wc * 32 + 8 * fq;
#pragma unroll
        for (int ai = 0; ai < 2; ++ai)
#pragma unroll
            for (int m = 0; m < 4; ++m) { unsigned char* rowp = O + (size_t)(row0 + ai * HALF + m * 16) * ldc + col0;
                const f32x4 g0 = acc[ai][0][m][0] * sin, g1 = acc[ai][0][m][1] * sin, u0 = acc[ai][1][m][0] * (sin * sout), u1 = acc[ai][1][m][1] * (sin * sout);
                f32x4 v0, v1;
#pragma unroll
                for (int j = 0; j < 4; ++j) { v0[j] = fsilu(g0[j]) * u0[j]; v1[j] = fsilu(g1[j]) * u1[j]; }
                uint2 w; w.x = pk_fp8x4(v0[0], v0[1], v0[2], v0[3]); w.y = pk_fp8x4(v1[0], v1[1], v1[2], v1[3]);
                *(uint2*)rowp = w; }
    }
};


struct EpiF32S {
    static constexpr bool PERM = false, AFTER_DRAIN = false;
    float* C; int ldc; float scale;
    __device__ __forceinline__ void operator()(const f32x4 (&acc)[2][2][4][2], const Unit& u, int wr, int wc, int fr, int fq) const {
        const int row0 = u.pm * BM + wr * 64 + fr, col0 = u.pn * BM + wc * 32 + 4 * fq;
#pragma unroll
        for (int ai = 0; ai < 2; ++ai)
#pragma unroll
            for (int m = 0; m < 4; ++m) { float* rowp = C + (size_t)(row0 + ai * HALF + m * 16) * ldc + col0;
#pragma unroll
                for (int bj = 0; bj < 2; ++bj)
#pragma unroll
                    for (int n = 0; n < 2; ++n) *(f32x4*)(rowp + bj * HALF + n * 16) = acc[ai][bj][m][n] * scale; }
    }
};

template <class Epi, class Sched, bool STAMP = false, bool F8 = false>
__device__ __forceinline__ void gemm_phase(PG8_LAS unsigned char* lds, const Gemm g, const Sched& S, const Epi& E, unsigned long long* stamps, const int tid_in) {
    const int tid = opq(tid_in), wid = __builtin_amdgcn_readfirstlane(tid >> 6), lane = tid & 63, wr = wid >> 2, wc = wid & 3, fr = lane & 15, fq = lane >> 4;
    const int K = g.K, nt = K / BK;
    int ts_lo = 0, ts_hi = 0, nts = 0; const unsigned long long rt_entry = STAMP ? (unsigned long long)wall_clock64() : 0ull;
#define PG8_STAMP() do { if (STAMP && wid == 0 && nts < 64) { const unsigned long long _c = (unsigned long long)clock64(); \
        ts_lo = (lane == nts) ? (int)(unsigned)_c : ts_lo; ts_hi = (lane == nts) ? (int)(unsigned)(_c >> 32) : ts_hi; ++nts; } } while (0)
    PG8_STAMP();
    unsigned voffA[2], voffB[2];
#pragma unroll
    for (int i = 0; i < 2; ++i) { int R, C; stage_rc(tid * 16 + i * 8192, R, C); const int Rb = Epi::PERM ? ((R & ~31) + perm32(R & 31)) : R;
        voffA[i] = (unsigned)(R * K + C) * 2u; voffB[i] = (unsigned)(Rb * K + C) * 2u; }
    const size_t kstep = (size_t)(BK * 2);
    const size_t qstep = (size_t)64 * K * 2;
    const size_t hstep = (size_t)HALF * K * 2;
    const size_t tstep = 2 * hstep;
    const unsigned ldsw = (unsigned)wid * 1024u;
    const int aoff = lds_byte(wr * 64 + fr, fq * 8), boff = lds_byte(wc * 32 + fr, fq * 8);
#define PG8_SA(b, h) (((b) * 2 + (h)) * HTB)
#define PG8_SB(b, h) ((4 + (b) * 2 + (h)) * HTB)
#define PG8_STAGE(bufoff, gbase, voff) do { _Pragma("unroll") for (int _i = 0; _i < 2; ++_i) \
        __builtin_amdgcn_global_load_lds((const unsigned*)((const char*)(gbase) + (size_t)_i * qstep + (voff)[0]), (PG8_LAS unsigned*)(lds + (bufoff) + ldsw + _i * 8192), 16, 0, 0); } while (0)
#define PG8_LDA(dst, b, h) do { _Pragma("unroll") for (int m = 0; m < 4; ++m) { if constexpr (F8) { const i32x4 lo_ = *(const PG8_LAS i32x4*)(lds + PG8_SA(b, h) + aoff + m * 2048), hi_ = *(const PG8_LAS i32x4*)(lds + PG8_SA(b, h) + aoff + m * 2048 + 1024); \
            dst##8[m] = __builtin_shufflevector(lo_, hi_, 0, 1, 2, 3, 4, 5, 6, 7); } else { _Pragma("unroll") for (int k = 0; k < 2; ++k) dst[m][k] = *(const PG8_LAS bf16x8*)(lds + PG8_SA(b, h) + aoff + m * 2048 + k * 1024); } } } while (0)
#define PG8_LDB(dst, b, h) do { _Pragma("unroll") for (int n = 0; n < 2; ++n) { if constexpr (F8) { const i32x4 lo_ = *(const PG8_LAS i32x4*)(lds + PG8_SB(b, h) + boff + n * 2048), hi_ = *(const PG8_LAS i32x4*)(lds + PG8_SB(b, h) + boff + n * 2048 + 1024); \
            dst##8[n] = __builtin_shufflevector(lo_, hi_, 0, 1, 2, 3, 4, 5, 6, 7); } else { _Pragma("unroll") for (int k = 0; k < 2; ++k) dst[n][k] = *(const PG8_LAS bf16x8*)(lds + PG8_SB(b, h) + boff + n * 2048 + k * 1024); } } } while (0)
#define PG8_MMA(ai, bj, At, Bt) do { __builtin_amdgcn_s_setprio(1); _Pragma("unroll") for (int m = 0; m < 4; ++m) _Pragma("unroll") for (int n = 0; n < 2; ++n) { \
        if constexpr (F8) {   \
            asm volatile("v_mfma_scale_f32_16x16x128_f8f6f4 %0, %1, %2, %0, %3, %3 op_sel_hi:[0,0,0]" : "+v"(acc[ai][bj][m][n]) : "v"(Bt##8[n]), "v"(At##8[m]), "v"(f8scale)); } \
        else { _Pragma("unroll") for (int k = 0; k < 2; ++k) acc[ai][bj][m][n] = __builtin_amdgcn_mfma_f32_16x16x32_bf16(Bt[n][k], At[m][k], acc[ai][bj][m][n], 0, 0, 0); } } \
        __builtin_amdgcn_s_setprio(0); } while (0)
#define PG8_WAIT_V(n) asm volatile("s_waitcnt vmcnt(" #n ")" ::: "memory")
#define PG8_WAIT_L(n) asm volatile("s_waitcnt lgkmcnt(" #n ")" ::: "memory")
#define PG8_BAR __builtin_amdgcn_s_barrier()
#define PG8_SCHED __builtin_amdgcn_sched_barrier(0)
    float zf_ = 0.f; asm volatile("" : "+v"(zf_));
    Unit cur, nxt; int ui = 0;
    if (!S.next(0, cur)) return;
    f32x4 acc[2][2][4][2];
#pragma unroll
    for (int a = 0; a < 2; ++a)
#pragma unroll
        for (int b = 0; b < 2; ++b)
#pragma unroll
            for (int m = 0; m < 4; ++m)
#pragma unroll
                for (int n = 0; n < 2; ++n) acc[a][b][m][n] = (f32x4){zf_, zf_, zf_, zf_};
    int f8scale = 0x7F7F7F7F; asm volatile("" : "+v"(f8scale));
    bf16x8 At[4][2], B0[2][2], B1[2][2]; i32x8 At8[4], B08[2], B18[2]; (void)At; (void)B0; (void)B1; (void)At8; (void)B08; (void)B18;
    const char* cA = (const char*)g.A + (size_t)cur.pm * tstep; const char* cB = (const char*)g.Bt + (size_t)cur.pn * tstep;
    S.a_ready(cur);
    PG8_STAGE(PG8_SB(0, 0), cB, voffB); PG8_STAGE(PG8_SA(0, 0), cA, voffA); PG8_STAGE(PG8_SB(0, 1), cB + hstep, voffB); PG8_STAGE(PG8_SA(0, 1), cA + hstep, voffA);
    if (wr == 1) PG8_BAR;
    PG8_WAIT_V(4); PG8_BAR;
    PG8_STAGE(PG8_SB(1, 0), cB + kstep, voffB); PG8_STAGE(PG8_SA(1, 0), cA + kstep, voffA); PG8_STAGE(PG8_SB(1, 1), cB + hstep + kstep, voffB);
    PG8_WAIT_V(6); PG8_BAR;
    PG8_STAMP();
    for (;;) {
        const bool has_next = S.next(ui + 1, nxt);
        const char* nA = has_next ? (const char*)g.A + (size_t)nxt.pm * tstep : cA; const char* nB = has_next ? (const char*)g.Bt + (size_t)nxt.pn * tstep : cB;
        for (int t = 0; t < nt; t += 2) {
            const bool last = (t == nt - 2);
            const char* a1 = cA + (size_t)(t + 1) * kstep;
            const char* a2 = last ? nA : cA + (size_t)(t + 2) * kstep; const char* b2 = last ? nB : cB + (size_t)(t + 2) * kstep;
            const char* a3 = a2 + kstep; const char* b3 = b2 + kstep;
            if (last && has_next) S.a_ready(nxt);
            PG8_LDB(B0, 0, 0); PG8_SCHED; PG8_LDA(At, 0, 0); PG8_STAGE(PG8_SA(1, 1), a1 + hstep, voffA);
            PG8_WAIT_L(8); PG8_BAR; PG8_WAIT_L(0); PG8_MMA(0, 0, At, B0); PG8_BAR; PG8_SCHED;
            PG8_LDB(B1, 0, 1); PG8_STAGE(PG8_SB(0, 0), b2, voffB);
            PG8_BAR; PG8_WAIT_L(0); PG8_MMA(0, 1, At, B1); PG8_BAR;
            PG8_LDA(At, 0, 1); PG8_STAGE(PG8_SA(0, 0), a2, voffA);
            PG8_BAR; PG8_WAIT_L(0); PG8_MMA(1, 0, At, B0); PG8_BAR; PG8_SCHED;
            PG8_STAGE(PG8_SB(0, 1), b2 + hstep, voffB);
            PG8_WAIT_V(6); PG8_BAR; PG8_MMA(1, 1, At, B1); PG8_BAR;
            PG8_LDB(B0, 1, 0); PG8_SCHED; PG8_LDA(At, 1, 0); PG8_STAGE(PG8_SA(0, 1), a2 + hstep, voffA);
            PG8_WAIT_L(8); PG8_BAR; PG8_WAIT_L(0); PG8_MMA(0, 0, At, B0); PG8_BAR; PG8_SCHED;
            PG8_LDB(B1, 1, 1); PG8_STAGE(PG8_SB(1, 0), b3, voffB);
            PG8_BAR; PG8_WAIT_L(0); PG8_MMA(0, 1, At, B1); PG8_BAR;
            PG8_LDA(At, 1, 1); PG8_STAGE(PG8_SA(1, 0), a3, voffA);
            PG8_BAR; PG8_WAIT_L(0); PG8_MMA(1, 0, At, B0); PG8_BAR; PG8_SCHED;
            PG8_STAGE(PG8_SB(1, 1), b3 + hstep, voffB);
            PG8_WAIT_V(6); PG8_BAR; PG8_MMA(1, 1, At, B1); PG8_BAR;
        }
        PG8_STAMP();
        if constexpr (F8) { asm volatile("s_nop 15\n\ts_nop 15" ::: "memory"); }
        if constexpr (!Epi::AFTER_DRAIN) { E(acc, cur, wr, wc, fr, fq); S.done(cur); }
        PG8_STAMP();
        if (!has_next) break;
#pragma unroll
        for (int a = 0; a < 2; ++a)
#pragma unroll
            for (int b = 0; b < 2; ++b)
#pragma unroll
                for (int m = 0; m < 4; ++m)
#pragma unroll
                    for (int n = 0; n < 2; ++n) acc[a][b][m][n] = (f32x4){zf_, zf_, zf_, zf_};
        cur = nxt; cA = nA; cB = nB; ++ui;
    }
    PG8_WAIT_V(0);
    if (wr == 0) PG8_BAR;
    PG8_BAR;
    if constexpr (Epi::AFTER_DRAIN) { E.fused(acc, cur, wr, wc, fr, fq, lds, wid, lane); S.done(cur); }
    PG8_STAMP();
    if (STAMP && wid == 0) { stamps[lane] = lane < nts ? (((unsigned long long)(unsigned)ts_hi << 32) | (unsigned)ts_lo) : 0ull;
        if (lane == 62) stamps[62] = rt_entry; if (lane == 63) stamps[63] = (unsigned long long)wall_clock64(); }
#undef PG8_STAMP
#undef PG8_SA
#undef PG8_SB
#undef PG8_STAGE
#undef PG8_LDA
#undef PG8_LDB
#undef PG8_MMA
#undef PG8_WAIT_V
#undef PG8_WAIT_L
#undef PG8_BAR
#undef PG8_SCHED
}
}
#define RLX_AGENT __ATOMIC_RELAXED, __HIP_MEMORY_SCOPE_AGENT
#define XB_TMO      128
#define XB_XCNT(j)  (256  + 64 * (j))
#define XB_XSUB(j)  (1280 + 64 * (j))
#define XB_XGEN(j)  (2304 + 64 * (j))
#define XB_TOP      3328
#define XB_TOPGEN   3392
#define XCD_BAR_WORDS 3456
#define XB_SPIN_CAP (1u << 18)

__device__ __forceinline__ unsigned xb_ld(unsigned* p)              { return __hip_atomic_load(p, __ATOMIC_RELAXED, __HIP_MEMORY_SCOPE_AGENT); }
__device__ __forceinline__ unsigned xb_add(unsigned* p, unsigned v) { return __hip_atomic_fetch_add(p, v, __ATOMIC_RELAXED, __HIP_MEMORY_SCOPE_AGENT); }
__device__ __forceinline__ unsigned xb_xcc_id() { return (unsigned)__builtin_amdgcn_s_getreg((3 << 11) | 20) & 0xFu; }
#define XB_SPIN(cond, bar) do { unsigned _sp = 0; while (cond) { __builtin_amdgcn_s_sleep(1); \
    if ((++_sp & 255u) == 0u) { if (xb_ld(&(bar)[XB_TMO])) break; if (_sp > XB_SPIN_CAP) { atomicAdd(&(bar)[XB_TMO], 1u); break; } } } } while (0)

struct XcdBarrier {
    unsigned* bar; unsigned x; int wv;
    volatile LAS unsigned* st;
};

__device__ __forceinline__ XcdBarrier xcd_barrier_post(unsigned* bar, volatile LAS unsigned* st) {
    XcdBarrier b; b.bar = bar; b.x = xb_xcc_id(); b.st = st; b.wv = __builtin_amdgcn_readfirstlane((int)threadIdx.x >> 6);
    if (threadIdx.x == 0) (void)xb_add(&bar[XB_XCNT(b.x)], 1u);
    return b;
}
__device__ __forceinline__ void xcd_barrier_complete(unsigned* bar, unsigned x, unsigned& nloc, unsigned& nx) {
    const unsigned G = gridDim.x * gridDim.y * gridDim.z;
    unsigned sum, cnt, mine, sp = 0u;
    for (;;) {
        sum = 0u; cnt = 0u; mine = 0u;
#pragma unroll
        for (unsigned j = 0; j < 16; ++j) { const unsigned c = xb_ld(&bar[XB_XCNT(j)]); sum += c; cnt += (c > 0u) ? 1u : 0u; mine = (j == x) ? c : mine; }
        if (sum == G) break;
        __builtin_amdgcn_s_sleep(1);
        if ((++sp & 255u) == 0u) { if (xb_ld(&bar[XB_TMO])) break; if (sp > XB_SPIN_CAP) { atomicAdd(&bar[XB_TMO], 1u); break; } }
    }
    nloc = mine > 0u ? mine : 1u; nx = cnt > 0u ? cnt : 1u;
}

__device__ __forceinline__ void xcd_barrier(const XcdBarrier& b) {
    asm volatile("s_waitcnt vmcnt(0)" ::: "memory");
    __syncthreads();
    if (((b.wv << 6) | lane_v()) == 0) {
        unsigned* bar = b.bar;
        __builtin_amdgcn_s_waitcnt(0);
        unsigned nloc = b.st[0], nx = b.st[1];
        if (nloc == 0u) { xcd_barrier_complete(bar, b.x, nloc, nx); b.st[0] = nloc; b.st[1] = nx; }
        const unsigned old = xb_add(&bar[XB_XSUB(b.x)], 1u);
        const unsigned gen = old / nloc;
        if (old + 1u == (gen + 1u) * nloc) {
            __builtin_amdgcn_fence(__ATOMIC_RELEASE, "agent");
            asm volatile("s_waitcnt vmcnt(0)" ::: "memory");
            const unsigned og = xb_add(&bar[XB_TOP], 1u);
            const unsigned tg = og / nx;
            if (og + 1u == (tg + 1u) * nx) xb_add(&bar[XB_TOPGEN], 1u);
            else XB_SPIN(xb_ld(&bar[XB_TOPGEN]) == tg, bar);
            __builtin_amdgcn_fence(__ATOMIC_ACQUIRE, "agent");
            xb_add(&bar[XB_XGEN(b.x)], 1u);
            asm volatile("s_waitcnt vmcnt(0)" ::: "memory");
        } else {
            XB_SPIN(xb_ld(&bar[XB_XGEN(b.x)]) == gen, bar);
            __builtin_amdgcn_fence(__ATOMIC_ACQUIRE, "agent");
            asm volatile("s_waitcnt vmcnt(0)" ::: "memory");
        }
    }
    __syncthreads();
}

typedef unsigned short bf16;
using pg8::bf16x8; using pg8::f32x4; using pg8::u32x4;
typedef unsigned u32x2 __attribute__((ext_vector_type(2)));
constexpr int NT = 512, NW = 8;
constexpr int DM = 2048, NB = 8, SEQ = 2048, CTXL = 256;
constexpr int MLAT = NB * SEQ, MCTX = NB * CTXL, MTOT = MLAT + MCTX;
constexpr int NIN = 5920, NINP = 6144;
constexpr int C_RW_R = 0, C_RW_K = 512, C_RW_V = 1024, C_RW_XW = 1536;
constexpr int C_MB_Z = 1792, C_MB_XBC = 2816, C_MB_DT = 4352;
constexpr int C_DA_Q = 4384, C_DA_V = 5408;
constexpr int FF = 5632, FE = 7168, NE = 8;
constexpr int MOE_ROWS = 34816;
constexpr int LDS_STAGE = 131072, LDS_MISC = 1024, LDS_BYTES = LDS_STAGE + LDS_MISC;

#ifndef MOE_FP8
#define MOE_FP8 1
#endif
#ifndef DENSE_GU8
#define DENSE_GU8 1
#endif
#ifndef DENSE_D8
#define DENSE_D8 0
#endif
constexpr float MOE_SGU = 32.0f, MOE_SD = 64.0f, MOE_SH = 4.0f;
constexpr size_t MiB = 1048576;
constexpr size_t WS_CTL   = 0;
constexpr size_t CTL_BYTES = 65536;
constexpr size_t CW_BAR = 0, CW_CNT = 4096  , CW_Q = 8192  , CW_BG = 8704  , CW_DONE = 9216  ;
constexpr size_t WS_ADA   = 1 * MiB;
constexpr size_t WS_ROPE  = 2 * MiB;
constexpr size_t WS_TOK   = 3 * MiB;
constexpr size_t WS_WIN   = 4 * MiB;
constexpr size_t WS_WOUT  = WS_WIN  + 48 * MiB;
constexpr size_t WS_WSM   = WS_WOUT + 16 * MiB;
constexpr size_t WS_WGU   = WS_WSM  + 2 * MiB;
constexpr size_t WS_WD    = WS_WGU  + 44 * MiB;
constexpr size_t WS_MGU   = WS_WD   + 22 * MiB;
constexpr size_t WS_MD    = WS_MGU  + 448 * MiB;
constexpr size_t WS_XC    = WS_MD   + 224 * MiB;
constexpr size_t WS_HA    = WS_XC   + 16 * MiB;
constexpr size_t WS_U     = WS_HA   + 72 * MiB;
constexpr size_t WS_MIX   = WS_U    + 216 * MiB;
constexpr size_t WS_BIG   = WS_MIX  + 144 * MiB;
constexpr size_t WS_XSB   = WS_BIG  + 476 * MiB;
constexpr size_t WS_END   = WS_XSB  + 64 * MiB;
constexpr size_t WS_ASM   = WS_BIG;
constexpr size_t WS_XBC   = WS_ASM  + 9 * MiB;
constexpr size_t WS_DT    = WS_XBC  + 54 * MiB;
constexpr size_t WS_QK    = WS_DT   + 5 * MiB;
constexpr size_t WS_RW5   = WS_QK   + 36 * MiB;
constexpr size_t WS_YR    = WS_RW5  + 90 * MiB;
constexpr size_t WS_YM    = WS_YR   + 72 * MiB;
constexpr size_t WS_ST    = WS_YM   + 72 * MiB;
constexpr size_t WS_AC    = WS_ST   + 72 * MiB;
static_assert(WS_AC + 1 * MiB <= WS_END, "mixer intermediates overflow BIG");
static_assert((size_t)MOE_ROWS * FE * 2 <= 476 * MiB && (size_t)MOE_ROWS * DM * 2 <= 144 * MiB, "moe buffers");

struct Args { const float* in[38]; float* out; unsigned char* ws; int ph_lo, ph_hi, sub, pad; };
struct Ctx { unsigned char* ws; int wv; int sub; };

constexpr int LDS_PTRS = LDS_STAGE + 128;
__device__ __forceinline__ const float* ldin(int k) {
    extern __shared__ __attribute__((aligned(16))) unsigned char lds_dyn[];
    const int base = opqs((int)(unsigned)(unsigned long long)(LAS unsigned char*)lds_dyn);
    const LAS unsigned* p = (const LAS unsigned*)(unsigned long long)(unsigned)(base + LDS_PTRS + 8 * k);
    const unsigned lo = __builtin_amdgcn_readfirstlane(p[0]), hi = __builtin_amdgcn_readfirstlane(p[1]);
    return (const float*)(const GAS float*)(((unsigned long long)hi << 32) | (unsigned long long)lo);
}
__device__ __forceinline__ float bf2f(unsigned short b) { return __uint_as_float(((unsigned)b) << 16); }
typedef float f32x2_t __attribute__((ext_vector_type(2)));
typedef __bf16 bf16x2_t __attribute__((ext_vector_type(2)));
__device__ __forceinline__ unsigned pk2(float lo, float hi) { const f32x2_t v = {lo, hi}; return __builtin_bit_cast(unsigned, __builtin_convertvector(v, bf16x2_t)); }
__device__ __forceinline__ unsigned f2bf(float f) { return pk2(f, f) & 0xffffu; }
__device__ __forceinline__ void unpack8(const uint4 w, float (&f)[8]) {
    f[0] = __uint_as_float(w.x << 16); f[1] = __uint_as_float(w.x & 0xffff0000u); f[2] = __uint_as_float(w.y << 16); f[3] = __uint_as_float(w.y & 0xffff0000u);
    f[4] = __uint_as_float(w.z << 16); f[5] = __uint_as_float(w.z & 0xffff0000u); f[6] = __uint_as_float(w.w << 16); f[7] = __uint_as_float(w.w & 0xffff0000u); }
__device__ __forceinline__ uint4 pack8(const float (&f)[8]) { uint4 w; w.x = pk2(f[0], f[1]); w.y = pk2(f[2], f[3]); w.z = pk2(f[4], f[5]); w.w = pk2(f[6], f[7]); return w; }
__device__ __forceinline__ void unpack4(const uint2 w, float (&f)[4]) {
    f[0] = __uint_as_float(w.x << 16); f[1] = __uint_as_float(w.x & 0xffff0000u); f[2] = __uint_as_float(w.y << 16); f[3] = __uint_as_float(w.y & 0xffff0000u); }
template <int CTRL> __device__ __forceinline__ float dppf(float v) { return __int_as_float(__builtin_amdgcn_update_dpp(0, __float_as_int(v), CTRL, 0xf, 0xf, false)); }
__device__ __forceinline__ float red8(float v)  { v += dppf<0xB1>(v); v += dppf<0x4E>(v); v += dppf<0x141>(v); return v; }
__device__ __forceinline__ float red16(float v) { v += dppf<0xB1>(v); v += dppf<0x4E>(v); v += dppf<0x141>(v); v += dppf<0x140>(v); return v; }
__device__ __forceinline__ float swz16(float v) { return __int_as_float(__builtin_amdgcn_ds_swizzle(__float_as_int(v), 0x401F)); }
__device__ __forceinline__ float red32(float v) { v = red16(v); v += swz16(v); return v; }
__device__ __forceinline__ float wsum(float v) { v = red32(v); return __int_as_float(__builtin_amdgcn_readlane(__float_as_int(v), 0)) + __int_as_float(__builtin_amdgcn_readlane(__float_as_int(v), 32)); }
__device__ __forceinline__ float shx32(float v, int lane) { return __int_as_float(__builtin_amdgcn_ds_bpermute((lane ^ 32) << 2, __float_as_int(v))); }
__device__ __forceinline__ float fsilu(float x) { return pg8::fsilu(x); }
__device__ __forceinline__ float fsigm(float x) { return pg8::fsigm(x); }
__device__ __forceinline__ float softplusf(float x) { return fmaxf(x, 0.f) + log1pf(__expf(-fabsf(x))); }


template <bool F8>
__device__ __forceinline__ void cvt_job_t(const float* __restrict__ src, int ld, int ncols_valid, int ncols_total, void* __restrict__ dstv, int K, int mode, float scale, LAS float* tile, int bid, int G, const int tid, int t_end = 0x7fffffff) {
    const int ntn = ncols_total >> 6, ntk = K >> 7; const int nt = (ntn * ntk) < t_end ? (ntn * ntk) : t_end;
    const int lk = tid >> 4, lc = (tid & 15) * 4;
    constexpr int TP = 65;
    float4 r[4]; int buf = 0;
    const float4 z4 = make_float4(0.f, 0.f, 0.f, 0.f);
#define CVT_LOAD(t_, dst_) do { const int tn_ = (t_) % ntn, tk_ = (t_) / ntn; const int n_ = tn_ * 64 + lc; const float* p_ = src + (size_t)(tk_ * 128 + lk) * ld + n_; \
        _Pragma("unroll") for (int i_ = 0; i_ < 4; ++i_) dst_[i_] = (n_ < ncols_valid) ? *(const float4*)(p_ + (size_t)(32 * i_) * ld) : z4; } while (0)
    int t = bid;
    if (t < nt) CVT_LOAD(t, r);
    __syncthreads();
    for (; t < nt; t += G) {
        float4 nx[4] = {z4, z4, z4, z4};
        if (t + G < nt) CVT_LOAD(t + G, nx);
        LAS float* tl = tile + buf * (128 * TP);
#pragma unroll
        for (int i = 0; i < 4; ++i) { LAS float* q = tl + (lk + 32 * i) * TP + lc; q[0] = r[i].x; q[1] = r[i].y; q[2] = r[i].z; q[3] = r[i].w; }
        __syncthreads();
        const int tn = t % ntn, tk = t / ntn, k0 = tk * 128, nb = tn * 64;
        const int kq = tid & 7, nl = tid >> 3, nn = nb + nl;
        const int drow = mode == 0 ? nn : ((nn >> 7) * 256 + (nn & 127) + (mode == 2 ? 128 : 0));
        const LAS float* c = tl + (kq * 16) * TP + nl;
        if (F8) {
            uint4 w;
            w.x = pg8::pk_fp8x4(c[0 * TP] * scale, c[1 * TP] * scale, c[2 * TP] * scale, c[3 * TP] * scale); w.y = pg8::pk_fp8x4(c[4 * TP] * scale, c[5 * TP] * scale, c[6 * TP] * scale, c[7 * TP] * scale);
            w.z = pg8::pk_fp8x4(c[8 * TP] * scale, c[9 * TP] * scale, c[10 * TP] * scale, c[11 * TP] * scale); w.w = pg8::pk_fp8x4(c[12 * TP] * scale, c[13 * TP] * scale, c[14 * TP] * scale, c[15 * TP] * scale);
            *(uint4*)((unsigned char*)dstv + (size_t)drow * K + k0 + kq * 16) = w;
        } else {
            uint4 w0, w1;
            w0.x = pk2(c[0 * TP], c[1 * TP]); w0.y = pk2(c[2 * TP], c[3 * TP]); w0.z = pk2(c[4 * TP], c[5 * TP]); w0.w = pk2(c[6 * TP], c[7 * TP]);
            w1.x = pk2(c[8 * TP], c[9 * TP]); w1.y = pk2(c[10 * TP], c[11 * TP]); w1.z = pk2(c[12 * TP], c[13 * TP]); w1.w = pk2(c[14 * TP], c[15 * TP]);
            uint4* q = (uint4*)((bf16*)dstv + (size_t)drow * K + k0 + kq * 16); q[0] = w0; q[1] = w1;
        }
#pragma unroll
        for (int i = 0; i < 4; ++i) r[i] = nx[i];
        buf ^= 1;
    }
#undef CVT_LOAD
}
__device__ __forceinline__ void cvt_job_f8(const float* __restrict__ src, int ld, int ncols, unsigned char* __restrict__ dst, int K, int mode, float scale, LAS unsigned char* tile, int t_begin, int t_end, const int tid) {
    const int ntn = ncols >> 6;
    const int q = tid >> 4, i4 = tid & 15;
    constexpr int TP = 144;
    float4 r[4]; int buf = 0;
#define CVT8_LOAD(t_, dst_) do { const int tn_ = (t_) % ntn, tk_ = (t_) / ntn; const float* p_ = src + (size_t)(tk_ * 128 + 4 * q) * ld + tn_ * 64 + 4 * i4; \
        _Pragma("unroll") for (int j_ = 0; j_ < 4; ++j_) dst_[j_] = *(const float4*)(p_ + (size_t)j_ * ld); } while (0)
    int t = t_begin;
    if (t < t_end) CVT8_LOAD(t, r);
    __syncthreads();
    for (; t < t_end; ++t) {
        float4 nx[4];
#pragma unroll
        for (int j = 0; j < 4; ++j) nx[j] = r[j];
        if (t + 1 < t_end) CVT8_LOAD(t + 1, nx);
        unsigned w[4];
#pragma unroll
        for (int j = 0; j < 4; ++j) w[j] = pg8::pk_fp8x4(r[j].x * scale, r[j].y * scale, r[j].z * scale, r[j].w * scale);
        const unsigned a_lo = __builtin_amdgcn_perm(w[1], w[0], 0x05010400u), a_hi = __builtin_amdgcn_perm(w[1], w[0], 0x07030602u);
        const unsigned b_lo = __builtin_amdgcn_perm(w[3], w[2], 0x05010400u), b_hi = __builtin_amdgcn_perm(w[3], w[2], 0x07030602u);
        unsigned o[4];
        o[0] = __builtin_amdgcn_perm(b_lo, a_lo, 0x05040100u); o[1] = __builtin_amdgcn_perm(b_lo, a_lo, 0x07060302u);
        o[2] = __builtin_amdgcn_perm(b_hi, a_hi, 0x05040100u); o[3] = __builtin_amdgcn_perm(b_hi, a_hi, 0x07060302u);
        LAS unsigned char* tl = tile + buf * (64 * TP);
        const int cw = ((q >> 2) ^ (i4 & 7)) * 16 + (q & 3) * 4;
#pragma unroll
        for (int m = 0; m < 4; ++m) *(LAS unsigned*)(tl + (4 * i4 + m) * TP + cw) = o[m];
        __syncthreads();
        const int tn = t % ntn, tk = t / ntn, k0 = tk * 128, nb = tn * 64;
        const int kq = tid & 7, nl = tid >> 3, nn = nb + nl;
        const int drow = mode == 0 ? nn : ((nn >> 7) * 256 + (nn & 127) + (mode == 2 ? 128 : 0));
        const u32x4 v = *(const LAS u32x4*)(tl + nl * TP + ((kq ^ ((nl >> 2) & 7)) * 16));
        *(uint4*)(dst + (size_t)drow * K + k0 + kq * 16) = make_uint4(v.x, v.y, v.z, v.w);
#pragma unroll
        for (int j = 0; j < 4; ++j) r[j] = nx[j];
        buf ^= 1;
    }
#undef CVT8_LOAD
}
__device__ __forceinline__ void cvt_job8(const float* src, int ld, int ncols, unsigned char* dst, int K, int mode, float scale, LAS float* tile, int bid, int G, const int tid) { cvt_job_t<true>(src, ld, ncols, ncols, dst, K, mode, scale, tile, bid, G, tid); }
__device__ __forceinline__ void cvt_job(const float* src, int ld, int ncols_valid, int ncols_total, bf16* dst, int K, int mode, LAS float* tile, int bid, int G, const int tid) { cvt_job_t<false>(src, ld, ncols_valid, ncols_total, dst, K, mode, 1.0f, tile, bid, G, tid); }

__device__ __forceinline__ void p0_prologue(const Ctx& a, LAS unsigned char* lds, int bid, int G) {
    unsigned char* ws = opqp(a.ws); const int tid = ((a.wv << 6) | lane_v());
    LAS float* tile = (LAS float*)lds;
    for (int l = 0; l < 2; ++l) {
        cvt_job(ldin(10) + (size_t)l * DM * NIN, NIN, NIN, NINP, (bf16*)(ws + WS_WIN) + (size_t)l * NINP * DM, DM, 0, tile, bid, G, tid);
        cvt_job(ldin(11) + (size_t)l * DM * DM, DM, DM, DM, (bf16*)(ws + WS_WOUT) + (size_t)l * DM * DM, DM, 0, tile, bid, G, tid);
    }
#if DENSE_GU8
    cvt_job8(ldin(31), FF, FF, ws + WS_WGU, DM, 1, MOE_SGU, tile, bid, G, tid);
    cvt_job8(ldin(32), FF, FF, ws + WS_WGU, DM, 2, MOE_SGU, tile, bid, G, tid);
#else
    cvt_job(ldin(31), FF, FF, FF, (bf16*)(ws + WS_WGU), DM, 1, tile, bid, G, tid);
    cvt_job(ldin(32), FF, FF, FF, (bf16*)(ws + WS_WGU), DM, 2, tile, bid, G, tid);
#endif
#if DENSE_D8
    cvt_job8(ldin(33), DM, DM, ws + WS_WD, FF, 0, MOE_SD, tile, bid, G, tid);
#else
    cvt_job(ldin(33), DM, DM, DM, (bf16*)(ws + WS_WD), FF, 0, tile, bid, G, tid);
#endif
#if !MOE_FP8
    for (int e = 0; e < NE; ++e) {
        cvt_job(ldin(35) + (size_t)e * DM * FE, FE, FE, FE, (bf16*)(ws + WS_MGU) + (size_t)e * 2 * FE * DM, DM, 1, tile, bid, G, tid);
        cvt_job(ldin(36) + (size_t)e * DM * FE, FE, FE, FE, (bf16*)(ws + WS_MGU) + (size_t)e * 2 * FE * DM, DM, 2, tile, bid, G, tid);
        cvt_job(ldin(37) + (size_t)e * FE * DM, DM, DM, DM, (bf16*)(ws + WS_MD) + (size_t)e * DM * FE, FE, 0, tile, bid, G, tid);
    }
#endif
    {
        bf16* wsm = (bf16*)(ws + WS_WSM);
        for (size_t i = (size_t)bid * NT + tid; i < (size_t)2 * 2048 * 256; i += (size_t)G * NT) {
            const int l = (int)(i >> 19), n = (int)((i >> 8) & 2047), k = (int)(i & 255); float v = 0.f;
            if (n < 1024) { if (k < 64) v = ldin(14)[(((size_t)l * 2 + (n >> 9)) * 64 + k) * 512 + (n & 511)]; }
            else if (n < 1536) { if (k >= 64 && k < 128) v = ldin(16)[((size_t)l * 64 + (k - 64)) * 512 + (n - 1024)]; }
            else { if (k >= 128) v = ldin(17)[((size_t)l * 128 + (k - 128)) * 512 + (n - 1536)]; }
            wsm[i] = (bf16)f2bf(v);
        }
    }
    {
        float* rope = (float*)(ws + WS_ROPE);
        for (int i = bid * NT + tid; i < SEQ * 32; i += G * NT) {
            const int t = i >> 5, j = i & 31, half = j >> 4, f = j & 15;
            const float pos = (float)(half ? (t & 63) : (t >> 6));
            const float inv = powf(10000.0f, -(float)f / 16.0f);
            const float ang = pos * inv;
            double ad = (double)ang; const double twopi = 6.283185307179586476925; ad -= twopi * floor(ad / twopi);
            const float ar = (float)ad;
            rope[t * 64 + half * 32 + f] = cosf(ar); rope[t * 64 + half * 32 + 16 + f] = sinf(ar);
        }
    }
    {
        LAS float* sil = (LAS float*)lds;
        LAS float* red = sil + 9 * 2048;
        __syncthreads();
        for (int i = tid; i < 9 * 2048; i += NT) { const float v = i < 8 * 2048 ? ldin(1)[i] : ldin(3)[i - 8 * 2048]; sil[i] = v / (1.0f + __expf(-v)); }
        __syncthreads();
        float* ada = (float*)(ws + WS_ADA);
        for (int it = bid; it < 2 * 96; it += G) {
            const int l = it / 96, col0 = (it % 96) * 128; const int cn = tid & 127, kg = tid >> 7;
            const float* w = ldin(4) + (size_t)l * DM * 12288 + col0 + cn;
            float acc[9];
#pragma unroll
            for (int v = 0; v < 9; ++v) acc[v] = 0.f;
            for (int k = kg * 512; k < kg * 512 + 512; ++k) { const float wv = w[(size_t)k * 12288];
#pragma unroll
                for (int v = 0; v < 9; ++v) acc[v] += sil[v * 2048 + k] * wv; }
#pragma unroll
            for (int v = 0; v < 9; ++v) red[(kg * 9 + v) * 128 + cn] = acc[v];
            __syncthreads();
            if (kg == 0) {
                const float bb = ldin(5)[(size_t)l * 12288 + col0 + cn];
#pragma unroll
                for (int v = 0; v < 9; ++v) ada[((size_t)l * 9 + v) * 12288 + col0 + cn] = red[v * 128 + cn] + red[(9 + v) * 128 + cn] + red[(18 + v) * 128 + cn] + red[(27 + v) * 128 + cn] + bb;
            }
            __syncthreads();
        }
    }
}


constexpr int BG_TPJ = 1792, BG_NT = 24 * BG_TPJ, BG_B = 8;
__device__ __forceinline__ void bg_convert(const Ctx& a, LAS unsigned char* lds, unsigned* until_done, int G) {
#if MOE_FP8
    unsigned char* ws = opqp(a.ws); const int tid = ((a.wv << 6) | lane_v());
    unsigned* ctr = (unsigned*)(ws + WS_CTL) + CW_BG; volatile LAS unsigned* slot = (volatile LAS unsigned*)(lds + LDS_STAGE + 8);
    LAS float* tile = (LAS float*)lds;
    for (;;) {
        __syncthreads();
        if (tid == 0) { unsigned v = 0xffffffffu;
            if (!until_done || __hip_atomic_load(until_done, __ATOMIC_RELAXED, __HIP_MEMORY_SCOPE_AGENT) < (unsigned)G) v = __hip_atomic_fetch_add(ctr, (unsigned)BG_B, __ATOMIC_RELAXED, __HIP_MEMORY_SCOPE_AGENT);
            *slot = v; }
        __syncthreads();
        const unsigned t0 = *slot;
        if (t0 >= (unsigned)BG_NT) break;
        const int job = (int)t0 / BG_TPJ, tl = (int)t0 % BG_TPJ; const int e = job / 3, kind = job % 3;
        if (kind < 2) cvt_job_f8(ldin(35 + kind) + (size_t)e * DM * FE, FE, FE, ws + WS_MGU + (size_t)e * 2 * FE * DM, DM, 1 + kind, MOE_SGU, (LAS unsigned char*)lds, tl, tl + BG_B, tid);
        else cvt_job_f8(ldin(37) + (size_t)e * FE * DM, DM, DM, ws + WS_MD + (size_t)e * DM * FE, FE, 0, MOE_SD, (LAS unsigned char*)lds, tl, tl + BG_B, tid);
    }
    __syncthreads();
#endif
}
__device__ __forceinline__ void bg_tail(const Ctx& a, LAS unsigned char* lds, int slotid, int G) {
#if MOE_FP8
    unsigned char* ws = opqp(a.ws); const int tid = ((a.wv << 6) | lane_v());
    unsigned* done = (unsigned*)(ws + WS_CTL) + CW_DONE + slotid * 64;
    __syncthreads();
    if (tid == 0) (void)__hip_atomic_fetch_add(done, 1u, __ATOMIC_RELAXED, __HIP_MEMORY_SCOPE_AGENT);
    bg_convert(a, lds, done, G);
#endif
}

__device__ __forceinline__ void ld_row(const float* p, int lane, float (&x)[32]) {
#pragma unroll
    for (int i = 0; i < 8; ++i) { const float4 v = *(const float4*)(p + i * 256 + lane * 4); x[i * 4] = v.x; x[i * 4 + 1] = v.y; x[i * 4 + 2] = v.z; x[i * 4 + 3] = v.w; }
}
__device__ __forceinline__ void st_row(float* p, int lane, const float (&x)[32]) {
#pragma unroll
    for (int i = 0; i < 8; ++i) *(float4*)(p + i * 256 + lane * 4) = make_float4(x[i * 4], x[i * 4 + 1], x[i * 4 + 2], x[i * 4 + 3]);
}
__device__ __forceinline__ float sumsq(const float (&x)[32]) { float s = 0.f;
#pragma unroll
    for (int i = 0; i < 32; ++i) s += x[i] * x[i];
    return wsum(s); }

template <int TMODE, int HMODE, int XIN = 0, int XOUT = 0>
__device__ __forceinline__ void thin_phase(const Ctx& a, LAS unsigned char* lds, int bid, int G, int M,
                           const float* xlat, const float* xctx, float* olat, float* octx,
                           const float* T, const float* postw, int lg, int kg,
                           const float* prew, int lm, int ksc, int ksh) {
    unsigned char* ws = opqp(a.ws); const int tid = ((a.wv << 6) | lane_v()), lane = tid & 63, wid = tid >> 6;
    const float* ada = (const float*)(ws + WS_ADA);
    bf16* HA = (bf16*)(ws + WS_HA);
    LAS float* rt = (LAS float*)lds;
    if (HMODE == 2) { __syncthreads(); for (int i = tid; i < DM * NE; i += NT) rt[i] = ldin(34)[i]; __syncthreads(); }
    for (int r = bid * NW + wid; r < M; r += G * NW) {
        const int vec = r < MLAT ? r / SEQ : 8;
        float x[32];
        if (XIN == 1 && r < MLAT) { const bf16* xb = (const bf16*)xlat + (size_t)r * DM;
#pragma unroll
            for (int i = 0; i < 8; ++i) { const uint2 p1 = *(const uint2*)(xb + i * 256 + lane * 4); float f1[4]; unpack4(p1, f1); x[i * 4] = f1[0]; x[i * 4 + 1] = f1[1]; x[i * 4 + 2] = f1[2]; x[i * 4 + 3] = f1[3]; } }
        else { const float* xs = r < MLAT ? xlat + (size_t)r * DM : xctx + (size_t)(r - MLAT) * DM; ld_row(xs, lane, x); }
        if (TMODE != 0) {
            float t[32];
            if (TMODE == 1) { const bf16* tb = (const bf16*)T + (size_t)r * DM;
#pragma unroll
                for (int i = 0; i < 8; ++i) { const uint2 p1 = *(const uint2*)(tb + i * 256 + lane * 4); float f1[4]; unpack4(p1, f1); t[i * 4] = f1[0]; t[i * 4 + 1] = f1[1]; t[i * 4 + 2] = f1[2]; t[i * 4 + 3] = f1[3]; } }
            else {
                const unsigned* tok = (const unsigned*)(ws + WS_TOK) + (size_t)r * 8;
                const float w1 = __uint_as_float(tok[4]), w2 = __uint_as_float(tok[5]); const unsigned d1 = tok[6], d2 = tok[7];
                const bf16* y1 = (const bf16*)(ws + WS_MIX) + (size_t)d1 * DM; const bf16* y2 = (const bf16*)(ws + WS_MIX) + (size_t)d2 * DM;
#pragma unroll
                for (int i = 0; i < 8; ++i) { const uint2 p1 = *(const uint2*)(y1 + i * 256 + lane * 4), p2 = *(const uint2*)(y2 + i * 256 + lane * 4);
                    float f1[4], f2[4]; unpack4(p1, f1); unpack4(p2, f2);
#pragma unroll
                    for (int j = 0; j < 4; ++j) t[i * 4 + j] = w1 * f1[j] + w2 * f2[j]; }
            }
            const float rs = rsqrtf(sumsq(t) * (1.0f / DM) + 1e-6f);
            float pw[32], gg[32]; ld_row(postw, lane, pw); ld_row(ada + ((size_t)lg * 9 + vec) * 12288 + kg * DM, lane, gg);
#pragma unroll
            for (int i = 0; i < 32; ++i) x[i] += gg[i] * (t[i] * rs * pw[i]);
            if (XOUT == 1 && r < MLAT) { bf16* xd = (bf16*)olat + (size_t)r * DM;
#pragma unroll
                for (int i = 0; i < 8; ++i) { uint2 p; p.x = pk2(x[i * 4], x[i * 4 + 1]); p.y = pk2(x[i * 4 + 2], x[i * 4 + 3]); *(uint2*)(xd + i * 256 + lane * 4) = p; } }
            else { float* xd = r < MLAT ? olat + (size_t)r * DM : octx + (size_t)(r - MLAT) * DM; st_row(xd, lane, x); }
        }
        if (HMODE != 0) {
            const float rs = rsqrtf(sumsq(x) * (1.0f / DM) + 1e-6f);
            float pw[32], sc[32], sh[32]; ld_row(prew, lane, pw);
            ld_row(ada + ((size_t)lm * 9 + vec) * 12288 + ksc * DM, lane, sc); ld_row(ada + ((size_t)lm * 9 + vec) * 12288 + ksh * DM, lane, sh);
            float h[32];
#pragma unroll
            for (int i = 0; i < 32; ++i) h[i] = x[i] * rs * pw[i] * (1.0f + sc[i]) + sh[i];
            if ((HMODE == 2 && MOE_FP8) || HMODE == 3) { unsigned char* hd8 = (unsigned char*)HA + (size_t)r * DM;
#pragma unroll
                for (int i = 0; i < 8; ++i) *(unsigned*)(hd8 + i * 256 + lane * 4) = pg8::pk_fp8x4(h[i * 4], h[i * 4 + 1], h[i * 4 + 2], h[i * 4 + 3]); }
            else { bf16* hd = HA + (size_t)r * DM;
#pragma unroll
                for (int i = 0; i < 8; ++i) { uint2 p; p.x = pk2(h[i * 4], h[i * 4 + 1]); p.y = pk2(h[i * 4 + 2], h[i * 4 + 3]); *(uint2*)(hd + i * 256 + lane * 4) = p; } }
            if (HMODE == 2) {
                float lg8[8];
#pragma unroll
                for (int e = 0; e < 8; ++e) lg8[e] = 0.f;
#pragma unroll 1
                for (int i = 0; i < 8; ++i) {
                    float hv4[4];
#pragma unroll
                    for (int j = 0; j < 4; ++j) hv4[j] = 0.f;
#pragma unroll
                    for (int ii = 0; ii < 8; ++ii) if (ii == i) { hv4[0] = h[ii * 4]; hv4[1] = h[ii * 4 + 1]; hv4[2] = h[ii * 4 + 2]; hv4[3] = h[ii * 4 + 3]; }
#pragma unroll
                    for (int j = 0; j < 4; ++j) { const int c = i * 256 + lane * 4 + j; const f32x4 r0 = *(const LAS f32x4*)(rt + c * 8), r1 = *(const LAS f32x4*)(rt + c * 8 + 4); const float hv = hv4[j];
                        lg8[0] += hv * r0[0]; lg8[1] += hv * r0[1]; lg8[2] += hv * r0[2]; lg8[3] += hv * r0[3]; lg8[4] += hv * r1[0]; lg8[5] += hv * r1[1]; lg8[6] += hv * r1[2]; lg8[7] += hv * r1[3]; }
                }
#pragma unroll
                for (int e = 0; e < 8; ++e) lg8[e] = wsum(lg8[e]);
                if (lane == 0) {
                    int e1 = 0; float v1 = lg8[0];
#pragma unroll
                    for (int e = 1; e < 8; ++e) if (lg8[e] > v1) { v1 = lg8[e]; e1 = e; }
                    int e2 = -1; float v2 = -3.0e38f;
#pragma unroll
                    for (int e = 0; e < 8; ++e) if (e != e1 && lg8[e] > v2) { v2 = lg8[e]; e2 = e; }
                    const float ex = __expf(v2 - v1); const float w1 = 1.0f / (1.0f + ex), w2 = ex / (1.0f + ex);
                    unsigned* cnt = (unsigned*)(ws + WS_CTL) + CW_CNT;
                    const unsigned p1 = atomicAdd(cnt + e1 * 64, 1u), p2 = atomicAdd(cnt + e2 * 64, 1u);
                    unsigned* tok = (unsigned*)(ws + WS_TOK) + (size_t)r * 8;
                    tok[0] = (unsigned)e1; tok[1] = (unsigned)e2; tok[2] = p1; tok[3] = p2; tok[4] = __float_as_uint(w1); tok[5] = __float_as_uint(w2);
                }
            }
        }
    }
}

__device__ __forceinline__ void moe_gather(const Ctx& a, int bid, int G) {
    unsigned char* ws = opqp(a.ws); const int tid = ((a.wv << 6) | lane_v()), lane = tid & 63, wid = tid >> 6;
    const unsigned* cnt = (const unsigned*)(ws + WS_CTL) + CW_CNT;
    const bf16* HA = (const bf16*)(ws + WS_HA); bf16* AG = (bf16*)(ws + WS_U);
    for (int r = bid * NW + wid; r < MLAT; r += G * NW) {
        unsigned* tok = (unsigned*)(ws + WS_TOK) + (size_t)r * 8;
        const int e1 = (int)tok[0], e2 = (int)tok[1]; const unsigned p1 = tok[2], p2 = tok[3];
        unsigned run = 0, s1 = 0, s2 = 0;
#pragma unroll
        for (int e = 0; e < 8; ++e) { const unsigned t = (cnt[e * 64] + 255u) >> 8; if (e == e1) s1 = run; if (e == e2) s2 = run; run += t; }
        const unsigned d1 = s1 * 256u + p1, d2 = s2 * 256u + p2;
#if MOE_FP8
        const uint4* src = (const uint4*)((const unsigned char*)HA + (size_t)r * DM); uint4* q1 = (uint4*)((unsigned char*)AG + (size_t)d1 * DM); uint4* q2 = (uint4*)((unsigned char*)AG + (size_t)d2 * DM);
#pragma unroll
        for (int i = 0; i < 2; ++i) { const uint4 v = src[i * 64 + lane]; q1[i * 64 + lane] = v; q2[i * 64 + lane] = v; }
#else
        const uint4* src = (const uint4*)(HA + (size_t)r * DM); uint4* q1 = (uint4*)(AG + (size_t)d1 * DM); uint4* q2 = (uint4*)(AG + (size_t)d2 * DM);
#pragma unroll
        for (int i = 0; i < 4; ++i) { const uint4 v = src[i * 64 + lane]; q1[i * 64 + lane] = v; q2[i * 64 + lane] = v; }
#endif
        if (lane == 0) { tok[6] = d1; tok[7] = d2; }
    }
    unsigned zq = 0u; asm volatile("" : "+v"(zq));
    unsigned run = 0;
    for (int e = 0; e < 8; ++e) { const unsigned c = cnt[e * 64], t = (c + 255u) >> 8; const unsigned lo = run * 256u + c, hi = (run + t) * 256u; run += t;
        for (unsigned r = lo + bid * NW + wid; r < hi; r += G * NW) { uint4* q = (uint4*)((unsigned char*)AG + (size_t)r * DM * (MOE_FP8 ? 1 : 2));
#pragma unroll
            for (int i = 0; i < (MOE_FP8 ? 2 : 4); ++i) q[i * 64 + lane] = make_uint4(zq, zq, zq, zq); } }
}


__device__ __forceinline__ uint4 ldg16(const bf16* p) { return *(const uint4*)p; }
__device__ __forceinline__ uint4 zero16() { return make_uint4(0u, 0u, 0u, 0u); }

__device__ __forceinline__ void feat_a(const Ctx& a, int l, int bid, int G) {
    unsigned char* ws = opqp(a.ws); const int tid = ((a.wv << 6) | lane_v()), lane = tid & 63, wid = tid >> 6;
    const bf16* U = (const bf16*)(ws + WS_U); bf16* ASM = (bf16*)(ws + WS_ASM); bf16* XBC = (bf16*)(ws + WS_XBC); bf16* QK = (bf16*)(ws + WS_QK);
    float* DT = (float*)(ws + WS_DT); const float* rope = (const float*)(ws + WS_ROPE);
    const float* mu = ldin(12) + (size_t)l * 2 * 1792; const float* cw = ldin(23) + (size_t)l * 3 * 1536; const float* cb = ldin(24) + (size_t)l * 1536;
    const float* dtb = ldin(25) + l * 32; const float* alog = ldin(26) + l * 32;
    for (int r = bid * NW + wid; r < MTOT; r += G * NW) {
        const bool lat = r < MLAT; const int t = lat ? (r & (SEQ - 1)) : ((r - MLAT) & (CTXL - 1)); const int L = lat ? SEQ : CTXL;
        const bool hp = t > 0, hn = t < L - 1;
        const bf16* up = U + (size_t)r * NINP;
        if (lane < 32) {
            const int c = C_RW_XW + lane * 8; float u[8], p[8], n[8], o[8];
            unpack8(ldg16(up + c), u); unpack8(hp ? ldg16(up - NINP + c) : zero16(), p); unpack8(hn ? ldg16(up + NINP + c) : zero16(), n);
#pragma unroll
            for (int e = 0; e < 8; ++e) { const float s = u[e] + mu[c + e] * (p[e] - u[e]) + mu[1792 + c + e] * (n[e] - u[e]); const int k = lane * 8 + e;
                o[e] = k < 64 ? (1.0f - 2.0f / (__expf(2.0f * s) + 1.0f)) : (k < 128 ? s : fsigm(s)); }
            *(uint4*)(ASM + (size_t)r * 256 + lane * 8) = pack8(o);
        }
#pragma unroll
        for (int it = 0; it < 3; ++it) {
            const int cc = (it * 64 + lane) * 8, c = C_MB_XBC + cc; float u[8], p[8], n[8], o[8];
            unpack8(ldg16(up + c), u); unpack8(hp ? ldg16(up - NINP + c) : zero16(), p); unpack8(hn ? ldg16(up + NINP + c) : zero16(), n);
#pragma unroll
            for (int e = 0; e < 8; ++e) o[e] = fsilu(cw[cc + e] * p[e] + cw[1536 + cc + e] * u[e] + cw[3072 + cc + e] * n[e] + cb[cc + e]);
            *(uint4*)(XBC + (size_t)r * 1536 + cc) = pack8(o);
        }
        if (lane < 32) {
            const float raw = bf2f(up[C_MB_DT + lane]); const float dtv = softplusf(raw + dtb[lane]); const float A = -__expf(alog[lane]);
            DT[(size_t)r * 64 + lane] = dtv; DT[(size_t)r * 64 + 32 + lane] = dtv * A;
        }
        {
            const int blk = lane >> 1, sub = lane & 1, c1 = C_DA_Q + blk * 32 + sub * 8; float u1[8], u2[8], o1[8], o2[8];
            unpack8(ldg16(up + c1), u1); unpack8(ldg16(up + c1 + 16), u2);
            const int half = blk & 1; const float scale = blk < 16 ? 0.125f * 1.44269504f : 1.0f;
#pragma unroll
            for (int e = 0; e < 8; ++e) {
                float cs = 1.0f, sn = 0.0f;
                if (lat) { cs = rope[t * 64 + half * 32 + sub * 8 + e]; sn = rope[t * 64 + half * 32 + 16 + sub * 8 + e]; }
                o1[e] = (u1[e] * cs - u2[e] * sn) * scale; o2[e] = (u2[e] * cs + u1[e] * sn) * scale; }
            *(uint4*)(QK + (size_t)r * 1024 + blk * 32 + sub * 8) = pack8(o1); *(uint4*)(QK + (size_t)r * 1024 + blk * 32 + 16 + sub * 8) = pack8(o2);
        }
    }
}

__device__ __forceinline__ void feat_b(const Ctx& a, int l, int bid, int G) {
    unsigned char* ws = opqp(a.ws); const int tid = ((a.wv << 6) | lane_v()), lane = tid & 63, wid = tid >> 6;
    const bf16* U = (const bf16*)(ws + WS_U); const float* F = (const float*)(ws + WS_MIX); bf16* R5 = (bf16*)(ws + WS_RW5);
    const float* mu = ldin(12) + (size_t)l * 2 * 1792; const float* k_k = ldin(18) + l * 512; const float* k_a = ldin(19) + l * 512; const float* a0 = ldin(15) + l * 512;
    for (int r = bid * NW + wid; r < MTOT; r += G * NW) {
        const bool lat = r < MLAT; const int t = lat ? (r & (SEQ - 1)) : ((r - MLAT) & (CTXL - 1)); const int L = lat ? SEQ : CTXL;
        const bool hp = t > 0, hn = t < L - 1;
        const bf16* up = U + (size_t)r * NINP; const int c = lane * 8;
        float s[3][8];
#pragma unroll
        for (int q = 0; q < 3; ++q) { const int col = q * 512 + c; float u[8], p[8], n[8];
            unpack8(ldg16(up + col), u); unpack8(hp ? ldg16(up - NINP + col) : zero16(), p); unpack8(hn ? ldg16(up + NINP + col) : zero16(), n);
#pragma unroll
            for (int e = 0; e < 8; ++e) s[q][e] = u[e] + mu[col + e] * (p[e] - u[e]) + mu[1792 + col + e] * (n[e] - u[e]); }
        float av[8]; { const float4 q0 = *(const float4*)(F + (size_t)r * 2048 + 1024 + c), a1 = *(const float4*)(F + (size_t)r * 2048 + 1024 + c + 4);
            av[0] = q0.x; av[1] = q0.y; av[2] = q0.z; av[3] = q0.w; av[4] = a1.x; av[5] = a1.y; av[6] = a1.z; av[7] = a1.w; }
#pragma unroll
        for (int e = 0; e < 8; ++e) av[e] = fsigm(av[e] + a0[c + e]);
        float kkv[8], k2[8], bv[8]; float ss = 0.f;
#pragma unroll
        for (int e = 0; e < 8; ++e) { kkv[e] = s[1][e] * k_k[c + e]; ss += kkv[e] * kkv[e]; }
        ss = red8(ss); const float inv = 1.0f / fmaxf(sqrtf(ss), 1e-12f);
#pragma unroll
        for (int e = 0; e < 8; ++e) { kkv[e] *= inv; k2[e] = s[1][e] * (1.0f + (av[e] - 1.0f) * k_a[c + e]); bv[e] = kkv[e] * av[e]; }
        const size_t o = (size_t)r * 512 + c, st = (size_t)MTOT * 512;
        *(uint4*)(R5 + o) = pack8(s[0]); *(uint4*)(R5 + st + o) = pack8(k2); *(uint4*)(R5 + 2 * st + o) = pack8(s[2]); *(uint4*)(R5 + 3 * st + o) = pack8(kkv); *(uint4*)(R5 + 4 * st + o) = pack8(bv);
    }
}

__device__ __forceinline__ void mix_out(const Ctx& a, int l, int M, int bid, int G) {
    unsigned char* ws = opqp(a.ws); const int tid = ((a.wv << 6) | lane_v()), lane = tid & 63, wid = tid >> 6;
    const bf16* U = (const bf16*)(ws + WS_U); const float* F = (const float*)(ws + WS_MIX); const bf16* R5 = (const bf16*)(ws + WS_RW5); const bf16* XBC = (const bf16*)(ws + WS_XBC);
    const bf16* YR = (const bf16*)(ws + WS_YR); const bf16* YM = (const bf16*)(ws + WS_YM); bf16* A2 = (bf16*)(ws + WS_HA);
    const float* r_k = ldin(20) + l * 512; const float* ln_w = ldin(21) + l * 512; const float* ln_b = ldin(22) + l * 512;
    const float* Dsk = ldin(27) + l * 16; const float* nw = ldin(28) + l * 1024;
    for (int r = bid * NW + wid; r < M; r += G * NW) {
        {
            const int c = lane * 8; const size_t o = (size_t)r * 512 + c, st = (size_t)MTOT * 512;
            float y[8];
            { float yf[8], yb[8]; unpack8(ldg16(YR + o), yf); unpack8(ldg16(YR + st + o), yb);
#pragma unroll
              for (int e = 0; e < 8; ++e) y[e] = yf[e] + yb[e]; }
            float sm = 0.f;
#pragma unroll
            for (int e = 0; e < 8; ++e) sm += y[e];
            const float mean = red8(sm) * (1.0f / 64.0f); float sv = 0.f;
#pragma unroll
            for (int e = 0; e < 8; ++e) { y[e] -= mean; sv += y[e] * y[e]; }
            const float rs = rsqrtf(red8(sv) * (1.0f / 64.0f) + 64e-5f);
            float rr[8], kk[8], vv[8]; unpack8(ldg16(R5 + o), rr); unpack8(ldg16(R5 + st + o), kk); unpack8(ldg16(R5 + 2 * st + o), vv);
            float dot = 0.f;
#pragma unroll
            for (int e = 0; e < 8; ++e) dot += rr[e] * kk[e] * r_k[c + e];
            dot = red8(dot);
            const float4 g0 = *(const float4*)(F + (size_t)r * 2048 + 1536 + c), g1 = *(const float4*)(F + (size_t)r * 2048 + 1536 + c + 4);
            const float g[8] = {g0.x, g0.y, g0.z, g0.w, g1.x, g1.y, g1.z, g1.w}; float ov[8];
#pragma unroll
            for (int e = 0; e < 8; ++e) ov[e] = (y[e] * rs * ln_w[c + e] + ln_b[c + e] + dot * vv[e]) * g[e];
            *(uint4*)(A2 + (size_t)r * DM + c) = pack8(ov);
        }
        {
            const int m0 = lane * 16, hh = m0 >> 6; const float dsk = Dsk[hh]; float y[16]; float ss = 0.f;
#pragma unroll
            for (int q = 0; q < 2; ++q) { const int m = m0 + q * 8; const size_t o = (size_t)r * 1024 + m;
                float ys[8]; unpack8(ldg16(YM + o), ys);
                float xs[8], z[8]; unpack8(ldg16(XBC + (size_t)r * 1536 + m), xs); unpack8(ldg16(U + (size_t)r * NINP + C_MB_Z + m), z);
#pragma unroll
                for (int e = 0; e < 8; ++e) { const float v = (ys[e] + dsk * xs[e]) * fsilu(z[e]); y[q * 8 + e] = v; ss += v * v; } }
            ss = red32(ss);
            const float rs = rsqrtf(ss * (1.0f / 512.0f) + 1e-5f);
#pragma unroll
            for (int q = 0; q < 2; ++q) { const int m = m0 + q * 8; float ov[8];
#pragma unroll
                for (int e = 0; e < 8; ++e) ov[e] = y[q * 8 + e] * rs * nw[m + e];
                *(uint4*)(A2 + (size_t)r * DM + 512 + m) = pack8(ov); }
        }
    }
}

__device__ __forceinline__ int chain_row(int s, int b, int dir) {
    if (s < CTXL) return MLAT + b * CTXL + (dir ? (CTXL - 1 - s) : s);
    const int t = s - CTXL; return b * SEQ + (dir ? (SEQ - 1 - t) : t);
}
constexpr int CH_STEPS = CTXL + SEQ, CH_T = 32, CH_NC = CH_STEPS / CH_T;


typedef short s16x4 __attribute__((ext_vector_type(4)));
constexpr int MB_NCH = 18;
__device__ __forceinline__ int mb_row0(int b, int cc) { return cc < 2 ? MLAT + b * CTXL + cc * 128 : b * SEQ + (cc - 2) * 128; }
__device__ __forceinline__ bf16x8 trfrag(const LAS bf16* pA, const LAS bf16* pB) {
    const s16x4 v0 = __builtin_amdgcn_ds_read_tr16_b64_v4i16((LAS s16x4*)pA), v1 = __builtin_amdgcn_ds_read_tr16_b64_v4i16((LAS s16x4*)pB);
    return __builtin_shufflevector(v0, v1, 0, 1, 2, 3, 4, 5, 6, 7);
}
constexpr int MB_PB = 144, MB_PX = 72;
constexpr int MB_OFF_C = 0, MB_OFF_B = 36864, MB_OFF_X = 73728  , MB_OFF_V = 110592  ;

__device__ __forceinline__ void mb_vectors(const float* DT, int row0, int g, LAS float* tmp, LAS float* vec, int tid) {
    for (int i = tid; i < 128 * 16; i += NT) { const int l = i >> 4, q4 = i & 15; *(LAS f32x4*)(tmp + l * 64 + q4 * 4) = *(const f32x4*)(DT + (size_t)(row0 + l) * 64 + q4 * 4); }
    __syncthreads();
    LAS float* tot = tmp + 128 * 64;
    const int seq = tid >> 5, j = tid & 31, hh = seq & 7, dir = seq >> 3;
    float v[4], run = 0.f;
#pragma unroll
    for (int e = 0; e < 4; ++e) { const int l = dir ? 127 - (4 * j + e) : 4 * j + e; run += tmp[l * 64 + 32 + dir * 16 + g * 8 + hh]; v[e] = run; }
    tot[seq * 32 + j] = run;
    __syncthreads();
    float off = 0.f;
    for (int q = 0; q < 32; ++q) { const float tq = tot[seq * 32 + q]; off += q < j ? tq : 0.f; }
#pragma unroll
    for (int e = 0; e < 4; ++e) { const int l = dir ? 127 - (4 * j + e) : 4 * j + e; vec[dir * 1024 + hh * 128 + l] = v[e] + off; }
    __syncthreads();
    for (int i = tid; i < 2048; i += NT) { const int d2 = i >> 10, h2 = (i >> 7) & 7, l = i & 127; const int ref = d2 ? (l & ~15) : (l | 15);
        vec[2048 + i] = __expf(fmaxf(vec[d2 * 1024 + h2 * 128 + ref] - vec[d2 * 1024 + h2 * 128 + l], -80.f)) * tmp[l * 64 + d2 * 16 + g * 8 + h2]; }
    __syncthreads();
}

__device__ __forceinline__ void mamba_m1(const Ctx& a, LAS unsigned char* lds, int item) {
    unsigned char* ws = opqp(a.ws); const int tid = ((a.wv << 6) | lane_v()), lane = tid & 63, wid = tid >> 6, fr = lane & 15, fq = lane >> 4, q4 = (lane & 15) >> 2, p4 = lane & 3;
    const int g = item & 1, cc = (item >> 1) % MB_NCH, b = (item >> 1) / MB_NCH; const int row0 = mb_row0(b, cc);
    const bf16* XBC = (const bf16*)(ws + WS_XBC); const float* DT = (const float*)(ws + WS_DT); bf16* ST = (bf16*)(ws + WS_ST); float* AC = (float*)(ws + WS_AC);
    LAS bf16* Bs = (LAS bf16*)(lds + MB_OFF_B); LAS float* vec = (LAS float*)(lds + MB_OFF_V);
    __syncthreads();
    mb_vectors(DT, row0, g, (LAS float*)(lds + MB_OFF_C), vec, tid);
    if (tid < 16) { const int hh = tid & 7, dir = tid >> 3; AC[((size_t)(b * MB_NCH + cc) * 16 + g * 8 + hh) * 2 + dir] = dir ? vec[1024 + hh * 128] : vec[hh * 128 + 127]; }
    for (int i = tid; i < 2048; i += NT) { const int l = i >> 4, ch = i & 15; *(LAS u32x4*)(Bs + l * MB_PB + ch * 8) = *(const u32x4*)(XBC + (size_t)(row0 + l) * 1536 + 1024 + g * 128 + ch * 8); }
    uint4 xq[2];
#pragma unroll
    for (int j = 0; j < 2; ++j) { const int id = tid + j * NT; xq[j] = *(const uint4*)(XBC + (size_t)(row0 + (id >> 3)) * 1536 + (g * 8) * 64 + (id & 7) * 8); }
    for (int hh = 0; hh < 8; ++hh) {
        const int h = g * 8 + hh;
        LAS bf16* Yf = (LAS bf16*)(lds + ((hh & 1) ? MB_OFF_X : MB_OFF_C)); LAS bf16* Yb = Yf + 128 * MB_PX;
        const float tf = vec[hh * 128 + 127];
        uint4 xc[2] = {xq[0], xq[1]};
        if (hh + 1 < 8) {
#pragma unroll
            for (int j = 0; j < 2; ++j) { const int id = tid + j * NT; xq[j] = *(const uint4*)(XBC + (size_t)(row0 + (id >> 3)) * 1536 + (h + 1) * 64 + (id & 7) * 8); } }
#pragma unroll
        for (int j = 0; j < 2; ++j) { const int id = tid + j * NT, l = id >> 3, ch = id & 7; float x8[8], of[8], ob[8];
            unpack8(xc[j], x8);
            const float sf = __expf(tf - vec[hh * 128 + (l | 15)]) * vec[2048 + hh * 128 + l], sb = __expf(vec[1024 + hh * 128] - vec[1024 + hh * 128 + (l & ~15)]) * vec[3072 + hh * 128 + l];
#pragma unroll
            for (int e = 0; e < 8; ++e) { of[e] = x8[e] * sf; ob[e] = x8[e] * sb; }
            const uint4 pf = pack8(of), pb = pack8(ob);
            *(LAS u32x4*)(Yf + l * MB_PX + ch * 8) = (u32x4){pf.x, pf.y, pf.z, pf.w}; *(LAS u32x4*)(Yb + l * MB_PX + ch * 8) = (u32x4){pb.x, pb.y, pb.z, pb.w}; }
        __syncthreads();
        const int pt = wid & 3, nh = wid >> 2;
#pragma unroll
        for (int dir = 0; dir < 2; ++dir) { const LAS bf16* Xd = dir ? Yb : Yf;
            bf16x8 yf4[4];
#pragma unroll
            for (int ks = 0; ks < 4; ++ks) { const LAS bf16* pa = Xd + (ks * 32 + 8 * fq + q4) * MB_PX + pt * 16 + 4 * p4; yf4[ks] = trfrag(pa, pa + 4 * MB_PX); }
#pragma unroll
            for (int ns = 0; ns < 4; ++ns) { f32x4 acc = (f32x4){0.f, 0.f, 0.f, 0.f};
#pragma unroll
                for (int ks = 0; ks < 4; ++ks) { const LAS bf16* pa = Bs + (ks * 32 + 8 * fq + q4) * MB_PB + (nh * 4 + ns) * 16 + 4 * p4;
                    acc = __builtin_amdgcn_mfma_f32_16x16x32_bf16(trfrag(pa, pa + 4 * MB_PB), yf4[ks], acc, 0, 0, 0); }
                uint2 pk; pk.x = pk2(acc[0], acc[1]); pk.y = pk2(acc[2], acc[3]);
                *(uint2*)(ST + ((((size_t)(b * MB_NCH + cc) * 16 + h) * 2 + dir) * 64 + pt * 16 + fr) * 128 + (nh * 4 + ns) * 16 + 4 * fq) = pk; } }
    }
}

__device__ __forceinline__ void mamba_m2(const Ctx& a, int item) {
    unsigned char* ws = opqp(a.ws); const int tid = ((a.wv << 6) | lane_v());
    const int dir = item & 1, h = (item >> 1) & 15, b = item >> 5;
    bf16* ST = (bf16*)(ws + WS_ST); const float* AC = (const float*)(ws + WS_AC);
    float H[16];
#pragma unroll
    for (int i = 0; i < 16; ++i) H[i] = 0.f;
#define M2_CC(st_) (dir == 0 ? (st_) : ((st_) < 2 ? 1 - (st_) : 19 - (st_)))
#define M2_PTR(st_) (ST + ((((size_t)(b * MB_NCH + M2_CC(st_)) * 16 + h) * 2 + dir) * 64) * 128 + tid * 16)
    uint4 s0 = *(const uint4*)M2_PTR(0), s1 = *(const uint4*)(M2_PTR(0) + 8); float la = AC[((size_t)(b * MB_NCH + M2_CC(0)) * 16 + h) * 2 + dir];
    for (int st = 0; st < MB_NCH; ++st) {
        bf16* p = M2_PTR(st);
        const int sn = st + 1 < MB_NCH ? st + 1 : st;
        const uint4 n0 = *(const uint4*)M2_PTR(sn), n1 = *(const uint4*)(M2_PTR(sn) + 8); const float ln = AC[((size_t)(b * MB_NCH + M2_CC(sn)) * 16 + h) * 2 + dir];
        float f0[8], f1[8]; unpack8(s0, f0); unpack8(s1, f1);
        const float ea = __expf(la);
        float o0[8], o1[8];
#pragma unroll
        for (int e = 0; e < 8; ++e) { o0[e] = H[e]; o1[e] = H[8 + e]; H[e] = ea * H[e] + f0[e]; H[8 + e] = ea * H[8 + e] + f1[e]; }
        *(uint4*)p = pack8(o0); *(uint4*)(p + 8) = pack8(o1);
        s0 = n0; s1 = n1; la = ln;
    }
#undef M2_CC
#undef M2_PTR
}

__device__ __forceinline__ void mamba_m3(const Ctx& a, LAS unsigned char* lds, int b, int cc, int g) {
    unsigned char* ws = opqp(a.ws); const int tid = ((a.wv << 6) | lane_v()), lane = tid & 63, wid = tid >> 6, fr = lane & 15, fq = lane >> 4, q4 = (lane & 15) >> 2, p4 = lane & 3;
    const int row0 = mb_row0(b, cc);
    const bf16* XBC = (const bf16*)(ws + WS_XBC); const float* DT = (const float*)(ws + WS_DT); const bf16* ST = (const bf16*)(ws + WS_ST); bf16* YM = (bf16*)(ws + WS_YM);
    LAS bf16* Cs = (LAS bf16*)(lds + MB_OFF_C); LAS bf16* Bs = (LAS bf16*)(lds + MB_OFF_B); LAS float* vec = (LAS float*)(lds + MB_OFF_V);
    __syncthreads();
    mb_vectors(DT, row0, g, (LAS float*)(lds + MB_OFF_C), vec, tid);
    for (int i = tid; i < 2048; i += NT) { const int l = i >> 4, ch = i & 15; const bf16* src = XBC + (size_t)(row0 + l) * 1536 + g * 128 + ch * 8;
        *(LAS u32x4*)(Bs + l * MB_PB + ch * 8) = *(const u32x4*)(src + 1024); *(LAS u32x4*)(Cs + l * MB_PB + ch * 8) = *(const u32x4*)(src + 1280); }
    uint4 xr[2];
#define M3_XLOAD(hh_) do { _Pragma("unroll") for (int j_ = 0; j_ < 2; ++j_) { const int id_ = tid + j_ * NT; xr[j_] = *(const uint4*)(XBC + (size_t)(row0 + (id_ >> 3)) * 1536 + (g * 8 + (hh_)) * 64 + (id_ & 7) * 8); } } while (0)
#define M3_XSTORE(hh_) do { LAS bf16* X_ = (LAS bf16*)(lds + MB_OFF_X) + ((hh_) & 1) * 128 * MB_PX; _Pragma("unroll") for (int j_ = 0; j_ < 2; ++j_) { const int id_ = tid + j_ * NT; \
        *(LAS u32x4*)(X_ + (id_ >> 3) * MB_PX + (id_ & 7) * 8) = (u32x4){xr[j_].x, xr[j_].y, xr[j_].z, xr[j_].w}; } } while (0)
    M3_XLOAD(0); M3_XSTORE(0);
    __syncthreads();
    const int l0 = wid * 16;
    bf16x8 cf[4];
#pragma unroll
    for (int ks = 0; ks < 4; ++ks) cf[ks] = *(const LAS bf16x8*)(Cs + (l0 + fr) * MB_PB + ks * 32 + fq * 8);
    f32x4 CB[8];
#pragma unroll
    for (int sb = 0; sb < 8; ++sb) { f32x4 acc = (f32x4){0.f, 0.f, 0.f, 0.f};
#pragma unroll
        for (int ks = 0; ks < 4; ++ks) acc = __builtin_amdgcn_mfma_f32_16x16x32_bf16(*(const LAS bf16x8*)(Bs + (sb * 16 + fr) * MB_PB + ks * 32 + fq * 8), cf[ks], acc, 0, 0, 0);
        CB[sb] = acc; }
    bf16x8 hs0[8], hs1[8];
#define M3_HLOAD(SET_, hh_, pt_) do { const bf16* Hf_ = ST + ((((size_t)(b * MB_NCH + cc) * 16 + g * 8 + (hh_)) * 2 + 0) * 64) * 128 + (size_t)((pt_) * 16 + fr) * 128 + fq * 8; \
        _Pragma("unroll") for (int ks_ = 0; ks_ < 4; ++ks_) { SET_[ks_] = *(const bf16x8*)(Hf_ + ks_ * 32); SET_[4 + ks_] = *(const bf16x8*)(Hf_ + 64 * 128 + ks_ * 32); } } while (0)
    M3_HLOAD(hs0, 0, 0);
    float mfd[4], mbd[4];
#pragma unroll
    for (int e = 0; e < 4; ++e) { const int dd = 4 * fq + e - fr; mfd[e] = dd <= 0 ? 1.f : 0.f; mbd[e] = dd >= 0 ? 1.f : 0.f; }
    const int nhh = (a.sub & 16) ? 0 : ((a.sub & 8) ? 1 : 8);
    for (int hh = 0; hh < nhh; ++hh) {
        const int h = g * 8 + hh;
        if (hh + 1 < 8) M3_XLOAD(hh + 1);
        const LAS bf16* X = (const LAS bf16*)(lds + MB_OFF_X) + (hh & 1) * 128 * MB_PX;
        const LAS float* vf = vec + hh * 128; const LAS float* vb = vec + 1024 + hh * 128; const LAS float* cF = vec + 2048 + hh * 128; const LAS float* cB = vec + 3072 + hh * 128;
        const float afl = vf[l0 + fr], abl = vb[l0 + fr];
        bf16x8 wf[4];
#pragma unroll
        for (int kc = 0; kc < 4; ++kc) { float wv[8];
#pragma unroll
            for (int hs = 0; hs < 2; ++hs) { const int sb = 2 * kc + hs, s0 = sb * 16 + 4 * fq;
                float rf = 0.f, rb = 0.f;
                if (sb <= wid) rf = __expf(fminf(afl - vf[sb * 16 + 15], 80.f));
                if (sb >= wid) rb = __expf(fminf(abl - vb[sb * 16], 80.f));
                const f32x4 c_f = *(const LAS f32x4*)(cF + s0), c_b = *(const LAS f32x4*)(cB + s0);
#pragma unroll
                for (int e = 0; e < 4; ++e) { float m;
                    if (sb < wid) m = rf * c_f[e]; else if (sb > wid) m = rb * c_b[e]; else m = rf * c_f[e] * mfd[e] + rb * c_b[e] * mbd[e];
                    wv[hs * 4 + e] = CB[sb][e] * m; } }
            u32x4 w; w.x = pk2(wv[0], wv[1]); w.y = pk2(wv[2], wv[3]); w.z = pk2(wv[4], wv[5]); w.w = pk2(wv[6], wv[7]); wf[kc] = __builtin_bit_cast(bf16x8, w); }
        const float ef = __expf(afl), eb = __expf(abl);
#define M3_STEP(SET_, NXT_, pt_, hn_, ptn_, do_load_) do { \
            if (do_load_) M3_HLOAD(NXT_, hn_, ptn_); \
            f32x4 yd = (f32x4){0.f, 0.f, 0.f, 0.f}, y1 = yd, y2 = yd; \
            _Pragma("unroll") for (int kc = 0; kc < 4; ++kc) { const LAS bf16* pa = X + (kc * 32 + 4 * fq + q4) * MB_PX + (pt_) * 16 + 4 * p4; \
                yd = __builtin_amdgcn_mfma_f32_16x16x32_bf16(trfrag(pa, pa + 16 * MB_PX), wf[kc], yd, 0, 0, 0); } \
            _Pragma("unroll") for (int ks = 0; ks < 4; ++ks) { y1 = __builtin_amdgcn_mfma_f32_16x16x32_bf16(SET_[ks], cf[ks], y1, 0, 0, 0); y2 = __builtin_amdgcn_mfma_f32_16x16x32_bf16(SET_[4 + ks], cf[ks], y2, 0, 0, 0); } \
            f32x4 o; \
            _Pragma("unroll") for (int e = 0; e < 4; ++e) o[e] = yd[e] + ef * y1[e] + eb * y2[e]; \
            { uint2 pk; pk.x = pk2(o[0], o[1]); pk.y = pk2(o[2], o[3]); *(uint2*)(YM + (size_t)(row0 + l0 + fr) * 1024 + h * 64 + (pt_) * 16 + 4 * fq) = pk; } } while (0)
        M3_STEP(hs0, hs1, 0, hh, 1, true);
        M3_STEP(hs1, hs0, 1, hh, 2, true);
        M3_STEP(hs0, hs1, 2, hh, 3, true);
        M3_STEP(hs1, hs0, 3, hh + 1, 0, hh + 1 < 8);
#undef M3_STEP
        if (hh + 1 < 8) { M3_XSTORE(hh + 1); }
        __syncthreads();
    }
#undef M3_XLOAD
#undef M3_XSTORE
#undef M3_HLOAD
}


constexpr int RC_NCH = CH_STEPS / 16;
constexpr int RC_UNITS = 128 * RC_NCH;
constexpr int RC_TP = 72;
constexpr int RC_WAVE_LDS = 5 * 16 * RC_TP * 2 + 16 * 17 * 4 + 16 * 24 * 2;
constexpr int RC_CT_FLOATS = 6 * 512 + 3 * 512;
static_assert(8 * RC_WAVE_LDS + RC_CT_FLOATS * 4 <= LDS_STAGE, "rwkv R1 LDS");
__device__ __forceinline__ void rc_consts(LAS unsigned char* lds, int l, int tid) {
    LAS float* CT = (LAS float*)(lds + 8 * RC_WAVE_LDS);
    const float* mu = ldin(12) + (size_t)l * 2 * 1792; const float* a0 = ldin(15) + l * 512; const float* k_k = ldin(18) + l * 512; const float* k_a = ldin(19) + l * 512;
    for (int i = tid; i < 1536; i += NT) { CT[i] = mu[i]; CT[1536 + i] = mu[1792 + i]; }
    for (int i = tid; i < 512; i += NT) { CT[3072 + i] = a0[i]; CT[3584 + i] = k_k[i]; CT[4096 + i] = k_a[i]; }
    __syncthreads();
}
constexpr size_t RC_REC = 16 * 64 + 16 * 64 + 16 * 64 + 64 * 32 + 16 * 64;
constexpr size_t WS_RC1 = WS_MGU + 224 * MiB;
constexpr size_t WS_RC2 = WS_MD + 112 * MiB;
static_assert(MOE_FP8 == 1 && (size_t)RC_UNITS * RC_REC * 2 <= 224 * MiB && (size_t)RC_UNITS * (4096 + 256) <= 112 * MiB, "rwkv chunk records");

__device__ __forceinline__ bf16x8 pack_lo4(const f32x4 v) { u32x4 w; w.x = pk2(v[0], v[1]); w.y = pk2(v[2], v[3]); w.z = 0u; w.w = 0u; return __builtin_bit_cast(bf16x8, w); }

__device__ __forceinline__ void rwkv_r1(const Ctx& a, LAS unsigned char* lds, int l, int unit) {
    unsigned char* ws = opqp(a.ws); const int tid = ((a.wv << 6) | lane_v()), lane = tid & 63, wid = tid >> 6, fr = lane & 15, fq = lane >> 4, q4 = (lane & 15) >> 2, p4 = lane & 3;
    const int chain = unit / RC_NCH, c = unit % RC_NCH; const int dir = chain & 1, h = (chain >> 1) & 7, b = chain >> 4;
    const bf16* R5 = (const bf16*)(ws + WS_RW5); const float* F = (const float*)(ws + WS_MIX); const size_t st = (size_t)MTOT * 512;
    bf16* rec = (bf16*)(ws + WS_RC1) + (size_t)unit * RC_REC; float* Ycg = (float*)(ws + WS_RC2) + (size_t)unit * 1024; float* PCg = (float*)(ws + WS_RC2) + (size_t)RC_UNITS * 1024 + (size_t)unit * 64;
    LAS bf16* tA = (LAS bf16*)(lds + wid * RC_WAVE_LDS); LAS bf16* tR = tA + 16 * RC_TP; LAS bf16* tB = tR + 16 * RC_TP; LAS bf16* tK = tB + 16 * RC_TP; LAS bf16* tV = tK + 16 * RC_TP;
    LAS float* L1s = (LAS float*)(tV + 16 * RC_TP); LAS bf16* Ts = (LAS bf16*)(L1s + 16 * 17);
    {   const int t = lane >> 2, part = lane & 3; const int row = chain_row(c * 16 + t, b, dir);
        const bool lat = row < MLAT; const int pos = lat ? (row & (SEQ - 1)) : ((row - MLAT) & (CTXL - 1)); const bool hp = pos > 0, hn = pos < (lat ? SEQ : CTXL) - 1;
        const bf16* U = (const bf16*)(ws + WS_U); const bf16* up = U + (size_t)row * NINP + h * 64 + part * 16; const int ch = h * 64 + part * 16;
        const LAS float* CT = (const LAS float*)(lds + 8 * RC_WAVE_LDS);
        float sv[3][16];
#pragma unroll
        for (int q = 0; q < 3; ++q)
#pragma unroll
            for (int hf = 0; hf < 2; ++hf) { float u[8], p[8], n[8];
                unpack8(*(const uint4*)(up + q * 512 + hf * 8), u); unpack8(hp ? *(const uint4*)(up - NINP + q * 512 + hf * 8) : make_uint4(0u, 0u, 0u, 0u), p); unpack8(hn ? *(const uint4*)(up + NINP + q * 512 + hf * 8) : make_uint4(0u, 0u, 0u, 0u), n);
#pragma unroll
                for (int e = 0; e < 8; ++e) { const int cc = ch + hf * 8 + e; sv[q][hf * 8 + e] = u[e] + CT[q * 512 + cc] * (p[e] - u[e]) + CT[1536 + q * 512 + cc] * (n[e] - u[e]); } }
        float av[16];
#pragma unroll
        for (int q4_ = 0; q4_ < 4; ++q4_) { const f32x4 f = *(const f32x4*)(F + (size_t)row * 2048 + 1024 + ch + q4_ * 4);
#pragma unroll
            for (int e = 0; e < 4; ++e) av[q4_ * 4 + e] = fsigm(f[e] + CT[3072 + ch + q4_ * 4 + e]); }
        float kkv[16], k2[16], bv[16], ss = 0.f;
#pragma unroll
        for (int e = 0; e < 16; ++e) { kkv[e] = sv[1][e] * CT[3584 + ch + e]; ss += kkv[e] * kkv[e]; }
        ss += dppf<0xB1>(ss); ss += dppf<0x4E>(ss);
        const float inv = 1.0f / fmaxf(sqrtf(ss), 1e-12f);
#pragma unroll
        for (int e = 0; e < 16; ++e) { kkv[e] *= inv; k2[e] = sv[1][e] * (1.0f + (av[e] - 1.0f) * CT[4096 + ch + e]); bv[e] = kkv[e] * av[e]; }
        const int lo = t * RC_TP + part * 16;
#define RC_PUT(T_, A_) do { *(LAS u32x4*)(T_ + lo) = (u32x4){pk2(A_[0], A_[1]), pk2(A_[2], A_[3]), pk2(A_[4], A_[5]), pk2(A_[6], A_[7])}; \
            *(LAS u32x4*)(T_ + lo + 8) = (u32x4){pk2(A_[8], A_[9]), pk2(A_[10], A_[11]), pk2(A_[12], A_[13]), pk2(A_[14], A_[15])}; } while (0)
        RC_PUT(tR, sv[0]); RC_PUT(tK, k2); RC_PUT(tV, sv[2]); RC_PUT(tA, kkv); RC_PUT(tB, bv);
#undef RC_PUT
        if (dir == 0) {
            bf16* R5w = (bf16*)(ws + WS_RW5); const size_t o = (size_t)row * 512 + ch;
            *(u32x4*)(R5w + o) = *(const LAS u32x4*)(tR + lo); *(u32x4*)(R5w + o + 8) = *(const LAS u32x4*)(tR + lo + 8);
            *(u32x4*)(R5w + st + o) = *(const LAS u32x4*)(tK + lo); *(u32x4*)(R5w + st + o + 8) = *(const LAS u32x4*)(tK + lo + 8);
            *(u32x4*)(R5w + 2 * st + o) = *(const LAS u32x4*)(tV + lo); *(u32x4*)(R5w + 2 * st + o + 8) = *(const LAS u32x4*)(tV + lo + 8); }
    }
    const int j = lane; const float w0j = ldin(13)[l * 1024 + dir * 512 + h * 64 + j];
    float wraw[16];
#pragma unroll
    for (int t = 0; t < 16; ++t) wraw[t] = F[(size_t)chain_row(c * 16 + t, b, dir) * 2048 + dir * 512 + h * 64 + j];
    __builtin_amdgcn_sched_barrier(0);
    float Lc = 0.f, Pprev = 1.0f, Lct[16], bq[16], kq[16];
#pragma unroll
    for (int t = 0; t < 16; ++t) {
        const float rv = bf2f(tR[t * RC_TP + j]), kv = bf2f(tK[t * RC_TP + j]), kkv = bf2f(tA[t * RC_TP + j]), bv = bf2f(tB[t * RC_TP + j]);
        const float lw = (-0.60653066f * 1.44269504f) * fsigm(wraw[t] + w0j);
        const float Pm1 = Pprev; Lc += lw; const float P = __builtin_amdgcn_exp2f(Lc), iP = __builtin_amdgcn_rcpf(P); Pprev = P;
        Lct[t] = Lc; bq[t] = bv; kq[t] = kv;
        tA[t * RC_TP + j] = (bf16)f2bf(-kkv * Pm1); tR[t * RC_TP + j] = (bf16)f2bf(rv * P); tB[t * RC_TP + j] = (bf16)f2bf(bv * iP); tK[t * RC_TP + j] = (bf16)f2bf(kv * iP);
    }
    PCg[j] = Pprev;
    {   unsigned vw[8];
#pragma unroll
        for (int t2 = 0; t2 < 8; ++t2) vw[t2] = (unsigned)tV[(2 * t2) * RC_TP + j] | ((unsigned)tV[(2 * t2 + 1) * RC_TP + j] << 16);
        *(uint4*)(rec + 5120 + (size_t)j * 16) = make_uint4(vw[0], vw[1], vw[2], vw[3]); *(uint4*)(rec + 5120 + (size_t)j * 16 + 8) = make_uint4(vw[4], vw[5], vw[6], vw[7]); }
    {   bf16* BK = rec + 3072 + (size_t)j * 32;
#pragma unroll
        for (int g = 0; g < 4; ++g) { float o8[8];
#pragma unroll
            for (int e = 0; e < 4; ++e) { const float d = __builtin_amdgcn_exp2f(Lc - Lct[4 * g + e]); o8[e] = bq[4 * g + e] * d; o8[4 + e] = kq[4 * g + e] * d; }
            *(uint4*)(BK + g * 8) = pack8(o8); } }
    f32x4 L1 = (f32x4){0.f, 0.f, 0.f, 0.f}, L2 = L1, M1 = L1, M2 = L1;
#pragma unroll
    for (int ks = 0; ks < 2; ++ks) {
        const bf16x8 ya = *(const LAS bf16x8*)(tA + fr * RC_TP + ks * 32 + fq * 8), yr = *(const LAS bf16x8*)(tR + fr * RC_TP + ks * 32 + fq * 8);
        const bf16x8 xb = *(const LAS bf16x8*)(tB + fr * RC_TP + ks * 32 + fq * 8), xk = *(const LAS bf16x8*)(tK + fr * RC_TP + ks * 32 + fq * 8);
        L1 = __builtin_amdgcn_mfma_f32_16x16x32_bf16(xb, ya, L1, 0, 0, 0); L2 = __builtin_amdgcn_mfma_f32_16x16x32_bf16(xk, ya, L2, 0, 0, 0);
        M1 = __builtin_amdgcn_mfma_f32_16x16x32_bf16(xb, yr, M1, 0, 0, 0); M2 = __builtin_amdgcn_mfma_f32_16x16x32_bf16(xk, yr, M2, 0, 0, 0);
    }
#pragma unroll
    for (int e = 0; e < 4; ++e) { const int s = 4 * fq + e, t = fr;
        if (!(s < t)) { L1[e] = 0.f; L2[e] = 0.f; } if (!(s <= t)) { M1[e] = 0.f; M2[e] = 0.f; }
        }
    {   const int cc = lane & 15; float Tc[16];
#pragma unroll
        for (int t = 0; t < 16; ++t) { float acc = (t == cc) ? 1.f : 0.f;
#pragma unroll
            for (int s = 0; s < t; ++s) { const float lts = __int_as_float(__builtin_amdgcn_readlane(__float_as_int(L1[s & 3]), 16 * (s >> 2) + t)); acc += lts * Tc[s]; }
            Tc[t] = acc; }
        if (lane < 16) {
#pragma unroll
            for (int t = 0; t < 16; ++t) Ts[t * 24 + cc] = (bf16)f2bf(Tc[t]); } }
    const bf16x8 Top = __builtin_bit_cast(bf16x8, (u32x4){((const LAS unsigned*)(Ts + fr * 24 + 4 * fq))[0], ((const LAS unsigned*)(Ts + fr * 24 + 4 * fq))[1], 0u, 0u});
    const bf16x8 L2op = pack_lo4(L2), M1op = pack_lo4(M1), M2op = pack_lo4(M2);
#pragma unroll
    for (int kt = 0; kt < 4; ++kt) { const LAS bf16* pa = tA + (4 * fq + q4) * RC_TP + kt * 16 + 4 * p4;
        const f32x4 ta = __builtin_amdgcn_mfma_f32_16x16x32_bf16(trfrag(pa, pa), Top, (f32x4){0.f, 0.f, 0.f, 0.f}, 0, 0, 0);
        uint2 pk; pk.x = pk2(ta[0], ta[1]); pk.y = pk2(ta[2], ta[3]);
        *(uint2*)(rec + fr * 64 + 32 * (kt >> 1) + 8 * fq + 4 * (kt & 1)) = pk;
        *(LAS u32x2*)(tB + fr * RC_TP + kt * 16 + 4 * fq) = (u32x2){pk.x, pk.y}; }
#pragma unroll
    for (int vt = 0; vt < 4; ++vt) { const LAS bf16* pa = tV + (4 * fq + q4) * RC_TP + vt * 16 + 4 * p4;
        const f32x4 x = __builtin_amdgcn_mfma_f32_16x16x32_bf16(trfrag(pa, pa), L2op, (f32x4){0.f, 0.f, 0.f, 0.f}, 0, 0, 0);
        *(LAS u32x2*)(tK + fr * RC_TP + vt * 16 + 4 * fq) = (u32x2){pk2(x[0], x[1]), pk2(x[2], x[3])}; }
#pragma unroll
    for (int kt = 0; kt < 4; ++kt) { const LAS bf16* pa = tB + (4 * fq + q4) * RC_TP + kt * 16 + 4 * p4;
        const u32x2 r2 = *(const LAS u32x2*)(tR + fr * RC_TP + kt * 16 + 4 * fq);
        f32x4 ra = (f32x4){__uint_as_float(r2.x << 16), __uint_as_float(r2.x & 0xffff0000u), __uint_as_float(r2.y << 16), __uint_as_float(r2.y & 0xffff0000u)};
        ra = __builtin_amdgcn_mfma_f32_16x16x32_bf16(trfrag(pa, pa), M1op, ra, 0, 0, 0);
        uint2 pk; pk.x = pk2(ra[0], ra[1]); pk.y = pk2(ra[2], ra[3]);
        *(uint2*)(rec + 1024 + fr * 64 + 32 * (kt >> 1) + 8 * fq + 4 * (kt & 1)) = pk; }
#pragma unroll
    for (int vt = 0; vt < 4; ++vt) { const LAS bf16* pa = tK + (4 * fq + q4) * RC_TP + vt * 16 + 4 * p4;
        const f32x4 x = __builtin_amdgcn_mfma_f32_16x16x32_bf16(trfrag(pa, pa), Top, (f32x4){0.f, 0.f, 0.f, 0.f}, 0, 0, 0);
        uint2 pk; pk.x = pk2(x[0], x[1]); pk.y = pk2(x[2], x[3]);
#pragma unroll
        for (int e = 0; e < 4; ++e) rec[2048 + (size_t)(vt * 16 + 4 * fq + e) * 16 + fr] = (bf16)f2bf(x[e]);
        *(LAS u32x2*)(tA + fr * RC_TP + vt * 16 + 4 * fq) = (u32x2){pk.x, pk.y}; }
#pragma unroll
    for (int vt = 0; vt < 4; ++vt) { const LAS bf16* pg = tA + (4 * fq + q4) * RC_TP + vt * 16 + 4 * p4; const LAS bf16* pv = tV + (4 * fq + q4) * RC_TP + vt * 16 + 4 * p4;
        f32x4 x = __builtin_amdgcn_mfma_f32_16x16x32_bf16(trfrag(pg, pg), M1op, (f32x4){0.f, 0.f, 0.f, 0.f}, 0, 0, 0);
        x = __builtin_amdgcn_mfma_f32_16x16x32_bf16(trfrag(pv, pv), M2op, x, 0, 0, 0);
#pragma unroll
        for (int e = 0; e < 4; ++e) Ycg[(size_t)(vt * 16 + 4 * fq + e) * 16 + fr] = x[e]; }
}

constexpr int R2_NV = 2;
__device__ __forceinline__ void rwkv_r2(const Ctx& a, int l, int item) {
    unsigned char* ws = opqp(a.ws); const int tid = ((a.wv << 6) | lane_v()), lane = tid & 63, wid = tid >> 6, fr = lane & 15, fq = lane >> 4;
    const int chain = 4 * item + (wid >> 1), v0 = 32 * (wid & 1); const int dir = chain & 1, h = (chain >> 1) & 7, b = chain >> 4;
    bf16* Y = (bf16*)(ws + WS_YR) + (size_t)dir * MTOT * 512;
    f32x4 S[R2_NV][4];
#pragma unroll
    for (int vg = 0; vg < R2_NV; ++vg)
#pragma unroll
        for (int kt = 0; kt < 4; ++kt) S[vg][kt] = (f32x4){0.f, 0.f, 0.f, 0.f};
    struct Rec { bf16x8 taf[2], raf[2], bkf[4]; f32x4 pc[4]; uint2 g2[R2_NV], v2[R2_NV]; f32x4 yc[R2_NV]; int r0; };
    Rec cur, nxt;
#define R2_LOAD(R_, c_) do { const size_t unit_ = (size_t)chain * RC_NCH + (c_); \
        const bf16* rec_ = (const bf16*)(ws + WS_RC1) + unit_ * RC_REC; const float* Ycg_ = (const float*)(ws + WS_RC2) + unit_ * 1024; const float* PCg_ = (const float*)(ws + WS_RC2) + (size_t)RC_UNITS * 1024 + unit_ * 64; \
        _Pragma("unroll") for (int jj = 0; jj < 2; ++jj) { R_.taf[jj] = *(const bf16x8*)(rec_ + fr * 64 + jj * 32 + fq * 8); R_.raf[jj] = *(const bf16x8*)(rec_ + 1024 + fr * 64 + jj * 32 + fq * 8); } \
        _Pragma("unroll") for (int kt = 0; kt < 4; ++kt) { R_.bkf[kt] = *(const bf16x8*)(rec_ + 3072 + (size_t)(kt * 16 + fr) * 32 + fq * 8); R_.pc[kt] = *(const f32x4*)(PCg_ + kt * 16 + 4 * fq); } \
        _Pragma("unroll") for (int vg = 0; vg < R2_NV; ++vg) { const size_t vo_ = (size_t)(v0 + 16 * vg + fr) * 16 + 4 * fq; \
            R_.g2[vg] = *(const uint2*)(rec_ + 2048 + vo_); R_.v2[vg] = *(const uint2*)(rec_ + 5120 + vo_); R_.yc[vg] = *(const f32x4*)(Ycg_ + vo_); } \
        const int s0_ = (c_) * 16; const int inc_ = s0_ < CTXL ? 1 : 0; const int t0_ = s0_ - (inc_ ? 0 : CTXL), L_ = inc_ ? CTXL : SEQ, base_ = inc_ ? MLAT + b * CTXL : b * SEQ; \
        R_.r0 = base_ + (dir ? L_ - 1 - t0_ : t0_); } while (0)
#define R2_STEP(R_, c_) do { _Pragma("unroll") for (int vg = 0; vg < R2_NV; ++vg) { \
        bf16x8 sb[2]; \
        _Pragma("unroll") for (int jj = 0; jj < 2; ++jj) { u32x4 w; w.x = pk2(S[vg][2 * jj][0], S[vg][2 * jj][1]); w.y = pk2(S[vg][2 * jj][2], S[vg][2 * jj][3]); w.z = pk2(S[vg][2 * jj + 1][0], S[vg][2 * jj + 1][1]); w.w = pk2(S[vg][2 * jj + 1][2], S[vg][2 * jj + 1][3]); sb[jj] = __builtin_bit_cast(bf16x8, w); } \
        f32x4 xt = (f32x4){0.f, 0.f, 0.f, 0.f}, yt = xt; \
        _Pragma("unroll") for (int jj = 0; jj < 2; ++jj) { xt = __builtin_amdgcn_mfma_f32_16x16x32_bf16(R_.taf[jj], sb[jj], xt, 0, 0, 0); yt = __builtin_amdgcn_mfma_f32_16x16x32_bf16(R_.raf[jj], sb[jj], yt, 0, 0, 0); }     \
        _Pragma("unroll") for (int e = 0; e < 4; ++e) Y[(size_t)(R_.r0 + (dir ? -(4 * fq + e) : (4 * fq + e))) * 512 + h * 64 + v0 + 16 * vg + fr] = (bf16)f2bf(yt[e] + R_.yc[vg][e]); \
        float g4_[4]; unpack4(R_.g2[vg], g4_); \
        u32x4 w; w.x = pk2(xt[0] + g4_[0], xt[1] + g4_[1]); w.y = pk2(xt[2] + g4_[2], xt[3] + g4_[3]); w.z = R_.v2[vg].x; w.w = R_.v2[vg].y; \
        const bf16x8 yop = __builtin_bit_cast(bf16x8, w);                    \
        _Pragma("unroll") for (int kt = 0; kt < 4; ++kt) { S[vg][kt] = S[vg][kt] * R_.pc[kt]; S[vg][kt] = __builtin_amdgcn_mfma_f32_16x16x32_bf16(R_.bkf[kt], yop, S[vg][kt], 0, 0, 0); } } } while (0)
#define R2_CL(x_) ((x_) < RC_NCH ? (x_) : RC_NCH - 1)
    R2_LOAD(cur, 0);
    for (int c = 0; c < RC_NCH; c += 2) {
        R2_LOAD(nxt, R2_CL(c + 1)); R2_STEP(cur, c);
        R2_LOAD(cur, R2_CL(c + 2)); R2_STEP(nxt, c + 1);
    }
#undef R2_STEP
#undef R2_CL
#undef R2_LOAD
}

constexpr int RW_LD = 384;
constexpr int RW_YOFF = 2 * CH_T * RW_LD;
__device__ __forceinline__ void rwkv_chain(const Ctx& a, LAS unsigned char* lds, int l, int item) {
    unsigned char* ws = opqp(a.ws); const int tid = ((a.wv << 6) | lane_v());
    const int dir = item & 1, h = (item >> 1) & 7, b = item >> 4;
    const int rp = tid >> 4, js = tid & 15, j0 = js * 4; const bool odd = js & 1;
    const bf16* R5 = (const bf16*)(ws + WS_RW5); const float* F = (const float*)(ws + WS_MIX); float* Y = (float*)(ws + WS_YR) + (size_t)dir * MTOT * 512;
    const size_t st = (size_t)MTOT * 512;
    LAS float* buf = (LAS float*)lds;
    const int ls = tid >> 4, lp = tid & 15;
    typedef float f32x2 __attribute__((ext_vector_type(2)));
    f32x2 S00 = {0.f, 0.f}, S01 = {0.f, 0.f}, S10 = {0.f, 0.f}, S11 = {0.f, 0.f};
    float4 wreg; uint2 kkr, br, kr, rr, vr;
    const float4 w0r = *(const float4*)(ldin(13) + l * 1024 + dir * 512 + h * 64 + lp * 4);
#define RW_LOAD(c) do { const int row_ = chain_row((c) * CH_T + ls, b, dir); const size_t o_ = (size_t)row_ * 512 + h * 64 + lp * 4; \
        wreg = *(const float4*)(F + (size_t)row_ * 2048 + dir * 512 + h * 64 + lp * 4); \
        rr = *(const uint2*)(R5 + o_); kr = *(const uint2*)(R5 + st + o_); vr = *(const uint2*)(R5 + 2 * st + o_); kkr = *(const uint2*)(R5 + 3 * st + o_); br = *(const uint2*)(R5 + 4 * st + o_); } while (0)
#define RW_STORE(c) do { LAS float* q_ = buf + (((c) & 1) * CH_T + ls) * RW_LD; float f_[4]; \
        unpack4(kkr, f_); *(LAS f32x4*)(q_ + lp * 4) = (f32x4){f_[0], f_[1], f_[2], f_[3]}; \
        unpack4(br, f_);  *(LAS f32x4*)(q_ + 64 + lp * 4) = (f32x4){f_[0], f_[1], f_[2], f_[3]}; \
        *(LAS f32x4*)(q_ + 128 + lp * 4) = (f32x4){__expf(-0.60653066f * fsigm(wreg.x + w0r.x)), __expf(-0.60653066f * fsigm(wreg.y + w0r.y)), __expf(-0.60653066f * fsigm(wreg.z + w0r.z)), __expf(-0.60653066f * fsigm(wreg.w + w0r.w))}; \
        unpack4(kr, f_);  *(LAS f32x4*)(q_ + 192 + lp * 4) = (f32x4){f_[0], f_[1], f_[2], f_[3]}; \
        unpack4(rr, f_);  *(LAS f32x4*)(q_ + 256 + lp * 4) = (f32x4){f_[0], f_[1], f_[2], f_[3]}; \
        unpack4(vr, f_);  *(LAS f32x4*)(q_ + 320 + lp * 4) = (f32x4){f_[0], f_[1], f_[2], f_[3]}; } while (0)
    __syncthreads();
    RW_LOAD(0); RW_STORE(0);
    __syncthreads();
    for (int c = 0; c < CH_NC; ++c) {
        if (c + 1 < CH_NC) RW_LOAD(c + 1);
        if (c > 0) {
            const int row = chain_row((c - 1) * CH_T + ls, b, dir);
            *(f32x4*)(Y + (size_t)row * 512 + h * 64 + lp * 4) = *(const LAS f32x4*)(buf + RW_YOFF + (((c - 1) & 1) * CH_T + ls) * 64 + lp * 4);
        }
        const LAS float* cb = buf + ((c & 1) * CH_T) * RW_LD; LAS float* yb = buf + RW_YOFF + ((c & 1) * CH_T) * 64;
#pragma unroll 2
        for (int s = 0; s < CH_T; ++s) {
            const LAS float* q = cb + s * RW_LD;
            const f32x4 kk4 = *(const LAS f32x4*)(q + j0), b4 = *(const LAS f32x4*)(q + 64 + j0), w4 = *(const LAS f32x4*)(q + 128 + j0), k4 = *(const LAS f32x4*)(q + 192 + j0), r4 = *(const LAS f32x4*)(q + 256 + j0);
            const f32x2 v2 = *(const LAS f32x2*)(q + 320 + 2 * rp);
            const f32x2 kkA = {kk4[0], kk4[1]}, kkB = {kk4[2], kk4[3]}, bA = {b4[0], b4[1]}, bB = {b4[2], b4[3]}, wA = {w4[0], w4[1]}, wB = {w4[2], w4[3]}, kA = {k4[0], k4[1]}, kB = {k4[2], k4[3]}, rA = {r4[0], r4[1]}, rB = {r4[2], r4[3]};
            f32x2 t0 = S00 * kkA + S01 * kkB, t1 = S10 * kkA + S11 * kkB;
            const float sa0 = -red16(t0[0] + t0[1]), sa1 = -red16(t1[0] + t1[1]);
            S00 = S00 * wA + (bA * sa0 + kA * v2[0]); S01 = S01 * wB + (bB * sa0 + kB * v2[0]);
            S10 = S10 * wA + (bA * sa1 + kA * v2[1]); S11 = S11 * wB + (bB * sa1 + kB * v2[1]);
            t0 = S00 * rA + S01 * rB; t1 = S10 * rA + S11 * rB;
            const float p0 = t0[0] + t0[1], p1 = t1[0] + t1[1];
            float ym = odd ? p1 : p0; const float yo = odd ? p0 : p1;
            ym += dppf<0xB1>(yo); ym += dppf<0x4E>(ym); ym += dppf<0x124>(ym); ym += dppf<0x128>(ym);
            if (js < 2) yb[s * 64 + 2 * rp + js] = ym;
        }
        if (c + 1 < CH_NC) RW_STORE(c + 1);
        __syncthreads();
    }
    { const int row = chain_row((CH_NC - 1) * CH_T + ls, b, dir);
      *(f32x4*)(Y + (size_t)row * 512 + h * 64 + lp * 4) = *(const LAS f32x4*)(buf + RW_YOFF + (((CH_NC - 1) & 1) * CH_T + ls) * 64 + lp * 4); }
#undef RW_LOAD
#undef RW_STORE
}

constexpr int AT_KP = 136, AT_VP = 144;
constexpr int AT_KB = 64 * AT_KP * 2, AT_VB = 64 * AT_VP * 2, AT_BUF = AT_KB + AT_VB;
__device__ __forceinline__ void attn_item(const Ctx& a, LAS unsigned char* lds, int l, int b, int h, int qt, bool ctxq, float lam, float post) {
    unsigned char* ws = opqp(a.ws); const int tid = ((a.wv << 6) | lane_v()), lane = tid & 63, wid = tid >> 6, fr = lane & 15, fq = lane >> 4, q4 = (lane & 15) >> 2, p4 = lane & 3;
    const bf16* QK = (const bf16*)(ws + WS_QK); const bf16* U = (const bf16*)(ws + WS_U); bf16* A2 = (bf16*)(ws + WS_HA);
    const int qrow = (ctxq ? MLAT + b * CTXL : b * SEQ) + qt * 128 + wid * 16 + fr;
    const int nkt = ctxq ? 4 : 36;
    bf16x8 qf[2][2];
#pragma unroll
    for (int c = 0; c < 2; ++c)
#pragma unroll
        for (int ks = 0; ks < 2; ++ks) qf[c][ks] = *(const bf16x8*)(QK + (size_t)qrow * 1024 + h * 128 + c * 64 + ks * 32 + fq * 8);
    f32x4 O[2][8];
#pragma unroll
    for (int c = 0; c < 2; ++c)
#pragma unroll
        for (int d = 0; d < 8; ++d) O[c][d] = (f32x4){0.f, 0.f, 0.f, 0.f};
    float mrun[2] = {-3.0e38f, -3.0e38f}, lrun[2] = {0.f, 0.f};
    uint4 kreg[2], vreg[2];
#define AT_LOAD(kt) do { const int kr0_ = ((kt) < 4 ? MLAT + b * CTXL + (kt) * 64 : b * SEQ + ((kt) - 4) * 64); \
        _Pragma("unroll") for (int j_ = 0; j_ < 2; ++j_) { const int id_ = tid + j_ * NT, key_ = id_ >> 4, part_ = id_ & 15; \
            kreg[j_] = *(const uint4*)(QK + (size_t)(kr0_ + key_) * 1024 + 512 + h * 128 + part_ * 8); \
            vreg[j_] = *(const uint4*)(U + (size_t)(kr0_ + key_) * NINP + C_DA_V + h * 128 + part_ * 8); } } while (0)
#define AT_STORE(kt) do { LAS bf16* Ks_ = (LAS bf16*)(lds + ((kt) & 1) * AT_BUF); LAS bf16* Vs_ = (LAS bf16*)(lds + ((kt) & 1) * AT_BUF + AT_KB); \
        _Pragma("unroll") for (int j_ = 0; j_ < 2; ++j_) { const int id_ = tid + j_ * NT, key_ = id_ >> 4, part_ = id_ & 15; \
            *(LAS u32x4*)(Ks_ + key_ * AT_KP + part_ * 8) = (u32x4){kreg[j_].x, kreg[j_].y, kreg[j_].z, kreg[j_].w}; \
            *(LAS u32x4*)(Vs_ + key_ * AT_VP + part_ * 8) = (u32x4){vreg[j_].x, vreg[j_].y, vreg[j_].z, vreg[j_].w}; } } while (0)
    __syncthreads();
    AT_LOAD(0); AT_STORE(0);
    __syncthreads();
    for (int kt = 0; kt < nkt; ++kt) {
        if (kt + 1 < nkt) AT_LOAD(kt + 1);
        const LAS bf16* Ks = (const LAS bf16*)(lds + (kt & 1) * AT_BUF); const LAS bf16* Vs = (const LAS bf16*)(lds + (kt & 1) * AT_BUF + AT_KB);
        f32x4 S[2][4];
#pragma unroll
        for (int c = 0; c < 2; ++c)
#pragma unroll
            for (int sb = 0; sb < 4; ++sb) { f32x4 acc = (f32x4){0.f, 0.f, 0.f, 0.f};
#pragma unroll
                for (int ks = 0; ks < 2; ++ks) { const bf16x8 kf = *(const LAS bf16x8*)(Ks + (sb * 16 + fr) * AT_KP + c * 64 + ks * 32 + fq * 8);
                    acc = __builtin_amdgcn_mfma_f32_16x16x32_bf16(kf, qf[c][ks], acc, 0, 0, 0); }
                S[c][sb] = acc; }
        bf16x8 pf[2][2];
#pragma unroll
        for (int c = 0; c < 2; ++c) {
            float mx = S[c][0][0];
#pragma unroll
            for (int sb = 0; sb < 4; ++sb)
#pragma unroll
                for (int e = 0; e < 4; ++e) mx = fmaxf(mx, S[c][sb][e]);
            mx = fmaxf(mx, swz16(mx)); mx = fmaxf(mx, shx32(mx, lane));
            const float mnew = fmaxf(mrun[c], mx), alpha = __builtin_amdgcn_exp2f(mrun[c] - mnew); mrun[c] = mnew;
            float ps = 0.f;
#pragma unroll
            for (int sb = 0; sb < 4; ++sb)
#pragma unroll
                for (int e = 0; e < 4; ++e) { const float pv = __builtin_amdgcn_exp2f(S[c][sb][e] - mnew); S[c][sb][e] = pv; ps += pv; }
            lrun[c] = lrun[c] * alpha + ps;
#pragma unroll
            for (int d = 0; d < 8; ++d) O[c][d] *= alpha;
#pragma unroll
            for (int kc = 0; kc < 2; ++kc) { u32x4 w; w.x = pk2(S[c][2 * kc][0], S[c][2 * kc][1]); w.y = pk2(S[c][2 * kc][2], S[c][2 * kc][3]); w.z = pk2(S[c][2 * kc + 1][0], S[c][2 * kc + 1][1]); w.w = pk2(S[c][2 * kc + 1][2], S[c][2 * kc + 1][3]);
                pf[c][kc] = __builtin_bit_cast(bf16x8, w); }
        }
#pragma unroll
        for (int kc = 0; kc < 2; ++kc)
#pragma unroll
            for (int d = 0; d < 8; ++d) {
                const LAS bf16* pa = Vs + (kc * 32 + 4 * fq + q4) * AT_VP + d * 16 + 4 * p4;
                const bf16x8 vf = trfrag(pa, pa + 16 * AT_VP);
                O[0][d] = __builtin_amdgcn_mfma_f32_16x16x32_bf16(vf, pf[0][kc], O[0][d], 0, 0, 0);
                O[1][d] = __builtin_amdgcn_mfma_f32_16x16x32_bf16(vf, pf[1][kc], O[1][d], 0, 0, 0);
            }
        if (kt + 1 < nkt) AT_STORE(kt + 1);
        __syncthreads();
    }
#undef AT_LOAD
#undef AT_STORE
    float l0 = lrun[0], l1 = lrun[1];
    l0 += swz16(l0); l0 += shx32(l0, lane); l1 += swz16(l1); l1 += shx32(l1, lane);
    const float i0 = 1.0f / l0, i1 = lam / l1;
    float ss = 0.f;
#pragma unroll
    for (int d = 0; d < 8; ++d)
#pragma unroll
        for (int e = 0; e < 4; ++e) { const float o = O[0][d][e] * i0 - O[1][d][e] * i1; O[0][d][e] = o; ss += o * o; }
    ss += swz16(ss); ss += shx32(ss, lane);
    const float rs = rsqrtf(ss * (1.0f / 128.0f) + 1e-5f) * post;
    const float* sw = ldin(30) + l * 128;
#pragma unroll
    for (int d = 0; d < 8; ++d) { const int dc = d * 16 + 4 * fq; const float4 w4 = *(const float4*)(sw + dc);
        uint2 pk; pk.x = pk2(O[0][d][0] * rs * w4.x, O[0][d][1] * rs * w4.y); pk.y = pk2(O[0][d][2] * rs * w4.z, O[0][d][3] * rs * w4.w);
        *(uint2*)(A2 + (size_t)qrow * DM + 1536 + h * 128 + dc) = pk; }
}

__device__ __forceinline__ int q_pull(unsigned* ctr, volatile LAS unsigned* slot, int tid) {
    __syncthreads();
    if (tid == 0) *slot = __hip_atomic_fetch_add(ctr, 1u, __ATOMIC_RELAXED, __HIP_MEMORY_SCOPE_AGENT);
    __syncthreads();
    return (int)*slot;
}
__device__ __forceinline__ void p6_mixers(const Ctx& a, LAS unsigned char* lds, int l, int bid, int G) {
    unsigned char* ws = opqp(a.ws); const int tid = ((a.wv << 6) | lane_v());
    volatile LAS unsigned* slot = (volatile LAS unsigned*)(lds + LDS_STAGE + 8);
    unsigned* qm = (unsigned*)(ws + WS_CTL) + CW_Q + (l * 2 + 0) * 64; unsigned* qa = (unsigned*)(ws + WS_CTL) + CW_Q + (l * 2 + 1) * 64;
    if (a.sub & 1) for (int it = bid; it < 32; it += G) rwkv_r2(a, l, it);
    if (a.sub & 4) {
    const float* lp = ldin(29) + l * 256; float s01 = 0.f, s23 = 0.f;
    for (int i = 0; i < 64; ++i) { s01 += lp[i] * lp[64 + i]; s23 += lp[128 + i] * lp[192 + i]; }
    const float lam_init = l == 0 ? 0.2f : (0.8f - 0.6f * 0.74081822068f);
    const float lam = expf(s01) - expf(s23) + lam_init, post = 1.0f - lam_init;
    const int nat = l == 0 ? 576 : 512;
    for (;;) { const int it = q_pull(qa, slot, tid); if (it >= nat) break;
        if (it < 512) { const int qt = it & 15, h = (it >> 4) & 3, b = it >> 6; attn_item(a, lds, l, b, h, qt, false, lam, post); }
        else { const int i2 = it - 512; const int qt = i2 & 1, h = (i2 >> 1) & 3, b = i2 >> 3; attn_item(a, lds, l, b, h, qt, true, lam, post); } }
    }
    if (a.sub & 2) { const int nit = l == 0 ? 8 * MB_NCH * 2 : 8 * 16 * 2;
        for (;;) { const int it = q_pull(qm, slot, tid); if (it >= nit) break;
            const int g = it & 1; int cc, b; if (l == 0) { cc = (it >> 1) % MB_NCH; b = (it >> 1) / MB_NCH; } else { cc = 2 + ((it >> 1) & 15); b = it >> 5; } mamba_m3(a, lds, b, cc, g); } }
}


constexpr int N_PHASES = 27;
__global__ void __launch_bounds__(NT, 2) fwd(Args args) {
    extern __shared__ __attribute__((aligned(16))) unsigned char lds_dyn[];
    LAS unsigned char* lds = (LAS unsigned char*)lds_dyn;
    volatile LAS unsigned* MISC = (volatile LAS unsigned*)(lds + LDS_STAGE);
    const int wv = __builtin_amdgcn_readfirstlane((int)threadIdx.x >> 6);
    const int tid = (wv << 6) | lane_v(), bid = blockIdx.x, G = gridDim.x;
    unsigned char* ws = args.ws;
    const Ctx cx{ws, wv, args.sub};
    for (int u = tid; u < LDS_MISC / 4; u += NT) MISC[u] = 0u;
    __syncthreads();
    if (tid == 0) {
#pragma unroll
        for (int i = 0; i < 38; ++i) *(LAS unsigned long long*)(lds + LDS_PTRS + 8 * i) = (unsigned long long)args.in[i];
    }
    __syncthreads();
#if MK_PER_PHASE
#define GRID_BAR() do { } while (0)
#else
    XcdBarrier bar = xcd_barrier_post((unsigned*)(ws + WS_CTL) + CW_BAR, MISC);
#define GRID_BAR() do { XcdBarrier b_ = bar; b_.bar = opqp(b_.bar); b_.x = (unsigned)opqs((int)b_.x); xcd_barrier(b_); } while (0)
#endif
    const int lo = args.ph_lo, hi = args.ph_hi;
#define IN(k) (opqs(lo) <= (k) && (k) < opqs(hi))
#define SEAM(k) do { if (IN((k) + 1)) GRID_BAR(); } while (0)

#define XS (args.out)
#define XSB ((float*)(wsq + WS_XSB))
#define XC ((float*)(wsq + WS_XC))
#define HA ((bf16*)(wsq + WS_HA))
#define Ub ((bf16*)(wsq + WS_U))
#define MIX ((float*)(wsq + WS_MIX))
#define HID ((bf16*)(wsq + WS_BIG))
#define PH_LOCALS unsigned char* const wsq = opqp(ws); const int bidq = opqs(bid), Gq = opqs(G); (void)wsq; (void)bidq; (void)Gq

    if (IN(0)) { PH_LOCALS; if (args.sub & 64) bg_convert(cx, lds, nullptr, Gq); else p0_prologue(cx, lds,  bidq, Gq); SEAM(0); }
    if (IN(1)) { PH_LOCALS;
        thin_phase<0, 1>(cx, lds,  bidq, Gq, MTOT, ldin(0), ldin(2), nullptr, nullptr, nullptr, nullptr, 0, 0, ldin(6), 0, 1, 0);
        SEAM(1);
    }
    for (int l = 0; l < 2; ++l) {
        const int pb = 2 + 12 * l;
        const int Mo = l == 0 ? MTOT : MLAT;
        if (IN(pb + 0)) { PH_LOCALS;
            pg8::Gemm g{HA, (const bf16*)(wsq + WS_WIN) + (size_t)l * NINP * DM, MTOT, NINP, DM}; pg8::StaticOrder S; S.init(MTOT, NINP, Gq, bidq);
            pg8::EpiBf16P E{Ub, NINP, 0, 1.0f};
            pg8::gemm_phase<pg8::EpiBf16P, pg8::StaticOrder>(lds, g, S, E, nullptr, (wv << 6) | lane_v());
            bg_tail(cx, lds, l * 8 + 0, Gq);
            SEAM(pb + 0);
        }
        if (IN(pb + 1)) { PH_LOCALS; feat_a(cx, l,  bidq, Gq); SEAM(pb + 1); }
        if (IN(pb + 2)) { PH_LOCALS;
            pg8::Gemm g{(const bf16*)(wsq + WS_ASM), (const bf16*)(wsq + WS_WSM) + (size_t)l * 2048 * 256, MTOT, 2048, 256}; pg8::StaticOrder S; S.init(MTOT, 2048, Gq, bidq);
            pg8::EpiF32 E{MIX, 2048, nullptr};
            pg8::gemm_phase<pg8::EpiF32, pg8::StaticOrder>(lds, g, S, E, nullptr, (wv << 6) | lane_v());
            for (int it = bidq; it < 8 * MB_NCH * 2; it += Gq) mamba_m1(cx, lds, it);
            bg_tail(cx, lds, l * 8 + 1, Gq);
            SEAM(pb + 2);
        }
        if (IN(pb + 4)) { PH_LOCALS; for (int it = bidq; it < 256; it += Gq) mamba_m2(cx, it);
            rc_consts(lds, l, (wv << 6) | lane_v());
            for (int u = bidq * NW + wv; u < RC_UNITS; u += Gq * NW) rwkv_r1(cx, lds, l, u); SEAM(pb + 4); }
        if (IN(pb + 5)) { PH_LOCALS; p6_mixers(cx, lds, l,  bidq, Gq); if (!(args.sub & 32)) bg_tail(cx, lds, l * 8 + 5, Gq); SEAM(pb + 5); }
        if (IN(pb + 6)) { PH_LOCALS; mix_out(cx, l, Mo,  bidq, Gq); SEAM(pb + 6); }
        if (IN(pb + 7)) { PH_LOCALS;
            pg8::Gemm g{HA, (const bf16*)(wsq + WS_WOUT) + (size_t)l * DM * DM, Mo, DM, DM}; pg8::StaticOrder S; S.init(Mo, DM, Gq, bidq);
            pg8::EpiBf16P E{(bf16*)MIX, DM, 0, 1.0f};
            pg8::gemm_phase<pg8::EpiBf16P, pg8::StaticOrder>(lds, g, S, E, nullptr, (wv << 6) | lane_v());
            bg_tail(cx, lds, l * 8 + 2, Gq);
            SEAM(pb + 7);
        }
        if (l == 0) {
            if (IN(pb + 8)) { PH_LOCALS;
                thin_phase<1, DENSE_GU8 ? 3 : 1, 0, 1>(cx, lds,  bidq, Gq, MTOT, ldin(0), ldin(2), XSB, XC, MIX, ldin(7), 0, 2, ldin(8), 0, 4, 3);
                SEAM(pb + 8);
            }
            if (IN(pb + 9)) { PH_LOCALS;
                pg8::StaticOrder S; S.init(MTOT, 2 * FF, Gq, bidq);
#if DENSE_GU8 && DENSE_D8
                pg8::Gemm g{HA, (const bf16*)(wsq + WS_WGU), MTOT, 2 * FF, DM / 2};
                pg8::EpiSwiGLU8 E{(unsigned char*)(wsq + WS_BIG), FF, 0, 1.0f / MOE_SGU, MOE_SH};
                pg8::gemm_phase<pg8::EpiSwiGLU8, pg8::StaticOrder, false, true>(lds, g, S, E, nullptr, (wv << 6) | lane_v());
#elif DENSE_GU8
                pg8::Gemm g{HA, (const bf16*)(wsq + WS_WGU), MTOT, 2 * FF, DM / 2};
                pg8::EpiSwiGLUS E{HID, FF, 0, 1.0f / MOE_SGU};
                pg8::gemm_phase<pg8::EpiSwiGLUS, pg8::StaticOrder, false, true>(lds, g, S, E, nullptr, (wv << 6) | lane_v());
#elif DENSE_D8
                pg8::Gemm g{HA, (const bf16*)(wsq + WS_WGU), MTOT, 2 * FF, DM};
                pg8::EpiSwiGLU8 E{(unsigned char*)(wsq + WS_BIG), FF, 0, 1.0f, MOE_SH};
                pg8::gemm_phase<pg8::EpiSwiGLU8, pg8::StaticOrder>(lds, g, S, E, nullptr, (wv << 6) | lane_v());
#else
                pg8::Gemm g{HA, (const bf16*)(wsq + WS_WGU), MTOT, 2 * FF, DM};
                pg8::EpiSwiGLU E{HID, FF, 0};
                pg8::gemm_phase<pg8::EpiSwiGLU, pg8::StaticOrder>(lds, g, S, E, nullptr, (wv << 6) | lane_v());
#endif
                bg_tail(cx, lds, 3, Gq);
                SEAM(pb + 9);
            }
            if (IN(pb + 10)) { PH_LOCALS;
                pg8::StaticOrder S; S.init(MTOT, DM, Gq, bidq);
#if DENSE_D8
                pg8::Gemm g{HID, (const bf16*)(wsq + WS_WD), MTOT, DM, FF / 2};
                pg8::EpiBf16P E{(bf16*)MIX, DM, 0, 1.0f / (MOE_SD * MOE_SH)};
                pg8::gemm_phase<pg8::EpiBf16P, pg8::StaticOrder, false, true>(lds, g, S, E, nullptr, (wv << 6) | lane_v());
#else
                pg8::Gemm g{HID, (const bf16*)(wsq + WS_WD), MTOT, DM, FF};
                pg8::EpiBf16P E{(bf16*)MIX, DM, 0, 1.0f};
                pg8::gemm_phase<pg8::EpiBf16P, pg8::StaticOrder>(lds, g, S, E, nullptr, (wv << 6) | lane_v());
#endif
                bg_tail(cx, lds, 4, Gq);
                SEAM(pb + 10);
            }
            if (IN(pb + 11)) { PH_LOCALS;
                thin_phase<1, 1, 1, 1>(cx, lds,  bidq, Gq, MTOT, XSB, XC, XSB, XC, MIX, ldin(9), 0, 5, ldin(6) + DM, 1, 1, 0);
                SEAM(pb + 11);
            }
        } else {
            if (IN(pb + 8)) { PH_LOCALS;
                thin_phase<1, 2, 1, 1>(cx, lds,  bidq, Gq, MLAT, XSB, XC, XSB, XC, MIX, ldin(7) + DM, 1, 2, ldin(8) + DM, 1, 4, 3);
                SEAM(pb + 8);
            }
            if (IN(pb + 9)) { PH_LOCALS; moe_gather(cx,  bidq, Gq); bg_convert(cx, lds, nullptr, Gq); SEAM(pb + 9); }
            if (IN(pb + 10) || IN(pb + 11)) { PH_LOCALS;
                if (((wv << 6) | lane_v()) == 0) { const unsigned* cnt = (const unsigned*)(wsq + WS_CTL) + CW_CNT; int run = 0;
                    for (int e = 0; e < 8; ++e) { const int t = (int)((cnt[e * 64] + 255u) >> 8); MISC[16 + e] = (unsigned)t; MISC[24 + e] = (unsigned)run; run += t; } }
                __syncthreads();
            }
            if (IN(pb + 10)) { PH_LOCALS;
                pg8::MoeOrder S{(const LAS int*)(lds + LDS_STAGE + 64), (2 * FE) / 256, Gq, bidq};
#if MOE_FP8
                pg8::Gemm g{(const bf16*)(wsq + WS_U), (const bf16*)(wsq + WS_MGU), MOE_ROWS, 2 * FE, DM / 2};
                pg8::EpiSwiGLU8 E{(unsigned char*)(wsq + WS_BIG), FE, (2 * FE) / 256, 1.0f / MOE_SGU, MOE_SH};
                pg8::gemm_phase<pg8::EpiSwiGLU8, pg8::MoeOrder, false, true>(lds, g, S, E, nullptr, (wv << 6) | lane_v());
#else
                pg8::Gemm g{(const bf16*)(wsq + WS_U), (const bf16*)(wsq + WS_MGU), MOE_ROWS, 2 * FE, DM};
                pg8::EpiSwiGLU E{HID, FE, (2 * FE) / 256};
                pg8::gemm_phase<pg8::EpiSwiGLU, pg8::MoeOrder>(lds, g, S, E, nullptr, (wv << 6) | lane_v());
#endif
                SEAM(pb + 10);
            }
            if (IN(pb + 11)) { PH_LOCALS;
                pg8::MoeOrder S{(const LAS int*)(lds + LDS_STAGE + 64), DM / 256, Gq, bidq};
#if MOE_FP8
                pg8::Gemm g{HID, (const bf16*)(wsq + WS_MD), MOE_ROWS, DM, FE / 2};
                pg8::EpiBf16P E{(bf16*)(wsq + WS_MIX), DM, DM / 256, 1.0f / (MOE_SD * MOE_SH)};
                pg8::gemm_phase<pg8::EpiBf16P, pg8::MoeOrder, false, true>(lds, g, S, E, nullptr, (wv << 6) | lane_v());
#else
                pg8::Gemm g{HID, (const bf16*)(wsq + WS_MD), MOE_ROWS, DM, FE};
                pg8::EpiBf16P E{(bf16*)(wsq + WS_MIX), DM, DM / 256, 1.0f};
                pg8::gemm_phase<pg8::EpiBf16P, pg8::MoeOrder>(lds, g, S, E, nullptr, (wv << 6) | lane_v());
#endif
                SEAM(pb + 11);
            }
            if (IN(pb + 12)) { PH_LOCALS;
                thin_phase<2, 0, 1, 0>(cx, lds,  bidq, Gq, MLAT, XSB, XC, XS, XC, nullptr, ldin(9) + DM, 1, 5, nullptr, 0, 0, 0);
            }
        }
    }
#undef IN
#undef SEAM
}

extern "C" void kernel_launch(void* const* d_in, const int* in_sizes, int n_in, void* d_out, int out_size, void* d_ws, size_t ws_size, hipStream_t stream) {
    static int grid = 0;
    if (grid == 0) {
        if (n_in != 38 || out_size != MLAT * DM || ws_size < WS_END) { fprintf(stderr, "kernel_launch: unexpected shapes (n_in %d out %d ws %zu need %zu)\n", n_in, out_size, ws_size, (size_t)WS_END); grid = -1; return; }
        int dev = 0, cus = 0, per_cu = 0;
        if (hipGetDevice(&dev) != hipSuccess || hipDeviceGetAttribute(&cus, hipDeviceAttributeMultiprocessorCount, dev) != hipSuccess) { grid = -1; return; }
        if (hipFuncSetAttribute((const void*)fwd, hipFuncAttributeMaxDynamicSharedMemorySize, LDS_BYTES) != hipSuccess) { fprintf(stderr, "kernel_launch: hipFuncSetAttribute failed\n"); grid = -1; return; }
        if (hipOccupancyMaxActiveBlocksPerMultiprocessor(&per_cu, (const void*)fwd, NT, LDS_BYTES) != hipSuccess || per_cu < 1) { fprintf(stderr, "kernel_launch: occupancy query says %d\n", per_cu); per_cu = 1; }
        (void)hipGetLastError();
        grid = cus;
    }
    if (grid < 0) return;
    if (hipMemsetAsync((char*)d_ws + WS_CTL, 0, CTL_BYTES, stream) != hipSuccess) return;
    Args a{};
    for (int i = 0; i < 38; ++i) a.in[i] = (const float*)d_in[i];
    a.out = (float*)d_out; a.ws = (unsigned char*)d_ws; a.sub = 7;
#if MK_PER_PHASE
#ifndef PROBE_SUB
#define PROBE_SUB 7
#endif
#ifndef PROBE_MASK
#define PROBE_MASK 0u
#endif
#ifndef PROBE_SPLIT
#define PROBE_SPLIT 0
#endif
#ifndef PROBE_REP
#define PROBE_REP 1
#endif
    for (int p = 0; p < N_PHASES; ++p) { a.ph_lo = p; a.ph_hi = p + 1;
        if (PROBE_SPLIT && (p == 7 || p == 19)) {
            a.sub = 1; hipLaunchKernelGGL(fwd, dim3(grid), dim3(NT), LDS_BYTES, stream, a);
            if (PROBE_SPLIT == 1) { a.sub = 2; hipLaunchKernelGGL(fwd, dim3(grid), dim3(NT), LDS_BYTES, stream, a); a.sub = 4; hipLaunchKernelGGL(fwd, dim3(grid), dim3(NT), LDS_BYTES, stream, a); }
            else if (PROBE_SPLIT == 2) { a.sub = 6; hipLaunchKernelGGL(fwd, dim3(grid), dim3(NT), LDS_BYTES, stream, a); }
            else { a.sub = 2; hipLaunchKernelGGL(fwd, dim3(grid), dim3(NT), LDS_BYTES, stream, a); a.sub = 5; hipLaunchKernelGGL(fwd, dim3(grid), dim3(NT), LDS_BYTES, stream, a); }
            a.sub = 7; continue; }
        if ((PROBE_MASK >> p) & 1u) { a.sub = PROBE_SUB;
            for (int rep = 0; rep < PROBE_REP; ++rep) { if (rep) (void)hipMemsetAsync((char*)d_ws + WS_CTL + CW_BG * 4, 0, 256, stream); hipLaunchKernelGGL(fwd, dim3(grid), dim3(NT), LDS_BYTES, stream, a); }
            a.sub = 7;
            (void)hipMemsetAsync((char*)d_ws + WS_CTL + CW_Q * 4, 0, 4 * 256, stream); }
        hipLaunchKernelGGL(fwd, dim3(grid), dim3(NT), LDS_BYTES, stream, a); }
#else
    a.ph_lo = 0; a.ph_hi = N_PHASES; hipLaunchKernelGGL(fwd, dim3(grid), dim3(NT), LDS_BYTES, stream, a);
#endif
}
```

```cpp
#include <hip/hip_runtime.h>
#include <cstdio>
#include <cstdint>

#ifndef MK_PER_PHASE
#define MK_PER_PHASE 0
#endif

#define GAS __attribute__((address_space(1)))
#define LAS __attribute__((address_space(3)))
typedef GAS unsigned gu32;
typedef GAS unsigned long long gu64;

__device__ __forceinline__ int opq(int x) { asm volatile("" : "+v"(x)); return x; }
template <class T> __device__ __forceinline__ T* opqp(T* p) { int z = 0; asm volatile("" : "+s"(z)); return (T*)((unsigned char*)p + z); }
__device__ __forceinline__ int opqs(int x) { asm volatile("" : "+s"(x)); return x; }

__device__ __forceinline__ int lane_v() { int l; asm volatile("v_mbcnt_lo_u32_b32 %0, -1, 0\n\tv_mbcnt_hi_u32_b32 %0, -1, %0" : "=v"(l)); return l; }

namespace pg8 {
#define PG8_LAS __attribute__((address_space(3)))
typedef unsigned short bf16_t;
typedef short bf16x8 __attribute__((ext_vector_type(8)));
typedef float f32x4 __attribute__((ext_vector_type(4)));
typedef unsigned u32x4 __attribute__((ext_vector_type(4)));
typedef int i32x4 __attribute__((ext_vector_type(4)));
typedef int i32x8 __attribute__((ext_vector_type(8)));
constexpr int BM = 256, BK = 64, HALF = 128, HTB = HALF * BK * 2  , STAGE_BYTES = 8 * HTB, NXCD = 8, WGM = 8;

__host__ __device__ __forceinline__ int lds_byte(int r, int c) { const int st = (r >> 4) * 2 + (c >> 5), rr = r & 15, cc = c & 31, ob = rr * 64 + cc * 2; return st * 1024 + (ob ^ (((ob >> 9) & 1) << 5)); }
__host__ __device__ __forceinline__ void stage_rc(int b, int& R, int& C) { const int st = b / 1024, sb = b % 1024, swz = sb ^ (((sb >> 9) & 1) << 5); R = (st >> 1) * 16 + swz / 64; C = (st & 1) * 32 + (swz % 64) / 2; }
__host__ __device__ __forceinline__ int perm32(int rho) { const int n = rho >> 4, i = rho & 15; return 8 * (i >> 2) + 4 * n + (i & 3); }

struct Unit { int pm, pn; };
struct Gemm { const bf16_t* A; const bf16_t* Bt; int M, N, K; };

struct StaticOrder {
    int nM, nN, nwg, G, c;
    __host__ __device__ void init(int M, int N, int G_, int c_) { nM = M / BM; nN = N / BM; nwg = nM * nN; G = G_; c = c_; }
    __host__ __device__ bool next(int i, Unit& u) const {
        const long L = (long)i * G + c; if (L >= nwg) return false;
        int wgid = (int)L; { const int q = nwg / NXCD, r = nwg % NXCD, xcd = wgid % NXCD, off = wgid / NXCD; wgid = (xcd < r ? xcd * (q + 1) : r * (q + 1) + (xcd - r) * q) + off; }
        const int nig = WGM * nN, gid = wgid / nig, fm = gid * WGM, gsz = (nM - fm) < WGM ? (nM - fm) : WGM;
        u.pm = fm + ((wgid % nig) % gsz); u.pn = (wgid % nig) / gsz; return true;
    }
    __device__ __forceinline__ void a_ready(const Unit&) const {}
    __device__ __forceinline__ void done(const Unit&) const {}
};
__device__ __forceinline__ unsigned cvt_pk_bf16(float lo, float hi) { unsigned r; asm volatile("v_cvt_pk_bf16_f32 %0, %1, %2" : "=v"(r) : "v"(lo), "v"(hi)); return r; }
struct EpiF32 {
    static constexpr bool PERM = false, AFTER_DRAIN = false;
    float* C; int ldc; const float* bias;
    __device__ __forceinline__ void operator()(const f32x4 (&acc)[2][2][4][2], const Unit& u, int wr, int wc, int fr, int fq) const {
        const int row0 = u.pm * BM + wr * 64 + fr, col0 = u.pn * BM + wc * 32 + 4 * fq;
        f32x4 bv[2][2];
#pragma unroll
        for (int bj = 0; bj < 2; ++bj)
#pragma unroll
            for (int n = 0; n < 2; ++n) bv[bj][n] = bias ? *(const f32x4*)(bias + col0 + bj * HALF + n * 16) : (f32x4){0.f, 0.f, 0.f, 0.f};
#pragma unroll
        for (int ai = 0; ai < 2; ++ai)
#pragma unroll
            for (int m = 0; m < 4; ++m) { float* rowp = C + (size_t)(row0 + ai * HALF + m * 16) * ldc + col0;
#pragma unroll
                for (int bj = 0; bj < 2; ++bj)
#pragma unroll
                    for (int n = 0; n < 2; ++n) *(f32x4*)(rowp + bj * HALF + n * 16) = acc[ai][bj][m][n] + bv[bj][n]; }
    }
};

__device__ __forceinline__ float fsilu(float x) { return x * __builtin_amdgcn_rcpf(1.0f + __expf(-x)); }
__device__ __forceinline__ float fsigm(float x) { return __builtin_amdgcn_rcpf(1.0f + __expf(-x)); }

struct MoeOrder {
    const PG8_LAS int* tab; int nN, G, c;
    __device__ __forceinline__ bool next(int i, Unit& u) const {
        long L = (long)i * G + c;
#pragma unroll
        for (int e = 0; e < 8; ++e) { const int te = tab[e]; const long n = (long)te * nN; if (L < n) { u.pn = e * nN + (int)(L / te); u.pm = tab[8 + e] + (int)(L % te); return true; } L -= n; }
        return false;
    }
    __device__ __forceinline__ void a_ready(const Unit&) const {}
    __device__ __forceinline__ void done(const Unit&) const {}
};

struct EpiBf16P {
    static constexpr bool PERM = true, AFTER_DRAIN = false;
    bf16_t* O; int ldc; int nN; float scale;
    __device__ __forceinline__ void operator()(const f32x4 (&acc)[2][2][4][2], const Unit& u, int wr, int wc, int fr, int fq) const {
        const int row0 = u.pm * BM + wr * 64 + fr; const int pnr = nN ? (u.pn % nN) : u.pn; const int col0 = pnr * BM + wc * 32 + 8 * fq;
#pragma unroll
        for (int ai = 0; ai < 2; ++ai)
#pragma unroll
            for (int m = 0; m < 4; ++m) { bf16_t* rowp = O + (size_t)(row0 + ai * HALF + m * 16) * ldc + col0;
#pragma unroll
                for (int bj = 0; bj < 2; ++bj) { const f32x4 v0 = acc[ai][bj][m][0] * scale, v1 = acc[ai][bj][m][1] * scale;
                    u32x4 w; w.x = cvt_pk_bf16(v0[0], v0[1]); w.y = cvt_pk_bf16(v0[2], v0[3]); w.z = cvt_pk_bf16(v1[0], v1[1]); w.w = cvt_pk_bf16(v1[2], v1[3]);
                    *(u32x4*)(rowp + bj * HALF) = w; } }
    }
};

struct EpiSwiGLU {
    static constexpr bool PERM = true, AFTER_DRAIN = false;
    bf16_t* O; int ldc; int nN;
    __device__ __forceinline__ void operator()(const f32x4 (&acc)[2][2][4][2], const Unit& u, int wr, int wc, int fr, int fq) const {
        const int row0 = u.pm * BM + wr * 64 + fr; const int pnr = nN ? (u.pn % nN) : u.pn; const int col0 = pnr * HALF + wc * 32 + 8 * fq;
#pragma unroll
        for (int ai = 0; ai < 2; ++ai)
#pragma unroll
            for (int m = 0; m < 4; ++m) { bf16_t* rowp = O + (size_t)(row0 + ai * HALF + m * 16) * ldc + col0;
                const f32x4 g0 = acc[ai][0][m][0], g1 = acc[ai][0][m][1], u0 = acc[ai][1][m][0], u1 = acc[ai][1][m][1];
                f32x4 v0, v1;
#pragma unroll
                for (int j = 0; j < 4; ++j) { v0[j] = fsilu(g0[j]) * u0[j]; v1[j] = fsilu(g1[j]) * u1[j]; }
                u32x4 w; w.x = cvt_pk_bf16(v0[0], v0[1]); w.y = cvt_pk_bf16(v0[2], v0[3]); w.z = cvt_pk_bf16(v1[0], v1[1]); w.w = cvt_pk_bf16(v1[2], v1[3]);
                *(u32x4*)rowp = w; }
    }
};


__device__ __forceinline__ float clamp8(float x) { return fminf(fmaxf(x, -448.0f), 448.0f); }
__device__ __forceinline__ unsigned pk_fp8x4(float a, float b, float c, float d) { int w = __builtin_amdgcn_cvt_pk_fp8_f32(clamp8(a), clamp8(b), 0, false); w = __builtin_amdgcn_cvt_pk_fp8_f32(clamp8(c), clamp8(d), w, true); return (unsigned)w; }
struct EpiSwiGLUS {
    static constexpr bool PERM = true, AFTER_DRAIN = false;
    bf16_t* O; int ldc; int nN; float sin;
    __device__ __forceinline__ void operator()(const f32x4 (&acc)[2][2][4][2], const Unit& u, int wr, int wc, int fr, int fq) const {
        const int row0 = u.pm * BM + wr * 64 + fr; const int pnr = nN ? (u.pn % nN) : u.pn; const int col0 = pnr * HALF + wc * 32 + 8 * fq;
#pragma unroll
        for (int ai = 0; ai < 2; ++ai)
#pragma unroll
            for (int m = 0; m < 4; ++m) { bf16_t* rowp = O + (size_t)(row0 + ai * HALF + m * 16) * ldc + col0;
                const f32x4 g0 = acc[ai][0][m][0] * sin, g1 = acc[ai][0][m][1] * sin, u0 = acc[ai][1][m][0] * sin, u1 = acc[ai][1][m][1] * sin;
                f32x4 v0, v1;
#pragma unroll
                for (int j = 0; j < 4; ++j) { v0[j] = fsilu(g0[j]) * u0[j]; v1[j] = fsilu(g1[j]) * u1[j]; }
                u32x4 w; w.x = cvt_pk_bf16(v0[0], v0[1]); w.y = cvt_pk_bf16(v0[2], v0[3]); w.z = cvt_pk_bf16(v1[0], v1[1]); w.w = cvt_pk_bf16(v1[2], v1[3]);
                *(u32x4*)rowp = w; }
    }
};


struct EpiSwiGLU8 {
    static constexpr bool PERM = true, AFTER_DRAIN = false;
    unsigned char* O; int ldc; int nN; float sin, sout;
    __device__ __forceinline__ void operator()(const f32x4 (&acc)[2][2][4][2], const Unit& u, int wr, int wc, int fr, int fq) const {
        const int row0 = u.pm * BM + wr * 64 + fr; const int pnr = nN ? (u.pn % nN) : u.pn; const int col0 = pnr * HALF + wc * 32 + 8 * fq;
#pragma unroll
        for (int ai = 0; ai < 2; ++ai)
#pragma unroll
            for (int m = 0; m < 4; ++m) { unsigned char* rowp = O + (size_t)(row0 + ai * HALF + m * 16) * ldc + col0;
                const f32x4 g0 = acc[ai][0][m][0] * sin, g1 = acc[ai][0][m][1] * sin, u0 = acc[ai][1][m][0] * (sin * sout), u1 = acc[ai][1][m][1] * (sin * sout);
                f32x4 v0, v1;
#pragma unroll
                for (int j = 0; j < 4; ++j) { v0[j] = fsilu(g0[j]) * u0[j]; v1[j] = fsilu(g1[j]) * u1[j]; }
                uint2 w; w.x = pk_fp8x4(v0[0], v0[1], v0[2], v0[3]); w.y = pk_fp8x4(v1[0], v1[1], v1[2], v1[3]);
                *(uint2*)rowp = w; }
    }
};


struct EpiF32S {
    static constexpr bool PERM = false, AFTER_DRAIN = false;
    float* C; int ldc; float scale;
    __device__ __forceinline__ void operator()(const f32x4 (&acc)[2][2][4][2], const Unit& u, int wr, int wc, int fr, int fq) const {
        const int row0 = u.pm * BM + wr * 64 + fr, col0 = u.pn * BM + wc * 32 + 4 * fq;
#pragma unroll
        for (int ai = 0; ai < 2; ++ai)
#pragma unroll
            for (int m = 0; m < 4; ++m) { float* rowp = C + (size_t)(row0 + ai * HALF + m * 16) * ldc + col0;
#pragma unroll
                for (int bj = 0; bj < 2; ++bj)
#pragma unroll
                    for (int n = 0; n < 2; ++n) *(f32x4*)(rowp + bj * HALF + n * 16) = acc[ai][bj][m][n] * scale; }
    }
};

template <class Epi, class Sched, bool STAMP = false, bool F8 = false>
__device__ __forceinline__ void gemm_phase(PG8_LAS unsigned char* lds, const Gemm g, const Sched& S, const Epi& E, unsigned long long* stamps, const int tid_in) {
    const int tid = opq(tid_in), wid = __builtin_amdgcn_readfirstlane(tid >> 6), lane = tid & 63, wr = wid >> 2, wc = wid & 3, fr = lane & 15, fq = lane >> 4;
    const int K = g.K, nt = K / BK;
    int ts_lo = 0, ts_hi = 0, nts = 0; const unsigned long long rt_entry = STAMP ? (unsigned long long)wall_clock64() : 0ull;
#define PG8_STAMP() do { if (STAMP && wid == 0 && nts < 64) { const unsigned long long _c = (unsigned long long)clock64(); \
        ts_lo = (lane == nts) ? (int)(unsigned)_c : ts_lo; ts_hi = (lane == nts) ? (int)(unsigned)(_c >> 32) : ts_hi; ++nts; } } while (0)
    PG8_STAMP();
    unsigned voffA[2], voffB[2];
#pragma unroll
    for (int i = 0; i < 2; ++i) { int R, C; stage_rc(tid * 16 + i * 8192, R, C); const int Rb = Epi::PERM ? ((R & ~31) + perm32(R & 31)) : R;
        voffA[i] = (unsigned)(R * K + C) * 2u; voffB[i] = (unsigned)(Rb * K + C) * 2u; }
    const size_t kstep = (size_t)(BK * 2);
    const size_t qstep = (size_t)64 * K * 2;
    const size_t hstep = (size_t)HALF * K * 2;
    const size_t tstep = 2 * hstep;
    const unsigned ldsw = (unsigned)wid * 1024u;
    const int aoff = lds_byte(wr * 64 + fr, fq * 8), boff = lds_byte(wc * 32 + fr, fq * 8);
#define PG8_SA(b, h) (((b) * 2 + (h)) * HTB)
#define PG8_SB(b, h) ((4 + (b) * 2 + (h)) * HTB)
#define PG8_STAGE(bufoff, gbase, voff) do { _Pragma("unroll") for (int _i = 0; _i < 2; ++_i) \
        __builtin_amdgcn_global_load_lds((const unsigned*)((const char*)(gbase) + (size_t)_i * qstep + (voff)[0]), (PG8_LAS unsigned*)(lds + (bufoff) + ldsw + _i * 8192), 16, 0, 0); } while (0)
#define PG8_LDA(dst, b, h) do { _Pragma("unroll") for (int m = 0; m < 4; ++m) { if constexpr (F8) { const i32x4 lo_ = *(const PG8_LAS i32x4*)(lds + PG8_SA(b, h) + aoff + m * 2048), hi_ = *(const PG8_LAS i32x4*)(lds + PG8_SA(b, h) + aoff + m * 2048 + 1024); \
            dst##8[m] = __builtin_shufflevector(lo_, hi_, 0, 1, 2, 3, 4, 5, 6, 7); } else { _Pragma("unroll") for (int k = 0; k < 2; ++k) dst[m][k] = *(const PG8_LAS bf16x8*)(lds + PG8_SA(b, h) + aoff + m * 2048 + k * 1024); } } } while (0)
#define PG8_LDB(dst, b, h) do { _Pragma("unroll") for (int n = 0; n < 2; ++n) { if constexpr (F8) { const i32x4 lo_ = *(const PG8_LAS i32x4*)(lds + PG8_SB(b, h) + boff + n * 2048), hi_ = *(const PG8_LAS i32x4*)(lds + PG8_SB(b, h) + boff + n * 2048 + 1024); \
            dst##8[n] = __builtin_shufflevector(lo_, hi_, 0, 1, 2, 3, 4, 5, 6, 7); } else { _Pragma("unroll") for (int k = 0; k < 2; ++k) dst[n][k] = *(const PG8_LAS bf16x8*)(lds + PG8_SB(b, h) + boff + n * 2048 + k * 1024); } } } while (0)
#define PG8_MMA(ai, bj, At, Bt) do { __builtin_amdgcn_s_setprio(1); _Pragma("unroll") for (int m = 0; m < 4; ++m) _Pragma("unroll") for (int n = 0; n < 2; ++n) { \
        if constexpr (F8) {   \
            asm volatile("v_mfma_scale_f32_16x16x128_f8f6f4 %0, %1, %2, %0, %3, %3 op_sel_hi:[0,0,0]" : "+v"(acc[ai][bj][m][n]) : "v"(Bt##8[n]), "v"(At##8[m]), "v"(f8scale)); } \
        else { _Pragma("unroll") for (int k = 0; k < 2; ++k) acc[ai][bj][m][n] = __builtin_amdgcn_mfma_f32_16x16x32_bf16(Bt[n][k], At[m][k], acc[ai][bj][m][n], 0, 0, 0); } } \
        __builtin_amdgcn_s_setprio(0); } while (0)
#define PG8_WAIT_V(n) asm volatile("s_waitcnt vmcnt(" #n ")" ::: "memory")
#define PG8_WAIT_L(n) asm volatile("s_waitcnt lgkmcnt(" #n ")" ::: "memory")
#define PG8_BAR __builtin_amdgcn_s_barrier()
#define PG8_SCHED __builtin_amdgcn_sched_barrier(0)
    float zf_ = 0.f; asm volatile("" : "+v"(zf_));
    Unit cur, nxt; int ui = 0;
    if (!S.next(0, cur)) return;
    f32x4 acc[2][2][4][2];
#pragma unroll
    for (int a = 0; a < 2; ++a)
#pragma unroll
        for (int b = 0; b < 2; ++b)
#pragma unroll
            for (int m = 0; m < 4; ++m)
#pragma unroll
                for (int n = 0; n < 2; ++n) acc[a][b][m][n] = (f32x4){zf_, zf_, zf_, zf_};
    int f8scale = 0x7F7F7F7F; asm volatile("" : "+v"(f8scale));
    bf16x8 At[4][2], B0[2][2], B1[2][2]; i32x8 At8[4], B08[2], B18[2]; (void)At; (void)B0; (void)B1; (void)At8; (void)B08; (void)B18;
    const char* cA = (const char*)g.A + (size_t)cur.pm * tstep; const char* cB = (const char*)g.Bt + (size_t)cur.pn * tstep;
    S.a_ready(cur);
    PG8_STAGE(PG8_SB(0, 0), cB, voffB); PG8_STAGE(PG8_SA(0, 0), cA, voffA); PG8_STAGE(PG8_SB(0, 1), cB + hstep, voffB); PG8_STAGE(PG8_SA(0, 1), cA + hstep, voffA);
    if (wr == 1) PG8_BAR;
    PG8_WAIT_V(4); PG8_BAR;
    PG8_STAGE(PG8_SB(1, 0), cB + kstep, voffB); PG8_STAGE(PG8_SA(1, 0), cA + kstep, voffA); PG8_STAGE(PG8_SB(1, 1), cB + hstep + kstep, voffB);
    PG8_WAIT_V(6); PG8_BAR;
    PG8_STAMP();
    for (;;) {
        const bool has_next = S.next(ui + 1, nxt);
        const char* nA = has_next ? (const char*)g.A + (size_t)nxt.pm * tstep : cA; const char* nB = has_next ? (const char*)g.Bt + (size_t)nxt.pn * tstep : cB;
        for (int t = 0; t < nt; t += 2) {
            const bool last = (t == nt - 2);
            const char* a1 = cA + (size_t)(t + 1) * kstep;
            const char* a2 = last ? nA : cA + (size_t)(t + 2) * kstep; const char* b2 = last ? nB : cB + (size_t)(t + 2) * kstep;
            const char* a3 = a2 + kstep; const char* b3 = b2 + kstep;
            if (last && has_next) S.a_ready(nxt);
            PG8_LDB(B0, 0, 0); PG8_SCHED; PG8_LDA(At, 0, 0); PG8_STAGE(PG8_SA(1, 1), a1 + hstep, voffA);
            PG8_WAIT_L(8); PG8_BAR; PG8_WAIT_L(0); PG8_MMA(0, 0, At, B0); PG8_BAR; PG8_SCHED;
            PG8_LDB(B1, 0, 1); PG8_STAGE(PG8_SB(0, 0), b2, voffB);
            PG8_BAR; PG8_WAIT_L(0); PG8_MMA(0, 1, At, B1); PG8_BAR;
            PG8_LDA(At, 0, 1); PG8_STAGE(PG8_SA(0, 0), a2, voffA);
            PG8_BAR; PG8_WAIT_L(0); PG8_MMA(1, 0, At, B0); PG8_BAR; PG8_SCHED;
            PG8_STAGE(PG8_SB(0, 1), b2 + hstep, voffB);
            PG8_WAIT_V(6); PG8_BAR; PG8_MMA(1, 1, At, B1); PG8_BAR;
            PG8_LDB(B0, 1, 0); PG8_SCHED; PG8_LDA(At, 1, 0); PG8_STAGE(PG8_SA(0, 1), a2 + hstep, voffA);
            PG8_WAIT_L(8); PG8_BAR; PG8_WAIT_L(0); PG8_MMA(0, 0, At, B0); PG8_BAR; PG8_SCHED;
            PG8_LDB(B1, 1, 1); PG8_STAGE(PG8_SB(1, 0), b3, voffB);
            PG8_BAR; PG8_WAIT_L(0); PG8_MMA(0, 1, At, B1); PG8_BAR;
            PG8_LDA(At, 1, 1); PG8_STAGE(PG8_SA(1, 0), a3, voffA);
            PG8_BAR; PG8_WAIT_L(0); PG8_MMA(1, 0, At, B0); PG8_BAR; PG8_SCHED;
            PG8_STAGE(PG8_SB(1, 1), b3 + hstep, voffB);
            PG8_WAIT_V(6); PG8_BAR; PG8_MMA(1, 1, At, B1); PG8_BAR;
        }
        PG8_STAMP();
        if constexpr (F8) { asm volatile("s_nop 15\n\ts_nop 15" ::: "memory"); }
        if constexpr (!Epi::AFTER_DRAIN) { E(acc, cur, wr, wc, fr, fq); S.done(cur); }
        PG8_STAMP();
        if (!has_next) break;
#pragma unroll
        for (int a = 0; a < 2; ++a)
#pragma unroll
            for (int b = 0; b < 2; ++b)
#pragma unroll
                for (int m = 0; m < 4; ++m)
#pragma unroll
                    for (int n = 0; n < 2; ++n) acc[a][b][m][n] = (f32x4){zf_, zf_, zf_, zf_};
        cur = nxt; cA = nA; cB = nB; ++ui;
    }
    PG8_WAIT_V(0);
    if (wr == 0) PG8_BAR;
    PG8_BAR;
    if constexpr (Epi::AFTER_DRAIN) { E.fused(acc, cur, wr, wc, fr, fq, lds, wid, lane); S.done(cur); }
    PG8_STAMP();
    if (STAMP && wid == 0) { stamps[lane] = lane < nts ? (((unsigned long long)(unsigned)ts_hi << 32) | (unsigned)ts_lo) : 0ull;
        if (lane == 62) stamps[62] = rt_entry; if (lane == 63) stamps[63] = (unsigned long long)wall_clock64(); }
#undef PG8_STAMP
#undef PG8_SA
#undef PG8_SB
#undef PG8_STAGE
#undef PG8_LDA
#undef PG8_LDB
#undef PG8_MMA
#undef PG8_WAIT_V
#undef PG8_WAIT_L
#undef PG8_BAR
#undef PG8_SCHED
}
}
#define RLX_AGENT __ATOMIC_RELAXED, __HIP_MEMORY_SCOPE_AGENT
#define XB_TMO      128
#define XB_XCNT(j)  (256  + 64 * (j))
#define XB_XSUB(j)  (1280 + 64 * (j))
#define XB_XGEN(j)  (2304 + 64 * (j))
#define XB_TOP      3328
#define XB_TOPGEN   3392
#define XCD_BAR_WORDS 3456
#define XB_SPIN_CAP (1u << 18)

__device__ __forceinline__ unsigned xb_ld(unsigned* p)              { return __hip_atomic_load(p, __ATOMIC_RELAXED, __HIP_MEMORY_SCOPE_AGENT); }
__device__ __forceinline__ unsigned xb_add(unsigned* p, unsigned v) { return __hip_atomic_fetch_add(p, v, __ATOMIC_RELAXED, __HIP_MEMORY_SCOPE_AGENT); }
__device__ __forceinline__ unsigned xb_xcc_id() { return (unsigned)__builtin_amdgcn_s_getreg((3 << 11) | 20) & 0xFu; }
#define XB_SPIN(cond, bar) do { unsigned _sp = 0; while (cond) { __builtin_amdgcn_s_sleep(1); \
    if ((++_sp & 255u) == 0u) { if (xb_ld(&(bar)[XB_TMO])) break; if (_sp > XB_SPIN_CAP) { atomicAdd(&(bar)[XB_TMO], 1u); break; } } } } while (0)

struct XcdBarrier {
    unsigned* bar; unsigned x; int wv;
    volatile LAS unsigned* st;
};

__device__ __forceinline__ XcdBarrier xcd_barrier_post(unsigned* bar, volatile LAS unsigned* st) {
    XcdBarrier b; b.bar = bar; b.x = xb_xcc_id(); b.st = st; b.wv = __builtin_amdgcn_readfirstlane((int)threadIdx.x >> 6);
    if (threadIdx.x == 0) (void)xb_add(&bar[XB_XCNT(b.x)], 1u);
    return b;
}
__device__ __forceinline__ void xcd_barrier_complete(unsigned* bar, unsigned x, unsigned& nloc, unsigned& nx) {
    const unsigned G = gridDim.x * gridDim.y * gridDim.z;
    unsigned sum, cnt, mine, sp = 0u;
    for (;;) {
        sum = 0u; cnt = 0u; mine = 0u;
#pragma unroll
        for (unsigned j = 0; j < 16; ++j) { const unsigned c = xb_ld(&bar[XB_XCNT(j)]); sum += c; cnt += (c > 0u) ? 1u : 0u; mine = (j == x) ? c : mine; }
        if (sum == G) break;
        __builtin_amdgcn_s_sleep(1);
        if ((++sp & 255u) == 0u) { if (xb_ld(&bar[XB_TMO])) break; if (sp > XB_SPIN_CAP) { atomicAdd(&bar[XB_TMO], 1u); break; } }
    }
    nloc = mine > 0u ? mine : 1u; nx = cnt > 0u ? cnt : 1u;
}

__device__ __forceinline__ void xcd_barrier(const XcdBarrier& b) {
    asm volatile("s_waitcnt vmcnt(0)" ::: "memory");
    __syncthreads();
    if (((b.wv << 6) | lane_v()) == 0) {
        unsigned* bar = b.bar;
        __builtin_amdgcn_s_waitcnt(0);
        unsigned nloc = b.st[0], nx = b.st[1];
        if (nloc == 0u) { xcd_barrier_complete(bar, b.x, nloc, nx); b.st[0] = nloc; b.st[1] = nx; }
        const unsigned old = xb_add(&bar[XB_XSUB(b.x)], 1u);
        const unsigned gen = old / nloc;
        if (old + 1u == (gen + 1u) * nloc) {
            __builtin_amdgcn_fence(__ATOMIC_RELEASE, "agent");
            asm volatile("s_waitcnt vmcnt(0)" ::: "memory");
            const unsigned og = xb_add(&bar[XB_TOP], 1u);
            const unsigned tg = og / nx;
            if (og + 1u == (tg + 1u) * nx) xb_add(&bar[XB_TOPGEN], 1u);
            else XB_SPIN(xb_ld(&bar[XB_TOPGEN]) == tg, bar);
            __builtin_amdgcn_fence(__ATOMIC_ACQUIRE, "agent");
            xb_add(&bar[XB_XGEN(b.x)], 1u);
            asm volatile("s_waitcnt vmcnt(0)" ::: "memory");
        } else {
            XB_SPIN(xb_ld(&bar[XB_XGEN(b.x)]) == gen, bar);
            __builtin_amdgcn_fence(__ATOMIC_ACQUIRE, "agent");
            asm volatile("s_waitcnt vmcnt(0)" ::: "memory");
        }
    }
    __syncthreads();
}

typedef unsigned short bf16;
using pg8::bf16x8; using pg8::f32x4; using pg8::u32x4;
typedef unsigned u32x2 __attribute__((ext_vector_type(2)));
constexpr int NT = 512, NW = 8;
constexpr int DM = 2048, NB = 8, SEQ = 2048, CTXL = 256;
constexpr int MLAT = NB * SEQ, MCTX = NB * CTXL, MTOT = MLAT + MCTX;
constexpr int NIN = 5920, NINP = 6144;
constexpr int C_RW_R = 0, C_RW_K = 512, C_RW_V = 1024, C_RW_XW = 1536;
constexpr int C_MB_Z = 1792, C_MB_XBC = 2816, C_MB_DT = 4352;
constexpr int C_DA_Q = 4384, C_DA_V = 5408;
constexpr int FF = 5632, FE = 7168, NE = 8;
constexpr int MOE_ROWS = 34816;
constexpr int LDS_STAGE = 131072, LDS_MISC = 1024, LDS_BYTES = LDS_STAGE + LDS_MISC;

#ifndef MOE_FP8
#define MOE_FP8 1
#endif
#ifndef DENSE_GU8
#define DENSE_GU8 1
#endif
#ifndef DENSE_D8
#define DENSE_D8 0
#endif
constexpr float MOE_SGU = 32.0f, MOE_SD = 64.0f, MOE_SH = 4.0f;
constexpr size_t MiB = 1048576;
constexpr size_t WS_CTL   = 0;
constexpr size_t CTL_BYTES = 65536;
constexpr size_t CW_BAR = 0, CW_CNT = 4096  , CW_Q = 8192  , CW_BG = 8704  , CW_DONE = 9216  ;
constexpr size_t WS_ADA   = 1 * MiB;
constexpr size_t WS_ROPE  = 2 * MiB;
constexpr size_t WS_TOK   = 3 * MiB;
constexpr size_t WS_WIN   = 4 * MiB;
constexpr size_t WS_WOUT  = WS_WIN  + 48 * MiB;
constexpr size_t WS_WSM   = WS_WOUT + 16 * MiB;
constexpr size_t WS_WGU   = WS_WSM  + 2 * MiB;
constexpr size_t WS_WD    = WS_WGU  + 44 * MiB;
constexpr size_t WS_MGU   = WS_WD   + 22 * MiB;
constexpr size_t WS_MD    = WS_MGU  + 448 * MiB;
constexpr size_t WS_XC    = WS_MD   + 224 * MiB;
constexpr size_t WS_HA    = WS_XC   + 16 * MiB;
constexpr size_t WS_U     = WS_HA   + 72 * MiB;
constexpr size_t WS_MIX   = WS_U    + 216 * MiB;
constexpr size_t WS_BIG   = WS_MIX  + 144 * MiB;
constexpr size_t WS_XSB   = WS_BIG  + 476 * MiB;
constexpr size_t WS_END   = WS_XSB  + 64 * MiB;
constexpr size_t WS_ASM   = WS_BIG;
constexpr size_t WS_XBC   = WS_ASM  + 9 * MiB;
constexpr size_t WS_DT    = WS_XBC  + 54 * MiB;
constexpr size_t WS_QK    = WS_DT   + 5 * MiB;
constexpr size_t WS_RW5   = WS_QK   + 36 * MiB;
constexpr size_t WS_YR    = WS_RW5  + 90 * MiB;
constexpr size_t WS_YM    = WS_YR   + 72 * MiB;
constexpr size_t WS_ST    = WS_YM   + 72 * MiB;
constexpr size_t WS_AC    = WS_ST   + 72 * MiB;
static_assert(WS_AC + 1 * MiB <= WS_END, "mixer intermediates overflow BIG");
static_assert((size_t)MOE_ROWS * FE * 2 <= 476 * MiB && (size_t)MOE_ROWS * DM * 2 <= 144 * MiB, "moe buffers");

struct Args { const float* in[38]; float* out; unsigned char* ws; int ph_lo, ph_hi, sub, pad; };
struct Ctx { unsigned char* ws; int wv; int sub; };

constexpr int LDS_PTRS = LDS_STAGE + 128;
__device__ __forceinline__ const float* ldin(int k) {
    extern __shared__ __attribute__((aligned(16))) unsigned char lds_dyn[];
    const int base = opqs((int)(unsigned)(unsigned long long)(LAS unsigned char*)lds_dyn);
    const LAS unsigned* p = (const LAS unsigned*)(unsigned long long)(unsigned)(base + LDS_PTRS + 8 * k);
    const unsigned lo = __builtin_amdgcn_readfirstlane(p[0]), hi = __builtin_amdgcn_readfirstlane(p[1]);
    return (const float*)(const GAS float*)(((unsigned long long)hi << 32) | (unsigned long long)lo);
}
__device__ __forceinline__ float bf2f(unsigned short b) { return __uint_as_float(((unsigned)b) << 16); }
typedef float f32x2_t __attribute__((ext_vector_type(2)));
typedef __bf16 bf16x2_t __attribute__((ext_vector_type(2)));
__device__ __forceinline__ unsigned pk2(float lo, float hi) { const f32x2_t v = {lo, hi}; return __builtin_bit_cast(unsigned, __builtin_convertvector(v, bf16x2_t)); }
__device__ __forceinline__ unsigned f2bf(float f) { return pk2(f, f) & 0xffffu; }
__device__ __forceinline__ void unpack8(const uint4 w, float (&f)[8]) {
    f[0] = __uint_as_float(w.x << 16); f[1] = __uint_as_float(w.x & 0xffff0000u); f[2] = __uint_as_float(w.y << 16); f[3] = __uint_as_float(w.y & 0xffff0000u);
    f[4] = __uint_as_float(w.z << 16); f[5] = __uint_as_float(w.z & 0xffff0000u); f[6] = __uint_as_float(w.w << 16); f[7] = __uint_as_float(w.w & 0xffff0000u); }
__device__ __forceinline__ uint4 pack8(const float (&f)[8]) { uint4 w; w.x = pk2(f[0], f[1]); w.y = pk2(f[2], f[3]); w.z = pk2(f[4], f[5]); w.w = pk2(f[6], f[7]); return w; }
__device__ __forceinline__ void unpack4(const uint2 w, float (&f)[4]) {
    f[0] = __uint_as_float(w.x << 16); f[1] = __uint_as_float(w.x & 0xffff0000u); f[2] = __uint_as_float(w.y << 16); f[3] = __uint_as_float(w.y & 0xffff0000u); }
template <int CTRL> __device__ __forceinline__ float dppf(float v) { return __int_as_float(__builtin_amdgcn_update_dpp(0, __float_as_int(v), CTRL, 0xf, 0xf, false)); }
__device__ __forceinline__ float red8(float v)  { v += dppf<0xB1>(v); v += dppf<0x4E>(v); v += dppf<0x141>(v); return v; }
__device__ __forceinline__ float red16(float v) { v += dppf<0xB1>(v); v += dppf<0x4E>(v); v += dppf<0x141>(v); v += dppf<0x140>(v); return v; }
__device__ __forceinline__ float swz16(float v) { return __int_as_float(__builtin_amdgcn_ds_swizzle(__float_as_int(v), 0x401F)); }
__device__ __forceinline__ float red32(float v) { v = red16(v); v += swz16(v); return v; }
__device__ __forceinline__ float wsum(float v) { v = red32(v); return __int_as_float(__builtin_amdgcn_readlane(__float_as_int(v), 0)) + __int_as_float(__builtin_amdgcn_readlane(__float_as_int(v), 32)); }
__device__ __forceinline__ float shx32(float v, int lane) { return __int_as_float(__builtin_amdgcn_ds_bpermute((lane ^ 32) << 2, __float_as_int(v))); }
__device__ __forceinline__ float fsilu(float x) { return pg8::fsilu(x); }
__device__ __forceinline__ float fsigm(float x) { return pg8::fsigm(x); }
__device__ __forceinline__ float softplusf(float x) { return fmaxf(x, 0.f) + log1pf(__expf(-fabsf(x))); }


template <bool F8>
__device__ __forceinline__ void cvt_job_t(const float* __restrict__ src, int ld, int ncols_valid, int ncols_total, void* __restrict__ dstv, int K, int mode, float scale, LAS float* tile, int bid, int G, const int tid, int t_end = 0x7fffffff) {
    const int ntn = ncols_total >> 6, ntk = K >> 7; const int nt = (ntn * ntk) < t_end ? (ntn * ntk) : t_end;
    const int lk = tid >> 4, lc = (tid & 15) * 4;
    constexpr int TP = 65;
    float4 r[4]; int buf = 0;
    const float4 z4 = make_float4(0.f, 0.f, 0.f, 0.f);
#define CVT_LOAD(t_, dst_) do { const int tn_ = (t_) % ntn, tk_ = (t_) / ntn; const int n_ = tn_ * 64 + lc; const float* p_ = src + (size_t)(tk_ * 128 + lk) * ld + n_; \
        _Pragma("unroll") for (int i_ = 0; i_ < 4; ++i_) dst_[i_] = (n_ < ncols_valid) ? *(const float4*)(p_ + (size_t)(32 * i_) * ld) : z4; } while (0)
    int t = bid;
    if (t < nt) CVT_LOAD(t, r);
    __syncthreads();
    for (; t < nt; t += G) {
        float4 nx[4] = {z4, z4, z4, z4};
        if (t + G < nt) CVT_LOAD(t + G, nx);
        LAS float* tl = tile + buf * (128 * TP);
#pragma unroll
        for (int i = 0; i < 4; ++i) { LAS float* q = tl + (lk + 32 * i) * TP + lc; q[0] = r[i].x; q[1] = r[i].y; q[2] = r[i].z; q[3] = r[i].w; }
        __syncthreads();
        const int tn = t % ntn, tk = t / ntn, k0 = tk * 128, nb = tn * 64;
        const int kq = tid & 7, nl = tid >> 3, nn = nb + nl;
        const int drow = mode == 0 ? nn : ((nn >> 7) * 256 + (nn & 127) + (mode == 2 ? 128 : 0));
        const LAS float* c = tl + (kq * 16) * TP + nl;
        if (F8) {
            uint4 w;
            w.x = pg8::pk_fp8x4(c[0 * TP] * scale, c[1 * TP] * scale, c[2 * TP] * scale, c[3 * TP] * scale); w.y = pg8::pk_fp8x4(c[4 * TP] * scale, c[5 * TP] * scale, c[6 * TP] * scale, c[7 * TP] * scale);
            w.z = pg8::pk_fp8x4(c[8 * TP] * scale, c[9 * TP] * scale, c[10 * TP] * scale, c[11 * TP] * scale); w.w = pg8::pk_fp8x4(c[12 * TP] * scale, c[13 * TP] * scale, c[14 * TP] * scale, c[15 * TP] * scale);
            *(uint4*)((unsigned char*)dstv + (size_t)drow * K + k0 + kq * 16) = w;
        } else {
            uint4 w0, w1;
            w0.x = pk2(c[0 * TP], c[1 * TP]); w0.y = pk2(c[2 * TP], c[3 * TP]); w0.z = pk2(c[4 * TP], c[5 * TP]); w0.w = pk2(c[6 * TP], c[7 * TP]);
            w1.x = pk2(c[8 * TP], c[9 * TP]); w1.y = pk2(c[10 * TP], c[11 * TP]); w1.z = pk2(c[12 * TP], c[13 * TP]); w1.w = pk2(c[14 * TP], c[15 * TP]);
            uint4* q = (uint4*)((bf16*)dstv + (size_t)drow * K + k0 + kq * 16); q[0] = w0; q[1] = w1;
        }
#pragma unroll
        for (int i = 0; i < 4; ++i) r[i] = nx[i];
        buf ^= 1;
    }
#undef CVT_LOAD
}
__device__ __forceinline__ void cvt_job_f8(const float* __restrict__ src, int ld, int ncols, unsigned char* __restrict__ dst, int K, int mode, float scale, LAS unsigned char* tile, int t_begin, int t_end, const int tid) {
    const int ntn = ncols >> 6;
    const int q = tid >> 4, i4 = tid & 15;
    constexpr int TP = 144;
    float4 r[4]; int buf = 0;
#define CVT8_LOAD(t_, dst_) do { const int tn_ = (t_) % ntn, tk_ = (t_) / ntn; const float* p_ = src + (size_t)(tk_ * 128 + 4 * q) * ld + tn_ * 64 + 4 * i4; \
        _Pragma("unroll") for (int j_ = 0; j_ < 4; ++j_) dst_[j_] = *(const float4*)(p_ + (size_t)j_ * ld); } while (0)
    int t = t_begin;
    if (t < t_end) CVT8_LOAD(t, r);
    __syncthreads();
    for (; t < t_end; ++t) {
        float4 nx[4];
#pragma unroll
        for (int j = 0; j < 4; ++j) nx[j] = r[j];
        if (t + 1 < t_end) CVT8_LOAD(t + 1, nx);
        unsigned w[4];
#pragma unroll
        for (int j = 0; j < 4; ++j) w[j] = pg8::pk_fp8x4(r[j].x * scale, r[j].y * scale, r[j].z * scale, r[j].w * scale);
        const unsigned a_lo = __builtin_amdgcn_perm(w[1], w[0], 0x05010400u), a_hi = __builtin_amdgcn_perm(w[1], w[0], 0x07030602u);
        const unsigned b_lo = __builtin_amdgcn_perm(w[3], w[2], 0x05010400u), b_hi = __builtin_amdgcn_perm(w[3], w[2], 0x07030602u);
        unsigned o[4];
        o[0] = __builtin_amdgcn_perm(b_lo, a_lo, 0x05040100u); o[1] = __builtin_amdgcn_perm(b_lo, a_lo, 0x07060302u);
        o[2] = __builtin_amdgcn_perm(b_hi, a_hi, 0x05040100u); o[3] = __builtin_amdgcn_perm(b_hi, a_hi, 0x07060302u);
        LAS unsigned char* tl = tile + buf * (64 * TP);
        const int cw = ((q >> 2) ^ (i4 & 7)) * 16 + (q & 3) * 4;
#pragma unroll
        for (int m = 0; m < 4; ++m) *(LAS unsigned*)(tl + (4 * i4 + m) * TP + cw) = o[m];
        __syncthreads();
        const int tn = t % ntn, tk = t / ntn, k0 = tk * 128, nb = tn * 64;
        const int kq = tid & 7, nl = tid >> 3, nn = nb + nl;
        const int drow = mode == 0 ? nn : ((nn >> 7) * 256 + (nn & 127) + (mode == 2 ? 128 : 0));
        const u32x4 v = *(const LAS u32x4*)(tl + nl * TP + ((kq ^ ((nl >> 2) & 7)) * 16));
        *(uint4*)(dst + (size_t)drow * K + k0 + kq * 16) = make_uint4(v.x, v.y, v.z, v.w);
#pragma unroll
        for (int j = 0; j < 4; ++j) r[j] = nx[j];
        buf ^= 1;
    }
#undef CVT8_LOAD
}
template <int NTB, int D>
__device__ __forceinline__ void cvt_job_f8d(const float* __restrict__ src, int ld, int ncols, unsigned char* __restrict__ dst, int K, int mode, float scale, LAS unsigned char* tile, int t_begin, const int tid) {
    const int ntn = ncols >> 6;
    const int q = tid >> 4, i4 = tid & 15;
    constexpr int TP = 144;
    float4 r[D][4];
#define CVT8_LOAD(t_, dst_) do { const int tn_ = (t_) % ntn, tk_ = (t_) / ntn; const float* p_ = src + (size_t)(tk_ * 128 + 4 * q) * ld + tn_ * 64 + 4 * i4; \
        _Pragma("unroll") for (int j_ = 0; j_ < 4; ++j_) dst_[j_] = *(const float4*)(p_ + (size_t)j_ * ld); } while (0)
#pragma unroll
    for (int d = 0; d < D; ++d) CVT8_LOAD(t_begin + d, r[d]);
    __syncthreads();
#pragma unroll
    for (int i = 0; i < NTB; ++i) {
        const int t = t_begin + i;
        unsigned w[4];
#pragma unroll
        for (int j = 0; j < 4; ++j) w[j] = pg8::pk_fp8x4(r[i % D][j].x * scale, r[i % D][j].y * scale, r[i % D][j].z * scale, r[i % D][j].w * scale);
        if (i + D < NTB) CVT8_LOAD(t + D, r[i % D]);
        const unsigned a_lo = __builtin_amdgcn_perm(w[1], w[0], 0x05010400u), a_hi = __builtin_amdgcn_perm(w[1], w[0], 0x07030602u);
        const unsigned b_lo = __builtin_amdgcn_perm(w[3], w[2], 0x05010400u), b_hi = __builtin_amdgcn_perm(w[3], w[2], 0x07030602u);
        unsigned o[4];
        o[0] = __builtin_amdgcn_perm(b_lo, a_lo, 0x05040100u); o[1] = __builtin_amdgcn_perm(b_lo, a_lo, 0x07060302u);
        o[2] = __builtin_amdgcn_perm(b_hi, a_hi, 0x05040100u); o[3] = __builtin_amdgcn_perm(b_hi, a_hi, 0x07060302u);
        LAS unsigned char* tl = tile + (i & 1) * (64 * TP);
        const int cw = ((q >> 2) ^ (i4 & 7)) * 16 + (q & 3) * 4;
#pragma unroll
        for (int m = 0; m < 4; ++m) *(LAS unsigned*)(tl + (4 * i4 + m) * TP + cw) = o[m];
        __syncthreads();
        const int tn = t % ntn, tk = t / ntn, k0 = tk * 128, nb = tn * 64;
        const int kq = tid & 7, nl = tid >> 3, nn = nb + nl;
        const int drow = mode == 0 ? nn : ((nn >> 7) * 256 + (nn & 127) + (mode == 2 ? 128 : 0));
        const u32x4 v = *(const LAS u32x4*)(tl + nl * TP + ((kq ^ ((nl >> 2) & 7)) * 16));
        *(uint4*)(dst + (size_t)drow * K + k0 + kq * 16) = make_uint4(v.x, v.y, v.z, v.w);
    }
#undef CVT8_LOAD
}
__device__ __forceinline__ void cvt_job8(const float* src, int ld, int ncols, unsigned char* dst, int K, int mode, float scale, LAS float* tile, int bid, int G, const int tid) { cvt_job_t<true>(src, ld, ncols, ncols, dst, K, mode, scale, tile, bid, G, tid); }
__device__ __forceinline__ void cvt_job(const float* src, int ld, int ncols_valid, int ncols_total, bf16* dst, int K, int mode, LAS float* tile, int bid, int G, const int tid) { cvt_job_t<false>(src, ld, ncols_valid, ncols_total, dst, K, mode, 1.0f, tile, bid, G, tid); }

__device__ __forceinline__ void p0_prologue(const Ctx& a, LAS unsigned char* lds, int bid, int G) {
    unsigned char* ws = opqp(a.ws); const int tid = ((a.wv << 6) | lane_v());
    LAS float* tile = (LAS float*)lds;
    for (int l = 0; l < 2; ++l) {
        cvt_job(ldin(10) + (size_t)l * DM * NIN, NIN, NIN, NINP, (bf16*)(ws + WS_WIN) + (size_t)l * NINP * DM, DM, 0, tile, bid, G, tid);
        cvt_job(ldin(11) + (size_t)l * DM * DM, DM, DM, DM, (bf16*)(ws + WS_WOUT) + (size_t)l * DM * DM, DM, 0, tile, bid, G, tid);
    }
#if DENSE_GU8
    cvt_job8(ldin(31), FF, FF, ws + WS_WGU, DM, 1, MOE_SGU, tile, bid, G, tid);
    cvt_job8(ldin(32), FF, FF, ws + WS_WGU, DM, 2, MOE_SGU, tile, bid, G, tid);
#else
    cvt_job(ldin(31), FF, FF, FF, (bf16*)(ws + WS_WGU), DM, 1, tile, bid, G, tid);
    cvt_job(ldin(32), FF, FF, FF, (bf16*)(ws + WS_WGU), DM, 2, tile, bid, G, tid);
#endif
#if DENSE_D8
    cvt_job8(ldin(33), DM, DM, ws + WS_WD, FF, 0, MOE_SD, tile, bid, G, tid);
#else
    cvt_job(ldin(33), DM, DM, DM, (bf16*)(ws + WS_WD), FF, 0, tile, bid, G, tid);
#endif
#if !MOE_FP8
    for (int e = 0; e < NE; ++e) {
        cvt_job(ldin(35) + (size_t)e * DM * FE, FE, FE, FE, (bf16*)(ws + WS_MGU) + (size_t)e * 2 * FE * DM, DM, 1, tile, bid, G, tid);
        cvt_job(ldin(36) + (size_t)e * DM * FE, FE, FE, FE, (bf16*)(ws + WS_MGU) + (size_t)e * 2 * FE * DM, DM, 2, tile, bid, G, tid);
        cvt_job(ldin(37) + (size_t)e * FE * DM, DM, DM, DM, (bf16*)(ws + WS_MD) + (size_t)e * DM * FE, FE, 0, tile, bid, G, tid);
    }
#endif
    {
        bf16* wsm = (bf16*)(ws + WS_WSM);
        for (size_t i = (size_t)bid * NT + tid; i < (size_t)2 * 2048 * 256; i += (size_t)G * NT) {
            const int l = (int)(i >> 19), n = (int)((i >> 8) & 2047), k = (int)(i & 255); float v = 0.f;
            if (n < 1024) { if (k < 64) v = ldin(14)[(((size_t)l * 2 + (n >> 9)) * 64 + k) * 512 + (n & 511)]; }
            else if (n < 1536) { if (k >= 64 && k < 128) v = ldin(16)[((size_t)l * 64 + (k - 64)) * 512 + (n - 1024)]; }
            else { if (k >= 128) v = ldin(17)[((size_t)l * 128 + (k - 128)) * 512 + (n - 1536)]; }
            wsm[i] = (bf16)f2bf(v);
        }
    }
    {
        float* rope = (float*)(ws + WS_ROPE);
        for (int i = bid * NT + tid; i < SEQ * 32; i += G * NT) {
            const int t = i >> 5, j = i & 31, half = j >> 4, f = j & 15;
            const float pos = (float)(half ? (t & 63) : (t >> 6));
            const float inv = powf(10000.0f, -(float)f / 16.0f);
            const float ang = pos * inv;
            double ad = (double)ang; const double twopi = 6.283185307179586476925; ad -= twopi * floor(ad / twopi);
            const float ar = (float)ad;
            rope[t * 64 + half * 32 + f] = cosf(ar); rope[t * 64 + half * 32 + 16 + f] = sinf(ar);
        }
    }
    {
        LAS float* sil = (LAS float*)lds;
        LAS float* red = sil + 9 * 2048;
        __syncthreads();
        for (int i = tid; i < 9 * 2048; i += NT) { const float v = i < 8 * 2048 ? ldin(1)[i] : ldin(3)[i - 8 * 2048]; sil[i] = v / (1.0f + __expf(-v)); }
        __syncthreads();
        float* ada = (float*)(ws + WS_ADA);
        for (int it = bid; it < 2 * 96; it += G) {
            const int l = it / 96, col0 = (it % 96) * 128; const int cn = tid & 127, kg = tid >> 7;
            const float* w = ldin(4) + (size_t)l * DM * 12288 + col0 + cn;
            float acc[9];
#pragma unroll
            for (int v = 0; v < 9; ++v) acc[v] = 0.f;
            for (int k = kg * 512; k < kg * 512 + 512; ++k) { const float wv = w[(size_t)k * 12288];
#pragma unroll
                for (int v = 0; v < 9; ++v) acc[v] += sil[v * 2048 + k] * wv; }
#pragma unroll
            for (int v = 0; v < 9; ++v) red[(kg * 9 + v) * 128 + cn] = acc[v];
            __syncthreads();
            if (kg == 0) {
                const float bb = ldin(5)[(size_t)l * 12288 + col0 + cn];
#pragma unroll
                for (int v = 0; v < 9; ++v) ada[((size_t)l * 9 + v) * 12288 + col0 + cn] = red[v * 128 + cn] + red[(9 + v) * 128 + cn] + red[(18 + v) * 128 + cn] + red[(27 + v) * 128 + cn] + bb;
            }
            __syncthreads();
        }
    }
}


constexpr int BG_TPJ = 1792, BG_NT = 24 * BG_TPJ, BG_B = 8, BG_D = 1;
__device__ __forceinline__ void bg_convert(const Ctx& a, LAS unsigned char* lds, unsigned* until_done, int G) {
#if MOE_FP8
    unsigned char* ws = opqp(a.ws); const int tid = ((a.wv << 6) | lane_v());
    unsigned* ctr = (unsigned*)(ws + WS_CTL) + CW_BG; volatile LAS unsigned* slot = (volatile LAS unsigned*)(lds + LDS_STAGE + 8);
    LAS float* tile = (LAS float*)lds;
    for (;;) {
        __syncthreads();
        if (tid == 0) { unsigned v = 0xffffffffu;
            if (!until_done || __hip_atomic_load(until_done, __ATOMIC_RELAXED, __HIP_MEMORY_SCOPE_AGENT) < (unsigned)G) v = __hip_atomic_fetch_add(ctr, (unsigned)BG_B, __ATOMIC_RELAXED, __HIP_MEMORY_SCOPE_AGENT);
            *slot = v; }
        __syncthreads();
        const unsigned t0 = *slot;
        if (t0 >= (unsigned)BG_NT) break;
        const int job = (int)t0 / BG_TPJ, tl = (int)t0 % BG_TPJ; const int e = job / 3, kind = job % 3;
        if (kind < 2) cvt_job_f8d<BG_B, BG_D>(ldin(35 + kind) + (size_t)e * DM * FE, FE, FE, ws + WS_MGU + (size_t)e * 2 * FE * DM, DM, 1 + kind, MOE_SGU, (LAS unsigned char*)lds, tl, tid);
        else cvt_job_f8d<BG_B, BG_D>(ldin(37) + (size_t)e * FE * DM, DM, DM, ws + WS_MD + (size_t)e * DM * FE, FE, 0, MOE_SD, (LAS unsigned char*)lds, tl, tid);
    }
    __syncthreads();
#endif
}
#ifndef BG_MASK
#define BG_MASK 0x2020u
#endif
__device__ __forceinline__ void bg_tail(const Ctx& a, LAS unsigned char* lds, int slotid, int G) {
#if MOE_FP8
    unsigned char* ws = opqp(a.ws); const int tid = ((a.wv << 6) | lane_v());
    if (!((BG_MASK >> slotid) & 1u)) return;
    unsigned* done = (unsigned*)(ws + WS_CTL) + CW_DONE + slotid * 64;
    __syncthreads();
    if (tid == 0) (void)__hip_atomic_fetch_add(done, 1u, __ATOMIC_RELAXED, __HIP_MEMORY_SCOPE_AGENT);
    bg_convert(a, lds, done, G);
#endif
}

__device__ __forceinline__ void ld_row(const float* p, int lane, float (&x)[32]) {
#pragma unroll
    for (int i = 0; i < 8; ++i) { const float4 v = *(const float4*)(p + i * 256 + lane * 4); x[i * 4] = v.x; x[i * 4 + 1] = v.y; x[i * 4 + 2] = v.z; x[i * 4 + 3] = v.w; }
}
__device__ __forceinline__ void st_row(float* p, int lane, const float (&x)[32]) {
#pragma unroll
    for (int i = 0; i < 8; ++i) *(float4*)(p + i * 256 + lane * 4) = make_float4(x[i * 4], x[i * 4 + 1], x[i * 4 + 2], x[i * 4 + 3]);
}
__device__ __forceinline__ float sumsq(const float (&x)[32]) { float s = 0.f;
#pragma unroll
    for (int i = 0; i < 32; ++i) s += x[i] * x[i];
    return wsum(s); }

template <int TMODE, int HMODE, int XIN = 0, int XOUT = 0>
__device__ __forceinline__ void thin_phase(const Ctx& a, LAS unsigned char* lds, int bid, int G, int M,
                           const float* xlat, const float* xctx, float* olat, float* octx,
                           const float* T, const float* postw, int lg, int kg,
                           const float* prew, int lm, int ksc, int ksh) {
    unsigned char* ws = opqp(a.ws); const int tid = ((a.wv << 6) | lane_v()), lane = tid & 63, wid = tid >> 6;
    const float* ada = (const float*)(ws + WS_ADA);
    bf16* HA = (bf16*)(ws + WS_HA);
    LAS float* rt = (LAS float*)lds;
    if (HMODE == 2) { __syncthreads(); for (int i = tid; i < DM * NE; i += NT) rt[i] = ldin(34)[i]; __syncthreads(); }
    for (int r = bid * NW + wid; r < M; r += G * NW) {
        const int vec = r < MLAT ? r / SEQ : 8;
        float x[32];
        if (XIN == 1 && r < MLAT) { const bf16* xb = (const bf16*)xlat + (size_t)r * DM;
#pragma unroll
            for (int i = 0; i < 8; ++i) { const uint2 p1 = *(const uint2*)(xb + i * 256 + lane * 4); float f1[4]; unpack4(p1, f1); x[i * 4] = f1[0]; x[i * 4 + 1] = f1[1]; x[i * 4 + 2] = f1[2]; x[i * 4 + 3] = f1[3]; } }
        else { const float* xs = r < MLAT ? xlat + (size_t)r * DM : xctx + (size_t)(r - MLAT) * DM; ld_row(xs, lane, x); }
        if (TMODE != 0) {
            float t[32];
            if (TMODE == 1) { const bf16* tb = (const bf16*)T + (size_t)r * DM;
#pragma unroll
                for (int i = 0; i < 8; ++i) { const uint2 p1 = *(const uint2*)(tb + i * 256 + lane * 4); float f1[4]; unpack4(p1, f1); t[i * 4] = f1[0]; t[i * 4 + 1] = f1[1]; t[i * 4 + 2] = f1[2]; t[i * 4 + 3] = f1[3]; } }
            else {
                const unsigned* tok = (const unsigned*)(ws + WS_TOK) + (size_t)r * 8;
                const float w1 = __uint_as_float(tok[4]), w2 = __uint_as_float(tok[5]); const unsigned d1 = tok[6], d2 = tok[7];
                const bf16* y1 = (const bf16*)(ws + WS_MIX) + (size_t)d1 * DM; const bf16* y2 = (const bf16*)(ws + WS_MIX) + (size_t)d2 * DM;
#pragma unroll
                for (int i = 0; i < 8; ++i) { const uint2 p1 = *(const uint2*)(y1 + i * 256 + lane * 4), p2 = *(const uint2*)(y2 + i * 256 + lane * 4);
                    float f1[4], f2[4]; unpack4(p1, f1); unpack4(p2, f2);
#pragma unroll
                    for (int j = 0; j < 4; ++j) t[i * 4 + j] = w1 * f1[j] + w2 * f2[j]; }
            }
            const float rs = rsqrtf(sumsq(t) * (1.0f / DM) + 1e-6f);
            float pw[32], gg[32]; ld_row(postw, lane, pw); ld_row(ada + ((size_t)lg * 9 + vec) * 12288 + kg * DM, lane, gg);
#pragma unroll
            for (int i = 0; i < 32; ++i) x[i] += gg[i] * (t[i] * rs * pw[i]);
            if (XOUT == 1 && r < MLAT) { bf16* xd = (bf16*)olat + (size_t)r * DM;
#pragma unroll
                for (int i = 0; i < 8; ++i) { uint2 p; p.x = pk2(x[i * 4], x[i * 4 + 1]); p.y = pk2(x[i * 4 + 2], x[i * 4 + 3]); *(uint2*)(xd + i * 256 + lane * 4) = p; } }
            else { float* xd = r < MLAT ? olat + (size_t)r * DM : octx + (size_t)(r - MLAT) * DM; st_row(xd, lane, x); }
        }
        if (HMODE != 0) {
            const float rs = rsqrtf(sumsq(x) * (1.0f / DM) + 1e-6f);
            float pw[32], sc[32], sh[32]; ld_row(prew, lane, pw);
            ld_row(ada + ((size_t)lm * 9 + vec) * 12288 + ksc * DM, lane, sc); ld_row(ada + ((size_t)lm * 9 + vec) * 12288 + ksh * DM, lane, sh);
            float h[32];
#pragma unroll
            for (int i = 0; i < 32; ++i) h[i] = x[i] * rs * pw[i] * (1.0f + sc[i]) + sh[i];
            if ((HMODE == 2 && MOE_FP8) || HMODE == 3) { unsigned char* hd8 = (unsigned char*)HA + (size_t)r * DM;
#pragma unroll
                for (int i = 0; i < 8; ++i) *(unsigned*)(hd8 + i * 256 + lane * 4) = pg8::pk_fp8x4(h[i * 4], h[i * 4 + 1], h[i * 4 + 2], h[i * 4 + 3]); }
            else { bf16* hd = HA + (size_t)r * DM;
#pragma unroll
                for (int i = 0; i < 8; ++i) { uint2 p; p.x = pk2(h[i * 4], h[i * 4 + 1]); p.y = pk2(h[i * 4 + 2], h[i * 4 + 3]); *(uint2*)(hd + i * 256 + lane * 4) = p; } }
            if (HMODE == 2) {
                float lg8[8];
#pragma unroll
                for (int e = 0; e < 8; ++e) lg8[e] = 0.f;
#pragma unroll 1
                for (int i = 0; i < 8; ++i) {
                    float hv4[4];
#pragma unroll
                    for (int j = 0; j < 4; ++j) hv4[j] = 0.f;
#pragma unroll
                    for (int ii = 0; ii < 8; ++ii) if (ii == i) { hv4[0] = h[ii * 4]; hv4[1] = h[ii * 4 + 1]; hv4[2] = h[ii * 4 + 2]; hv4[3] = h[ii * 4 + 3]; }
#pragma unroll
                    for (int j = 0; j < 4; ++j) { const int c = i * 256 + lane * 4 + j; const f32x4 r0 = *(const LAS f32x4*)(rt + c * 8), r1 = *(const LAS f32x4*)(rt + c * 8 + 4); const float hv = hv4[j];
                        lg8[0] += hv * r0[0]; lg8[1] += hv * r0[1]; lg8[2] += hv * r0[2]; lg8[3] += hv * r0[3]; lg8[4] += hv * r1[0]; lg8[5] += hv * r1[1]; lg8[6] += hv * r1[2]; lg8[7] += hv * r1[3]; }
                }
#pragma unroll
                for (int e = 0; e < 8; ++e) lg8[e] = wsum(lg8[e]);
                if (lane == 0) {
                    int e1 = 0; float v1 = lg8[0];
#pragma unroll
                    for (int e = 1; e < 8; ++e) if (lg8[e] > v1) { v1 = lg8[e]; e1 = e; }
                    int e2 = -1; float v2 = -3.0e38f;
#pragma unroll
                    for (int e = 0; e < 8; ++e) if (e != e1 && lg8[e] > v2) { v2 = lg8[e]; e2 = e; }
                    const float ex = __expf(v2 - v1); const float w1 = 1.0f / (1.0f + ex), w2 = ex / (1.0f + ex);
                    unsigned* cnt = (unsigned*)(ws + WS_CTL) + CW_CNT;
                    const unsigned p1 = atomicAdd(cnt + e1 * 64, 1u), p2 = atomicAdd(cnt + e2 * 64, 1u);
                    unsigned* tok = (unsigned*)(ws + WS_TOK) + (size_t)r * 8;
                    tok[0] = (unsigned)e1; tok[1] = (unsigned)e2; tok[2] = p1; tok[3] = p2; tok[4] = __float_as_uint(w1); tok[5] = __float_as_uint(w2);
                }
            }
        }
    }
}

__device__ __forceinline__ void moe_gather(const Ctx& a, int bid, int G) {
    unsigned char* ws = opqp(a.ws); const int tid = ((a.wv << 6) | lane_v()), lane = tid & 63, wid = tid >> 6;
    const unsigned* cnt = (const unsigned*)(ws + WS_CTL) + CW_CNT;
    const bf16* HA = (const bf16*)(ws + WS_HA); bf16* AG = (bf16*)(ws + WS_U);
    for (int r = bid * NW + wid; r < MLAT; r += G * NW) {
        unsigned* tok = (unsigned*)(ws + WS_TOK) + (size_t)r * 8;
        const int e1 = (int)tok[0], e2 = (int)tok[1]; const unsigned p1 = tok[2], p2 = tok[3];
        unsigned run = 0, s1 = 0, s2 = 0;
#pragma unroll
        for (int e = 0; e < 8; ++e) { const unsigned t = (cnt[e * 64] + 255u) >> 8; if (e == e1) s1 = run; if (e == e2) s2 = run; run += t; }
        const unsigned d1 = s1 * 256u + p1, d2 = s2 * 256u + p2;
#if MOE_FP8
        const uint4* src = (const uint4*)((const unsigned char*)HA + (size_t)r * DM); uint4* q1 = (uint4*)((unsigned char*)AG + (size_t)d1 * DM); uint4* q2 = (uint4*)((unsigned char*)AG + (size_t)d2 * DM);
#pragma unroll
        for (int i = 0; i < 2; ++i) { const uint4 v = src[i * 64 + lane]; q1[i * 64 + lane] = v; q2[i * 64 + lane] = v; }
#else
        const uint4* src = (const uint4*)(HA + (size_t)r * DM); uint4* q1 = (uint4*)(AG + (size_t)d1 * DM); uint4* q2 = (uint4*)(AG + (size_t)d2 * DM);
#pragma unroll
        for (int i = 0; i < 4; ++i) { const uint4 v = src[i * 64 + lane]; q1[i * 64 + lane] = v; q2[i * 64 + lane] = v; }
#endif
        if (lane == 0) { tok[6] = d1; tok[7] = d2; }
    }
    unsigned zq = 0u; asm volatile("" : "+v"(zq));
    unsigned run = 0;
    for (int e = 0; e < 8; ++e) { const unsigned c = cnt[e * 64], t = (c + 255u) >> 8; const unsigned lo = run * 256u + c, hi = (run + t) * 256u; run += t;
        for (unsigned r = lo + bid * NW + wid; r < hi; r += G * NW) { uint4* q = (uint4*)((unsigned char*)AG + (size_t)r * DM * (MOE_FP8 ? 1 : 2));
#pragma unroll
            for (int i = 0; i < (MOE_FP8 ? 2 : 4); ++i) q[i * 64 + lane] = make_uint4(zq, zq, zq, zq); } }
}


__device__ __forceinline__ uint4 ldg16(const bf16* p) { return *(const uint4*)p; }
__device__ __forceinline__ uint4 zero16() { return make_uint4(0u, 0u, 0u, 0u); }

__device__ __forceinline__ void feat_a(const Ctx& a, int l, int bid, int G) {
    unsigned char* ws = opqp(a.ws); const int tid = ((a.wv << 6) | lane_v()), lane = tid & 63, wid = tid >> 6;
    const bf16* U = (const bf16*)(ws + WS_U); bf16* ASM = (bf16*)(ws + WS_ASM); bf16* XBC = (bf16*)(ws + WS_XBC); bf16* QK = (bf16*)(ws + WS_QK);
    float* DT = (float*)(ws + WS_DT); const float* rope = (const float*)(ws + WS_ROPE);
    const float* mu = ldin(12) + (size_t)l * 2 * 1792; const float* cw = ldin(23) + (size_t)l * 3 * 1536; const float* cb = ldin(24) + (size_t)l * 1536;
    const float* dtb = ldin(25) + l * 32; const float* alog = ldin(26) + l * 32;
    for (int r = bid * NW + wid; r < MTOT; r += G * NW) {
        const bool lat = r < MLAT; const int t = lat ? (r & (SEQ - 1)) : ((r - MLAT) & (CTXL - 1)); const int L = lat ? SEQ : CTXL;
        const bool hp = t > 0, hn = t < L - 1;
        const bf16* up = U + (size_t)r * NINP;
        if (lane < 32) {
            const int c = C_RW_XW + lane * 8; float u[8], p[8], n[8], o[8];
            unpack8(ldg16(up + c), u); unpack8(hp ? ldg16(up - NINP + c) : zero16(), p); unpack8(hn ? ldg16(up + NINP + c) : zero16(), n);
#pragma unroll
            for (int e = 0; e < 8; ++e) { const float s = u[e] + mu[c + e] * (p[e] - u[e]) + mu[1792 + c + e] * (n[e] - u[e]); const int k = lane * 8 + e;
                o[e] = k < 64 ? (1.0f - 2.0f / (__expf(2.0f * s) + 1.0f)) : (k < 128 ? s : fsigm(s)); }
            *(uint4*)(ASM + (size_t)r * 256 + lane * 8) = pack8(o);
        }
#pragma unroll
        for (int it = 0; it < 3; ++it) {
            const int cc = (it * 64 + lane) * 8, c = C_MB_XBC + cc; float u[8], p[8], n[8], o[8];
            unpack8(ldg16(up + c), u); unpack8(hp ? ldg16(up - NINP + c) : zero16(), p); unpack8(hn ? ldg16(up + NINP + c) : zero16(), n);
#pragma unroll
            for (int e = 0; e < 8; ++e) o[e] = fsilu(cw[cc + e] * p[e] + cw[1536 + cc + e] * u[e] + cw[3072 + cc + e] * n[e] + cb[cc + e]);
            *(uint4*)(XBC + (size_t)r * 1536 + cc) = pack8(o);
        }
        if (lane < 32) {
            const float raw = bf2f(up[C_MB_DT + lane]); const float dtv = softplusf(raw + dtb[lane]); const float A = -__expf(alog[lane]);
            DT[(size_t)r * 64 + lane] = dtv; DT[(size_t)r * 64 + 32 + lane] = dtv * A;
        }
        {
            const int blk = lane >> 1, sub = lane & 1, c1 = C_DA_Q + blk * 32 + sub * 8; float u1[8], u2[8], o1[8], o2[8];
            unpack8(ldg16(up + c1), u1); unpack8(ldg16(up + c1 + 16), u2);
            const int half = blk & 1; const float scale = blk < 16 ? 0.125f * 1.44269504f : 1.0f;
#pragma unroll
            for (int e = 0; e < 8; ++e) {
                float cs = 1.0f, sn = 0.0f;
                if (lat) { cs = rope[t * 64 + half * 32 + sub * 8 + e]; sn = rope[t * 64 + half * 32 + 16 + sub * 8 + e]; }
                o1[e] = (u1[e] * cs - u2[e] * sn) * scale; o2[e] = (u2[e] * cs + u1[e] * sn) * scale; }
            *(uint4*)(QK + (size_t)r * 1024 + blk * 32 + sub * 8) = pack8(o1); *(uint4*)(QK + (size_t)r * 1024 + blk * 32 + 16 + sub * 8) = pack8(o2);
        }
    }
}

__device__ __forceinline__ void feat_b(const Ctx& a, int l, int bid, int G) {
    unsigned char* ws = opqp(a.ws); const int tid = ((a.wv << 6) | lane_v()), lane = tid & 63, wid = tid >> 6;
    const bf16* U = (const bf16*)(ws + WS_U); const float* F = (const float*)(ws + WS_MIX); bf16* R5 = (bf16*)(ws + WS_RW5);
    const float* mu = ldin(12) + (size_t)l * 2 * 1792; const float* k_k = ldin(18) + l * 512; const float* k_a = ldin(19) + l * 512; const float* a0 = ldin(15) + l * 512;
    for (int r = bid * NW + wid; r < MTOT; r += G * NW) {
        const bool lat = r < MLAT; const int t = lat ? (r & (SEQ - 1)) : ((r - MLAT) & (CTXL - 1)); const int L = lat ? SEQ : CTXL;
        const bool hp = t > 0, hn = t < L - 1;
        const bf16* up = U + (size_t)r * NINP; const int c = lane * 8;
        float s[3][8];
#pragma unroll
        for (int q = 0; q < 3; ++q) { const int col = q * 512 + c; float u[8], p[8], n[8];
            unpack8(ldg16(up + col), u); unpack8(hp ? ldg16(up - NINP + col) : zero16(), p); unpack8(hn ? ldg16(up + NINP + col) : zero16(), n);
#pragma unroll
            for (int e = 0; e < 8; ++e) s[q][e] = u[e] + mu[col + e] * (p[e] - u[e]) + mu[1792 + col + e] * (n[e] - u[e]); }
        float av[8]; { const float4 q0 = *(const float4*)(F + (size_t)r * 2048 + 1024 + c), a1 = *(const float4*)(F + (size_t)r * 2048 + 1024 + c + 4);
            av[0] = q0.x; av[1] = q0.y; av[2] = q0.z; av[3] = q0.w; av[4] = a1.x; av[5] = a1.y; av[6] = a1.z; av[7] = a1.w; }
#pragma unroll
        for (int e = 0; e < 8; ++e) av[e] = fsigm(av[e] + a0[c + e]);
        float kkv[8], k2[8], bv[8]; float ss = 0.f;
#pragma unroll
        for (int e = 0; e < 8; ++e) { kkv[e] = s[1][e] * k_k[c + e]; ss += kkv[e] * kkv[e]; }
        ss = red8(ss); const float inv = 1.0f / fmaxf(sqrtf(ss), 1e-12f);
#pragma unroll
        for (int e = 0; e < 8; ++e) { kkv[e] *= inv; k2[e] = s[1][e] * (1.0f + (av[e] - 1.0f) * k_a[c + e]); bv[e] = kkv[e] * av[e]; }
        const size_t o = (size_t)r * 512 + c, st = (size_t)MTOT * 512;
        *(uint4*)(R5 + o) = pack8(s[0]); *(uint4*)(R5 + st + o) = pack8(k2); *(uint4*)(R5 + 2 * st + o) = pack8(s[2]); *(uint4*)(R5 + 3 * st + o) = pack8(kkv); *(uint4*)(R5 + 4 * st + o) = pack8(bv);
    }
}

__device__ __forceinline__ void mix_out(const Ctx& a, int l, int M, int bid, int G) {
    unsigned char* ws = opqp(a.ws); const int tid = ((a.wv << 6) | lane_v()), lane = tid & 63, wid = tid >> 6;
    const bf16* U = (const bf16*)(ws + WS_U); const float* F = (const float*)(ws + WS_MIX); const bf16* R5 = (const bf16*)(ws + WS_RW5); const bf16* XBC = (const bf16*)(ws + WS_XBC);
    const bf16* YR = (const bf16*)(ws + WS_YR); const bf16* YM = (const bf16*)(ws + WS_YM); bf16* A2 = (bf16*)(ws + WS_HA);
    const float* r_k = ldin(20) + l * 512; const float* ln_w = ldin(21) + l * 512; const float* ln_b = ldin(22) + l * 512;
    const float* Dsk = ldin(27) + l * 16; const float* nw = ldin(28) + l * 1024;
    for (int r = bid * NW + wid; r < M; r += G * NW) {
        {
            const int c = lane * 8; const size_t o = (size_t)r * 512 + c, st = (size_t)MTOT * 512;
            float y[8];
            { float yf[8], yb[8]; unpack8(ldg16(YR + o), yf); unpack8(ldg16(YR + st + o), yb);
#pragma unroll
              for (int e = 0; e < 8; ++e) y[e] = yf[e] + yb[e]; }
            float sm = 0.f;
#pragma unroll
            for (int e = 0; e < 8; ++e) sm += y[e];
            const float mean = red8(sm) * (1.0f / 64.0f); float sv = 0.f;
#pragma unroll
            for (int e = 0; e < 8; ++e) { y[e] -= mean; sv += y[e] * y[e]; }
            const float rs = rsqrtf(red8(sv) * (1.0f / 64.0f) + 64e-5f);
            float rr[8], kk[8], vv[8]; unpack8(ldg16(R5 + o), rr); unpack8(ldg16(R5 + st + o), kk); unpack8(ldg16(R5 + 2 * st + o), vv);
            float dot = 0.f;
#pragma unroll
            for (int e = 0; e < 8; ++e) dot += rr[e] * kk[e] * r_k[c + e];
            dot = red8(dot);
            const float4 g0 = *(const float4*)(F + (size_t)r * 2048 + 1536 + c), g1 = *(const float4*)(F + (size_t)r * 2048 + 1536 + c + 4);
            const float g[8] = {g0.x, g0.y, g0.z, g0.w, g1.x, g1.y, g1.z, g1.w}; float ov[8];
#pragma unroll
            for (int e = 0; e < 8; ++e) ov[e] = (y[e] * rs * ln_w[c + e] + ln_b[c + e] + dot * vv[e]) * g[e];
            *(uint4*)(A2 + (size_t)r * DM + c) = pack8(ov);
        }
        {
            const int m0 = lane * 16, hh = m0 >> 6; const float dsk = Dsk[hh]; float y[16]; float ss = 0.f;
#pragma unroll
            for (int q = 0; q < 2; ++q) { const int m = m0 + q * 8; const size_t o = (size_t)r * 1024 + m;
                float ys[8]; unpack8(ldg16(YM + o), ys);
                float xs[8], z[8]; unpack8(ldg16(XBC + (size_t)r * 1536 + m), xs); unpack8(ldg16(U + (size_t)r * NINP + C_MB_Z + m), z);
#pragma unroll
                for (int e = 0; e < 8; ++e) { const float v = (ys[e] + dsk * xs[e]) * fsilu(z[e]); y[q * 8 + e] = v; ss += v * v; } }
            ss = red32(ss);
            const float rs = rsqrtf(ss * (1.0f / 512.0f) + 1e-5f);
#pragma unroll
            for (int q = 0; q < 2; ++q) { const int m = m0 + q * 8; float ov[8];
#pragma unroll
                for (int e = 0; e < 8; ++e) ov[e] = y[q * 8 + e] * rs * nw[m + e];
                *(uint4*)(A2 + (size_t)r * DM + 512 + m) = pack8(ov); }
        }
    }
}

__device__ __forceinline__ int chain_row(int s, int b, int dir) {
    if (s < CTXL) return MLAT + b * CTXL + (dir ? (CTXL - 1 - s) : s);
    const int t = s - CTXL; return b * SEQ + (dir ? (SEQ - 1 - t) : t);
}
constexpr int CH_STEPS = CTXL + SEQ, CH_T = 32, CH_NC = CH_STEPS / CH_T;


typedef short s16x4 __attribute__((ext_vector_type(4)));
constexpr int MB_NCH = 18;
__device__ __forceinline__ int mb_row0(int b, int cc) { return cc < 2 ? MLAT + b * CTXL + cc * 128 : b * SEQ + (cc - 2) * 128; }
__device__ __forceinline__ bf16x8 trfrag(const LAS bf16* pA, const LAS bf16* pB) {
    const s16x4 v0 = __builtin_amdgcn_ds_read_tr16_b64_v4i16((LAS s16x4*)pA), v1 = __builtin_amdgcn_ds_read_tr16_b64_v4i16((LAS s16x4*)pB);
    return __builtin_shufflevector(v0, v1, 0, 1, 2, 3, 4, 5, 6, 7);
}
constexpr int MB_PB = 144, MB_PX = 72;
constexpr int MB_OFF_C = 0, MB_OFF_B = 36864, MB_OFF_X = 73728  , MB_OFF_V = 110592  ;

__device__ __forceinline__ void mb_vectors(const float* DT, int row0, int g, LAS float* tmp, LAS float* vec, int tid) {
    for (int i = tid; i < 128 * 16; i += NT) { const int l = i >> 4, q4 = i & 15; *(LAS f32x4*)(tmp + l * 64 + q4 * 4) = *(const f32x4*)(DT + (size_t)(row0 + l) * 64 + q4 * 4); }
    __syncthreads();
    LAS float* tot = tmp + 128 * 64;
    const int seq = tid >> 5, j = tid & 31, hh = seq & 7, dir = seq >> 3;
    float v[4], run = 0.f;
#pragma unroll
    for (int e = 0; e < 4; ++e) { const int l = dir ? 127 - (4 * j + e) : 4 * j + e; run += tmp[l * 64 + 32 + dir * 16 + g * 8 + hh]; v[e] = run; }
    tot[seq * 32 + j] = run;
    __syncthreads();
    float off = 0.f;
    for (int q = 0; q < 32; ++q) { const float tq = tot[seq * 32 + q]; off += q < j ? tq : 0.f; }
#pragma unroll
    for (int e = 0; e < 4; ++e) { const int l = dir ? 127 - (4 * j + e) : 4 * j + e; vec[dir * 1024 + hh * 128 + l] = v[e] + off; }
    __syncthreads();
    for (int i = tid; i < 2048; i += NT) { const int d2 = i >> 10, h2 = (i >> 7) & 7, l = i & 127; const int ref = d2 ? (l & ~15) : (l | 15);
        vec[2048 + i] = __expf(fmaxf(vec[d2 * 1024 + h2 * 128 + ref] - vec[d2 * 1024 + h2 * 128 + l], -80.f)) * tmp[l * 64 + d2 * 16 + g * 8 + h2]; }
    __syncthreads();
}

__device__ __forceinline__ void mamba_m1(const Ctx& a, LAS unsigned char* lds, int item) {
    unsigned char* ws = opqp(a.ws); const int tid = ((a.wv << 6) | lane_v()), lane = tid & 63, wid = tid >> 6, fr = lane & 15, fq = lane >> 4, q4 = (lane & 15) >> 2, p4 = lane & 3;
    const int g = item & 1, cc = (item >> 1) % MB_NCH, b = (item >> 1) / MB_NCH; const int row0 = mb_row0(b, cc);
    const bf16* XBC = (const bf16*)(ws + WS_XBC); const float* DT = (const float*)(ws + WS_DT); bf16* ST = (bf16*)(ws + WS_ST); float* AC = (float*)(ws + WS_AC);
    LAS bf16* Bs = (LAS bf16*)(lds + MB_OFF_B); LAS float* vec = (LAS float*)(lds + MB_OFF_V);
    __syncthreads();
    mb_vectors(DT, row0, g, (LAS float*)(lds + MB_OFF_C), vec, tid);
    if (tid < 16) { const int hh = tid & 7, dir = tid >> 3; AC[((size_t)(b * MB_NCH + cc) * 16 + g * 8 + hh) * 2 + dir] = dir ? vec[1024 + hh * 128] : vec[hh * 128 + 127]; }
    for (int i = tid; i < 2048; i += NT) { const int l = i >> 4, ch = i & 15; *(LAS u32x4*)(Bs + l * MB_PB + ch * 8) = *(const u32x4*)(XBC + (size_t)(row0 + l) * 1536 + 1024 + g * 128 + ch * 8); }
    uint4 xq[2];
#pragma unroll
    for (int j = 0; j < 2; ++j) { const int id = tid + j * NT; xq[j] = *(const uint4*)(XBC + (size_t)(row0 + (id >> 3)) * 1536 + (g * 8) * 64 + (id & 7) * 8); }
    for (int hh = 0; hh < 8; ++hh) {
        const int h = g * 8 + hh;
        LAS bf16* Yf = (LAS bf16*)(lds + ((hh & 1) ? MB_OFF_X : MB_OFF_C)); LAS bf16* Yb = Yf + 128 * MB_PX;
        const float tf = vec[hh * 128 + 127];
        uint4 xc[2] = {xq[0], xq[1]};
        if (hh + 1 < 8) {
#pragma unroll
            for (int j = 0; j < 2; ++j) { const int id = tid + j * NT; xq[j] = *(const uint4*)(XBC + (size_t)(row0 + (id >> 3)) * 1536 + (h + 1) * 64 + (id & 7) * 8); } }
#pragma unroll
        for (int j = 0; j < 2; ++j) { const int id = tid + j * NT, l = id >> 3, ch = id & 7; float x8[8], of[8], ob[8];
            unpack8(xc[j], x8);
            const float sf = __expf(tf - vec[hh * 128 + (l | 15)]) * vec[2048 + hh * 128 + l], sb = __expf(vec[1024 + hh * 128] - vec[1024 + hh * 128 + (l & ~15)]) * vec[3072 + hh * 128 + l];
#pragma unroll
            for (int e = 0; e < 8; ++e) { of[e] = x8[e] * sf; ob[e] = x8[e] * sb; }
            const uint4 pf = pack8(of), pb = pack8(ob);
            *(LAS u32x4*)(Yf + l * MB_PX + ch * 8) = (u32x4){pf.x, pf.y, pf.z, pf.w}; *(LAS u32x4*)(Yb + l * MB_PX + ch * 8) = (u32x4){pb.x, pb.y, pb.z, pb.w}; }
        __syncthreads();
        const int pt = wid & 3, nh = wid >> 2;
#pragma unroll
        for (int dir = 0; dir < 2; ++dir) { const LAS bf16* Xd = dir ? Yb : Yf;
            bf16x8 yf4[4];
#pragma unroll
            for (int ks = 0; ks < 4; ++ks) { const LAS bf16* pa = Xd + (ks * 32 + 8 * fq + q4) * MB_PX + pt * 16 + 4 * p4; yf4[ks] = trfrag(pa, pa + 4 * MB_PX); }
#pragma unroll
            for (int ns = 0; ns < 4; ++ns) { f32x4 acc = (f32x4){0.f, 0.f, 0.f, 0.f};
#pragma unroll
                for (int ks = 0; ks < 4; ++ks) { const LAS bf16* pa = Bs + (ks * 32 + 8 * fq + q4) * MB_PB + (nh * 4 + ns) * 16 + 4 * p4;
                    acc = __builtin_amdgcn_mfma_f32_16x16x32_bf16(trfrag(pa, pa + 4 * MB_PB), yf4[ks], acc, 0, 0, 0); }
                uint2 pk; pk.x = pk2(acc[0], acc[1]); pk.y = pk2(acc[2], acc[3]);
                *(uint2*)(ST + ((((size_t)(b * MB_NCH + cc) * 16 + h) * 2 + dir) * 64 + pt * 16 + fr) * 128 + (nh * 4 + ns) * 16 + 4 * fq) = pk; } }
    }
}

__device__ __forceinline__ void mamba_m2(const Ctx& a, int item) {
    unsigned char* ws = opqp(a.ws); const int tid = ((a.wv << 6) | lane_v());
    const int dir = item & 1, h = (item >> 1) & 15, b = item >> 5;
    bf16* ST = (bf16*)(ws + WS_ST); const float* AC = (const float*)(ws + WS_AC);
    float H[16];
#pragma unroll
    for (int i = 0; i < 16; ++i) H[i] = 0.f;
#define M2_CC(st_) (dir == 0 ? (st_) : ((st_) < 2 ? 1 - (st_) : 19 - (st_)))
#define M2_PTR(st_) (ST + ((((size_t)(b * MB_NCH + M2_CC(st_)) * 16 + h) * 2 + dir) * 64) * 128 + tid * 16)
    uint4 s0 = *(const uint4*)M2_PTR(0), s1 = *(const uint4*)(M2_PTR(0) + 8); float la = AC[((size_t)(b * MB_NCH + M2_CC(0)) * 16 + h) * 2 + dir];
    for (int st = 0; st < MB_NCH; ++st) {
        bf16* p = M2_PTR(st);
        const int sn = st + 1 < MB_NCH ? st + 1 : st;
        const uint4 n0 = *(const uint4*)M2_PTR(sn), n1 = *(const uint4*)(M2_PTR(sn) + 8); const float ln = AC[((size_t)(b * MB_NCH + M2_CC(sn)) * 16 + h) * 2 + dir];
        float f0[8], f1[8]; unpack8(s0, f0); unpack8(s1, f1);
        const float ea = __expf(la);
        float o0[8], o1[8];
#pragma unroll
        for (int e = 0; e < 8; ++e) { o0[e] = H[e]; o1[e] = H[8 + e]; H[e] = ea * H[e] + f0[e]; H[8 + e] = ea * H[8 + e] + f1[e]; }
        *(uint4*)p = pack8(o0); *(uint4*)(p + 8) = pack8(o1);
        s0 = n0; s1 = n1; la = ln;
    }
#undef M2_CC
#undef M2_PTR
}

__device__ __forceinline__ void mamba_m3(const Ctx& a, LAS unsigned char* lds, int b, int cc, int g) {
    unsigned char* ws = opqp(a.ws); const int tid = ((a.wv << 6) | lane_v()), lane = tid & 63, wid = tid >> 6, fr = lane & 15, fq = lane >> 4, q4 = (lane & 15) >> 2, p4 = lane & 3;
    const int row0 = mb_row0(b, cc);
    const bf16* XBC = (const bf16*)(ws + WS_XBC); const float* DT = (const float*)(ws + WS_DT); const bf16* ST = (const bf16*)(ws + WS_ST); bf16* YM = (bf16*)(ws + WS_YM);
    LAS bf16* Cs = (LAS bf16*)(lds + MB_OFF_C); LAS bf16* Bs = (LAS bf16*)(lds + MB_OFF_B); LAS float* vec = (LAS float*)(lds + MB_OFF_V);
    __syncthreads();
    mb_vectors(DT, row0, g, (LAS float*)(lds + MB_OFF_C), vec, tid);
    for (int i = tid; i < 2048; i += NT) { const int l = i >> 4, ch = i & 15; const bf16* src = XBC + (size_t)(row0 + l) * 1536 + g * 128 + ch * 8;
        *(LAS u32x4*)(Bs + l * MB_PB + ch * 8) = *(const u32x4*)(src + 1024); *(LAS u32x4*)(Cs + l * MB_PB + ch * 8) = *(const u32x4*)(src + 1280); }
    uint4 xr[2];
#define M3_XLOAD(hh_) do { _Pragma("unroll") for (int j_ = 0; j_ < 2; ++j_) { const int id_ = tid + j_ * NT; xr[j_] = *(const uint4*)(XBC + (size_t)(row0 + (id_ >> 3)) * 1536 + (g * 8 + (hh_)) * 64 + (id_ & 7) * 8); } } while (0)
#define M3_XSTORE(hh_) do { LAS bf16* X_ = (LAS bf16*)(lds + MB_OFF_X) + ((hh_) & 1) * 128 * MB_PX; _Pragma("unroll") for (int j_ = 0; j_ < 2; ++j_) { const int id_ = tid + j_ * NT; \
        *(LAS u32x4*)(X_ + (id_ >> 3) * MB_PX + (id_ & 7) * 8) = (u32x4){xr[j_].x, xr[j_].y, xr[j_].z, xr[j_].w}; } } while (0)
    M3_XLOAD(0); M3_XSTORE(0);
    __syncthreads();
    const int l0 = wid * 16;
    bf16x8 cf[4];
#pragma unroll
    for (int ks = 0; ks < 4; ++ks) cf[ks] = *(const LAS bf16x8*)(Cs + (l0 + fr) * MB_PB + ks * 32 + fq * 8);
    f32x4 CB[8];
#pragma unroll
    for (int sb = 0; sb < 8; ++sb) { f32x4 acc = (f32x4){0.f, 0.f, 0.f, 0.f};
#pragma unroll
        for (int ks = 0; ks < 4; ++ks) acc = __builtin_amdgcn_mfma_f32_16x16x32_bf16(*(const LAS bf16x8*)(Bs + (sb * 16 + fr) * MB_PB + ks * 32 + fq * 8), cf[ks], acc, 0, 0, 0);
        CB[sb] = acc; }
    bf16x8 hs0[8], hs1[8];
#define M3_HLOAD(SET_, hh_, pt_) do { const bf16* Hf_ = ST + ((((size_t)(b * MB_NCH + cc) * 16 + g * 8 + (hh_)) * 2 + 0) * 64) * 128 + (size_t)((pt_) * 16 + fr) * 128 + fq * 8; \
        _Pragma("unroll") for (int ks_ = 0; ks_ < 4; ++ks_) { SET_[ks_] = *(const bf16x8*)(Hf_ + ks_ * 32); SET_[4 + ks_] = *(const bf16x8*)(Hf_ + 64 * 128 + ks_ * 32); } } while (0)
    M3_HLOAD(hs0, 0, 0);
    float mfd[4], mbd[4];
#pragma unroll
    for (int e = 0; e < 4; ++e) { const int dd = 4 * fq + e - fr; mfd[e] = dd <= 0 ? 1.f : 0.f; mbd[e] = dd >= 0 ? 1.f : 0.f; }
    const int nhh = (a.sub & 16) ? 0 : ((a.sub & 8) ? 1 : 8);
    for (int hh = 0; hh < nhh; ++hh) {
        const int h = g * 8 + hh;
        if (hh + 1 < 8) M3_XLOAD(hh + 1);
        const LAS bf16* X = (const LAS bf16*)(lds + MB_OFF_X) + (hh & 1) * 128 * MB_PX;
        const LAS float* vf = vec + hh * 128; const LAS float* vb = vec + 1024 + hh * 128; const LAS float* cF = vec + 2048 + hh * 128; const LAS float* cB = vec + 3072 + hh * 128;
        const float afl = vf[l0 + fr], abl = vb[l0 + fr];
        bf16x8 wf[4];
#pragma unroll
        for (int kc = 0; kc < 4; ++kc) { float wv[8];
#pragma unroll
            for (int hs = 0; hs < 2; ++hs) { const int sb = 2 * kc + hs, s0 = sb * 16 + 4 * fq;
                float rf = 0.f, rb = 0.f;
                if (sb <= wid) rf = __expf(fminf(afl - vf[sb * 16 + 15], 80.f));
                if (sb >= wid) rb = __expf(fminf(abl - vb[sb * 16], 80.f));
                const f32x4 c_f = *(const LAS f32x4*)(cF + s0), c_b = *(const LAS f32x4*)(cB + s0);
#pragma unroll
                for (int e = 0; e < 4; ++e) { float m;
                    if (sb < wid) m = rf * c_f[e]; else if (sb > wid) m = rb * c_b[e]; else m = rf * c_f[e] * mfd[e] + rb * c_b[e] * mbd[e];
                    wv[hs * 4 + e] = CB[sb][e] * m; } }
            u32x4 w; w.x = pk2(wv[0], wv[1]); w.y = pk2(wv[2], wv[3]); w.z = pk2(wv[4], wv[5]); w.w = pk2(wv[6], wv[7]); wf[kc] = __builtin_bit_cast(bf16x8, w); }
        const float ef = __expf(afl), eb = __expf(abl);
#define M3_STEP(SET_, NXT_, pt_, hn_, ptn_, do_load_) do { \
            if (do_load_) M3_HLOAD(NXT_, hn_, ptn_); \
            f32x4 yd = (f32x4){0.f, 0.f, 0.f, 0.f}, y1 = yd, y2 = yd; \
            _Pragma("unroll") for (int kc = 0; kc < 4; ++kc) { const LAS bf16* pa = X + (kc * 32 + 4 * fq + q4) * MB_PX + (pt_) * 16 + 4 * p4; \
                yd = __builtin_amdgcn_mfma_f32_16x16x32_bf16(trfrag(pa, pa + 16 * MB_PX), wf[kc], yd, 0, 0, 0); } \
            _Pragma("unroll") for (int ks = 0; ks < 4; ++ks) { y1 = __builtin_amdgcn_mfma_f32_16x16x32_bf16(SET_[ks], cf[ks], y1, 0, 0, 0); y2 = __builtin_amdgcn_mfma_f32_16x16x32_bf16(SET_[4 + ks], cf[ks], y2, 0, 0, 0); } \
            f32x4 o; \
            _Pragma("unroll") for (int e = 0; e < 4; ++e) o[e] = yd[e] + ef * y1[e] + eb * y2[e]; \
            { uint2 pk; pk.x = pk2(o[0], o[1]); pk.y = pk2(o[2], o[3]); *(uint2*)(YM + (size_t)(row0 + l0 + fr) * 1024 + h * 64 + (pt_) * 16 + 4 * fq) = pk; } } while (0)
        M3_STEP(hs0, hs1, 0, hh, 1, true);
        M3_STEP(hs1, hs0, 1, hh, 2, true);
        M3_STEP(hs0, hs1, 2, hh, 3, true);
        M3_STEP(hs1, hs0, 3, hh + 1, 0, hh + 1 < 8);
#undef M3_STEP
        if (hh + 1 < 8) { M3_XSTORE(hh + 1); }
        __syncthreads();
    }
#undef M3_XLOAD
#undef M3_XSTORE
#undef M3_HLOAD
}


constexpr int RC_NCH = CH_STEPS / 16;
constexpr int RC_UNITS = 128 * RC_NCH;
constexpr int RC_TP = 72;
constexpr int RC_WAVE_LDS = 5 * 16 * RC_TP * 2 + 16 * 17 * 4 + 16 * 24 * 2;
constexpr int RC_CT_FLOATS = 6 * 512 + 3 * 512;
static_assert(8 * RC_WAVE_LDS + RC_CT_FLOATS * 4 <= LDS_STAGE, "rwkv R1 LDS");
__device__ __forceinline__ void rc_consts(LAS unsigned char* lds, int l, int tid) {
    LAS float* CT = (LAS float*)(lds + 8 * RC_WAVE_LDS);
    const float* mu = ldin(12) + (size_t)l * 2 * 1792; const float* a0 = ldin(15) + l * 512; const float* k_k = ldin(18) + l * 512; const float* k_a = ldin(19) + l * 512;
    for (int i = tid; i < 1536; i += NT) { CT[i] = mu[i]; CT[1536 + i] = mu[1792 + i]; }
    for (int i = tid; i < 512; i += NT) { CT[3072 + i] = a0[i]; CT[3584 + i] = k_k[i]; CT[4096 + i] = k_a[i]; }
    __syncthreads();
}
constexpr size_t RC_REC = 16 * 64 + 16 * 64 + 16 * 64 + 64 * 32 + 16 * 64;
constexpr size_t WS_RC1 = WS_MGU + 224 * MiB;
constexpr size_t WS_RC2 = WS_MD + 112 * MiB;
static_assert(MOE_FP8 == 1 && (size_t)RC_UNITS * RC_REC * 2 <= 224 * MiB && (size_t)RC_UNITS * (4096 + 256) <= 112 * MiB, "rwkv chunk records");

__device__ __forceinline__ bf16x8 pack_lo4(const f32x4 v) { u32x4 w; w.x = pk2(v[0], v[1]); w.y = pk2(v[2], v[3]); w.z = 0u; w.w = 0u; return __builtin_bit_cast(bf16x8, w); }

__device__ __forceinline__ void rwkv_r1(const Ctx& a, LAS unsigned char* lds, int l, int unit) {
    unsigned char* ws = opqp(a.ws); const int tid = ((a.wv << 6) | lane_v()), lane = tid & 63, wid = tid >> 6, fr = lane & 15, fq = lane >> 4, q4 = (lane & 15) >> 2, p4 = lane & 3;
    const int chain = unit / RC_NCH, c = unit % RC_NCH; const int dir = chain & 1, h = (chain >> 1) & 7, b = chain >> 4;
    const bf16* R5 = (const bf16*)(ws + WS_RW5); const float* F = (const float*)(ws + WS_MIX); const size_t st = (size_t)MTOT * 512;
    bf16* rec = (bf16*)(ws + WS_RC1) + (size_t)unit * RC_REC; float* Ycg = (float*)(ws + WS_RC2) + (size_t)unit * 1024; float* PCg = (float*)(ws + WS_RC2) + (size_t)RC_UNITS * 1024 + (size_t)unit * 64;
    LAS bf16* tA = (LAS bf16*)(lds + wid * RC_WAVE_LDS); LAS bf16* tR = tA + 16 * RC_TP; LAS bf16* tB = tR + 16 * RC_TP; LAS bf16* tK = tB + 16 * RC_TP; LAS bf16* tV = tK + 16 * RC_TP;
    LAS float* L1s = (LAS float*)(tV + 16 * RC_TP); LAS bf16* Ts = (LAS bf16*)(L1s + 16 * 17);
    {   const int t = lane >> 2, part = lane & 3; const int row = chain_row(c * 16 + t, b, dir);
        const bool lat = row < MLAT; const int pos = lat ? (row & (SEQ - 1)) : ((row - MLAT) & (CTXL - 1)); const bool hp = pos > 0, hn = pos < (lat ? SEQ : CTXL) - 1;
        const bf16* U = (const bf16*)(ws + WS_U); const bf16* up = U + (size_t)row * NINP + h * 64 + part * 16; const int ch = h * 64 + part * 16;
        const LAS float* CT = (const LAS float*)(lds + 8 * RC_WAVE_LDS);
        float sv[3][16];
#pragma unroll
        for (int q = 0; q < 3; ++q)
#pragma unroll
            for (int hf = 0; hf < 2; ++hf) { float u[8], p[8], n[8];
                unpack8(*(const uint4*)(up + q * 512 + hf * 8), u); unpack8(hp ? *(const uint4*)(up - NINP + q * 512 + hf * 8) : make_uint4(0u, 0u, 0u, 0u), p); unpack8(hn ? *(const uint4*)(up + NINP + q * 512 + hf * 8) : make_uint4(0u, 0u, 0u, 0u), n);
#pragma unroll
                for (int e = 0; e < 8; ++e) { const int cc = ch + hf * 8 + e; sv[q][hf * 8 + e] = u[e] + CT[q * 512 + cc] * (p[e] - u[e]) + CT[1536 + q * 512 + cc] * (n[e] - u[e]); } }
        float av[16];
#pragma unroll
        for (int q4_ = 0; q4_ < 4; ++q4_) { const f32x4 f = *(const f32x4*)(F + (size_t)row * 2048 + 1024 + ch + q4_ * 4);
#pragma unroll
            for (int e = 0; e < 4; ++e) av[q4_ * 4 + e] = fsigm(f[e] + CT[3072 + ch + q4_ * 4 + e]); }
        float kkv[16], k2[16], bv[16], ss = 0.f;
#pragma unroll
        for (int e = 0; e < 16; ++e) { kkv[e] = sv[1][e] * CT[3584 + ch + e]; ss += kkv[e] * kkv[e]; }
        ss += dppf<0xB1>(ss); ss += dppf<0x4E>(ss);
        const float inv = 1.0f / fmaxf(sqrtf(ss), 1e-12f);
#pragma unroll
        for (int e = 0; e < 16; ++e) { kkv[e] *= inv; k2[e] = sv[1][e] * (1.0f + (av[e] - 1.0f) * CT[4096 + ch + e]); bv[e] = kkv[e] * av[e]; }
        const int lo = t * RC_TP + part * 16;
#define RC_PUT(T_, A_) do { *(LAS u32x4*)(T_ + lo) = (u32x4){pk2(A_[0], A_[1]), pk2(A_[2], A_[3]), pk2(A_[4], A_[5]), pk2(A_[6], A_[7])}; \
            *(LAS u32x4*)(T_ + lo + 8) = (u32x4){pk2(A_[8], A_[9]), pk2(A_[10], A_[11]), pk2(A_[12], A_[13]), pk2(A_[14], A_[15])}; } while (0)
        RC_PUT(tR, sv[0]); RC_PUT(tK, k2); RC_PUT(tV, sv[2]); RC_PUT(tA, kkv); RC_PUT(tB, bv);
#undef RC_PUT
        if (dir == 0) {
            bf16* R5w = (bf16*)(ws + WS_RW5); const size_t o = (size_t)row * 512 + ch;
            *(u32x4*)(R5w + o) = *(const LAS u32x4*)(tR + lo); *(u32x4*)(R5w + o + 8) = *(const LAS u32x4*)(tR + lo + 8);
            *(u32x4*)(R5w + st + o) = *(const LAS u32x4*)(tK + lo); *(u32x4*)(R5w + st + o + 8) = *(const LAS u32x4*)(tK + lo + 8);
            *(u32x4*)(R5w + 2 * st + o) = *(const LAS u32x4*)(tV + lo); *(u32x4*)(R5w + 2 * st + o + 8) = *(const LAS u32x4*)(tV + lo + 8); }
    }
    const int j = lane; const float w0j = ldin(13)[l * 1024 + dir * 512 + h * 64 + j];
    float wraw[16];
#pragma unroll
    for (int t = 0; t < 16; ++t) wraw[t] = F[(size_t)chain_row(c * 16 + t, b, dir) * 2048 + dir * 512 + h * 64 + j];
    __builtin_amdgcn_sched_barrier(0);
    float Lc = 0.f, Pprev = 1.0f, Lct[16], bq[16], kq[16];
#pragma unroll
    for (int t = 0; t < 16; ++t) {
        const float rv = bf2f(tR[t * RC_TP + j]), kv = bf2f(tK[t * RC_TP + j]), kkv = bf2f(tA[t * RC_TP + j]), bv = bf2f(tB[t * RC_TP + j]);
        const float lw = (-0.60653066f * 1.44269504f) * fsigm(wraw[t] + w0j);
        const float Pm1 = Pprev; Lc += lw; const float P = __builtin_amdgcn_exp2f(Lc), iP = __builtin_amdgcn_rcpf(P); Pprev = P;
        Lct[t] = Lc; bq[t] = bv; kq[t] = kv;
        tA[t * RC_TP + j] = (bf16)f2bf(-kkv * Pm1); tR[t * RC_TP + j] = (bf16)f2bf(rv * P); tB[t * RC_TP + j] = (bf16)f2bf(bv * iP); tK[t * RC_TP + j] = (bf16)f2bf(kv * iP);
    }
    PCg[j] = Pprev;
    {   unsigned vw[8];
#pragma unroll
        for (int t2 = 0; t2 < 8; ++t2) vw[t2] = (unsigned)tV[(2 * t2) * RC_TP + j] | ((unsigned)tV[(2 * t2 + 1) * RC_TP + j] << 16);
        *(uint4*)(rec + 5120 + (size_t)j * 16) = make_uint4(vw[0], vw[1], vw[2], vw[3]); *(uint4*)(rec + 5120 + (size_t)j * 16 + 8) = make_uint4(vw[4], vw[5], vw[6], vw[7]); }
    {   bf16* BK = rec + 3072 + (size_t)j * 32;
#pragma unroll
        for (int g = 0; g < 4; ++g) { float o8[8];
#pragma unroll
            for (int e = 0; e < 4; ++e) { const float d = __builtin_amdgcn_exp2f(Lc - Lct[4 * g + e]); o8[e] = bq[4 * g + e] * d; o8[4 + e] = kq[4 * g + e] * d; }
            *(uint4*)(BK + g * 8) = pack8(o8); } }
    f32x4 L1 = (f32x4){0.f, 0.f, 0.f, 0.f}, L2 = L1, M1 = L1, M2 = L1;
#pragma unroll
    for (int ks = 0; ks < 2; ++ks) {
        const bf16x8 ya = *(const LAS bf16x8*)(tA + fr * RC_TP + ks * 32 + fq * 8), yr = *(const LAS bf16x8*)(tR + fr * RC_TP + ks * 32 + fq * 8);
        const bf16x8 xb = *(const LAS bf16x8*)(tB + fr * RC_TP + ks * 32 + fq * 8), xk = *(const LAS bf16x8*)(tK + fr * RC_TP + ks * 32 + fq * 8);
        L1 = __builtin_amdgcn_mfma_f32_16x16x32_bf16(xb, ya, L1, 0, 0, 0); L2 = __builtin_amdgcn_mfma_f32_16x16x32_bf16(xk, ya, L2, 0, 0, 0);
        M1 = __builtin_amdgcn_mfma_f32_16x16x32_bf16(xb, yr, M1, 0, 0, 0); M2 = __builtin_amdgcn_mfma_f32_16x16x32_bf16(xk, yr, M2, 0, 0, 0);
    }
#pragma unroll
    for (int e = 0; e < 4; ++e) { const int s = 4 * fq + e, t = fr;
        if (!(s < t)) { L1[e] = 0.f; L2[e] = 0.f; } if (!(s <= t)) { M1[e] = 0.f; M2[e] = 0.f; }
        }
    {   const int cc = lane & 15; float Tc[16];
#pragma unroll
        for (int t = 0; t < 16; ++t) { float acc = (t == cc) ? 1.f : 0.f;
#pragma unroll
            for (int s = 0; s < t; ++s) { const float lts = __int_as_float(__builtin_amdgcn_readlane(__float_as_int(L1[s & 3]), 16 * (s >> 2) + t)); acc += lts * Tc[s]; }
            Tc[t] = acc; }
        if (lane < 16) {
#pragma unroll
            for (int t = 0; t < 16; ++t) Ts[t * 24 + cc] = (bf16)f2bf(Tc[t]); } }
    const bf16x8 Top = __builtin_bit_cast(bf16x8, (u32x4){((const LAS unsigned*)(Ts + fr * 24 + 4 * fq))[0], ((const LAS unsigned*)(Ts + fr * 24 + 4 * fq))[1], 0u, 0u});
    const bf16x8 L2op = pack_lo4(L2), M1op = pack_lo4(M1), M2op = pack_lo4(M2);
#pragma unroll
    for (int kt = 0; kt < 4; ++kt) { const LAS bf16* pa = tA + (4 * fq + q4) * RC_TP + kt * 16 + 4 * p4;
        const f32x4 ta = __builtin_amdgcn_mfma_f32_16x16x32_bf16(trfrag(pa, pa), Top, (f32x4){0.f, 0.f, 0.f, 0.f}, 0, 0, 0);
        uint2 pk; pk.x = pk2(ta[0], ta[1]); pk.y = pk2(ta[2], ta[3]);
        *(uint2*)(rec + fr * 64 + 32 * (kt >> 1) + 8 * fq + 4 * (kt & 1)) = pk;
        *(LAS u32x2*)(tB + fr * RC_TP + kt * 16 + 4 * fq) = (u32x2){pk.x, pk.y}; }
#pragma unroll
    for (int vt = 0; vt < 4; ++vt) { const LAS bf16* pa = tV + (4 * fq + q4) * RC_TP + vt * 16 + 4 * p4;
        const f32x4 x = __builtin_amdgcn_mfma_f32_16x16x32_bf16(trfrag(pa, pa), L2op, (f32x4){0.f, 0.f, 0.f, 0.f}, 0, 0, 0);
        *(LAS u32x2*)(tK + fr * RC_TP + vt * 16 + 4 * fq) = (u32x2){pk2(x[0], x[1]), pk2(x[2], x[3])}; }
#pragma unroll
    for (int kt = 0; kt < 4; ++kt) { const LAS bf16* pa = tB + (4 * fq + q4) * RC_TP + kt * 16 + 4 * p4;
        const u32x2 r2 = *(const LAS u32x2*)(tR + fr * RC_TP + kt * 16 + 4 * fq);
        f32x4 ra = (f32x4){__uint_as_float(r2.x << 16), __uint_as_float(r2.x & 0xffff0000u), __uint_as_float(r2.y << 16), __uint_as_float(r2.y & 0xffff0000u)};
        ra = __builtin_amdgcn_mfma_f32_16x16x32_bf16(trfrag(pa, pa), M1op, ra, 0, 0, 0);
        uint2 pk; pk.x = pk2(ra[0], ra[1]); pk.y = pk2(ra[2], ra[3]);
        *(uint2*)(rec + 1024 + fr * 64 + 32 * (kt >> 1) + 8 * fq + 4 * (kt & 1)) = pk; }
#pragma unroll
    for (int vt = 0; vt < 4; ++vt) { const LAS bf16* pa = tK + (4 * fq + q4) * RC_TP + vt * 16 + 4 * p4;
        const f32x4 x = __builtin_amdgcn_mfma_f32_16x16x32_bf16(trfrag(pa, pa), Top, (f32x4){0.f, 0.f, 0.f, 0.f}, 0, 0, 0);
        uint2 pk; pk.x = pk2(x[0], x[1]); pk.y = pk2(x[2], x[3]);
#pragma unroll
        for (int e = 0; e < 4; ++e) rec[2048 + (size_t)(vt * 16 + 4 * fq + e) * 16 + fr] = (bf16)f2bf(x[e]);
        *(LAS u32x2*)(tA + fr * RC_TP + vt * 16 + 4 * fq) = (u32x2){pk.x, pk.y}; }
#pragma unroll
    for (int vt = 0; vt < 4; ++vt) { const LAS bf16* pg = tA + (4 * fq + q4) * RC_TP + vt * 16 + 4 * p4; const LAS bf16* pv = tV + (4 * fq + q4) * RC_TP + vt * 16 + 4 * p4;
        f32x4 x = __builtin_amdgcn_mfma_f32_16x16x32_bf16(trfrag(pg, pg), M1op, (f32x4){0.f, 0.f, 0.f, 0.f}, 0, 0, 0);
        x = __builtin_amdgcn_mfma_f32_16x16x32_bf16(trfrag(pv, pv), M2op, x, 0, 0, 0);
#pragma unroll
        for (int e = 0; e < 4; ++e) Ycg[(size_t)(vt * 16 + 4 * fq + e) * 16 + fr] = x[e]; }
}

constexpr int R2_NV = 2;
__device__ __forceinline__ void rwkv_r2(const Ctx& a, int l, int item) {
    unsigned char* ws = opqp(a.ws); const int tid = ((a.wv << 6) | lane_v()), lane = tid & 63, wid = tid >> 6, fr = lane & 15, fq = lane >> 4;
    const int chain = 4 * item + (wid >> 1), v0 = 32 * (wid & 1); const int dir = chain & 1, h = (chain >> 1) & 7, b = chain >> 4;
    bf16* Y = (bf16*)(ws + WS_YR) + (size_t)dir * MTOT * 512;
    f32x4 S[R2_NV][4];
#pragma unroll
    for (int vg = 0; vg < R2_NV; ++vg)
#pragma unroll
        for (int kt = 0; kt < 4; ++kt) S[vg][kt] = (f32x4){0.f, 0.f, 0.f, 0.f};
    struct Rec { bf16x8 taf[2], raf[2], bkf[4]; f32x4 pc[4]; uint2 g2[R2_NV], v2[R2_NV]; f32x4 yc[R2_NV]; int r0; };
    Rec cur, nxt;
#define R2_LOAD(R_, c_) do { const size_t unit_ = (size_t)chain * RC_NCH + (c_); \
        const bf16* rec_ = (const bf16*)(ws + WS_RC1) + unit_ * RC_REC; const float* Ycg_ = (const float*)(ws + WS_RC2) + unit_ * 1024; const float* PCg_ = (const float*)(ws + WS_RC2) + (size_t)RC_UNITS * 1024 + unit_ * 64; \
        _Pragma("unroll") for (int jj = 0; jj < 2; ++jj) { R_.taf[jj] = *(const bf16x8*)(rec_ + fr * 64 + jj * 32 + fq * 8); R_.raf[jj] = *(const bf16x8*)(rec_ + 1024 + fr * 64 + jj * 32 + fq * 8); } \
        _Pragma("unroll") for (int kt = 0; kt < 4; ++kt) { R_.bkf[kt] = *(const bf16x8*)(rec_ + 3072 + (size_t)(kt * 16 + fr) * 32 + fq * 8); R_.pc[kt] = *(const f32x4*)(PCg_ + kt * 16 + 4 * fq); } \
        _Pragma("unroll") for (int vg = 0; vg < R2_NV; ++vg) { const size_t vo_ = (size_t)(v0 + 16 * vg + fr) * 16 + 4 * fq; \
            R_.g2[vg] = *(const uint2*)(rec_ + 2048 + vo_); R_.v2[vg] = *(const uint2*)(rec_ + 5120 + vo_); R_.yc[vg] = *(const f32x4*)(Ycg_ + vo_); } \
        const int s0_ = (c_) * 16; const int inc_ = s0_ < CTXL ? 1 : 0; const int t0_ = s0_ - (inc_ ? 0 : CTXL), L_ = inc_ ? CTXL : SEQ, base_ = inc_ ? MLAT + b * CTXL : b * SEQ; \
        R_.r0 = base_ + (dir ? L_ - 1 - t0_ : t0_); } while (0)
#define R2_STEP(R_, c_) do { _Pragma("unroll") for (int vg = 0; vg < R2_NV; ++vg) { \
        bf16x8 sb[2]; \
        _Pragma("unroll") for (int jj = 0; jj < 2; ++jj) { u32x4 w; w.x = pk2(S[vg][2 * jj][0], S[vg][2 * jj][1]); w.y = pk2(S[vg][2 * jj][2], S[vg][2 * jj][3]); w.z = pk2(S[vg][2 * jj + 1][0], S[vg][2 * jj + 1][1]); w.w = pk2(S[vg][2 * jj + 1][2], S[vg][2 * jj + 1][3]); sb[jj] = __builtin_bit_cast(bf16x8, w); } \
        f32x4 xt = (f32x4){0.f, 0.f, 0.f, 0.f}, yt = xt; \
        _Pragma("unroll") for (int jj = 0; jj < 2; ++jj) { xt = __builtin_amdgcn_mfma_f32_16x16x32_bf16(R_.taf[jj], sb[jj], xt, 0, 0, 0); yt = __builtin_amdgcn_mfma_f32_16x16x32_bf16(R_.raf[jj], sb[jj], yt, 0, 0, 0); }     \
        _Pragma("unroll") for (int e = 0; e < 4; ++e) Y[(size_t)(R_.r0 + (dir ? -(4 * fq + e) : (4 * fq + e))) * 512 + h * 64 + v0 + 16 * vg + fr] = (bf16)f2bf(yt[e] + R_.yc[vg][e]); \
        float g4_[4]; unpack4(R_.g2[vg], g4_); \
        u32x4 w; w.x = pk2(xt[0] + g4_[0], xt[1] + g4_[1]); w.y = pk2(xt[2] + g4_[2], xt[3] + g4_[3]); w.z = R_.v2[vg].x; w.w = R_.v2[vg].y; \
        const bf16x8 yop = __builtin_bit_cast(bf16x8, w);                    \
        _Pragma("unroll") for (int kt = 0; kt < 4; ++kt) { S[vg][kt] = S[vg][kt] * R_.pc[kt]; S[vg][kt] = __builtin_amdgcn_mfma_f32_16x16x32_bf16(R_.bkf[kt], yop, S[vg][kt], 0, 0, 0); } } } while (0)
#define R2_CL(x_) ((x_) < RC_NCH ? (x_) : RC_NCH - 1)
    R2_LOAD(cur, 0);
    for (int c = 0; c < RC_NCH; c += 2) {
        R2_LOAD(nxt, R2_CL(c + 1)); R2_STEP(cur, c);
        R2_LOAD(cur, R2_CL(c + 2)); R2_STEP(nxt, c + 1);
    }
#undef R2_STEP
#undef R2_CL
#undef R2_LOAD
}

constexpr int RW_LD = 384;
constexpr int RW_YOFF = 2 * CH_T * RW_LD;
__device__ __forceinline__ void rwkv_chain(const Ctx& a, LAS unsigned char* lds, int l, int item) {
    unsigned char* ws = opqp(a.ws); const int tid = ((a.wv << 6) | lane_v());
    const int dir = item & 1, h = (item >> 1) & 7, b = item >> 4;
    const int rp = tid >> 4, js = tid & 15, j0 = js * 4; const bool odd = js & 1;
    const bf16* R5 = (const bf16*)(ws + WS_RW5); const float* F = (const float*)(ws + WS_MIX); float* Y = (float*)(ws + WS_YR) + (size_t)dir * MTOT * 512;
    const size_t st = (size_t)MTOT * 512;
    LAS float* buf = (LAS float*)lds;
    const int ls = tid >> 4, lp = tid & 15;
    typedef float f32x2 __attribute__((ext_vector_type(2)));
    f32x2 S00 = {0.f, 0.f}, S01 = {0.f, 0.f}, S10 = {0.f, 0.f}, S11 = {0.f, 0.f};
    float4 wreg; uint2 kkr, br, kr, rr, vr;
    const float4 w0r = *(const float4*)(ldin(13) + l * 1024 + dir * 512 + h * 64 + lp * 4);
#define RW_LOAD(c) do { const int row_ = chain_row((c) * CH_T + ls, b, dir); const size_t o_ = (size_t)row_ * 512 + h * 64 + lp * 4; \
        wreg = *(const float4*)(F + (size_t)row_ * 2048 + dir * 512 + h * 64 + lp * 4); \
        rr = *(const uint2*)(R5 + o_); kr = *(const uint2*)(R5 + st + o_); vr = *(const uint2*)(R5 + 2 * st + o_); kkr = *(const uint2*)(R5 + 3 * st + o_); br = *(const uint2*)(R5 + 4 * st + o_); } while (0)
#define RW_STORE(c) do { LAS float* q_ = buf + (((c) & 1) * CH_T + ls) * RW_LD; float f_[4]; \
        unpack4(kkr, f_); *(LAS f32x4*)(q_ + lp * 4) = (f32x4){f_[0], f_[1], f_[2], f_[3]}; \
        unpack4(br, f_);  *(LAS f32x4*)(q_ + 64 + lp * 4) = (f32x4){f_[0], f_[1], f_[2], f_[3]}; \
        *(LAS f32x4*)(q_ + 128 + lp * 4) = (f32x4){__expf(-0.60653066f * fsigm(wreg.x + w0r.x)), __expf(-0.60653066f * fsigm(wreg.y + w0r.y)), __expf(-0.60653066f * fsigm(wreg.z + w0r.z)), __expf(-0.60653066f * fsigm(wreg.w + w0r.w))}; \
        unpack4(kr, f_);  *(LAS f32x4*)(q_ + 192 + lp * 4) = (f32x4){f_[0], f_[1], f_[2], f_[3]}; \
        unpack4(rr, f_);  *(LAS f32x4*)(q_ + 256 + lp * 4) = (f32x4){f_[0], f_[1], f_[2], f_[3]}; \
        unpack4(vr, f_);  *(LAS f32x4*)(q_ + 320 + lp * 4) = (f32x4){f_[0], f_[1], f_[2], f_[3]}; } while (0)
    __syncthreads();
    RW_LOAD(0); RW_STORE(0);
    __syncthreads();
    for (int c = 0; c < CH_NC; ++c) {
        if (c + 1 < CH_NC) RW_LOAD(c + 1);
        if (c > 0) {
            const int row = chain_row((c - 1) * CH_T + ls, b, dir);
            *(f32x4*)(Y + (size_t)row * 512 + h * 64 + lp * 4) = *(const LAS f32x4*)(buf + RW_YOFF + (((c - 1) & 1) * CH_T + ls) * 64 + lp * 4);
        }
        const LAS float* cb = buf + ((c & 1) * CH_T) * RW_LD; LAS float* yb = buf + RW_YOFF + ((c & 1) * CH_T) * 64;
#pragma unroll 2
        for (int s = 0; s < CH_T; ++s) {
            const LAS float* q = cb + s * RW_LD;
            const f32x4 kk4 = *(const LAS f32x4*)(q + j0), b4 = *(const LAS f32x4*)(q + 64 + j0), w4 = *(const LAS f32x4*)(q + 128 + j0), k4 = *(const LAS f32x4*)(q + 192 + j0), r4 = *(const LAS f32x4*)(q + 256 + j0);
            const f32x2 v2 = *(const LAS f32x2*)(q + 320 + 2 * rp);
            const f32x2 kkA = {kk4[0], kk4[1]}, kkB = {kk4[2], kk4[3]}, bA = {b4[0], b4[1]}, bB = {b4[2], b4[3]}, wA = {w4[0], w4[1]}, wB = {w4[2], w4[3]}, kA = {k4[0], k4[1]}, kB = {k4[2], k4[3]}, rA = {r4[0], r4[1]}, rB = {r4[2], r4[3]};
            f32x2 t0 = S00 * kkA + S01 * kkB, t1 = S10 * kkA + S11 * kkB;
            const float sa0 = -red16(t0[0] + t0[1]), sa1 = -red16(t1[0] + t1[1]);
            S00 = S00 * wA + (bA * sa0 + kA * v2[0]); S01 = S01 * wB + (bB * sa0 + kB * v2[0]);
            S10 = S10 * wA + (bA * sa1 + kA * v2[1]); S11 = S11 * wB + (bB * sa1 + kB * v2[1]);
            t0 = S00 * rA + S01 * rB; t1 = S10 * rA + S11 * rB;
            const float p0 = t0[0] + t0[1], p1 = t1[0] + t1[1];
            float ym = odd ? p1 : p0; const float yo = odd ? p0 : p1;
            ym += dppf<0xB1>(yo); ym += dppf<0x4E>(ym); ym += dppf<0x124>(ym); ym += dppf<0x128>(ym);
            if (js < 2) yb[s * 64 + 2 * rp + js] = ym;
        }
        if (c + 1 < CH_NC) RW_STORE(c + 1);
        __syncthreads();
    }
    { const int row = chain_row((CH_NC - 1) * CH_T + ls, b, dir);
      *(f32x4*)(Y + (size_t)row * 512 + h * 64 + lp * 4) = *(const LAS f32x4*)(buf + RW_YOFF + (((CH_NC - 1) & 1) * CH_T + ls) * 64 + lp * 4); }
#undef RW_LOAD
#undef RW_STORE
}

constexpr int AT_KP = 136, AT_VP = 144;
constexpr int AT_KB = 64 * AT_KP * 2, AT_VB = 64 * AT_VP * 2, AT_BUF = AT_KB + AT_VB;
__device__ __forceinline__ void attn_item(const Ctx& a, LAS unsigned char* lds, int l, int b, int h, int qt, bool ctxq, float lam, float post) {
    unsigned char* ws = opqp(a.ws); const int tid = ((a.wv << 6) | lane_v()), lane = tid & 63, wid = tid >> 6, fr = lane & 15, fq = lane >> 4, q4 = (lane & 15) >> 2, p4 = lane & 3;
    const bf16* QK = (const bf16*)(ws + WS_QK); const bf16* U = (const bf16*)(ws + WS_U); bf16* A2 = (bf16*)(ws + WS_HA);
    const int qrow = (ctxq ? MLAT + b * CTXL : b * SEQ) + qt * 128 + wid * 16 + fr;
    const int nkt = ctxq ? 4 : 36;
    bf16x8 qf[2][2];
#pragma unroll
    for (int c = 0; c < 2; ++c)
#pragma unroll
        for (int ks = 0; ks < 2; ++ks) qf[c][ks] = *(const bf16x8*)(QK + (size_t)qrow * 1024 + h * 128 + c * 64 + ks * 32 + fq * 8);
    f32x4 O[2][8];
#pragma unroll
    for (int c = 0; c < 2; ++c)
#pragma unroll
        for (int d = 0; d < 8; ++d) O[c][d] = (f32x4){0.f, 0.f, 0.f, 0.f};
    float mrun[2] = {-3.0e38f, -3.0e38f}, lrun[2] = {0.f, 0.f};
    uint4 kreg[2], vreg[2];
#define AT_LOAD(kt) do { const int kr0_ = ((kt) < 4 ? MLAT + b * CTXL + (kt) * 64 : b * SEQ + ((kt) - 4) * 64); \
        _Pragma("unroll") for (int j_ = 0; j_ < 2; ++j_) { const int id_ = tid + j_ * NT, key_ = id_ >> 4, part_ = id_ & 15; \
            kreg[j_] = *(const uint4*)(QK + (size_t)(kr0_ + key_) * 1024 + 512 + h * 128 + part_ * 8); \
            vreg[j_] = *(const uint4*)(U + (size_t)(kr0_ + key_) * NINP + C_DA_V + h * 128 + part_ * 8); } } while (0)
#define AT_STORE(kt) do { LAS bf16* Ks_ = (LAS bf16*)(lds + ((kt) & 1) * AT_BUF); LAS bf16* Vs_ = (LAS bf16*)(lds + ((kt) & 1) * AT_BUF + AT_KB); \
        _Pragma("unroll") for (int j_ = 0; j_ < 2; ++j_) { const int id_ = tid + j_ * NT, key_ = id_ >> 4, part_ = id_ & 15; \
            *(LAS u32x4*)(Ks_ + key_ * AT_KP + part_ * 8) = (u32x4){kreg[j_].x, kreg[j_].y, kreg[j_].z, kreg[j_].w}; \
            *(LAS u32x4*)(Vs_ + key_ * AT_VP + part_ * 8) = (u32x4){vreg[j_].x, vreg[j_].y, vreg[j_].z, vreg[j_].w}; } } while (0)
    __syncthreads();
    AT_LOAD(0); AT_STORE(0);
    __syncthreads();
    for (int kt = 0; kt < nkt; ++kt) {
        if (kt + 1 < nkt) AT_LOAD(kt + 1);
        const LAS bf16* Ks = (const LAS bf16*)(lds + (kt & 1) * AT_BUF); const LAS bf16* Vs = (const LAS bf16*)(lds + (kt & 1) * AT_BUF + AT_KB);
        f32x4 S[2][4];
#pragma unroll
        for (int c = 0; c < 2; ++c)
#pragma unroll
            for (int sb = 0; sb < 4; ++sb) { f32x4 acc = (f32x4){0.f, 0.f, 0.f, 0.f};
#pragma unroll
                for (int ks = 0; ks < 2; ++ks) { const bf16x8 kf = *(const LAS bf16x8*)(Ks + (sb * 16 + fr) * AT_KP + c * 64 + ks * 32 + fq * 8);
                    acc = __builtin_amdgcn_mfma_f32_16x16x32_bf16(kf, qf[c][ks], acc, 0, 0, 0); }
                S[c][sb] = acc; }
        bf16x8 pf[2][2];
#pragma unroll
        for (int c = 0; c < 2; ++c) {
            float mx = S[c][0][0];
#pragma unroll
            for (int sb = 0; sb < 4; ++sb)
#pragma unroll
                for (int e = 0; e < 4; ++e) mx = fmaxf(mx, S[c][sb][e]);
            mx = fmaxf(mx, swz16(mx)); mx = fmaxf(mx, shx32(mx, lane));
            const float mnew = fmaxf(mrun[c], mx), alpha = __builtin_amdgcn_exp2f(mrun[c] - mnew); mrun[c] = mnew;
            float ps = 0.f;
#pragma unroll
            for (int sb = 0; sb < 4; ++sb)
#pragma unroll
                for (int e = 0; e < 4; ++e) { const float pv = __builtin_amdgcn_exp2f(S[c][sb][e] - mnew); S[c][sb][e] = pv; ps += pv; }
            lrun[c] = lrun[c] * alpha + ps;
#pragma unroll
            for (int d = 0; d < 8; ++d) O[c][d] *= alpha;
#pragma unroll
            for (int kc = 0; kc < 2; ++kc) { u32x4 w; w.x = pk2(S[c][2 * kc][0], S[c][2 * kc][1]); w.y = pk2(S[c][2 * kc][2], S[c][2 * kc][3]); w.z = pk2(S[c][2 * kc + 1][0], S[c][2 * kc + 1][1]); w.w = pk2(S[c][2 * kc + 1][2], S[c][2 * kc + 1][3]);
                pf[c][kc] = __builtin_bit_cast(bf16x8, w); }
        }
#pragma unroll
        for (int kc = 0; kc < 2; ++kc)
#pragma unroll
            for (int d = 0; d < 8; ++d) {
                const LAS bf16* pa = Vs + (kc * 32 + 4 * fq + q4) * AT_VP + d * 16 + 4 * p4;
                const bf16x8 vf = trfrag(pa, pa + 16 * AT_VP);
                O[0][d] = __builtin_amdgcn_mfma_f32_16x16x32_bf16(vf, pf[0][kc], O[0][d], 0, 0, 0);
                O[1][d] = __builtin_amdgcn_mfma_f32_16x16x32_bf16(vf, pf[1][kc], O[1][d], 0, 0, 0);
            }
        if (kt + 1 < nkt) AT_STORE(kt + 1);
        __syncthreads();
    }
#undef AT_LOAD
#undef AT_STORE
    float l0 = lrun[0], l1 = lrun[1];
    l0 += swz16(l0); l0 += shx32(l0, lane); l1 += swz16(l1); l1 += shx32(l1, lane);
    const float i0 = 1.0f / l0, i1 = lam / l1;
    float ss = 0.f;
#pragma unroll
    for (int d = 0; d < 8; ++d)
#pragma unroll
        for (int e = 0; e < 4; ++e) { const float o = O[0][d][e] * i0 - O[1][d][e] * i1; O[0][d][e] = o; ss += o * o; }
    ss += swz16(ss); ss += shx32(ss, lane);
    const float rs = rsqrtf(ss * (1.0f / 128.0f) + 1e-5f) * post;
    const float* sw = ldin(30) + l * 128;
#pragma unroll
    for (int d = 0; d < 8; ++d) { const int dc = d * 16 + 4 * fq; const float4 w4 = *(const float4*)(sw + dc);
        uint2 pk; pk.x = pk2(O[0][d][0] * rs * w4.x, O[0][d][1] * rs * w4.y); pk.y = pk2(O[0][d][2] * rs * w4.z, O[0][d][3] * rs * w4.w);
        *(uint2*)(A2 + (size_t)qrow * DM + 1536 + h * 128 + dc) = pk; }
}

__device__ __forceinline__ int q_pull(unsigned* ctr, volatile LAS unsigned* slot, int tid) {
    __syncthreads();
    if (tid == 0) *slot = __hip_atomic_fetch_add(ctr, 1u, __ATOMIC_RELAXED, __HIP_MEMORY_SCOPE_AGENT);
    __syncthreads();
    return (int)*slot;
}
__device__ __forceinline__ void p6_mixers(const Ctx& a, LAS unsigned char* lds, int l, int bid, int G) {
    unsigned char* ws = opqp(a.ws); const int tid = ((a.wv << 6) | lane_v());
    volatile LAS unsigned* slot = (volatile LAS unsigned*)(lds + LDS_STAGE + 8);
    unsigned* qm = (unsigned*)(ws + WS_CTL) + CW_Q + (l * 2 + 0) * 64; unsigned* qa = (unsigned*)(ws + WS_CTL) + CW_Q + (l * 2 + 1) * 64;
    if (a.sub & 1) for (int it = bid; it < 32; it += G) rwkv_r2(a, l, it);
    if (a.sub & 4) {
    const float* lp = ldin(29) + l * 256; float s01 = 0.f, s23 = 0.f;
    for (int i = 0; i < 64; ++i) { s01 += lp[i] * lp[64 + i]; s23 += lp[128 + i] * lp[192 + i]; }
    const float lam_init = l == 0 ? 0.2f : (0.8f - 0.6f * 0.74081822068f);
    const float lam = expf(s01) - expf(s23) + lam_init, post = 1.0f - lam_init;
    const int nat = l == 0 ? 576 : 512;
    for (;;) { const int it = q_pull(qa, slot, tid); if (it >= nat) break;
        if (it < 512) { const int qt = it & 15, h = (it >> 4) & 3, b = it >> 6; attn_item(a, lds, l, b, h, qt, false, lam, post); }
        else { const int i2 = it - 512; const int qt = i2 & 1, h = (i2 >> 1) & 3, b = i2 >> 3; attn_item(a, lds, l, b, h, qt, true, lam, post); } }
    }
    if (a.sub & 2) { const int nit = l == 0 ? 8 * MB_NCH * 2 : 8 * 16 * 2;
        for (;;) { const int it = q_pull(qm, slot, tid); if (it >= nit) break;
            const int g = it & 1; int cc, b; if (l == 0) { cc = (it >> 1) % MB_NCH; b = (it >> 1) / MB_NCH; } else { cc = 2 + ((it >> 1) & 15); b = it >> 5; } mamba_m3(a, lds, b, cc, g); } }
}


constexpr int N_PHASES = 27;
__global__ void __launch_bounds__(NT, 2) fwd(Args args) {
    extern __shared__ __attribute__((aligned(16))) unsigned char lds_dyn[];
    LAS unsigned char* lds = (LAS unsigned char*)lds_dyn;
    volatile LAS unsigned* MISC = (volatile LAS unsigned*)(lds + LDS_STAGE);
    const int wv = __builtin_amdgcn_readfirstlane((int)threadIdx.x >> 6);
    const int tid = (wv << 6) | lane_v(), bid = blockIdx.x, G = gridDim.x;
    unsigned char* ws = args.ws;
    const Ctx cx{ws, wv, args.sub};
    for (int u = tid; u < LDS_MISC / 4; u += NT) MISC[u] = 0u;
    __syncthreads();
    if (tid == 0) {
#pragma unroll
        for (int i = 0; i < 38; ++i) *(LAS unsigned long long*)(lds + LDS_PTRS + 8 * i) = (unsigned long long)args.in[i];
    }
    __syncthreads();
#if MK_PER_PHASE
#define GRID_BAR() do { } while (0)
#else
    XcdBarrier bar = xcd_barrier_post((unsigned*)(ws + WS_CTL) + CW_BAR, MISC);
#define GRID_BAR() do { XcdBarrier b_ = bar; b_.bar = opqp(b_.bar); b_.x = (unsigned)opqs((int)b_.x); xcd_barrier(b_); } while (0)
#endif
    const int lo = args.ph_lo, hi = args.ph_hi;
#define IN(k) (opqs(lo) <= (k) && (k) < opqs(hi))
#define SEAM(k) do { if (IN((k) + 1)) GRID_BAR(); } while (0)

#define XS (args.out)
#define XSB ((float*)(wsq + WS_XSB))
#define XC ((float*)(wsq + WS_XC))
#define HA ((bf16*)(wsq + WS_HA))
#define Ub ((bf16*)(wsq + WS_U))
#define MIX ((float*)(wsq + WS_MIX))
#define HID ((bf16*)(wsq + WS_BIG))
#define PH_LOCALS unsigned char* const wsq = opqp(ws); const int bidq = opqs(bid), Gq = opqs(G); (void)wsq; (void)bidq; (void)Gq

    if (IN(0)) { PH_LOCALS; if (args.sub & 64) bg_convert(cx, lds, nullptr, Gq); else p0_prologue(cx, lds,  bidq, Gq); SEAM(0); }
    if (IN(1)) { PH_LOCALS;
        thin_phase<0, 1>(cx, lds,  bidq, Gq, MTOT, ldin(0), ldin(2), nullptr, nullptr, nullptr, nullptr, 0, 0, ldin(6), 0, 1, 0);
        SEAM(1);
    }
    for (int l = 0; l < 2; ++l) {
        const int pb = 2 + 12 * l;
        const int Mo = l == 0 ? MTOT : MLAT;
        if (IN(pb + 0)) { PH_LOCALS;
            pg8::Gemm g{HA, (const bf16*)(wsq + WS_WIN) + (size_t)l * NINP * DM, MTOT, NINP, DM}; pg8::StaticOrder S; S.init(MTOT, NINP, Gq, bidq);
            pg8::EpiBf16P E{Ub, NINP, 0, 1.0f};
            pg8::gemm_phase<pg8::EpiBf16P, pg8::StaticOrder>(lds, g, S, E, nullptr, (wv << 6) | lane_v());
            bg_tail(cx, lds, l * 8 + 0, Gq);
            SEAM(pb + 0);
        }
        if (IN(pb + 1)) { PH_LOCALS; feat_a(cx, l,  bidq, Gq); SEAM(pb + 1); }
        if (IN(pb + 2)) { PH_LOCALS;
            pg8::Gemm g{(const bf16*)(wsq + WS_ASM), (const bf16*)(wsq + WS_WSM) + (size_t)l * 2048 * 256, MTOT, 2048, 256}; pg8::StaticOrder S; S.init(MTOT, 2048, Gq, bidq);
            pg8::EpiF32 E{MIX, 2048, nullptr};
            pg8::gemm_phase<pg8::EpiF32, pg8::StaticOrder>(lds, g, S, E, nullptr, (wv << 6) | lane_v());
            for (int it = bidq; it < 8 * MB_NCH * 2; it += Gq) mamba_m1(cx, lds, it);
            bg_tail(cx, lds, l * 8 + 1, Gq);
            SEAM(pb + 2);
        }
        if (IN(pb + 4)) { PH_LOCALS; for (int it = bidq; it < 256; it += Gq) mamba_m2(cx, it);
            rc_consts(lds, l, (wv << 6) | lane_v());
            for (int u = bidq * NW + wv; u < RC_UNITS; u += Gq * NW) rwkv_r1(cx, lds, l, u); SEAM(pb + 4); }
        if (IN(pb + 5)) { PH_LOCALS; p6_mixers(cx, lds, l,  bidq, Gq); if (!(args.sub & 32)) bg_tail(cx, lds, l * 8 + 5, Gq); SEAM(pb + 5); }
        if (IN(pb + 6)) { PH_LOCALS; mix_out(cx, l, Mo,  bidq, Gq); SEAM(pb + 6); }
        if (IN(pb + 7)) { PH_LOCALS;
            pg8::Gemm g{HA, (const bf16*)(wsq + WS_WOUT) + (size_t)l * DM * DM, Mo, DM, DM}; pg8::StaticOrder S; S.init(Mo, DM, Gq, bidq);
            pg8::EpiBf16P E{(bf16*)MIX, DM, 0, 1.0f};
            pg8::gemm_phase<pg8::EpiBf16P, pg8::StaticOrder>(lds, g, S, E, nullptr, (wv << 6) | lane_v());
            bg_tail(cx, lds, l * 8 + 2, Gq);
            SEAM(pb + 7);
        }
        if (l == 0) {
            if (IN(pb + 8)) { PH_LOCALS;
                thin_phase<1, DENSE_GU8 ? 3 : 1, 0, 1>(cx, lds,  bidq, Gq, MTOT, ldin(0), ldin(2), XSB, XC, MIX, ldin(7), 0, 2, ldin(8), 0, 4, 3);
                SEAM(pb + 8);
            }
            if (IN(pb + 9)) { PH_LOCALS;
                pg8::StaticOrder S; S.init(MTOT, 2 * FF, Gq, bidq);
#if DENSE_GU8 && DENSE_D8
                pg8::Gemm g{HA, (const bf16*)(wsq + WS_WGU), MTOT, 2 * FF, DM / 2};
                pg8::EpiSwiGLU8 E{(unsigned char*)(wsq + WS_BIG), FF, 0, 1.0f / MOE_SGU, MOE_SH};
                pg8::gemm_phase<pg8::EpiSwiGLU8, pg8::StaticOrder, false, true>(lds, g, S, E, nullptr, (wv << 6) | lane_v());
#elif DENSE_GU8
                pg8::Gemm g{HA, (const bf16*)(wsq + WS_WGU), MTOT, 2 * FF, DM / 2};
                pg8::EpiSwiGLUS E{HID, FF, 0, 1.0f / MOE_SGU};
                pg8::gemm_phase<pg8::EpiSwiGLUS, pg8::StaticOrder, false, true>(lds, g, S, E, nullptr, (wv << 6) | lane_v());
#elif DENSE_D8
                pg8::Gemm g{HA, (const bf16*)(wsq + WS_WGU), MTOT, 2 * FF, DM};
                pg8::EpiSwiGLU8 E{(unsigned char*)(wsq + WS_BIG), FF, 0, 1.0f, MOE_SH};
                pg8::gemm_phase<pg8::EpiSwiGLU8, pg8::StaticOrder>(lds, g, S, E, nullptr, (wv << 6) | lane_v());
#else
                pg8::Gemm g{HA, (const bf16*)(wsq + WS_WGU), MTOT, 2 * FF, DM};
                pg8::EpiSwiGLU E{HID, FF, 0};
                pg8::gemm_phase<pg8::EpiSwiGLU, pg8::StaticOrder>(lds, g, S, E, nullptr, (wv << 6) | lane_v());
#endif
                bg_tail(cx, lds, 3, Gq);
                SEAM(pb + 9);
            }
            if (IN(pb + 10)) { PH_LOCALS;
                pg8::StaticOrder S; S.init(MTOT, DM, Gq, bidq);
#if DENSE_D8
                pg8::Gemm g{HID, (const bf16*)(wsq + WS_WD), MTOT, DM, FF / 2};
                pg8::EpiBf16P E{(bf16*)MIX, DM, 0, 1.0f / (MOE_SD * MOE_SH)};
                pg8::gemm_phase<pg8::EpiBf16P, pg8::StaticOrder, false, true>(lds, g, S, E, nullptr, (wv << 6) | lane_v());
#else
                pg8::Gemm g{HID, (const bf16*)(wsq + WS_WD), MTOT, DM, FF};
                pg8::EpiBf16P E{(bf16*)MIX, DM, 0, 1.0f};
                pg8::gemm_phase<pg8::EpiBf16P, pg8::StaticOrder>(lds, g, S, E, nullptr, (wv << 6) | lane_v());
#endif
                bg_tail(cx, lds, 4, Gq);
                SEAM(pb + 10);
            }
            if (IN(pb + 11)) { PH_LOCALS;
                thin_phase<1, 1, 1, 1>(cx, lds,  bidq, Gq, MTOT, XSB, XC, XSB, XC, MIX, ldin(9), 0, 5, ldin(6) + DM, 1, 1, 0);
                SEAM(pb + 11);
            }
        } else {
            if (IN(pb + 8)) { PH_LOCALS;
                thin_phase<1, 2, 1, 1>(cx, lds,  bidq, Gq, MLAT, XSB, XC, XSB, XC, MIX, ldin(7) + DM, 1, 2, ldin(8) + DM, 1, 4, 3);
                SEAM(pb + 8);
            }
            if (IN(pb + 9)) { PH_LOCALS; moe_gather(cx,  bidq, Gq); bg_convert(cx, lds, nullptr, Gq); SEAM(pb + 9); }
            if (IN(pb + 10) || IN(pb + 11)) { PH_LOCALS;
                if (((wv << 6) | lane_v()) == 0) { const unsigned* cnt = (const unsigned*)(wsq + WS_CTL) + CW_CNT; int run = 0;
                    for (int e = 0; e < 8; ++e) { const int t = (int)((cnt[e * 64] + 255u) >> 8); MISC[16 + e] = (unsigned)t; MISC[24 + e] = (unsigned)run; run += t; } }
                __syncthreads();
            }
            if (IN(pb + 10)) { PH_LOCALS;
                pg8::MoeOrder S{(const LAS int*)(lds + LDS_STAGE + 64), (2 * FE) / 256, Gq, bidq};
#if MOE_FP8
                pg8::Gemm g{(const bf16*)(wsq + WS_U), (const bf16*)(wsq + WS_MGU), MOE_ROWS, 2 * FE, DM / 2};
                pg8::EpiSwiGLU8 E{(unsigned char*)(wsq + WS_BIG), FE, (2 * FE) / 256, 1.0f / MOE_SGU, MOE_SH};
                pg8::gemm_phase<pg8::EpiSwiGLU8, pg8::MoeOrder, false, true>(lds, g, S, E, nullptr, (wv << 6) | lane_v());
#else
                pg8::Gemm g{(const bf16*)(wsq + WS_U), (const bf16*)(wsq + WS_MGU), MOE_ROWS, 2 * FE, DM};
                pg8::EpiSwiGLU E{HID, FE, (2 * FE) / 256};
                pg8::gemm_phase<pg8::EpiSwiGLU, pg8::MoeOrder>(lds, g, S, E, nullptr, (wv << 6) | lane_v());
#endif
                SEAM(pb + 10);
            }
            if (IN(pb + 11)) { PH_LOCALS;
                pg8::MoeOrder S{(const LAS int*)(lds + LDS_STAGE + 64), DM / 256, Gq, bidq};
#if MOE_FP8
                pg8::Gemm g{HID, (const bf16*)(wsq + WS_MD), MOE_ROWS, DM, FE / 2};
                pg8::EpiBf16P E{(bf16*)(wsq + WS_MIX), DM, DM / 256, 1.0f / (MOE_SD * MOE_SH)};
                pg8::gemm_phase<pg8::EpiBf16P, pg8::MoeOrder, false, true>(lds, g, S, E, nullptr, (wv << 6) | lane_v());
#else
                pg8::Gemm g{HID, (const bf16*)(wsq + WS_MD), MOE_ROWS, DM, FE};
                pg8::EpiBf16P E{(bf16*)(wsq + WS_MIX), DM, DM / 256, 1.0f};
                pg8::gemm_phase<pg8::EpiBf16P, pg8::MoeOrder>(lds, g, S, E, nullptr, (wv << 6) | lane_v());
#endif
                SEAM(pb + 11);
            }
            if (IN(pb + 12)) { PH_LOCALS;
                thin_phase<2, 0, 1, 0>(cx, lds,  bidq, Gq, MLAT, XSB, XC, XS, XC, nullptr, ldin(9) + DM, 1, 5, nullptr, 0, 0, 0);
            }
        }
    }
#undef IN
#undef SEAM
}

extern "C" void kernel_launch(void* const* d_in, const int* in_sizes, int n_in, void* d_out, int out_size, void* d_ws, size_t ws_size, hipStream_t stream) {
    static int grid = 0;
    if (grid == 0) {
        if (n_in != 38 || out_size != MLAT * DM || ws_size < WS_END) { fprintf(stderr, "kernel_launch: unexpected shapes (n_in %d out %d ws %zu need %zu)\n", n_in, out_size, ws_size, (size_t)WS_END); grid = -1; return; }
        int dev = 0, cus = 0, per_cu = 0;
        if (hipGetDevice(&dev) != hipSuccess || hipDeviceGetAttribute(&cus, hipDeviceAttributeMultiprocessorCount, dev) != hipSuccess) { grid = -1; return; }
        if (hipFuncSetAttribute((const void*)fwd, hipFuncAttributeMaxDynamicSharedMemorySize, LDS_BYTES) != hipSuccess) { fprintf(stderr, "kernel_launch: hipFuncSetAttribute failed\n"); grid = -1; return; }
        if (hipOccupancyMaxActiveBlocksPerMultiprocessor(&per_cu, (const void*)fwd, NT, LDS_BYTES) != hipSuccess || per_cu < 1) { fprintf(stderr, "kernel_launch: occupancy query says %d\n", per_cu); per_cu = 1; }
        (void)hipGetLastError();
        grid = cus;
    }
    if (grid < 0) return;
    if (hipMemsetAsync((char*)d_ws + WS_CTL, 0, CTL_BYTES, stream) != hipSuccess) return;
    Args a{};
    for (int i = 0; i < 38; ++i) a.in[i] = (const float*)d_in[i];
    a.out = (float*)d_out; a.ws = (unsigned char*)d_ws; a.sub = 7;
#if MK_PER_PHASE
#ifndef PROBE_SUB
#define PROBE_SUB 7
#endif
#ifndef PROBE_MASK
#define PROBE_MASK 0u
#endif
#ifndef PROBE_SPLIT
#define PROBE_SPLIT 0
#endif
#ifndef PROBE_REP
#define PROBE_REP 1
#endif
    for (int p = 0; p < N_PHASES; ++p) { a.ph_lo = p; a.ph_hi = p + 1;
        if (PROBE_SPLIT && (p == 7 || p == 19)) {
            a.sub = 1; hipLaunchKernelGGL(fwd, dim3(grid), dim3(NT), LDS_BYTES, stream, a);
            if (PROBE_SPLIT == 1) { a.sub = 2; hipLaunchKernelGGL(fwd, dim3(grid), dim3(NT), LDS_BYTES, stream, a); a.sub = 4; hipLaunchKernelGGL(fwd, dim3(grid), dim3(NT), LDS_BYTES, stream, a); }
            else if (PROBE_SPLIT == 2) { a.sub = 6; hipLaunchKernelGGL(fwd, dim3(grid), dim3(NT), LDS_BYTES, stream, a); }
            else { a.sub = 2; hipLaunchKernelGGL(fwd, dim3(grid), dim3(NT), LDS_BYTES, stream, a); a.sub = 5; hipLaunchKernelGGL(fwd, dim3(grid), dim3(NT), LDS_BYTES, stream, a); }
            a.sub = 7; continue; }
        if ((PROBE_MASK >> p) & 1u) { a.sub = PROBE_SUB;
            for (int rep = 0; rep < PROBE_REP; ++rep) { if (rep) (void)hipMemsetAsync((char*)d_ws + WS_CTL + CW_BG * 4, 0, 256, stream); hipLaunchKernelGGL(fwd, dim3(grid), dim3(NT), LDS_BYTES, stream, a); }
            a.sub = 7;
            (void)hipMemsetAsync((char*)d_ws + WS_CTL + CW_Q * 4, 0, 4 * 256, stream); }
        hipLaunchKernelGGL(fwd, dim3(grid), dim3(NT), LDS_BYTES, stream, a); }
#else
    a.ph_lo = 0; a.ph_hi = N_PHASES; hipLaunchKernelGGL(fwd, dim3(grid), dim3(NT), LDS_BYTES, stream, a);
#endif
}
```

```cpp
#include <hip/hip_runtime.h>
#include <cstdio>
#include <cstdint>

#ifndef MK_PER_PHASE
#define MK_PER_PHASE 0
#endif

#define GAS __attribute__((address_space(1)))
#define LAS __attribute__((address_space(3)))
typedef GAS unsigned gu32;
typedef GAS unsigned long long gu64;

__device__ __forceinline__ int opq(int x) { asm volatile("" : "+v"(x)); return x; }
template <class T> __device__ __forceinline__ T* opqp(T* p) { int z = 0; asm volatile("" : "+s"(z)); return (T*)((unsigned char*)p + z); }
__device__ __forceinline__ int opqs(int x) { asm volatile("" : "+s"(x)); return x; }

__device__ __forceinline__ int lane_v() { int l; asm volatile("v_mbcnt_lo_u32_b32 %0, -1, 0\n\tv_mbcnt_hi_u32_b32 %0, -1, %0" : "=v"(l)); return l; }

namespace pg8 {
#define PG8_LAS __attribute__((address_space(3)))
typedef unsigned short bf16_t;
typedef short bf16x8 __attribute__((ext_vector_type(8)));
typedef float f32x4 __attribute__((ext_vector_type(4)));
typedef unsigned u32x4 __attribute__((ext_vector_type(4)));
typedef int i32x4 __attribute__((ext_vector_type(4)));
typedef int i32x8 __attribute__((ext_vector_type(8)));
constexpr int BM = 256, BK = 64, HALF = 128, HTB = HALF * BK * 2  , STAGE_BYTES = 8 * HTB, NXCD = 8, WGM = 8;

__host__ __device__ __forceinline__ int lds_byte(int r, int c) { const int st = (r >> 4) * 2 + (c >> 5), rr = r & 15, cc = c & 31, ob = rr * 64 + cc * 2; return st * 1024 + (ob ^ (((ob >> 9) & 1) << 5)); }
__host__ __device__ __forceinline__ void stage_rc(int b, int& R, int& C) { const int st = b / 1024, sb = b % 1024, swz = sb ^ (((sb >> 9) & 1) << 5); R = (st >> 1) * 16 + swz / 64; C = (st & 1) * 32 + (swz % 64) / 2; }
__host__ __device__ __forceinline__ int perm32(int rho) { const int n = rho >> 4, i = rho & 15; return 8 * (i >> 2) + 4 * n + (i & 3); }

struct Unit { int pm, pn; };
struct Gemm { const bf16_t* A; const bf16_t* Bt; int M, N, K; };

struct StaticOrder {
    int nM, nN, nwg, G, c;
    __host__ __device__ void init(int M, int N, int G_, int c_) { nM = M / BM; nN = N / BM; nwg = nM * nN; G = G_; c = c_; }
    __host__ __device__ bool next(int i, Unit& u) const {
        const long L = (long)i * G + c; if (L >= nwg) return false;
        int wgid = (int)L; { const int q = nwg / NXCD, r = nwg % NXCD, xcd = wgid % NXCD, off = wgid / NXCD; wgid = (xcd < r ? xcd * (q + 1) : r * (q + 1) + (xcd - r) * q) + off; }
        const int nig = WGM * nN, gid = wgid / nig, fm = gid * WGM, gsz = (nM - fm) < WGM ? (nM - fm) : WGM;
        u.pm = fm + ((wgid % nig) % gsz); u.pn = (wgid % nig) / gsz; return true;
    }
    __device__ __forceinline__ void a_ready(const Unit&) const {}
    __device__ __forceinline__ void done(const Unit&) const {}
};
__device__ __forceinline__ unsigned cvt_pk_bf16(float lo, float hi) { unsigned r; asm volatile("v_cvt_pk_bf16_f32 %0, %1, %2" : "=v"(r) : "v"(lo), "v"(hi)); return r; }
struct EpiF32 {
    static constexpr bool PERM = false, AFTER_DRAIN = false;
    float* C; int ldc; const float* bias;
    __device__ __forceinline__ void operator()(const f32x4 (&acc)[2][2][4][2], const Unit& u, int wr, int wc, int fr, int fq) const {
        const int row0 = u.pm * BM + wr * 64 + fr, col0 = u.pn * BM + wc * 32 + 4 * fq;
        f32x4 bv[2][2];
#pragma unroll
        for (int bj = 0; bj < 2; ++bj)
#pragma unroll
            for (int n = 0; n < 2; ++n) bv[bj][n] = bias ? *(const f32x4*)(bias + col0 + bj * HALF + n * 16) : (f32x4){0.f, 0.f, 0.f, 0.f};
#pragma unroll
        for (int ai = 0; ai < 2; ++ai)
#pragma unroll
            for (int m = 0; m < 4; ++m) { float* rowp = C + (size_t)(row0 + ai * HALF + m * 16) * ldc + col0;
#pragma unroll
                for (int bj = 0; bj < 2; ++bj)
#pragma unroll
                    for (int n = 0; n < 2; ++n) *(f32x4*)(rowp + bj * HALF + n * 16) = acc[ai][bj][m][n] + bv[bj][n]; }
    }
};

__device__ __forceinline__ float fsilu(float x) { return x * __builtin_amdgcn_rcpf(1.0f + __expf(-x)); }
__device__ __forceinline__ float fsigm(float x) { return __builtin_amdgcn_rcpf(1.0f + __expf(-x)); }

struct MoeOrder {
    const PG8_LAS int* tab; int nN, G, c;
    __device__ __forceinline__ bool next(int i, Unit& u) const {
        long L = (long)i * G + c;
#pragma unroll
        for (int e = 0; e < 8; ++e) { const int te = tab[e]; const long n = (long)te * nN; if (L < n) { u.pn = e * nN + (int)(L / te); u.pm = tab[8 + e] + (int)(L % te); return true; } L -= n; }
        return false;
    }
    __device__ __forceinline__ void a_ready(const Unit&) const {}
    __device__ __forceinline__ void done(const Unit&) const {}
};

struct EpiBf16P {
    static constexpr bool PERM = true, AFTER_DRAIN = false;
    bf16_t* O; int ldc; int nN; float scale;
    __device__ __forceinline__ void operator()(const f32x4 (&acc)[2][2][4][2], const Unit& u, int wr, int wc, int fr, int fq) const {
        const int row0 = u.pm * BM + wr * 64 + fr; const int pnr = nN ? (u.pn % nN) : u.pn; const int col0 = pnr * BM + wc * 32 + 8 * fq;
#pragma unroll
        for (int ai = 0; ai < 2; ++ai)
#pragma unroll
            for (int m = 0; m < 4; ++m) { bf16_t* rowp = O + (size_t)(row0 + ai * HALF + m * 16) * ldc + col0;
#pragma unroll
                for (int bj = 0; bj < 2; ++bj) { const f32x4 v0 = acc[ai][bj][m][0] * scale, v1 = acc[ai][bj][m][1] * scale;
                    u32x4 w; w.x = cvt_pk_bf16(v0[0], v0[1]); w.y = cvt_pk_bf16(v0[2], v0[3]); w.z = cvt_pk_bf16(v1[0], v1[1]); w.w = cvt_pk_bf16(v1[2], v1[3]);
                    *(u32x4*)(rowp + bj * HALF) = w; } }
    }
};

struct EpiSwiGLU {
    static constexpr bool PERM = true, AFTER_DRAIN = false;
    bf16_t* O; int ldc; int nN;
    __device__ __forceinline__ void operator()(const f32x4 (&acc)[2][2][4][2], const Unit& u, int wr, int wc, int fr, int fq) const {
        const int row0 = u.pm * BM + wr * 64 + fr; const int pnr = nN ? (u.pn % nN) : u.pn; const int col0 = pnr * HALF + wc * 32 + 8 * fq;
#pragma unroll
        for (int ai = 0; ai < 2; ++ai)
#pragma unroll
            for (int m = 0; m < 4; ++m) { bf16_t* rowp = O + (size_t)(row0 + ai * HALF + m * 16) * ldc + col0;
                const f32x4 g0 = acc[ai][0][m][0], g1 = acc[ai][0][m][1], u0 = acc[ai][1][m][0], u1 = acc[ai][1][m][1];
                f32x4 v0, v1;
#pragma unroll
                for (int j = 0; j < 4; ++j) { v0[j] = fsilu(g0[j]) * u0[j]; v1[j] = fsilu(g1[j]) * u1[j]; }
                u32x4 w; w.x = cvt_pk_bf16(v0[0], v0[1]); w.y = cvt_pk_bf16(v0[2], v0[3]); w.z = cvt_pk_bf16(v1[0], v1[1]); w.w = cvt_pk_bf16(v1[2], v1[3]);
                *(u32x4*)rowp = w; }
    }
};


__device__ __forceinline__ float clamp8(float x) { return fminf(fmaxf(x, -448.0f), 448.0f); }
__device__ __forceinline__ unsigned pk_fp8x4(float a, float b, float c, float d) { int w = __builtin_amdgcn_cvt_pk_fp8_f32(clamp8(a), clamp8(b), 0, false); w = __builtin_amdgcn_cvt_pk_fp8_f32(clamp8(c), clamp8(d), w, true); return (unsigned)w; }
struct EpiSwiGLUS {
    static constexpr bool PERM = true, AFTER_DRAIN = false;
    bf16_t* O; int ldc; int nN; float sin;
    __device__ __forceinline__ void operator()(const f32x4 (&acc)[2][2][4][2], const Unit& u, int wr, int wc, int fr, int fq) const {
        const int row0 = u.pm * BM + wr * 64 + fr; const int pnr = nN ? (u.pn % nN) : u.pn; const int col0 = pnr * HALF + wc * 32 + 8 * fq;
#pragma unroll
        for (int ai = 0; ai < 2; ++ai)
#pragma unroll
            for (int m = 0; m < 4; ++m) { bf16_t* rowp = O + (size_t)(row0 + ai * HALF + m * 16) * ldc + col0;
                const f32x4 g0 = acc[ai][0][m][0] * sin, g1 = acc[ai][0][m][1] * sin, u0 = acc[ai][1][m][0] * sin, u1 = acc[ai][1][m][1] * sin;
                f32x4 v0, v1;
#pragma unroll
                for (int j = 0; j < 4; ++j) { v0[j] = fsilu(g0[j]) * u0[j]; v1[j] = fsilu(g1[j]) * u1[j]; }
                u32x4 w; w.x = cvt_pk_bf16(v0[0], v0[1]); w.y = cvt_pk_bf16(v0[2], v0[3]); w.z = cvt_pk_bf16(v1[0], v1[1]); w.w = cvt_pk_bf16(v1[2], v1[3]);
                *(u32x4*)rowp = w; }
    }
};


struct EpiSwiGLU8 {
    static constexpr bool PERM = true, AFTER_DRAIN = false;
    unsigned char* O; int ldc; int nN; float sin, sout;
    __device__ __forceinline__ void operator()(const f32x4 (&acc)[2][2][4][2], const Unit& u, int wr, int wc, int fr, int fq) const {
        const int row0 = u.pm * BM + wr * 64 + fr; const int pnr = nN ? (u.pn % nN) : u.pn; const int col0 = pnr * HALF + wc * 32 + 8 * fq;
#pragma unroll
        for (int ai = 0; ai < 2; ++ai)
#pragma unroll
            for (int m = 0; m < 4; ++m) { unsigned char* rowp = O + (size_t)(row0 + ai * HALF + m * 16) * ldc + col0;
                const f32x4 g0 = acc[ai][0][m][0] * sin, g1 = acc[ai][0][m][1] * sin, u0 = acc[ai][1][m][0] * (sin * sout), u1 = acc[ai][1][m][1] * (sin * sout);
                f32x4 v0, v1;
#pragma unroll
                for (int j = 0; j < 4; ++j) { v0[j] = fsilu(g0[j]) * u0[j]; v1[j] = fsilu(g1[j]) * u1[j]; }
                uint2 w; w.x = pk_fp8x4(v0[0], v0[1], v0[2], v0[3]); w.y = pk_fp8x4(v1[0], v1[1], v1[2], v1[3]);
                *(uint2*)rowp = w; }
    }
};


struct EpiF32S {
    static constexpr bool PERM = false, AFTER_DRAIN = false;
    float* C; int ldc; float scale;
    __device__ __forceinline__ void operator()(const f32x4 (&acc)[2][2][4][2], const Unit& u, int wr, int wc, int fr, int fq) const {
        const int row0 = u.pm * BM + wr * 64 + fr, col0 = u.pn * BM + wc * 32 + 4 * fq;
#pragma unroll
        for (int ai = 0; ai < 2; ++ai)
#pragma unroll
            for (int m = 0; m < 4; ++m) { float* rowp = C + (size_t)(row0 + ai * HALF + m * 16) * ldc + col0;
#pragma unroll
                for (int bj = 0; bj < 2; ++bj)
#pragma unroll
                    for (int n = 0; n < 2; ++n) *(f32x4*)(rowp + bj * HALF + n * 16) = acc[ai][bj][m][n] * scale; }
    }
};

template <class Epi, class Sched, bool STAMP = false, bool F8 = false>
__device__ __forceinline__ void gemm_phase(PG8_LAS unsigned char* lds, const Gemm g, const Sched& S, const Epi& E, unsigned long long* stamps, const int tid_in) {
    const int tid = opq(tid_in), wid = __builtin_amdgcn_readfirstlane(tid >> 6), lane = tid & 63, wr = wid >> 2, wc = wid & 3, fr = lane & 15, fq = lane >> 4;
    const int K = g.K, nt = K / BK;
    int ts_lo = 0, ts_hi = 0, nts = 0; const unsigned long long rt_entry = STAMP ? (unsigned long long)wall_clock64() : 0ull;
#define PG8_STAMP() do { if (STAMP && wid == 0 && nts < 64) { const unsigned long long _c = (unsigned long long)clock64(); \
        ts_lo = (lane == nts) ? (int)(unsigned)_c : ts_lo; ts_hi = (lane == nts) ? (int)(unsigned)(_c >> 32) : ts_hi; ++nts; } } while (0)
    PG8_STAMP();
    unsigned voffA[2], voffB[2];
#pragma unroll
    for (int i = 0; i < 2; ++i) { int R, C; stage_rc(tid * 16 + i * 8192, R, C); const int Rb = Epi::PERM ? ((R & ~31) + perm32(R & 31)) : R;
        voffA[i] = (unsigned)(R * K + C) * 2u; voffB[i] = (unsigned)(Rb * K + C) * 2u; }
    const size_t kstep = (size_t)(BK * 2);
    const size_t qstep = (size_t)64 * K * 2;
    const size_t hstep = (size_t)HALF * K * 2;
    const size_t tstep = 2 * hstep;
    const unsigned ldsw = (unsigned)wid * 1024u;
    const int aoff = lds_byte(wr * 64 + fr, fq * 8), boff = lds_byte(wc * 32 + fr, fq * 8);
#define PG8_SA(b, h) (((b) * 2 + (h)) * HTB)
#define PG8_SB(b, h) ((4 + (b) * 2 + (h)) * HTB)
#define PG8_STAGE(bufoff, gbase, voff) do { _Pragma("unroll") for (int _i = 0; _i < 2; ++_i) \
        __builtin_amdgcn_global_load_lds((const unsigned*)((const char*)(gbase) + (size_t)_i * qstep + (voff)[0]), (PG8_LAS unsigned*)(lds + (bufoff) + ldsw + _i * 8192), 16, 0, 0); } while (0)
#define PG8_LDA(dst, b, h) do { _Pragma("unroll") for (int m = 0; m < 4; ++m) { if constexpr (F8) { const i32x4 lo_ = *(const PG8_LAS i32x4*)(lds + PG8_SA(b, h) + aoff + m * 2048), hi_ = *(const PG8_LAS i32x4*)(lds + PG8_SA(b, h) + aoff + m * 2048 + 1024); \
            dst##8[m] = __builtin_shufflevector(lo_, hi_, 0, 1, 2, 3, 4, 5, 6, 7); } else { _Pragma("unroll") for (int k = 0; k < 2; ++k) dst[m][k] = *(const PG8_LAS bf16x8*)(lds + PG8_SA(b, h) + aoff + m * 2048 + k * 1024); } } } while (0)
#define PG8_LDB(dst, b, h) do { _Pragma("unroll") for (int n = 0; n < 2; ++n) { if constexpr (F8) { const i32x4 lo_ = *(const PG8_LAS i32x4*)(lds + PG8_SB(b, h) + boff + n * 2048), hi_ = *(const PG8_LAS i32x4*)(lds + PG8_SB(b, h) + boff + n * 2048 + 1024); \
            dst##8[n] = __builtin_shufflevector(lo_, hi_, 0, 1, 2, 3, 4, 5, 6, 7); } else { _Pragma("unroll") for (int k = 0; k < 2; ++k) dst[n][k] = *(const PG8_LAS bf16x8*)(lds + PG8_SB(b, h) + boff + n * 2048 + k * 1024); } } } while (0)
#define PG8_MMA(ai, bj, At, Bt) do { __builtin_amdgcn_s_setprio(1); _Pragma("unroll") for (int m = 0; m < 4; ++m) _Pragma("unroll") for (int n = 0; n < 2; ++n) { \
        if constexpr (F8) {   \
            asm volatile("v_mfma_scale_f32_16x16x128_f8f6f4 %0, %1, %2, %0, %3, %3 op_sel_hi:[0,0,0]" : "+v"(acc[ai][bj][m][n]) : "v"(Bt##8[n]), "v"(At##8[m]), "v"(f8scale)); } \
        else { _Pragma("unroll") for (int k = 0; k < 2; ++k) acc[ai][bj][m][n] = __builtin_amdgcn_mfma_f32_16x16x32_bf16(Bt[n][k], At[m][k], acc[ai][bj][m][n], 0, 0, 0); } } \
        __builtin_amdgcn_s_setprio(0); } while (0)
#define PG8_WAIT_V(n) asm volatile("s_waitcnt vmcnt(" #n ")" ::: "memory")
#define PG8_WAIT_L(n) asm volatile("s_waitcnt lgkmcnt(" #n ")" ::: "memory")
#define PG8_BAR __builtin_amdgcn_s_barrier()
#define PG8_SCHED __builtin_amdgcn_sched_barrier(0)
    float zf_ = 0.f; asm volatile("" : "+v"(zf_));
    Unit cur, nxt; int ui = 0;
    if (!S.next(0, cur)) return;
    f32x4 acc[2][2][4][2];
#pragma unroll
    for (int a = 0; a < 2; ++a)
#pragma unroll
        for (int b = 0; b < 2; ++b)
#pragma unroll
            for (int m = 0; m < 4; ++m)
#pragma unroll
                for (int n = 0; n < 2; ++n) acc[a][b][m][n] = (f32x4){zf_, zf_, zf_, zf_};
    int f8scale = 0x7F7F7F7F; asm volatile("" : "+v"(f8scale));
    bf16x8 At[4][2], B0[2][2], B1[2][2]; i32x8 At8[4], B08[2], B18[2]; (void)At; (void)B0; (void)B1; (void)At8; (void)B08; (void)B18;
    const char* cA = (const char*)g.A + (size_t)cur.pm * tstep; const char* cB = (const char*)g.Bt + (size_t)cur.pn * tstep;
    S.a_ready(cur);
    PG8_STAGE(PG8_SB(0, 0), cB, voffB); PG8_STAGE(PG8_SA(0, 0), cA, voffA); PG8_STAGE(PG8_SB(0, 1), cB + hstep, voffB); PG8_STAGE(PG8_SA(0, 1), cA + hstep, voffA);
    if (wr == 1) PG8_BAR;
    PG8_WAIT_V(4); PG8_BAR;
    PG8_STAGE(PG8_SB(1, 0), cB + kstep, voffB); PG8_STAGE(PG8_SA(1, 0), cA + kstep, voffA); PG8_STAGE(PG8_SB(1, 1), cB + hstep + kstep, voffB);
    PG8_WAIT_V(6); PG8_BAR;
    PG8_STAMP();
    for (;;) {
        const bool has_next = S.next(ui + 1, nxt);
        const char* nA = has_next ? (const char*)g.A + (size_t)nxt.pm * tstep : cA; const char* nB = has_next ? (const char*)g.Bt + (size_t)nxt.pn * tstep : cB;
        for (int t = 0; t < nt; t += 2) {
            const bool last = (t == nt - 2);
            const char* a1 = cA + (size_t)(t + 1) * kstep;
            const char* a2 = last ? nA : cA + (size_t)(t + 2) * kstep; const char* b2 = last ? nB : cB + (size_t)(t + 2) * kstep;
            const char* a3 = a2 + kstep; const char* b3 = b2 + kstep;
            if (last && has_next) S.a_ready(nxt);
            PG8_LDB(B0, 0, 0); PG8_SCHED; PG8_LDA(At, 0, 0); PG8_STAGE(PG8_SA(1, 1), a1 + hstep, voffA);
            PG8_WAIT_L(8); PG8_BAR; PG8_WAIT_L(0); PG8_MMA(0, 0, At, B0); PG8_BAR; PG8_SCHED;
            PG8_LDB(B1, 0, 1); PG8_STAGE(PG8_SB(0, 0), b2, voffB);
            PG8_BAR; PG8_WAIT_L(0); PG8_MMA(0, 1, At, B1); PG8_BAR;
            PG8_LDA(At, 0, 1); PG8_STAGE(PG8_SA(0, 0), a2, voffA);
            PG8_BAR; PG8_WAIT_L(0); PG8_MMA(1, 0, At, B0); PG8_BAR; PG8_SCHED;
            PG8_STAGE(PG8_SB(0, 1), b2 + hstep, voffB);
            PG8_WAIT_V(6); PG8_BAR; PG8_MMA(1, 1, At, B1); PG8_BAR;
            PG8_LDB(B0, 1, 0); PG8_SCHED; PG8_LDA(At, 1, 0); PG8_STAGE(PG8_SA(0, 1), a2 + hstep, voffA);
            PG8_WAIT_L(8); PG8_BAR; PG8_WAIT_L(0); PG8_MMA(0, 0, At, B0); PG8_BAR; PG8_SCHED;
            PG8_LDB(B1, 1, 1); PG8_STAGE(PG8_SB(1, 0), b3, voffB);
            PG8_BAR; PG8_WAIT_L(0); PG8_MMA(0, 1, At, B1); PG8_BAR;
            PG8_LDA(At, 1, 1); PG8_STAGE(PG8_SA(1, 0), a3, voffA);
            PG8_BAR; PG8_WAIT_L(0); PG8_MMA(1, 0, At, B0); PG8_BAR; PG8_SCHED;
            PG8_STAGE(PG8_SB(1, 1), b3 + hstep, voffB);
            PG8_WAIT_V(6); PG8_BAR; PG8_MMA(1, 1, At, B1); PG8_BAR;
        }
        PG8_STAMP();
        if constexpr (F8) { asm volatile("s_nop 15\n\ts_nop 15" ::: "memory"); }
        if constexpr (!Epi::AFTER_DRAIN) { E(acc, cur, wr, wc, fr, fq); S.done(cur); }
        PG8_STAMP();
        if (!has_next) break;
#pragma unroll
        for (int a = 0; a < 2; ++a)
#pragma unroll
            for (int b = 0; b < 2; ++b)
#pragma unroll
                for (int m = 0; m < 4; ++m)
#pragma unroll
                    for (int n = 0; n < 2; ++n) acc[a][b][m][n] = (f32x4){zf_, zf_, zf_, zf_};
        cur = nxt; cA = nA; cB = nB; ++ui;
    }
    PG8_WAIT_V(0);
    if (wr == 0) PG8_BAR;
    PG8_BAR;
    if constexpr (Epi::AFTER_DRAIN) { E.fused(acc, cur, wr, wc, fr, fq, lds, wid, lane); S.done(cur); }
    PG8_STAMP();
    if (STAMP && wid == 0) { stamps[lane] = lane < nts ? (((unsigned long long)(unsigned)ts_hi << 32) | (unsigned)ts_lo) : 0ull;
        if (lane == 62) stamps[62] = rt_entry; if (lane == 63) stamps[63] = (unsigned long long)wall_clock64(); }
#undef PG8_STAMP
#undef PG8_SA
#undef PG8_SB
#undef PG8_STAGE
#undef PG8_LDA
#undef PG8_LDB
#undef PG8_MMA
#undef PG8_WAIT_V
#undef PG8_WAIT_L
#undef PG8_BAR
#undef PG8_SCHED
}
}
#define RLX_AGENT __ATOMIC_RELAXED, __HIP_MEMORY_SCOPE_AGENT
#define XB_TMO      128
#define XB_XCNT(j)  (256  + 64 * (j))
#define XB_XSUB(j)  (1280 + 64 * (j))
#define XB_XGEN(j)  (2304 + 64 * (j))
#define XB_TOP      3328
#define XB_TOPGEN   3392
#define XCD_BAR_WORDS 3456
#define XB_SPIN_CAP (1u << 18)

__device__ __forceinline__ unsigned xb_ld(unsigned* p)              { return __hip_atomic_load(p, __ATOMIC_RELAXED, __HIP_MEMORY_SCOPE_AGENT); }
__device__ __forceinline__ unsigned xb_add(unsigned* p, unsigned v) { return __hip_atomic_fetch_add(p, v, __ATOMIC_RELAXED, __HIP_MEMORY_SCOPE_AGENT); }
__device__ __forceinline__ unsigned xb_xcc_id() { return (unsigned)__builtin_amdgcn_s_getreg((3 << 11) | 20) & 0xFu; }
#define XB_SPIN(cond, bar) do { unsigned _sp = 0; while (cond) { __builtin_amdgcn_s_sleep(1); \
    if ((++_sp & 255u) == 0u) { if (xb_ld(&(bar)[XB_TMO])) break; if (_sp > XB_SPIN_CAP) { atomicAdd(&(bar)[XB_TMO], 1u); break; } } } } while (0)

struct XcdBarrier {
    unsigned* bar; unsigned x; int wv;
    volatile LAS unsigned* st;
};

__device__ __forceinline__ XcdBarrier xcd_barrier_post(unsigned* bar, volatile LAS unsigned* st) {
    XcdBarrier b; b.bar = bar; b.x = xb_xcc_id(); b.st = st; b.wv = __builtin_amdgcn_readfirstlane((int)threadIdx.x >> 6);
    if (threadIdx.x == 0) (void)xb_add(&bar[XB_XCNT(b.x)], 1u);
    return b;
}
__device__ __forceinline__ void xcd_barrier_complete(unsigned* bar, unsigned x, unsigned& nloc, unsigned& nx) {
    const unsigned G = gridDim.x * gridDim.y * gridDim.z;
    unsigned sum, cnt, mine, sp = 0u;
    for (;;) {
        sum = 0u; cnt = 0u; mine = 0u;
#pragma unroll
        for (unsigned j = 0; j < 16; ++j) { const unsigned c = xb_ld(&bar[XB_XCNT(j)]); sum += c; cnt += (c > 0u) ? 1u : 0u; mine = (j == x) ? c : mine; }
        if (sum == G) break;
        __builtin_amdgcn_s_sleep(1);
        if ((++sp & 255u) == 0u) { if (xb_ld(&bar[XB_TMO])) break; if (sp > XB_SPIN_CAP) { atomicAdd(&bar[XB_TMO], 1u); break; } }
    }
    nloc = mine > 0u ? mine : 1u; nx = cnt > 0u ? cnt : 1u;
}

__device__ __forceinline__ void xcd_barrier(const XcdBarrier& b) {
    asm volatile("s_waitcnt vmcnt(0)" ::: "memory");
    __syncthreads();
    if (((b.wv << 6) | lane_v()) == 0) {
        unsigned* bar = b.bar;
        __builtin_amdgcn_s_waitcnt(0);
        unsigned nloc = b.st[0], nx = b.st[1];
        if (nloc == 0u) { xcd_barrier_complete(bar, b.x, nloc, nx); b.st[0] = nloc; b.st[1] = nx; }
        const unsigned old = xb_add(&bar[XB_XSUB(b.x)], 1u);
        const unsigned gen = old / nloc;
        if (old + 1u == (gen + 1u) * nloc) {
            __builtin_amdgcn_fence(__ATOMIC_RELEASE, "agent");
            asm volatile("s_waitcnt vmcnt(0)" ::: "memory");
            const unsigned og = xb_add(&bar[XB_TOP], 1u);
            const unsigned tg = og / nx;
            if (og + 1u == (tg + 1u) * nx) xb_add(&bar[XB_TOPGEN], 1u);
            else XB_SPIN(xb_ld(&bar[XB_TOPGEN]) == tg, bar);
            __builtin_amdgcn_fence(__ATOMIC_ACQUIRE, "agent");
            xb_add(&bar[XB_XGEN(b.x)], 1u);
            asm volatile("s_waitcnt vmcnt(0)" ::: "memory");
        } else {
            XB_SPIN(xb_ld(&bar[XB_XGEN(b.x)]) == gen, bar);
            __builtin_amdgcn_fence(__ATOMIC_ACQUIRE, "agent");
            asm volatile("s_waitcnt vmcnt(0)" ::: "memory");
        }
    }
    __syncthreads();
}

typedef unsigned short bf16;
using pg8::bf16x8; using pg8::f32x4; using pg8::u32x4;
typedef unsigned u32x2 __attribute__((ext_vector_type(2)));
constexpr int NT = 512, NW = 8;
constexpr int DM = 2048, NB = 8, SEQ = 2048, CTXL = 256;
constexpr int MLAT = NB * SEQ, MCTX = NB * CTXL, MTOT = MLAT + MCTX;
constexpr int NIN = 5920, NINP = 6144;
constexpr int C_RW_R = 0, C_RW_K = 512, C_RW_V = 1024, C_RW_XW = 1536;
constexpr int C_MB_Z = 1792, C_MB_XBC = 2816, C_MB_DT = 4352;
constexpr int C_DA_Q = 4384, C_DA_V = 5408;
constexpr int FF = 5632, FE = 7168, NE = 8;
constexpr int MOE_ROWS = 34816;
constexpr int LDS_STAGE = 131072, LDS_MISC = 1024, LDS_BYTES = LDS_STAGE + LDS_MISC;

#ifndef MOE_FP8
#define MOE_FP8 1
#endif
#ifndef DENSE_GU8
#define DENSE_GU8 1
#endif
#ifndef DENSE_D8
#define DENSE_D8 0
#endif
constexpr float MOE_SGU = 32.0f, MOE_SD = 64.0f, MOE_SH = 4.0f;
constexpr size_t MiB = 1048576;
constexpr size_t WS_CTL   = 0;
constexpr size_t CTL_BYTES = 65536;
constexpr size_t CW_BAR = 0, CW_CNT = 4096  , CW_Q = 8192  , CW_BG = 8704  , CW_DONE = 9216  ;
constexpr size_t WS_ADA   = 1 * MiB;
constexpr size_t WS_ROPE  = 2 * MiB;
constexpr size_t WS_TOK   = 3 * MiB;
constexpr size_t WS_WIN   = 4 * MiB;
constexpr size_t WS_WOUT  = WS_WIN  + 48 * MiB;
constexpr size_t WS_WSM   = WS_WOUT + 16 * MiB;
constexpr size_t WS_WGU   = WS_WSM  + 2 * MiB;
constexpr size_t WS_WD    = WS_WGU  + 44 * MiB;
constexpr size_t WS_MGU   = WS_WD   + 22 * MiB;
constexpr size_t WS_MD    = WS_MGU  + 448 * MiB;
constexpr size_t WS_XC    = WS_MD   + 224 * MiB;
constexpr size_t WS_HA    = WS_XC   + 16 * MiB;
constexpr size_t WS_U     = WS_HA   + 72 * MiB;
constexpr size_t WS_MIX   = WS_U    + 216 * MiB;
constexpr size_t WS_BIG   = WS_MIX  + 144 * MiB;
constexpr size_t WS_XSB   = WS_BIG  + 476 * MiB;
constexpr size_t WS_END   = WS_XSB  + 64 * MiB;
constexpr size_t WS_ASM   = WS_BIG;
constexpr size_t WS_XBC   = WS_ASM  + 9 * MiB;
constexpr size_t WS_DT    = WS_XBC  + 54 * MiB;
constexpr size_t WS_QK    = WS_DT   + 5 * MiB;
constexpr size_t WS_RW5   = WS_QK   + 36 * MiB;
constexpr size_t WS_YR    = WS_RW5  + 90 * MiB;
constexpr size_t WS_YM    = WS_YR   + 72 * MiB;
constexpr size_t WS_ST    = WS_YM   + 72 * MiB;
constexpr size_t WS_AC    = WS_ST   + 72 * MiB;
static_assert(WS_AC + 1 * MiB <= WS_END, "mixer intermediates overflow BIG");
static_assert((size_t)MOE_ROWS * FE * 2 <= 476 * MiB && (size_t)MOE_ROWS * DM * 2 <= 144 * MiB, "moe buffers");

struct Args { const float* in[38]; float* out; unsigned char* ws; int ph_lo, ph_hi, sub, pad; };
struct Ctx { unsigned char* ws; int wv; int sub; };

constexpr int LDS_PTRS = LDS_STAGE + 128;
__device__ __forceinline__ const float* ldin(int k) {
    extern __shared__ __attribute__((aligned(16))) unsigned char lds_dyn[];
    const int base = opqs((int)(unsigned)(unsigned long long)(LAS unsigned char*)lds_dyn);
    const LAS unsigned* p = (const LAS unsigned*)(unsigned long long)(unsigned)(base + LDS_PTRS + 8 * k);
    const unsigned lo = __builtin_amdgcn_readfirstlane(p[0]), hi = __builtin_amdgcn_readfirstlane(p[1]);
    return (const float*)(const GAS float*)(((unsigned long long)hi << 32) | (unsigned long long)lo);
}
__device__ __forceinline__ float bf2f(unsigned short b) { return __uint_as_float(((unsigned)b) << 16); }
typedef float f32x2_t __attribute__((ext_vector_type(2)));
typedef __bf16 bf16x2_t __attribute__((ext_vector_type(2)));
__device__ __forceinline__ unsigned pk2(float lo, float hi) { const f32x2_t v = {lo, hi}; return __builtin_bit_cast(unsigned, __builtin_convertvector(v, bf16x2_t)); }
__device__ __forceinline__ unsigned f2bf(float f) { return pk2(f, f) & 0xffffu; }
__device__ __forceinline__ void unpack8(const uint4 w, float (&f)[8]) {
    f[0] = __uint_as_float(w.x << 16); f[1] = __uint_as_float(w.x & 0xffff0000u); f[2] = __uint_as_float(w.y << 16); f[3] = __uint_as_float(w.y & 0xffff0000u);
    f[4] = __uint_as_float(w.z << 16); f[5] = __uint_as_float(w.z & 0xffff0000u); f[6] = __uint_as_float(w.w << 16); f[7] = __uint_as_float(w.w & 0xffff0000u); }
__device__ __forceinline__ uint4 pack8(const float (&f)[8]) { uint4 w; w.x = pk2(f[0], f[1]); w.y = pk2(f[2], f[3]); w.z = pk2(f[4], f[5]); w.w = pk2(f[6], f[7]); return w; }
__device__ __forceinline__ void unpack4(const uint2 w, float (&f)[4]) {
    f[0] = __uint_as_float(w.x << 16); f[1] = __uint_as_float(w.x & 0xffff0000u); f[2] = __uint_as_float(w.y << 16); f[3] = __uint_as_float(w.y & 0xffff0000u); }
template <int CTRL> __device__ __forceinline__ float dppf(float v) { return __int_as_float(__builtin_amdgcn_update_dpp(0, __float_as_int(v), CTRL, 0xf, 0xf, false)); }
__device__ __forceinline__ float red8(float v)  { v += dppf<0xB1>(v); v += dppf<0x4E>(v); v += dppf<0x141>(v); return v; }
__device__ __forceinline__ float red16(float v) { v += dppf<0xB1>(v); v += dppf<0x4E>(v); v += dppf<0x141>(v); v += dppf<0x140>(v); return v; }
__device__ __forceinline__ float swz16(float v) { return __int_as_float(__builtin_amdgcn_ds_swizzle(__float_as_int(v), 0x401F)); }
__device__ __forceinline__ float red32(float v) { v = red16(v); v += swz16(v); return v; }
__device__ __forceinline__ float wsum(float v) { v = red32(v); return __int_as_float(__builtin_amdgcn_readlane(__float_as_int(v), 0)) + __int_as_float(__builtin_amdgcn_readlane(__float_as_int(v), 32)); }
__device__ __forceinline__ float shx32(float v, int lane) { return __int_as_float(__builtin_amdgcn_ds_bpermute((lane ^ 32) << 2, __float_as_int(v))); }
__device__ __forceinline__ float fsilu(float x) { return pg8::fsilu(x); }
__device__ __forceinline__ float fsigm(float x) { return pg8::fsigm(x); }
__device__ __forceinline__ float softplusf(float x) { return fmaxf(x, 0.f) + log1pf(__expf(-fabsf(x))); }


template <bool F8>
__device__ __forceinline__ void cvt_job_t(const float* __restrict__ src, int ld, int ncols_valid, int ncols_total, void* __restrict__ dstv, int K, int mode, float scale, LAS float* tile, int bid, int G, const int tid, int t_end = 0x7fffffff) {
    const int ntn = ncols_total >> 6, ntk = K >> 7; const int nt = (ntn * ntk) < t_end ? (ntn * ntk) : t_end;
    const int lk = tid >> 4, lc = (tid & 15) * 4;
    constexpr int TP = 65;
    float4 r[4]; int buf = 0;
    const float4 z4 = make_float4(0.f, 0.f, 0.f, 0.f);
#define CVT_LOAD(t_, dst_) do { const int tn_ = (t_) % ntn, tk_ = (t_) / ntn; const int n_ = tn_ * 64 + lc; const float* p_ = src + (size_t)(tk_ * 128 + lk) * ld + n_; \
        _Pragma("unroll") for (int i_ = 0; i_ < 4; ++i_) dst_[i_] = (n_ < ncols_valid) ? *(const float4*)(p_ + (size_t)(32 * i_) * ld) : z4; } while (0)
    int t = bid;
    if (t < nt) CVT_LOAD(t, r);
    __syncthreads();
    for (; t < nt; t += G) {
        float4 nx[4] = {z4, z4, z4, z4};
        if (t + G < nt) CVT_LOAD(t + G, nx);
        LAS float* tl = tile + buf * (128 * TP);
#pragma unroll
        for (int i = 0; i < 4; ++i) { LAS float* q = tl + (lk + 32 * i) * TP + lc; q[0] = r[i].x; q[1] = r[i].y; q[2] = r[i].z; q[3] = r[i].w; }
        __syncthreads();
        const int tn = t % ntn, tk = t / ntn, k0 = tk * 128, nb = tn * 64;
        const int kq = tid & 7, nl = tid >> 3, nn = nb + nl;
        const int drow = mode == 0 ? nn : ((nn >> 7) * 256 + (nn & 127) + (mode == 2 ? 128 : 0));
        const LAS float* c = tl + (kq * 16) * TP + nl;
        if (F8) {
            uint4 w;
            w.x = pg8::pk_fp8x4(c[0 * TP] * scale, c[1 * TP] * scale, c[2 * TP] * scale, c[3 * TP] * scale); w.y = pg8::pk_fp8x4(c[4 * TP] * scale, c[5 * TP] * scale, c[6 * TP] * scale, c[7 * TP] * scale);
            w.z = pg8::pk_fp8x4(c[8 * TP] * scale, c[9 * TP] * scale, c[10 * TP] * scale, c[11 * TP] * scale); w.w = pg8::pk_fp8x4(c[12 * TP] * scale, c[13 * TP] * scale, c[14 * TP] * scale, c[15 * TP] * scale);
            *(uint4*)((unsigned char*)dstv + (size_t)drow * K + k0 + kq * 16) = w;
        } else {
            uint4 w0, w1;
            w0.x = pk2(c[0 * TP], c[1 * TP]); w0.y = pk2(c[2 * TP], c[3 * TP]); w0.z = pk2(c[4 * TP], c[5 * TP]); w0.w = pk2(c[6 * TP], c[7 * TP]);
            w1.x = pk2(c[8 * TP], c[9 * TP]); w1.y = pk2(c[10 * TP], c[11 * TP]); w1.z = pk2(c[12 * TP], c[13 * TP]); w1.w = pk2(c[14 * TP], c[15 * TP]);
            uint4* q = (uint4*)((bf16*)dstv + (size_t)drow * K + k0 + kq * 16); q[0] = w0; q[1] = w1;
        }
#pragma unroll
        for (int i = 0; i < 4; ++i) r[i] = nx[i];
        buf ^= 1;
    }
#undef CVT_LOAD
}
__device__ __forceinline__ void cvt_job_f8(const float* __restrict__ src, int ld, int ncols, unsigned char* __restrict__ dst, int K, int mode, float scale, LAS unsigned char* tile, int t_begin, int t_end, const int tid) {
    const int ntn = ncols >> 6;
    const int q = tid >> 4, i4 = tid & 15;
    constexpr int TP = 144;
    float4 r[4]; int buf = 0;
#define CVT8_LOAD(t_, dst_) do { const int tn_ = (t_) % ntn, tk_ = (t_) / ntn; const float* p_ = src + (size_t)(tk_ * 128 + 4 * q) * ld + tn_ * 64 + 4 * i4; \
        _Pragma("unroll") for (int j_ = 0; j_ < 4; ++j_) dst_[j_] = *(const float4*)(p_ + (size_t)j_ * ld); } while (0)
    int t = t_begin;
    if (t < t_end) CVT8_LOAD(t, r);
    __syncthreads();
    for (; t < t_end; ++t) {
        float4 nx[4];
#pragma unroll
        for (int j = 0; j < 4; ++j) nx[j] = r[j];
        if (t + 1 < t_end) CVT8_LOAD(t + 1, nx);
        unsigned w[4];
#pragma unroll
        for (int j = 0; j < 4; ++j) w[j] = pg8::pk_fp8x4(r[j].x * scale, r[j].y * scale, r[j].z * scale, r[j].w * scale);
        const unsigned a_lo = __builtin_amdgcn_perm(w[1], w[0], 0x05010400u), a_hi = __builtin_amdgcn_perm(w[1], w[0], 0x07030602u);
        const unsigned b_lo = __builtin_amdgcn_perm(w[3], w[2], 0x05010400u), b_hi = __builtin_amdgcn_perm(w[3], w[2], 0x07030602u);
        unsigned o[4];
        o[0] = __builtin_amdgcn_perm(b_lo, a_lo, 0x05040100u); o[1] = __builtin_amdgcn_perm(b_lo, a_lo, 0x07060302u);
        o[2] = __builtin_amdgcn_perm(b_hi, a_hi, 0x05040100u); o[3] = __builtin_amdgcn_perm(b_hi, a_hi, 0x07060302u);
        LAS unsigned char* tl = tile + buf * (64 * TP);
        const int cw = ((q >> 2) ^ (i4 & 7)) * 16 + (q & 3) * 4;
#pragma unroll
        for (int m = 0; m < 4; ++m) *(LAS unsigned*)(tl + (4 * i4 + m) * TP + cw) = o[m];
        __syncthreads();
        const int tn = t % ntn, tk = t / ntn, k0 = tk * 128, nb = tn * 64;
        const int kq = tid & 7, nl = tid >> 3, nn = nb + nl;
        const int drow = mode == 0 ? nn : ((nn >> 7) * 256 + (nn & 127) + (mode == 2 ? 128 : 0));
        const u32x4 v = *(const LAS u32x4*)(tl + nl * TP + ((kq ^ ((nl >> 2) & 7)) * 16));
        *(uint4*)(dst + (size_t)drow * K + k0 + kq * 16) = make_uint4(v.x, v.y, v.z, v.w);
#pragma unroll
        for (int j = 0; j < 4; ++j) r[j] = nx[j];
        buf ^= 1;
    }
#undef CVT8_LOAD
}
__device__ __forceinline__ void cvt_job_b16(const float* __restrict__ src, int ld, int ncols_valid, int ncols_total, bf16* __restrict__ dst, int K, int mode, LAS unsigned char* tile, int t_begin, int t_end, const int tid) {
    const int ntn = ncols_total >> 6;
    const int q = tid >> 4, i4 = tid & 15;
    constexpr int TP = 272;
    const float4 z4 = make_float4(0.f, 0.f, 0.f, 0.f);
    float4 r[4]; int buf = 0;
#define CVTB_LOAD(t_, dst_) do { const int tn_ = (t_) % ntn, tk_ = (t_) / ntn; const int n_ = tn_ * 64 + 4 * i4; const float* p_ = src + (size_t)(tk_ * 128 + 4 * q) * ld + n_; \
        _Pragma("unroll") for (int j_ = 0; j_ < 4; ++j_) dst_[j_] = (n_ < ncols_valid) ? *(const float4*)(p_ + (size_t)j_ * ld) : z4; } while (0)
    int t = t_begin;
    if (t < t_end) CVTB_LOAD(t, r);
    __syncthreads();
    for (; t < t_end; ++t) {
        float4 nx[4];
#pragma unroll
        for (int j = 0; j < 4; ++j) nx[j] = r[j];
        if (t + 1 < t_end) CVTB_LOAD(t + 1, nx);
        LAS unsigned char* tl = tile + buf * (64 * TP);
        *(LAS u32x2*)(tl + (4 * i4 + 0) * TP + 8 * q) = (u32x2){pk2(r[0].x, r[1].x), pk2(r[2].x, r[3].x)};
        *(LAS u32x2*)(tl + (4 * i4 + 1) * TP + 8 * q) = (u32x2){pk2(r[0].y, r[1].y), pk2(r[2].y, r[3].y)};
        *(LAS u32x2*)(tl + (4 * i4 + 2) * TP + 8 * q) = (u32x2){pk2(r[0].z, r[1].z), pk2(r[2].z, r[3].z)};
        *(LAS u32x2*)(tl + (4 * i4 + 3) * TP + 8 * q) = (u32x2){pk2(r[0].w, r[1].w), pk2(r[2].w, r[3].w)};
        __syncthreads();
        const int tn = t % ntn, tk = t / ntn, k0 = tk * 128, nb = tn * 64;
        const int kq = tid & 7, nl = tid >> 3, nn = nb + nl;
        const int drow = mode == 0 ? nn : ((nn >> 7) * 256 + (nn & 127) + (mode == 2 ? 128 : 0));
        const u32x4 v0 = *(const LAS u32x4*)(tl + nl * TP + kq * 16), v1 = *(const LAS u32x4*)(tl + nl * TP + 128 + kq * 16);
        bf16* o = dst + (size_t)drow * K + k0 + kq * 8;
        *(uint4*)o = make_uint4(v0.x, v0.y, v0.z, v0.w); *(uint4*)(o + 64) = make_uint4(v1.x, v1.y, v1.z, v1.w);
#pragma unroll
        for (int j = 0; j < 4; ++j) r[j] = nx[j];
        buf ^= 1;
    }
#undef CVTB_LOAD
}
template <int NTB, int D>
__device__ __forceinline__ void cvt_job_f8d(const float* __restrict__ src, int ld, int ncols, unsigned char* __restrict__ dst, int K, int mode, float scale, LAS unsigned char* tile, int t_begin, const int tid) {
    const int ntn = ncols >> 6;
    const int q = tid >> 4, i4 = tid & 15;
    constexpr int TP = 144;
    float4 r[D][4];
#define CVT8_LOAD(t_, dst_) do { const int tn_ = (t_) % ntn, tk_ = (t_) / ntn; const float* p_ = src + (size_t)(tk_ * 128 + 4 * q) * ld + tn_ * 64 + 4 * i4; \
        _Pragma("unroll") for (int j_ = 0; j_ < 4; ++j_) dst_[j_] = *(const float4*)(p_ + (size_t)j_ * ld); } while (0)
#pragma unroll
    for (int d = 0; d < D; ++d) CVT8_LOAD(t_begin + d, r[d]);
    __syncthreads();
#pragma unroll
    for (int i = 0; i < NTB; ++i) {
        const int t = t_begin + i;
        unsigned w[4];
#pragma unroll
        for (int j = 0; j < 4; ++j) w[j] = pg8::pk_fp8x4(r[i % D][j].x * scale, r[i % D][j].y * scale, r[i % D][j].z * scale, r[i % D][j].w * scale);
        if (i + D < NTB) CVT8_LOAD(t + D, r[i % D]);
        const unsigned a_lo = __builtin_amdgcn_perm(w[1], w[0], 0x05010400u), a_hi = __builtin_amdgcn_perm(w[1], w[0], 0x07030602u);
        const unsigned b_lo = __builtin_amdgcn_perm(w[3], w[2], 0x05010400u), b_hi = __builtin_amdgcn_perm(w[3], w[2], 0x07030602u);
        unsigned o[4];
        o[0] = __builtin_amdgcn_perm(b_lo, a_lo, 0x05040100u); o[1] = __builtin_amdgcn_perm(b_lo, a_lo, 0x07060302u);
        o[2] = __builtin_amdgcn_perm(b_hi, a_hi, 0x05040100u); o[3] = __builtin_amdgcn_perm(b_hi, a_hi, 0x07060302u);
        LAS unsigned char* tl = tile + (i & 1) * (64 * TP);
        const int cw = ((q >> 2) ^ (i4 & 7)) * 16 + (q & 3) * 4;
#pragma unroll
        for (int m = 0; m < 4; ++m) *(LAS unsigned*)(tl + (4 * i4 + m) * TP + cw) = o[m];
        __syncthreads();
        const int tn = t % ntn, tk = t / ntn, k0 = tk * 128, nb = tn * 64;
        const int kq = tid & 7, nl = tid >> 3, nn = nb + nl;
        const int drow = mode == 0 ? nn : ((nn >> 7) * 256 + (nn & 127) + (mode == 2 ? 128 : 0));
        const u32x4 v = *(const LAS u32x4*)(tl + nl * TP + ((kq ^ ((nl >> 2) & 7)) * 16));
        *(uint4*)(dst + (size_t)drow * K + k0 + kq * 16) = make_uint4(v.x, v.y, v.z, v.w);
    }
#undef CVT8_LOAD
}
__device__ __forceinline__ void cvt_job8(const float* src, int ld, int ncols, unsigned char* dst, int K, int mode, float scale, LAS float* tile, int bid, int G, const int tid) { cvt_job_t<true>(src, ld, ncols, ncols, dst, K, mode, scale, tile, bid, G, tid); }
__device__ __forceinline__ void cvt_job(const float* src, int ld, int ncols_valid, int ncols_total, bf16* dst, int K, int mode, LAS float* tile, int bid, int G, const int tid) { cvt_job_t<false>(src, ld, ncols_valid, ncols_total, dst, K, mode, 1.0f, tile, bid, G, tid); }

__device__ __forceinline__ void p0_prologue(const Ctx& a, LAS unsigned char* lds, int bid, int G) {
    unsigned char* ws = opqp(a.ws); const int tid = ((a.wv << 6) | lane_v());
    LAS float* tile = (LAS float*)lds;
    if (!(a.sub & 512)) {
#define P0_RANGE(nt_) const int nt__ = (nt_); const int tb = (int)((long)bid * nt__ / G), te = (int)((long)(bid + 1) * nt__ / G)
        for (int l = 0; l < 2; ++l) {
            { P0_RANGE((NINP >> 6) * (DM >> 7)); cvt_job_b16(ldin(10) + (size_t)l * DM * NIN, NIN, NIN, NINP, (bf16*)(ws + WS_WIN) + (size_t)l * NINP * DM, DM, 0, (LAS unsigned char*)lds, tb, te, tid); }
            { P0_RANGE((DM >> 6) * (DM >> 7)); cvt_job_b16(ldin(11) + (size_t)l * DM * DM, DM, DM, DM, (bf16*)(ws + WS_WOUT) + (size_t)l * DM * DM, DM, 0, (LAS unsigned char*)lds, tb, te, tid); }
        }
#if DENSE_GU8
        { P0_RANGE((FF >> 6) * (DM >> 7)); cvt_job_f8(ldin(31), FF, FF, ws + WS_WGU, DM, 1, MOE_SGU, (LAS unsigned char*)lds, tb, te, tid);
          cvt_job_f8(ldin(32), FF, FF, ws + WS_WGU, DM, 2, MOE_SGU, (LAS unsigned char*)lds, tb, te, tid); }
#else
        { P0_RANGE((FF >> 6) * (DM >> 7)); cvt_job_b16(ldin(31), FF, FF, FF, (bf16*)(ws + WS_WGU), DM, 1, (LAS unsigned char*)lds, tb, te, tid);
          cvt_job_b16(ldin(32), FF, FF, FF, (bf16*)(ws + WS_WGU), DM, 2, (LAS unsigned char*)lds, tb, te, tid); }
#endif
#if DENSE_D8
        { P0_RANGE((DM >> 6) * (FF >> 7)); cvt_job_f8(ldin(33), DM, DM, ws + WS_WD, FF, 0, MOE_SD, (LAS unsigned char*)lds, tb, te, tid); }
#else
        { P0_RANGE((DM >> 6) * (FF >> 7)); cvt_job_b16(ldin(33), DM, DM, DM, (bf16*)(ws + WS_WD), FF, 0, (LAS unsigned char*)lds, tb, te, tid); }
#endif
#undef P0_RANGE
    }
#if !MOE_FP8
    for (int e = 0; e < NE; ++e) {
        cvt_job(ldin(35) + (size_t)e * DM * FE, FE, FE, FE, (bf16*)(ws + WS_MGU) + (size_t)e * 2 * FE * DM, DM, 1, tile, bid, G, tid);
        cvt_job(ldin(36) + (size_t)e * DM * FE, FE, FE, FE, (bf16*)(ws + WS_MGU) + (size_t)e * 2 * FE * DM, DM, 2, tile, bid, G, tid);
        cvt_job(ldin(37) + (size_t)e * FE * DM, DM, DM, DM, (bf16*)(ws + WS_MD) + (size_t)e * DM * FE, FE, 0, tile, bid, G, tid);
    }
#endif
    {
        bf16* wsm = (bf16*)(ws + WS_WSM);
        for (size_t i = (size_t)bid * NT + tid; i < (size_t)2 * 2048 * 256; i += (size_t)G * NT) {
            const int l = (int)(i >> 19), n = (int)((i >> 8) & 2047), k = (int)(i & 255); float v = 0.f;
            if (n < 1024) { if (k < 64) v = ldin(14)[(((size_t)l * 2 + (n >> 9)) * 64 + k) * 512 + (n & 511)]; }
            else if (n < 1536) { if (k >= 64 && k < 128) v = ldin(16)[((size_t)l * 64 + (k - 64)) * 512 + (n - 1024)]; }
            else { if (k >= 128) v = ldin(17)[((size_t)l * 128 + (k - 128)) * 512 + (n - 1536)]; }
            wsm[i] = (bf16)f2bf(v);
        }
    }
    {
        float* rope = (float*)(ws + WS_ROPE);
        for (int i = bid * NT + tid; i < SEQ * 32; i += G * NT) {
            const int t = i >> 5, j = i & 31, half = j >> 4, f = j & 15;
            const float pos = (float)(half ? (t & 63) : (t >> 6));
            const float inv = powf(10000.0f, -(float)f / 16.0f);
            const float ang = pos * inv;
            double ad = (double)ang; const double twopi = 6.283185307179586476925; ad -= twopi * floor(ad / twopi);
            const float ar = (float)ad;
            rope[t * 64 + half * 32 + f] = cosf(ar); rope[t * 64 + half * 32 + 16 + f] = sinf(ar);
        }
    }
    if (!(a.sub & 256)) {
        LAS float* sil = (LAS float*)lds;
        LAS float* red = sil + 9 * 2048;
        __syncthreads();
        for (int i = tid; i < 9 * 2048; i += NT) { const float v = i < 8 * 2048 ? ldin(1)[i] : ldin(3)[i - 8 * 2048]; sil[i] = v / (1.0f + __expf(-v)); }
        __syncthreads();
        float* ada = (float*)(ws + WS_ADA);
        const int lane = tid & 63, wid = tid >> 6;
        for (int it = bid; it < 2 * 96; it += G) {
            const int l = it / 96, col0 = (it % 96) * 128;
            const float* w = ldin(4) + (size_t)l * DM * 12288 + (size_t)(wid * 256) * 12288 + col0 + 2 * lane;
            const LAS float* sl = sil + wid * 256;
            float2 acc[9];
#pragma unroll
            for (int v = 0; v < 9; ++v) acc[v] = make_float2(0.f, 0.f);
            float2 cur[16];
#pragma unroll
            for (int j = 0; j < 16; ++j) cur[j] = *(const float2*)(w + (size_t)j * 12288);
            for (int k0 = 0; k0 < 256; k0 += 16) {
                float2 nx[16];
#pragma unroll
                for (int j = 0; j < 16; ++j) nx[j] = cur[j];
                if (k0 + 16 < 256) {
#pragma unroll
                    for (int j = 0; j < 16; ++j) nx[j] = *(const float2*)(w + (size_t)(k0 + 16 + j) * 12288); }
#pragma unroll
                for (int v = 0; v < 9; ++v)
#pragma unroll
                    for (int q = 0; q < 4; ++q) { const f32x4 sv = *(const LAS f32x4*)(sl + v * 2048 + k0 + 4 * q);
#pragma unroll
                        for (int e = 0; e < 4; ++e) { acc[v].x += sv[e] * cur[4 * q + e].x; acc[v].y += sv[e] * cur[4 * q + e].y; } }
#pragma unroll
                for (int j = 0; j < 16; ++j) cur[j] = nx[j];
            }
#pragma unroll
            for (int v = 0; v < 9; ++v) *(LAS f32x2_t*)(red + (wid * 9 + v) * 128 + 2 * lane) = (f32x2_t){acc[v].x, acc[v].y};
            __syncthreads();
            for (int o = tid; o < 9 * 128; o += NT) { const int v = o >> 7, cn = o & 127; float sum = ldin(5)[(size_t)l * 12288 + col0 + cn];
#pragma unroll
                for (int g8 = 0; g8 < 8; ++g8) sum += red[(g8 * 9 + v) * 128 + cn];
                ada[((size_t)l * 9 + v) * 12288 + col0 + cn] = sum; }
            __syncthreads();
        }
    }
}


constexpr int BG_TPJ = 1792, BG_NT = 24 * BG_TPJ, BG_B = 8, BG_D = 1;
__device__ __forceinline__ void bg_convert(const Ctx& a, LAS unsigned char* lds, unsigned* until_done, int G) {
#if MOE_FP8
    unsigned char* ws = opqp(a.ws); const int tid = ((a.wv << 6) | lane_v());
    unsigned* ctr = (unsigned*)(ws + WS_CTL) + CW_BG; volatile LAS unsigned* slot = (volatile LAS unsigned*)(lds + LDS_STAGE + 8);
    LAS float* tile = (LAS float*)lds;
    for (;;) {
        __syncthreads();
        if (tid == 0) { unsigned v = 0xffffffffu;
            if (!until_done || __hip_atomic_load(until_done, __ATOMIC_RELAXED, __HIP_MEMORY_SCOPE_AGENT) < (unsigned)G) v = __hip_atomic_fetch_add(ctr, (unsigned)BG_B, __ATOMIC_RELAXED, __HIP_MEMORY_SCOPE_AGENT);
            *slot = v; }
        __syncthreads();
        const unsigned t0 = *slot;
        if (t0 >= (unsigned)BG_NT) break;
        const int job = (int)t0 / BG_TPJ, tl = (int)t0 % BG_TPJ; const int e = job / 3, kind = job % 3;
        if (kind < 2) cvt_job_f8d<BG_B, BG_D>(ldin(35 + kind) + (size_t)e * DM * FE, FE, FE, ws + WS_MGU + (size_t)e * 2 * FE * DM, DM, 1 + kind, MOE_SGU, (LAS unsigned char*)lds, tl, tid);
        else cvt_job_f8d<BG_B, BG_D>(ldin(37) + (size_t)e * FE * DM, DM, DM, ws + WS_MD + (size_t)e * DM * FE, FE, 0, MOE_SD, (LAS unsigned char*)lds, tl, tid);
    }
    __syncthreads();
#endif
}
#ifndef BG_MASK
#define BG_MASK 0x2020u
#endif
__device__ __forceinline__ void bg_tail(const Ctx& a, LAS unsigned char* lds, int slotid, int G) {
#if MOE_FP8
    unsigned char* ws = opqp(a.ws); const int tid = ((a.wv << 6) | lane_v());
    if (!((BG_MASK >> slotid) & 1u)) return;
    unsigned* done = (unsigned*)(ws + WS_CTL) + CW_DONE + slotid * 64;
    __syncthreads();
    if (tid == 0) (void)__hip_atomic_fetch_add(done, 1u, __ATOMIC_RELAXED, __HIP_MEMORY_SCOPE_AGENT);
    bg_convert(a, lds, done, G);
#endif
}

__device__ __forceinline__ void ld_row(const float* p, int lane, float (&x)[32]) {
#pragma unroll
    for (int i = 0; i < 8; ++i) { const float4 v = *(const float4*)(p + i * 256 + lane * 4); x[i * 4] = v.x; x[i * 4 + 1] = v.y; x[i * 4 + 2] = v.z; x[i * 4 + 3] = v.w; }
}
__device__ __forceinline__ void st_row(float* p, int lane, const float (&x)[32]) {
#pragma unroll
    for (int i = 0; i < 8; ++i) *(float4*)(p + i * 256 + lane * 4) = make_float4(x[i * 4], x[i * 4 + 1], x[i * 4 + 2], x[i * 4 + 3]);
}
__device__ __forceinline__ float sumsq(const float (&x)[32]) { float s = 0.f;
#pragma unroll
    for (int i = 0; i < 32; ++i) s += x[i] * x[i];
    return wsum(s); }

template <int TMODE, int HMODE, int XIN = 0, int XOUT = 0>
__device__ __forceinline__ void thin_phase(const Ctx& a, LAS unsigned char* lds, int bid, int G, int M,
                           const float* xlat, const float* xctx, float* olat, float* octx,
                           const float* T, const float* postw, int lg, int kg,
                           const float* prew, int lm, int ksc, int ksh) {
    unsigned char* ws = opqp(a.ws); const int tid = ((a.wv << 6) | lane_v()), lane = tid & 63, wid = tid >> 6;
    const float* ada = (const float*)(ws + WS_ADA);
    bf16* HA = (bf16*)(ws + WS_HA);
    LAS float* rt = (LAS float*)lds;
    if (HMODE == 2) { __syncthreads(); for (int i = tid; i < DM * NE; i += NT) rt[i] = ldin(34)[i]; __syncthreads(); }
    for (int r = bid * NW + wid; r < M; r += G * NW) {
        const int vec = r < MLAT ? r / SEQ : 8;
        float x[32];
        if (XIN == 1 && r < MLAT) { const bf16* xb = (const bf16*)xlat + (size_t)r * DM;
#pragma unroll
            for (int i = 0; i < 8; ++i) { const uint2 p1 = *(const uint2*)(xb + i * 256 + lane * 4); float f1[4]; unpack4(p1, f1); x[i * 4] = f1[0]; x[i * 4 + 1] = f1[1]; x[i * 4 + 2] = f1[2]; x[i * 4 + 3] = f1[3]; } }
        else { const float* xs = r < MLAT ? xlat + (size_t)r * DM : xctx + (size_t)(r - MLAT) * DM; ld_row(xs, lane, x); }
        if (TMODE != 0) {
            float t[32];
            if (TMODE == 1) { const bf16* tb = (const bf16*)T + (size_t)r * DM;
#pragma unroll
                for (int i = 0; i < 8; ++i) { const uint2 p1 = *(const uint2*)(tb + i * 256 + lane * 4); float f1[4]; unpack4(p1, f1); t[i * 4] = f1[0]; t[i * 4 + 1] = f1[1]; t[i * 4 + 2] = f1[2]; t[i * 4 + 3] = f1[3]; } }
            else {
                const unsigned* tok = (const unsigned*)(ws + WS_TOK) + (size_t)r * 8;
                const float w1 = __uint_as_float(tok[4]), w2 = __uint_as_float(tok[5]); const unsigned d1 = tok[6], d2 = tok[7];
                const bf16* y1 = (const bf16*)(ws + WS_MIX) + (size_t)d1 * DM; const bf16* y2 = (const bf16*)(ws + WS_MIX) + (size_t)d2 * DM;
#pragma unroll
                for (int i = 0; i < 8; ++i) { const uint2 p1 = *(const uint2*)(y1 + i * 256 + lane * 4), p2 = *(const uint2*)(y2 + i * 256 + lane * 4);
                    float f1[4], f2[4]; unpack4(p1, f1); unpack4(p2, f2);
#pragma unroll
                    for (int j = 0; j < 4; ++j) t[i * 4 + j] = w1 * f1[j] + w2 * f2[j]; }
            }
            const float rs = rsqrtf(sumsq(t) * (1.0f / DM) + 1e-6f);
            float pw[32], gg[32]; ld_row(postw, lane, pw); ld_row(ada + ((size_t)lg * 9 + vec) * 12288 + kg * DM, lane, gg);
#pragma unroll
            for (int i = 0; i < 32; ++i) x[i] += gg[i] * (t[i] * rs * pw[i]);
            if (XOUT == 1 && r < MLAT) { bf16* xd = (bf16*)olat + (size_t)r * DM;
#pragma unroll
                for (int i = 0; i < 8; ++i) { uint2 p; p.x = pk2(x[i * 4], x[i * 4 + 1]); p.y = pk2(x[i * 4 + 2], x[i * 4 + 3]); *(uint2*)(xd + i * 256 + lane * 4) = p; } }
            else { float* xd = r < MLAT ? olat + (size_t)r * DM : octx + (size_t)(r - MLAT) * DM; st_row(xd, lane, x); }
        }
        if (HMODE != 0) {
            const float rs = rsqrtf(sumsq(x) * (1.0f / DM) + 1e-6f);
            float pw[32], sc[32], sh[32]; ld_row(prew, lane, pw);
            ld_row(ada + ((size_t)lm * 9 + vec) * 12288 + ksc * DM, lane, sc); ld_row(ada + ((size_t)lm * 9 + vec) * 12288 + ksh * DM, lane, sh);
            float h[32];
#pragma unroll
            for (int i = 0; i < 32; ++i) h[i] = x[i] * rs * pw[i] * (1.0f + sc[i]) + sh[i];
            if ((HMODE == 2 && MOE_FP8) || HMODE == 3) { unsigned char* hd8 = (unsigned char*)HA + (size_t)r * DM;
#pragma unroll
                for (int i = 0; i < 8; ++i) *(unsigned*)(hd8 + i * 256 + lane * 4) = pg8::pk_fp8x4(h[i * 4], h[i * 4 + 1], h[i * 4 + 2], h[i * 4 + 3]); }
            else { bf16* hd = HA + (size_t)r * DM;
#pragma unroll
                for (int i = 0; i < 8; ++i) { uint2 p; p.x = pk2(h[i * 4], h[i * 4 + 1]); p.y = pk2(h[i * 4 + 2], h[i * 4 + 3]); *(uint2*)(hd + i * 256 + lane * 4) = p; } }
            if (HMODE == 2) {
                float lg8[8];
#pragma unroll
                for (int e = 0; e < 8; ++e) lg8[e] = 0.f;
#pragma unroll 1
                for (int i = 0; i < 8; ++i) {
                    float hv4[4];
#pragma unroll
                    for (int j = 0; j < 4; ++j) hv4[j] = 0.f;
#pragma unroll
                    for (int ii = 0; ii < 8; ++ii) if (ii == i) { hv4[0] = h[ii * 4]; hv4[1] = h[ii * 4 + 1]; hv4[2] = h[ii * 4 + 2]; hv4[3] = h[ii * 4 + 3]; }
#pragma unroll
                    for (int j = 0; j < 4; ++j) { const int c = i * 256 + lane * 4 + j; const f32x4 r0 = *(const LAS f32x4*)(rt + c * 8), r1 = *(const LAS f32x4*)(rt + c * 8 + 4); const float hv = hv4[j];
                        lg8[0] += hv * r0[0]; lg8[1] += hv * r0[1]; lg8[2] += hv * r0[2]; lg8[3] += hv * r0[3]; lg8[4] += hv * r1[0]; lg8[5] += hv * r1[1]; lg8[6] += hv * r1[2]; lg8[7] += hv * r1[3]; }
                }
#pragma unroll
                for (int e = 0; e < 8; ++e) lg8[e] = wsum(lg8[e]);
                if (lane == 0) {
                    int e1 = 0; float v1 = lg8[0];
#pragma unroll
                    for (int e = 1; e < 8; ++e) if (lg8[e] > v1) { v1 = lg8[e]; e1 = e; }
                    int e2 = -1; float v2 = -3.0e38f;
#pragma unroll
                    for (int e = 0; e < 8; ++e) if (e != e1 && lg8[e] > v2) { v2 = lg8[e]; e2 = e; }
                    const float ex = __expf(v2 - v1); const float w1 = 1.0f / (1.0f + ex), w2 = ex / (1.0f + ex);
                    unsigned* cnt = (unsigned*)(ws + WS_CTL) + CW_CNT;
                    const unsigned p1 = atomicAdd(cnt + e1 * 64, 1u), p2 = atomicAdd(cnt + e2 * 64, 1u);
                    unsigned* tok = (unsigned*)(ws + WS_TOK) + (size_t)r * 8;
                    tok[0] = (unsigned)e1; tok[1] = (unsigned)e2; tok[2] = p1; tok[3] = p2; tok[4] = __float_as_uint(w1); tok[5] = __float_as_uint(w2);
                }
            }
        }
    }
}

__device__ __forceinline__ void moe_gather(const Ctx& a, int bid, int G) {
    unsigned char* ws = opqp(a.ws); const int tid = ((a.wv << 6) | lane_v()), lane = tid & 63, wid = tid >> 6;
    const unsigned* cnt = (const unsigned*)(ws + WS_CTL) + CW_CNT;
    const bf16* HA = (const bf16*)(ws + WS_HA); bf16* AG = (bf16*)(ws + WS_U);
    for (int r = bid * NW + wid; r < MLAT; r += G * NW) {
        unsigned* tok = (unsigned*)(ws + WS_TOK) + (size_t)r * 8;
        const int e1 = (int)tok[0], e2 = (int)tok[1]; const unsigned p1 = tok[2], p2 = tok[3];
        unsigned run = 0, s1 = 0, s2 = 0;
#pragma unroll
        for (int e = 0; e < 8; ++e) { const unsigned t = (cnt[e * 64] + 255u) >> 8; if (e == e1) s1 = run; if (e == e2) s2 = run; run += t; }
        const unsigned d1 = s1 * 256u + p1, d2 = s2 * 256u + p2;
#if MOE_FP8
        const uint4* src = (const uint4*)((const unsigned char*)HA + (size_t)r * DM); uint4* q1 = (uint4*)((unsigned char*)AG + (size_t)d1 * DM); uint4* q2 = (uint4*)((unsigned char*)AG + (size_t)d2 * DM);
#pragma unroll
        for (int i = 0; i < 2; ++i) { const uint4 v = src[i * 64 + lane]; q1[i * 64 + lane] = v; q2[i * 64 + lane] = v; }
#else
        const uint4* src = (const uint4*)(HA + (size_t)r * DM); uint4* q1 = (uint4*)(AG + (size_t)d1 * DM); uint4* q2 = (uint4*)(AG + (size_t)d2 * DM);
#pragma unroll
        for (int i = 0; i < 4; ++i) { const uint4 v = src[i * 64 + lane]; q1[i * 64 + lane] = v; q2[i * 64 + lane] = v; }
#endif
        if (lane == 0) { tok[6] = d1; tok[7] = d2; }
    }
    unsigned zq = 0u; asm volatile("" : "+v"(zq));
    unsigned run = 0;
    for (int e = 0; e < 8; ++e) { const unsigned c = cnt[e * 64], t = (c + 255u) >> 8; const unsigned lo = run * 256u + c, hi = (run + t) * 256u; run += t;
        for (unsigned r = lo + bid * NW + wid; r < hi; r += G * NW) { uint4* q = (uint4*)((unsigned char*)AG + (size_t)r * DM * (MOE_FP8 ? 1 : 2));
#pragma unroll
            for (int i = 0; i < (MOE_FP8 ? 2 : 4); ++i) q[i * 64 + lane] = make_uint4(zq, zq, zq, zq); } }
}


__device__ __forceinline__ uint4 ldg16(const bf16* p) { return *(const uint4*)p; }
__device__ __forceinline__ uint4 zero16() { return make_uint4(0u, 0u, 0u, 0u); }

__device__ __forceinline__ void feat_a(const Ctx& a, int l, int bid, int G) {
    unsigned char* ws = opqp(a.ws); const int tid = ((a.wv << 6) | lane_v()), lane = tid & 63, wid = tid >> 6;
    const bf16* U = (const bf16*)(ws + WS_U); bf16* ASM = (bf16*)(ws + WS_ASM); bf16* XBC = (bf16*)(ws + WS_XBC); bf16* QK = (bf16*)(ws + WS_QK);
    float* DT = (float*)(ws + WS_DT); const float* rope = (const float*)(ws + WS_ROPE);
    const float* mu = ldin(12) + (size_t)l * 2 * 1792; const float* cw = ldin(23) + (size_t)l * 3 * 1536; const float* cb = ldin(24) + (size_t)l * 1536;
    const float* dtb = ldin(25) + l * 32; const float* alog = ldin(26) + l * 32;
    for (int r = bid * NW + wid; r < MTOT; r += G * NW) {
        const bool lat = r < MLAT; const int t = lat ? (r & (SEQ - 1)) : ((r - MLAT) & (CTXL - 1)); const int L = lat ? SEQ : CTXL;
        const bool hp = t > 0, hn = t < L - 1;
        const bf16* up = U + (size_t)r * NINP;
        if (lane < 32) {
            const int c = C_RW_XW + lane * 8; float u[8], p[8], n[8], o[8];
            unpack8(ldg16(up + c), u); unpack8(hp ? ldg16(up - NINP + c) : zero16(), p); unpack8(hn ? ldg16(up + NINP + c) : zero16(), n);
#pragma unroll
            for (int e = 0; e < 8; ++e) { const float s = u[e] + mu[c + e] * (p[e] - u[e]) + mu[1792 + c + e] * (n[e] - u[e]); const int k = lane * 8 + e;
                o[e] = k < 64 ? (1.0f - 2.0f / (__expf(2.0f * s) + 1.0f)) : (k < 128 ? s : fsigm(s)); }
            *(uint4*)(ASM + (size_t)r * 256 + lane * 8) = pack8(o);
        }
#pragma unroll
        for (int it = 0; it < 3; ++it) {
            const int cc = (it * 64 + lane) * 8, c = C_MB_XBC + cc; float u[8], p[8], n[8], o[8];
            unpack8(ldg16(up + c), u); unpack8(hp ? ldg16(up - NINP + c) : zero16(), p); unpack8(hn ? ldg16(up + NINP + c) : zero16(), n);
#pragma unroll
            for (int e = 0; e < 8; ++e) o[e] = fsilu(cw[cc + e] * p[e] + cw[1536 + cc + e] * u[e] + cw[3072 + cc + e] * n[e] + cb[cc + e]);
            *(uint4*)(XBC + (size_t)r * 1536 + cc) = pack8(o);
        }
        if (lane < 32) {
            const float raw = bf2f(up[C_MB_DT + lane]); const float dtv = softplusf(raw + dtb[lane]); const float A = -__expf(alog[lane]);
            DT[(size_t)r * 64 + lane] = dtv; DT[(size_t)r * 64 + 32 + lane] = dtv * A;
        }
        {
            const int blk = lane >> 1, sub = lane & 1, c1 = C_DA_Q + blk * 32 + sub * 8; float u1[8], u2[8], o1[8], o2[8];
            unpack8(ldg16(up + c1), u1); unpack8(ldg16(up + c1 + 16), u2);
            const int half = blk & 1; const float scale = blk < 16 ? 0.125f * 1.44269504f : 1.0f;
#pragma unroll
            for (int e = 0; e < 8; ++e) {
                float cs = 1.0f, sn = 0.0f;
                if (lat) { cs = rope[t * 64 + half * 32 + sub * 8 + e]; sn = rope[t * 64 + half * 32 + 16 + sub * 8 + e]; }
                o1[e] = (u1[e] * cs - u2[e] * sn) * scale; o2[e] = (u2[e] * cs + u1[e] * sn) * scale; }
            *(uint4*)(QK + (size_t)r * 1024 + blk * 32 + sub * 8) = pack8(o1); *(uint4*)(QK + (size_t)r * 1024 + blk * 32 + 16 + sub * 8) = pack8(o2);
        }
    }
}

__device__ __forceinline__ void feat_b(const Ctx& a, int l, int bid, int G) {
    unsigned char* ws = opqp(a.ws); const int tid = ((a.wv << 6) | lane_v()), lane = tid & 63, wid = tid >> 6;
    const bf16* U = (const bf16*)(ws + WS_U); const float* F = (const float*)(ws + WS_MIX); bf16* R5 = (bf16*)(ws + WS_RW5);
    const float* mu = ldin(12) + (size_t)l * 2 * 1792; const float* k_k = ldin(18) + l * 512; const float* k_a = ldin(19) + l * 512; const float* a0 = ldin(15) + l * 512;
    for (int r = bid * NW + wid; r < MTOT; r += G * NW) {
        const bool lat = r < MLAT; const int t = lat ? (r & (SEQ - 1)) : ((r - MLAT) & (CTXL - 1)); const int L = lat ? SEQ : CTXL;
        const bool hp = t > 0, hn = t < L - 1;
        const bf16* up = U + (size_t)r * NINP; const int c = lane * 8;
        float s[3][8];
#pragma unroll
        for (int q = 0; q < 3; ++q) { const int col = q * 512 + c; float u[8], p[8], n[8];
            unpack8(ldg16(up + col), u); unpack8(hp ? ldg16(up - NINP + col) : zero16(), p); unpack8(hn ? ldg16(up + NINP + col) : zero16(), n);
#pragma unroll
            for (int e = 0; e < 8; ++e) s[q][e] = u[e] + mu[col + e] * (p[e] - u[e]) + mu[1792 + col + e] * (n[e] - u[e]); }
        float av[8]; { const float4 q0 = *(const float4*)(F + (size_t)r * 2048 + 1024 + c), a1 = *(const float4*)(F + (size_t)r * 2048 + 1024 + c + 4);
            av[0] = q0.x; av[1] = q0.y; av[2] = q0.z; av[3] = q0.w; av[4] = a1.x; av[5] = a1.y; av[6] = a1.z; av[7] = a1.w; }
#pragma unroll
        for (int e = 0; e < 8; ++e) av[e] = fsigm(av[e] + a0[c + e]);
        float kkv[8], k2[8], bv[8]; float ss = 0.f;
#pragma unroll
        for (int e = 0; e < 8; ++e) { kkv[e] = s[1][e] * k_k[c + e]; ss += kkv[e] * kkv[e]; }
        ss = red8(ss); const float inv = 1.0f / fmaxf(sqrtf(ss), 1e-12f);
#pragma unroll
        for (int e = 0; e < 8; ++e) { kkv[e] *= inv; k2[e] = s[1][e] * (1.0f + (av[e] - 1.0f) * k_a[c + e]); bv[e] = kkv[e] * av[e]; }
        const size_t o = (size_t)r * 512 + c, st = (size_t)MTOT * 512;
        *(uint4*)(R5 + o) = pack8(s[0]); *(uint4*)(R5 + st + o) = pack8(k2); *(uint4*)(R5 + 2 * st + o) = pack8(s[2]); *(uint4*)(R5 + 3 * st + o) = pack8(kkv); *(uint4*)(R5 + 4 * st + o) = pack8(bv);
    }
}

__device__ __forceinline__ void mix_out(const Ctx& a, int l, int M, int bid, int G) {
    unsigned char* ws = opqp(a.ws); const int tid = ((a.wv << 6) | lane_v()), lane = tid & 63, wid = tid >> 6;
    const bf16* U = (const bf16*)(ws + WS_U); const float* F = (const float*)(ws + WS_MIX); const bf16* R5 = (const bf16*)(ws + WS_RW5); const bf16* XBC = (const bf16*)(ws + WS_XBC);
    const bf16* YR = (const bf16*)(ws + WS_YR); const bf16* YM = (const bf16*)(ws + WS_YM); bf16* A2 = (bf16*)(ws + WS_HA);
    const float* r_k = ldin(20) + l * 512; const float* ln_w = ldin(21) + l * 512; const float* ln_b = ldin(22) + l * 512;
    const float* Dsk = ldin(27) + l * 16; const float* nw = ldin(28) + l * 1024;
    for (int r = bid * NW + wid; r < M; r += G * NW) {
        {
            const int c = lane * 8; const size_t o = (size_t)r * 512 + c, st = (size_t)MTOT * 512;
            float y[8];
            { float yf[8], yb[8]; unpack8(ldg16(YR + o), yf); unpack8(ldg16(YR + st + o), yb);
#pragma unroll
              for (int e = 0; e < 8; ++e) y[e] = yf[e] + yb[e]; }
            float sm = 0.f;
#pragma unroll
            for (int e = 0; e < 8; ++e) sm += y[e];
            const float mean = red8(sm) * (1.0f / 64.0f); float sv = 0.f;
#pragma unroll
            for (int e = 0; e < 8; ++e) { y[e] -= mean; sv += y[e] * y[e]; }
            const float rs = rsqrtf(red8(sv) * (1.0f / 64.0f) + 64e-5f);
            float rr[8], kk[8], vv[8]; unpack8(ldg16(R5 + o), rr); unpack8(ldg16(R5 + st + o), kk); unpack8(ldg16(R5 + 2 * st + o), vv);
            float dot = 0.f;
#pragma unroll
            for (int e = 0; e < 8; ++e) dot += rr[e] * kk[e] * r_k[c + e];
            dot = red8(dot);
            const float4 g0 = *(const float4*)(F + (size_t)r * 2048 + 1536 + c), g1 = *(const float4*)(F + (size_t)r * 2048 + 1536 + c + 4);
            const float g[8] = {g0.x, g0.y, g0.z, g0.w, g1.x, g1.y, g1.z, g1.w}; float ov[8];
#pragma unroll
            for (int e = 0; e < 8; ++e) ov[e] = (y[e] * rs * ln_w[c + e] + ln_b[c + e] + dot * vv[e]) * g[e];
            *(uint4*)(A2 + (size_t)r * DM + c) = pack8(ov);
        }
        {
            const int m0 = lane * 16, hh = m0 >> 6; const float dsk = Dsk[hh]; float y[16]; float ss = 0.f;
#pragma unroll
            for (int q = 0; q < 2; ++q) { const int m = m0 + q * 8; const size_t o = (size_t)r * 1024 + m;
                float ys[8]; unpack8(ldg16(YM + o), ys);
                float xs[8], z[8]; unpack8(ldg16(XBC + (size_t)r * 1536 + m), xs); unpack8(ldg16(U + (size_t)r * NINP + C_MB_Z + m), z);
#pragma unroll
                for (int e = 0; e < 8; ++e) { const float v = (ys[e] + dsk * xs[e]) * fsilu(z[e]); y[q * 8 + e] = v; ss += v * v; } }
            ss = red32(ss);
            const float rs = rsqrtf(ss * (1.0f / 512.0f) + 1e-5f);
#pragma unroll
            for (int q = 0; q < 2; ++q) { const int m = m0 + q * 8; float ov[8];
#pragma unroll
                for (int e = 0; e < 8; ++e) ov[e] = y[q * 8 + e] * rs * nw[m + e];
                *(uint4*)(A2 + (size_t)r * DM + 512 + m) = pack8(ov); }
        }
    }
}

__device__ __forceinline__ int chain_row(int s, int b, int dir) {
    if (s < CTXL) return MLAT + b * CTXL + (dir ? (CTXL - 1 - s) : s);
    const int t = s - CTXL; return b * SEQ + (dir ? (SEQ - 1 - t) : t);
}
constexpr int CH_STEPS = CTXL + SEQ, CH_T = 32, CH_NC = CH_STEPS / CH_T;


typedef short s16x4 __attribute__((ext_vector_type(4)));
constexpr int MB_NCH = 18;
__device__ __forceinline__ int mb_row0(int b, int cc) { return cc < 2 ? MLAT + b * CTXL + cc * 128 : b * SEQ + (cc - 2) * 128; }
__device__ __forceinline__ bf16x8 trfrag(const LAS bf16* pA, const LAS bf16* pB) {
    const s16x4 v0 = __builtin_amdgcn_ds_read_tr16_b64_v4i16((LAS s16x4*)pA), v1 = __builtin_amdgcn_ds_read_tr16_b64_v4i16((LAS s16x4*)pB);
    return __builtin_shufflevector(v0, v1, 0, 1, 2, 3, 4, 5, 6, 7);
}
constexpr int MB_PB = 144, MB_PX = 72;
constexpr int MB_OFF_C = 0, MB_OFF_B = 36864, MB_OFF_X = 73728  , MB_OFF_V = 110592  ;

__device__ __forceinline__ void mb_vectors(const float* DT, int row0, int g, LAS float* tmp, LAS float* vec, int tid) {
    for (int i = tid; i < 128 * 16; i += NT) { const int l = i >> 4, q4 = i & 15; *(LAS f32x4*)(tmp + l * 64 + q4 * 4) = *(const f32x4*)(DT + (size_t)(row0 + l) * 64 + q4 * 4); }
    __syncthreads();
    LAS float* tot = tmp + 128 * 64;
    const int seq = tid >> 5, j = tid & 31, hh = seq & 7, dir = seq >> 3;
    float v[4], run = 0.f;
#pragma unroll
    for (int e = 0; e < 4; ++e) { const int l = dir ? 127 - (4 * j + e) : 4 * j + e; run += tmp[l * 64 + 32 + dir * 16 + g * 8 + hh]; v[e] = run; }
    tot[seq * 32 + j] = run;
    __syncthreads();
    float off = 0.f;
    for (int q = 0; q < 32; ++q) { const float tq = tot[seq * 32 + q]; off += q < j ? tq : 0.f; }
#pragma unroll
    for (int e = 0; e < 4; ++e) { const int l = dir ? 127 - (4 * j + e) : 4 * j + e; vec[dir * 1024 + hh * 128 + l] = v[e] + off; }
    __syncthreads();
    for (int i = tid; i < 2048; i += NT) { const int d2 = i >> 10, h2 = (i >> 7) & 7, l = i & 127; const int ref = d2 ? (l & ~15) : (l | 15);
        vec[2048 + i] = __expf(fmaxf(vec[d2 * 1024 + h2 * 128 + ref] - vec[d2 * 1024 + h2 * 128 + l], -80.f)) * tmp[l * 64 + d2 * 16 + g * 8 + h2]; }
    __syncthreads();
}

__device__ __forceinline__ void mamba_m1(const Ctx& a, LAS unsigned char* lds, int item) {
    unsigned char* ws = opqp(a.ws); const int tid = ((a.wv << 6) | lane_v()), lane = tid & 63, wid = tid >> 6, fr = lane & 15, fq = lane >> 4, q4 = (lane & 15) >> 2, p4 = lane & 3;
    const int g = item & 1, cc = (item >> 1) % MB_NCH, b = (item >> 1) / MB_NCH; const int row0 = mb_row0(b, cc);
    const bf16* XBC = (const bf16*)(ws + WS_XBC); const float* DT = (const float*)(ws + WS_DT); bf16* ST = (bf16*)(ws + WS_ST); float* AC = (float*)(ws + WS_AC);
    LAS bf16* Bs = (LAS bf16*)(lds + MB_OFF_B); LAS float* vec = (LAS float*)(lds + MB_OFF_V);
    __syncthreads();
    mb_vectors(DT, row0, g, (LAS float*)(lds + MB_OFF_C), vec, tid);
    if (tid < 16) { const int hh = tid & 7, dir = tid >> 3; AC[((size_t)(b * MB_NCH + cc) * 16 + g * 8 + hh) * 2 + dir] = dir ? vec[1024 + hh * 128] : vec[hh * 128 + 127]; }
    for (int i = tid; i < 2048; i += NT) { const int l = i >> 4, ch = i & 15; *(LAS u32x4*)(Bs + l * MB_PB + ch * 8) = *(const u32x4*)(XBC + (size_t)(row0 + l) * 1536 + 1024 + g * 128 + ch * 8); }
    uint4 xq[2];
#pragma unroll
    for (int j = 0; j < 2; ++j) { const int id = tid + j * NT; xq[j] = *(const uint4*)(XBC + (size_t)(row0 + (id >> 3)) * 1536 + (g * 8) * 64 + (id & 7) * 8); }
    for (int hh = 0; hh < 8; ++hh) {
        const int h = g * 8 + hh;
        LAS bf16* Yf = (LAS bf16*)(lds + ((hh & 1) ? MB_OFF_X : MB_OFF_C)); LAS bf16* Yb = Yf + 128 * MB_PX;
        const float tf = vec[hh * 128 + 127];
        uint4 xc[2] = {xq[0], xq[1]};
        if (hh + 1 < 8) {
#pragma unroll
            for (int j = 0; j < 2; ++j) { const int id = tid + j * NT; xq[j] = *(const uint4*)(XBC + (size_t)(row0 + (id >> 3)) * 1536 + (h + 1) * 64 + (id & 7) * 8); } }
#pragma unroll
        for (int j = 0; j < 2; ++j) { const int id = tid + j * NT, l = id >> 3, ch = id & 7; float x8[8], of[8], ob[8];
            unpack8(xc[j], x8);
            const float sf = __expf(tf - vec[hh * 128 + (l | 15)]) * vec[2048 + hh * 128 + l], sb = __expf(vec[1024 + hh * 128] - vec[1024 + hh * 128 + (l & ~15)]) * vec[3072 + hh * 128 + l];
#pragma unroll
            for (int e = 0; e < 8; ++e) { of[e] = x8[e] * sf; ob[e] = x8[e] * sb; }
            const uint4 pf = pack8(of), pb = pack8(ob);
            *(LAS u32x4*)(Yf + l * MB_PX + ch * 8) = (u32x4){pf.x, pf.y, pf.z, pf.w}; *(LAS u32x4*)(Yb + l * MB_PX + ch * 8) = (u32x4){pb.x, pb.y, pb.z, pb.w}; }
        __syncthreads();
        const int pt = wid & 3, nh = wid >> 2;
#pragma unroll
        for (int dir = 0; dir < 2; ++dir) { const LAS bf16* Xd = dir ? Yb : Yf;
            bf16x8 yf4[4];
#pragma unroll
            for (int ks = 0; ks < 4; ++ks) { const LAS bf16* pa = Xd + (ks * 32 + 8 * fq + q4) * MB_PX + pt * 16 + 4 * p4; yf4[ks] = trfrag(pa, pa + 4 * MB_PX); }
#pragma unroll
            for (int ns = 0; ns < 4; ++ns) { f32x4 acc = (f32x4){0.f, 0.f, 0.f, 0.f};
#pragma unroll
                for (int ks = 0; ks < 4; ++ks) { const LAS bf16* pa = Bs + (ks * 32 + 8 * fq + q4) * MB_PB + (nh * 4 + ns) * 16 + 4 * p4;
                    acc = __builtin_amdgcn_mfma_f32_16x16x32_bf16(trfrag(pa, pa + 4 * MB_PB), yf4[ks], acc, 0, 0, 0); }
                uint2 pk; pk.x = pk2(acc[0], acc[1]); pk.y = pk2(acc[2], acc[3]);
                *(uint2*)(ST + ((((size_t)(b * MB_NCH + cc) * 16 + h) * 2 + dir) * 64 + pt * 16 + fr) * 128 + (nh * 4 + ns) * 16 + 4 * fq) = pk; } }
    }
}

__device__ __forceinline__ void mamba_m2(const Ctx& a, int item) {
    unsigned char* ws = opqp(a.ws); const int tid = ((a.wv << 6) | lane_v());
    const int dir = item & 1, h = (item >> 1) & 15, b = item >> 5;
    bf16* ST = (bf16*)(ws + WS_ST); const float* AC = (const float*)(ws + WS_AC);
    float H[16];
#pragma unroll
    for (int i = 0; i < 16; ++i) H[i] = 0.f;
#define M2_CC(st_) (dir == 0 ? (st_) : ((st_) < 2 ? 1 - (st_) : 19 - (st_)))
#define M2_PTR(st_) (ST + ((((size_t)(b * MB_NCH + M2_CC(st_)) * 16 + h) * 2 + dir) * 64) * 128 + tid * 16)
    uint4 s0 = *(const uint4*)M2_PTR(0), s1 = *(const uint4*)(M2_PTR(0) + 8); float la = AC[((size_t)(b * MB_NCH + M2_CC(0)) * 16 + h) * 2 + dir];
    for (int st = 0; st < MB_NCH; ++st) {
        bf16* p = M2_PTR(st);
        const int sn = st + 1 < MB_NCH ? st + 1 : st;
        const uint4 n0 = *(const uint4*)M2_PTR(sn), n1 = *(const uint4*)(M2_PTR(sn) + 8); const float ln = AC[((size_t)(b * MB_NCH + M2_CC(sn)) * 16 + h) * 2 + dir];
        float f0[8], f1[8]; unpack8(s0, f0); unpack8(s1, f1);
        const float ea = __expf(la);
        float o0[8], o1[8];
#pragma unroll
        for (int e = 0; e < 8; ++e) { o0[e] = H[e]; o1[e] = H[8 + e]; H[e] = ea * H[e] + f0[e]; H[8 + e] = ea * H[8 + e] + f1[e]; }
        *(uint4*)p = pack8(o0); *(uint4*)(p + 8) = pack8(o1);
        s0 = n0; s1 = n1; la = ln;
    }
#undef M2_CC
#undef M2_PTR
}

__device__ __forceinline__ void mamba_m3(const Ctx& a, LAS unsigned char* lds, int b, int cc, int g) {
    unsigned char* ws = opqp(a.ws); const int tid = ((a.wv << 6) | lane_v()), lane = tid & 63, wid = tid >> 6, fr = lane & 15, fq = lane >> 4, q4 = (lane & 15) >> 2, p4 = lane & 3;
    const int row0 = mb_row0(b, cc);
    const bf16* XBC = (const bf16*)(ws + WS_XBC); const float* DT = (const float*)(ws + WS_DT); const bf16* ST = (const bf16*)(ws + WS_ST); bf16* YM = (bf16*)(ws + WS_YM);
    LAS bf16* Cs = (LAS bf16*)(lds + MB_OFF_C); LAS bf16* Bs = (LAS bf16*)(lds + MB_OFF_B); LAS float* vec = (LAS float*)(lds + MB_OFF_V);
    __syncthreads();
    mb_vectors(DT, row0, g, (LAS float*)(lds + MB_OFF_C), vec, tid);
    for (int i = tid; i < 2048; i += NT) { const int l = i >> 4, ch = i & 15; const bf16* src = XBC + (size_t)(row0 + l) * 1536 + g * 128 + ch * 8;
        *(LAS u32x4*)(Bs + l * MB_PB + ch * 8) = *(const u32x4*)(src + 1024); *(LAS u32x4*)(Cs + l * MB_PB + ch * 8) = *(const u32x4*)(src + 1280); }
    uint4 xr[2];
#define M3_XLOAD(hh_) do { _Pragma("unroll") for (int j_ = 0; j_ < 2; ++j_) { const int id_ = tid + j_ * NT; xr[j_] = *(const uint4*)(XBC + (size_t)(row0 + (id_ >> 3)) * 1536 + (g * 8 + (hh_)) * 64 + (id_ & 7) * 8); } } while (0)
#define M3_XSTORE(hh_) do { LAS bf16* X_ = (LAS bf16*)(lds + MB_OFF_X) + ((hh_) & 1) * 128 * MB_PX; _Pragma("unroll") for (int j_ = 0; j_ < 2; ++j_) { const int id_ = tid + j_ * NT; \
        *(LAS u32x4*)(X_ + (id_ >> 3) * MB_PX + (id_ & 7) * 8) = (u32x4){xr[j_].x, xr[j_].y, xr[j_].z, xr[j_].w}; } } while (0)
    M3_XLOAD(0); M3_XSTORE(0);
    __syncthreads();
    const int l0 = wid * 16;
    bf16x8 cf[4];
#pragma unroll
    for (int ks = 0; ks < 4; ++ks) cf[ks] = *(const LAS bf16x8*)(Cs + (l0 + fr) * MB_PB + ks * 32 + fq * 8);
    f32x4 CB[8];
#pragma unroll
    for (int sb = 0; sb < 8; ++sb) { f32x4 acc = (f32x4){0.f, 0.f, 0.f, 0.f};
#pragma unroll
        for (int ks = 0; ks < 4; ++ks) acc = __builtin_amdgcn_mfma_f32_16x16x32_bf16(*(const LAS bf16x8*)(Bs + (sb * 16 + fr) * MB_PB + ks * 32 + fq * 8), cf[ks], acc, 0, 0, 0);
        CB[sb] = acc; }
    bf16x8 hs0[8], hs1[8];
#define M3_HLOAD(SET_, hh_, pt_) do { const bf16* Hf_ = ST + ((((size_t)(b * MB_NCH + cc) * 16 + g * 8 + (hh_)) * 2 + 0) * 64) * 128 + (size_t)((pt_) * 16 + fr) * 128 + fq * 8; \
        _Pragma("unroll") for (int ks_ = 0; ks_ < 4; ++ks_) { SET_[ks_] = *(const bf16x8*)(Hf_ + ks_ * 32); SET_[4 + ks_] = *(const bf16x8*)(Hf_ + 64 * 128 + ks_ * 32); } } while (0)
    M3_HLOAD(hs0, 0, 0);
    float mfd[4], mbd[4];
#pragma unroll
    for (int e = 0; e < 4; ++e) { const int dd = 4 * fq + e - fr; mfd[e] = dd <= 0 ? 1.f : 0.f; mbd[e] = dd >= 0 ? 1.f : 0.f; }
    const int nhh = (a.sub & 16) ? 0 : ((a.sub & 8) ? 1 : 8);
    for (int hh = 0; hh < nhh; ++hh) {
        const int h = g * 8 + hh;
        if (hh + 1 < 8) M3_XLOAD(hh + 1);
        const LAS bf16* X = (const LAS bf16*)(lds + MB_OFF_X) + (hh & 1) * 128 * MB_PX;
        const LAS float* vf = vec + hh * 128; const LAS float* vb = vec + 1024 + hh * 128; const LAS float* cF = vec + 2048 + hh * 128; const LAS float* cB = vec + 3072 + hh * 128;
        const float afl = vf[l0 + fr], abl = vb[l0 + fr];
        bf16x8 wf[4];
#pragma unroll
        for (int kc = 0; kc < 4; ++kc) { float wv[8];
#pragma unroll
            for (int hs = 0; hs < 2; ++hs) { const int sb = 2 * kc + hs, s0 = sb * 16 + 4 * fq;
                float rf = 0.f, rb = 0.f;
                if (sb <= wid) rf = __expf(fminf(afl - vf[sb * 16 + 15], 80.f));
                if (sb >= wid) rb = __expf(fminf(abl - vb[sb * 16], 80.f));
                const f32x4 c_f = *(const LAS f32x4*)(cF + s0), c_b = *(const LAS f32x4*)(cB + s0);
#pragma unroll
                for (int e = 0; e < 4; ++e) { float m;
                    if (sb < wid) m = rf * c_f[e]; else if (sb > wid) m = rb * c_b[e]; else m = rf * c_f[e] * mfd[e] + rb * c_b[e] * mbd[e];
                    wv[hs * 4 + e] = CB[sb][e] * m; } }
            u32x4 w; w.x = pk2(wv[0], wv[1]); w.y = pk2(wv[2], wv[3]); w.z = pk2(wv[4], wv[5]); w.w = pk2(wv[6], wv[7]); wf[kc] = __builtin_bit_cast(bf16x8, w); }
        const float ef = __expf(afl), eb = __expf(abl);
#define M3_STEP(SET_, NXT_, pt_, hn_, ptn_, do_load_) do { \
            if (do_load_) M3_HLOAD(NXT_, hn_, ptn_); \
            f32x4 yd = (f32x4){0.f, 0.f, 0.f, 0.f}, y1 = yd, y2 = yd; \
            _Pragma("unroll") for (int kc = 0; kc < 4; ++kc) { const LAS bf16* pa = X + (kc * 32 + 4 * fq + q4) * MB_PX + (pt_) * 16 + 4 * p4; \
                yd = __builtin_amdgcn_mfma_f32_16x16x32_bf16(trfrag(pa, pa + 16 * MB_PX), wf[kc], yd, 0, 0, 0); } \
            _Pragma("unroll") for (int ks = 0; ks < 4; ++ks) { y1 = __builtin_amdgcn_mfma_f32_16x16x32_bf16(SET_[ks], cf[ks], y1, 0, 0, 0); y2 = __builtin_amdgcn_mfma_f32_16x16x32_bf16(SET_[4 + ks], cf[ks], y2, 0, 0, 0); } \
            f32x4 o; \
            _Pragma("unroll") for (int e = 0; e < 4; ++e) o[e] = yd[e] + ef * y1[e] + eb * y2[e]; \
            { uint2 pk; pk.x = pk2(o[0], o[1]); pk.y = pk2(o[2], o[3]); *(uint2*)(YM + (size_t)(row0 + l0 + fr) * 1024 + h * 64 + (pt_) * 16 + 4 * fq) = pk; } } while (0)
        M3_STEP(hs0, hs1, 0, hh, 1, true);
        M3_STEP(hs1, hs0, 1, hh, 2, true);
        M3_STEP(hs0, hs1, 2, hh, 3, true);
        M3_STEP(hs1, hs0, 3, hh + 1, 0, hh + 1 < 8);
#undef M3_STEP
        if (hh + 1 < 8) { M3_XSTORE(hh + 1); }
        __syncthreads();
    }
#undef M3_XLOAD
#undef M3_XSTORE
#undef M3_HLOAD
}


constexpr int RC_NCH = CH_STEPS / 16;
constexpr int RC_UNITS = 128 * RC_NCH;
constexpr int RC_TP = 72;
constexpr int RC_WAVE_LDS = 5 * 16 * RC_TP * 2 + 16 * 17 * 4 + 16 * 24 * 2;
constexpr int RC_CT_FLOATS = 6 * 512 + 3 * 512;
static_assert(8 * RC_WAVE_LDS + RC_CT_FLOATS * 4 <= LDS_STAGE, "rwkv R1 LDS");
__device__ __forceinline__ void rc_consts(LAS unsigned char* lds, int l, int tid) {
    LAS float* CT = (LAS float*)(lds + 8 * RC_WAVE_LDS);
    const float* mu = ldin(12) + (size_t)l * 2 * 1792; const float* a0 = ldin(15) + l * 512; const float* k_k = ldin(18) + l * 512; const float* k_a = ldin(19) + l * 512;
    for (int i = tid; i < 1536; i += NT) { CT[i] = mu[i]; CT[1536 + i] = mu[1792 + i]; }
    for (int i = tid; i < 512; i += NT) { CT[3072 + i] = a0[i]; CT[3584 + i] = k_k[i]; CT[4096 + i] = k_a[i]; }
    __syncthreads();
}
constexpr size_t RC_REC = 16 * 64 + 16 * 64 + 16 * 64 + 64 * 32 + 16 * 64;
constexpr size_t WS_RC1 = WS_MGU + 224 * MiB;
constexpr size_t WS_RC2 = WS_MD + 112 * MiB;
static_assert(MOE_FP8 == 1 && (size_t)RC_UNITS * RC_REC * 2 <= 224 * MiB && (size_t)RC_UNITS * (4096 + 256) <= 112 * MiB, "rwkv chunk records");

__device__ __forceinline__ bf16x8 pack_lo4(const f32x4 v) { u32x4 w; w.x = pk2(v[0], v[1]); w.y = pk2(v[2], v[3]); w.z = 0u; w.w = 0u; return __builtin_bit_cast(bf16x8, w); }

__device__ __forceinline__ void rwkv_r1(const Ctx& a, LAS unsigned char* lds, int l, int unit) {
    unsigned char* ws = opqp(a.ws); const int tid = ((a.wv << 6) | lane_v()), lane = tid & 63, wid = tid >> 6, fr = lane & 15, fq = lane >> 4, q4 = (lane & 15) >> 2, p4 = lane & 3;
    const int chain = unit / RC_NCH, c = unit % RC_NCH; const int dir = chain & 1, h = (chain >> 1) & 7, b = chain >> 4;
    const bf16* R5 = (const bf16*)(ws + WS_RW5); const float* F = (const float*)(ws + WS_MIX); const size_t st = (size_t)MTOT * 512;
    bf16* rec = (bf16*)(ws + WS_RC1) + (size_t)unit * RC_REC; float* Ycg = (float*)(ws + WS_RC2) + (size_t)unit * 1024; float* PCg = (float*)(ws + WS_RC2) + (size_t)RC_UNITS * 1024 + (size_t)unit * 64;
    LAS bf16* tA = (LAS bf16*)(lds + wid * RC_WAVE_LDS); LAS bf16* tR = tA + 16 * RC_TP; LAS bf16* tB = tR + 16 * RC_TP; LAS bf16* tK = tB + 16 * RC_TP; LAS bf16* tV = tK + 16 * RC_TP;
    LAS float* L1s = (LAS float*)(tV + 16 * RC_TP); LAS bf16* Ts = (LAS bf16*)(L1s + 16 * 17);
    {   const int t = lane >> 2, part = lane & 3; const int row = chain_row(c * 16 + t, b, dir);
        const bool lat = row < MLAT; const int pos = lat ? (row & (SEQ - 1)) : ((row - MLAT) & (CTXL - 1)); const bool hp = pos > 0, hn = pos < (lat ? SEQ : CTXL) - 1;
        const bf16* U = (const bf16*)(ws + WS_U); const bf16* up = U + (size_t)row * NINP + h * 64 + part * 16; const int ch = h * 64 + part * 16;
        const LAS float* CT = (const LAS float*)(lds + 8 * RC_WAVE_LDS);
        float sv[3][16];
#pragma unroll
        for (int q = 0; q < 3; ++q)
#pragma unroll
            for (int hf = 0; hf < 2; ++hf) { float u[8], p[8], n[8];
                unpack8(*(const uint4*)(up + q * 512 + hf * 8), u); unpack8(hp ? *(const uint4*)(up - NINP + q * 512 + hf * 8) : make_uint4(0u, 0u, 0u, 0u), p); unpack8(hn ? *(const uint4*)(up + NINP + q * 512 + hf * 8) : make_uint4(0u, 0u, 0u, 0u), n);
#pragma unroll
                for (int e = 0; e < 8; ++e) { const int cc = ch + hf * 8 + e; sv[q][hf * 8 + e] = u[e] + CT[q * 512 + cc] * (p[e] - u[e]) + CT[1536 + q * 512 + cc] * (n[e] - u[e]); } }
        float av[16];
#pragma unroll
        for (int q4_ = 0; q4_ < 4; ++q4_) { const f32x4 f = *(const f32x4*)(F + (size_t)row * 2048 + 1024 + ch + q4_ * 4);
#pragma unroll
            for (int e = 0; e < 4; ++e) av[q4_ * 4 + e] = fsigm(f[e] + CT[3072 + ch + q4_ * 4 + e]); }
        float kkv[16], k2[16], bv[16], ss = 0.f;
#pragma unroll
        for (int e = 0; e < 16; ++e) { kkv[e] = sv[1][e] * CT[3584 + ch + e]; ss += kkv[e] * kkv[e]; }
        ss += dppf<0xB1>(ss); ss += dppf<0x4E>(ss);
        const float inv = 1.0f / fmaxf(sqrtf(ss), 1e-12f);
#pragma unroll
        for (int e = 0; e < 16; ++e) { kkv[e] *= inv; k2[e] = sv[1][e] * (1.0f + (av[e] - 1.0f) * CT[4096 + ch + e]); bv[e] = kkv[e] * av[e]; }
        const int lo = t * RC_TP + part * 16;
#define RC_PUT(T_, A_) do { *(LAS u32x4*)(T_ + lo) = (u32x4){pk2(A_[0], A_[1]), pk2(A_[2], A_[3]), pk2(A_[4], A_[5]), pk2(A_[6], A_[7])}; \
            *(LAS u32x4*)(T_ + lo + 8) = (u32x4){pk2(A_[8], A_[9]), pk2(A_[10], A_[11]), pk2(A_[12], A_[13]), pk2(A_[14], A_[15])}; } while (0)
        RC_PUT(tR, sv[0]); RC_PUT(tK, k2); RC_PUT(tV, sv[2]); RC_PUT(tA, kkv); RC_PUT(tB, bv);
#undef RC_PUT
        if (dir == 0) {
            bf16* R5w = (bf16*)(ws + WS_RW5); const size_t o = (size_t)row * 512 + ch;
            *(u32x4*)(R5w + o) = *(const LAS u32x4*)(tR + lo); *(u32x4*)(R5w + o + 8) = *(const LAS u32x4*)(tR + lo + 8);
            *(u32x4*)(R5w + st + o) = *(const LAS u32x4*)(tK + lo); *(u32x4*)(R5w + st + o + 8) = *(const LAS u32x4*)(tK + lo + 8);
            *(u32x4*)(R5w + 2 * st + o) = *(const LAS u32x4*)(tV + lo); *(u32x4*)(R5w + 2 * st + o + 8) = *(const LAS u32x4*)(tV + lo + 8); }
    }
    const int j = lane; const float w0j = ldin(13)[l * 1024 + dir * 512 + h * 64 + j];
    float wraw[16];
#pragma unroll
    for (int t = 0; t < 16; ++t) wraw[t] = F[(size_t)chain_row(c * 16 + t, b, dir) * 2048 + dir * 512 + h * 64 + j];
    __builtin_amdgcn_sched_barrier(0);
    float Lc = 0.f, Pprev = 1.0f, Lct[16], bq[16], kq[16];
#pragma unroll
    for (int t = 0; t < 16; ++t) {
        const float rv = bf2f(tR[t * RC_TP + j]), kv = bf2f(tK[t * RC_TP + j]), kkv = bf2f(tA[t * RC_TP + j]), bv = bf2f(tB[t * RC_TP + j]);
        const float lw = (-0.60653066f * 1.44269504f) * fsigm(wraw[t] + w0j);
        const float Pm1 = Pprev; Lc += lw; const float P = __builtin_amdgcn_exp2f(Lc), iP = __builtin_amdgcn_rcpf(P); Pprev = P;
        Lct[t] = Lc; bq[t] = bv; kq[t] = kv;
        tA[t * RC_TP + j] = (bf16)f2bf(-kkv * Pm1); tR[t * RC_TP + j] = (bf16)f2bf(rv * P); tB[t * RC_TP + j] = (bf16)f2bf(bv * iP); tK[t * RC_TP + j] = (bf16)f2bf(kv * iP);
    }
    PCg[j] = Pprev;
    {   unsigned vw[8];
#pragma unroll
        for (int t2 = 0; t2 < 8; ++t2) vw[t2] = (unsigned)tV[(2 * t2) * RC_TP + j] | ((unsigned)tV[(2 * t2 + 1) * RC_TP + j] << 16);
        *(uint4*)(rec + 5120 + (size_t)j * 16) = make_uint4(vw[0], vw[1], vw[2], vw[3]); *(uint4*)(rec + 5120 + (size_t)j * 16 + 8) = make_uint4(vw[4], vw[5], vw[6], vw[7]); }
    {   bf16* BK = rec + 3072 + (size_t)j * 32;
#pragma unroll
        for (int g = 0; g < 4; ++g) { float o8[8];
#pragma unroll
            for (int e = 0; e < 4; ++e) { const float d = __builtin_amdgcn_exp2f(Lc - Lct[4 * g + e]); o8[e] = bq[4 * g + e] * d; o8[4 + e] = kq[4 * g + e] * d; }
            *(uint4*)(BK + g * 8) = pack8(o8); } }
    f32x4 L1 = (f32x4){0.f, 0.f, 0.f, 0.f}, L2 = L1, M1 = L1, M2 = L1;
#pragma unroll
    for (int ks = 0; ks < 2; ++ks) {
        const bf16x8 ya = *(const LAS bf16x8*)(tA + fr * RC_TP + ks * 32 + fq * 8), yr = *(const LAS bf16x8*)(tR + fr * RC_TP + ks * 32 + fq * 8);
        const bf16x8 xb = *(const LAS bf16x8*)(tB + fr * RC_TP + ks * 32 + fq * 8), xk = *(const LAS bf16x8*)(tK + fr * RC_TP + ks * 32 + fq * 8);
        L1 = __builtin_amdgcn_mfma_f32_16x16x32_bf16(xb, ya, L1, 0, 0, 0); L2 = __builtin_amdgcn_mfma_f32_16x16x32_bf16(xk, ya, L2, 0, 0, 0);
        M1 = __builtin_amdgcn_mfma_f32_16x16x32_bf16(xb, yr, M1, 0, 0, 0); M2 = __builtin_amdgcn_mfma_f32_16x16x32_bf16(xk, yr, M2, 0, 0, 0);
    }
#pragma unroll
    for (int e = 0; e < 4; ++e) { const int s = 4 * fq + e, t = fr;
        if (!(s < t)) { L1[e] = 0.f; L2[e] = 0.f; } if (!(s <= t)) { M1[e] = 0.f; M2[e] = 0.f; }
        }
    {   const int cc = lane & 15; float Tc[16];
#pragma unroll
        for (int t = 0; t < 16; ++t) { float acc = (t == cc) ? 1.f : 0.f;
#pragma unroll
            for (int s = 0; s < t; ++s) { const float lts = __int_as_float(__builtin_amdgcn_readlane(__float_as_int(L1[s & 3]), 16 * (s >> 2) + t)); acc += lts * Tc[s]; }
            Tc[t] = acc; }
        if (lane < 16) {
#pragma unroll
            for (int t = 0; t < 16; ++t) Ts[t * 24 + cc] = (bf16)f2bf(Tc[t]); } }
    const bf16x8 Top = __builtin_bit_cast(bf16x8, (u32x4){((const LAS unsigned*)(Ts + fr * 24 + 4 * fq))[0], ((const LAS unsigned*)(Ts + fr * 24 + 4 * fq))[1], 0u, 0u});
    const bf16x8 L2op = pack_lo4(L2), M1op = pack_lo4(M1), M2op = pack_lo4(M2);
#pragma unroll
    for (int kt = 0; kt < 4; ++kt) { const LAS bf16* pa = tA + (4 * fq + q4) * RC_TP + kt * 16 + 4 * p4;
        const f32x4 ta = __builtin_amdgcn_mfma_f32_16x16x32_bf16(trfrag(pa, pa), Top, (f32x4){0.f, 0.f, 0.f, 0.f}, 0, 0, 0);
        uint2 pk; pk.x = pk2(ta[0], ta[1]); pk.y = pk2(ta[2], ta[3]);
        *(uint2*)(rec + fr * 64 + 32 * (kt >> 1) + 8 * fq + 4 * (kt & 1)) = pk;
        *(LAS u32x2*)(tB + fr * RC_TP + kt * 16 + 4 * fq) = (u32x2){pk.x, pk.y}; }
#pragma unroll
    for (int vt = 0; vt < 4; ++vt) { const LAS bf16* pa = tV + (4 * fq + q4) * RC_TP + vt * 16 + 4 * p4;
        const f32x4 x = __builtin_amdgcn_mfma_f32_16x16x32_bf16(trfrag(pa, pa), L2op, (f32x4){0.f, 0.f, 0.f, 0.f}, 0, 0, 0);
        *(LAS u32x2*)(tK + fr * RC_TP + vt * 16 + 4 * fq) = (u32x2){pk2(x[0], x[1]), pk2(x[2], x[3])}; }
#pragma unroll
    for (int kt = 0; kt < 4; ++kt) { const LAS bf16* pa = tB + (4 * fq + q4) * RC_TP + kt * 16 + 4 * p4;
        const u32x2 r2 = *(const LAS u32x2*)(tR + fr * RC_TP + kt * 16 + 4 * fq);
        f32x4 ra = (f32x4){__uint_as_float(r2.x << 16), __uint_as_float(r2.x & 0xffff0000u), __uint_as_float(r2.y << 16), __uint_as_float(r2.y & 0xffff0000u)};
        ra = __builtin_amdgcn_mfma_f32_16x16x32_bf16(trfrag(pa, pa), M1op, ra, 0, 0, 0);
        uint2 pk; pk.x = pk2(ra[0], ra[1]); pk.y = pk2(ra[2], ra[3]);
        *(uint2*)(rec + 1024 + fr * 64 + 32 * (kt >> 1) + 8 * fq + 4 * (kt & 1)) = pk; }
#pragma unroll
    for (int vt = 0; vt < 4; ++vt) { const LAS bf16* pa = tK + (4 * fq + q4) * RC_TP + vt * 16 + 4 * p4;
        const f32x4 x = __builtin_amdgcn_mfma_f32_16x16x32_bf16(trfrag(pa, pa), Top, (f32x4){0.f, 0.f, 0.f, 0.f}, 0, 0, 0);
        uint2 pk; pk.x = pk2(x[0], x[1]); pk.y = pk2(x[2], x[3]);
#pragma unroll
        for (int e = 0; e < 4; ++e) rec[2048 + (size_t)(vt * 16 + 4 * fq + e) * 16 + fr] = (bf16)f2bf(x[e]);
        *(LAS u32x2*)(tA + fr * RC_TP + vt * 16 + 4 * fq) = (u32x2){pk.x, pk.y}; }
#pragma unroll
    for (int vt = 0; vt < 4; ++vt) { const LAS bf16* pg = tA + (4 * fq + q4) * RC_TP + vt * 16 + 4 * p4; const LAS bf16* pv = tV + (4 * fq + q4) * RC_TP + vt * 16 + 4 * p4;
        f32x4 x = __builtin_amdgcn_mfma_f32_16x16x32_bf16(trfrag(pg, pg), M1op, (f32x4){0.f, 0.f, 0.f, 0.f}, 0, 0, 0);
        x = __builtin_amdgcn_mfma_f32_16x16x32_bf16(trfrag(pv, pv), M2op, x, 0, 0, 0);
#pragma unroll
        for (int e = 0; e < 4; ++e) Ycg[(size_t)(vt * 16 + 4 * fq + e) * 16 + fr] = x[e]; }
}

constexpr int R2_NV = 2;
__device__ __forceinline__ void rwkv_r2(const Ctx& a, int l, int item) {
    unsigned char* ws = opqp(a.ws); const int tid = ((a.wv << 6) | lane_v()), lane = tid & 63, wid = tid >> 6, fr = lane & 15, fq = lane >> 4;
    const int chain = 4 * item + (wid >> 1), v0 = 32 * (wid & 1); const int dir = chain & 1, h = (chain >> 1) & 7, b = chain >> 4;
    bf16* Y = (bf16*)(ws + WS_YR) + (size_t)dir * MTOT * 512;
    f32x4 S[R2_NV][4];
#pragma unroll
    for (int vg = 0; vg < R2_NV; ++vg)
#pragma unroll
        for (int kt = 0; kt < 4; ++kt) S[vg][kt] = (f32x4){0.f, 0.f, 0.f, 0.f};
    struct Rec { bf16x8 taf[2], raf[2], bkf[4]; f32x4 pc[4]; uint2 g2[R2_NV], v2[R2_NV]; f32x4 yc[R2_NV]; int r0; };
    Rec cur, nxt;
#define R2_LOAD(R_, c_) do { const size_t unit_ = (size_t)chain * RC_NCH + (c_); \
        const bf16* rec_ = (const bf16*)(ws + WS_RC1) + unit_ * RC_REC; const float* Ycg_ = (const float*)(ws + WS_RC2) + unit_ * 1024; const float* PCg_ = (const float*)(ws + WS_RC2) + (size_t)RC_UNITS * 1024 + unit_ * 64; \
        _Pragma("unroll") for (int jj = 0; jj < 2; ++jj) { R_.taf[jj] = *(const bf16x8*)(rec_ + fr * 64 + jj * 32 + fq * 8); R_.raf[jj] = *(const bf16x8*)(rec_ + 1024 + fr * 64 + jj * 32 + fq * 8); } \
        _Pragma("unroll") for (int kt = 0; kt < 4; ++kt) { R_.bkf[kt] = *(const bf16x8*)(rec_ + 3072 + (size_t)(kt * 16 + fr) * 32 + fq * 8); R_.pc[kt] = *(const f32x4*)(PCg_ + kt * 16 + 4 * fq); } \
        _Pragma("unroll") for (int vg = 0; vg < R2_NV; ++vg) { const size_t vo_ = (size_t)(v0 + 16 * vg + fr) * 16 + 4 * fq; \
            R_.g2[vg] = *(const uint2*)(rec_ + 2048 + vo_); R_.v2[vg] = *(const uint2*)(rec_ + 5120 + vo_); R_.yc[vg] = *(const f32x4*)(Ycg_ + vo_); } \
        const int s0_ = (c_) * 16; const int inc_ = s0_ < CTXL ? 1 : 0; const int t0_ = s0_ - (inc_ ? 0 : CTXL), L_ = inc_ ? CTXL : SEQ, base_ = inc_ ? MLAT + b * CTXL : b * SEQ; \
        R_.r0 = base_ + (dir ? L_ - 1 - t0_ : t0_); } while (0)
#define R2_STEP(R_, c_) do { _Pragma("unroll") for (int vg = 0; vg < R2_NV; ++vg) { \
        bf16x8 sb[2]; \
        _Pragma("unroll") for (int jj = 0; jj < 2; ++jj) { u32x4 w; w.x = pk2(S[vg][2 * jj][0], S[vg][2 * jj][1]); w.y = pk2(S[vg][2 * jj][2], S[vg][2 * jj][3]); w.z = pk2(S[vg][2 * jj + 1][0], S[vg][2 * jj + 1][1]); w.w = pk2(S[vg][2 * jj + 1][2], S[vg][2 * jj + 1][3]); sb[jj] = __builtin_bit_cast(bf16x8, w); } \
        f32x4 xt = (f32x4){0.f, 0.f, 0.f, 0.f}, yt = xt; \
        _Pragma("unroll") for (int jj = 0; jj < 2; ++jj) { xt = __builtin_amdgcn_mfma_f32_16x16x32_bf16(R_.taf[jj], sb[jj], xt, 0, 0, 0); yt = __builtin_amdgcn_mfma_f32_16x16x32_bf16(R_.raf[jj], sb[jj], yt, 0, 0, 0); }     \
        _Pragma("unroll") for (int e = 0; e < 4; ++e) Y[(size_t)(R_.r0 + (dir ? -(4 * fq + e) : (4 * fq + e))) * 512 + h * 64 + v0 + 16 * vg + fr] = (bf16)f2bf(yt[e] + R_.yc[vg][e]); \
        float g4_[4]; unpack4(R_.g2[vg], g4_); \
        u32x4 w; w.x = pk2(xt[0] + g4_[0], xt[1] + g4_[1]); w.y = pk2(xt[2] + g4_[2], xt[3] + g4_[3]); w.z = R_.v2[vg].x; w.w = R_.v2[vg].y; \
        const bf16x8 yop = __builtin_bit_cast(bf16x8, w);                    \
        _Pragma("unroll") for (int kt = 0; kt < 4; ++kt) { S[vg][kt] = S[vg][kt] * R_.pc[kt]; S[vg][kt] = __builtin_amdgcn_mfma_f32_16x16x32_bf16(R_.bkf[kt], yop, S[vg][kt], 0, 0, 0); } } } while (0)
#define R2_CL(x_) ((x_) < RC_NCH ? (x_) : RC_NCH - 1)
    R2_LOAD(cur, 0);
    for (int c = 0; c < RC_NCH; c += 2) {
        R2_LOAD(nxt, R2_CL(c + 1)); R2_STEP(cur, c);
        R2_LOAD(cur, R2_CL(c + 2)); R2_STEP(nxt, c + 1);
    }
#undef R2_STEP
#undef R2_CL
#undef R2_LOAD
}

constexpr int RW_LD = 384;
constexpr int RW_YOFF = 2 * CH_T * RW_LD;
__device__ __forceinline__ void rwkv_chain(const Ctx& a, LAS unsigned char* lds, int l, int item) {
    unsigned char* ws = opqp(a.ws); const int tid = ((a.wv << 6) | lane_v());
    const int dir = item & 1, h = (item >> 1) & 7, b = item >> 4;
    const int rp = tid >> 4, js = tid & 15, j0 = js * 4; const bool odd = js & 1;
    const bf16* R5 = (const bf16*)(ws + WS_RW5); const float* F = (const float*)(ws + WS_MIX); float* Y = (float*)(ws + WS_YR) + (size_t)dir * MTOT * 512;
    const size_t st = (size_t)MTOT * 512;
    LAS float* buf = (LAS float*)lds;
    const int ls = tid >> 4, lp = tid & 15;
    typedef float f32x2 __attribute__((ext_vector_type(2)));
    f32x2 S00 = {0.f, 0.f}, S01 = {0.f, 0.f}, S10 = {0.f, 0.f}, S11 = {0.f, 0.f};
    float4 wreg; uint2 kkr, br, kr, rr, vr;
    const float4 w0r = *(const float4*)(ldin(13) + l * 1024 + dir * 512 + h * 64 + lp * 4);
#define RW_LOAD(c) do { const int row_ = chain_row((c) * CH_T + ls, b, dir); const size_t o_ = (size_t)row_ * 512 + h * 64 + lp * 4; \
        wreg = *(const float4*)(F + (size_t)row_ * 2048 + dir * 512 + h * 64 + lp * 4); \
        rr = *(const uint2*)(R5 + o_); kr = *(const uint2*)(R5 + st + o_); vr = *(const uint2*)(R5 + 2 * st + o_); kkr = *(const uint2*)(R5 + 3 * st + o_); br = *(const uint2*)(R5 + 4 * st + o_); } while (0)
#define RW_STORE(c) do { LAS float* q_ = buf + (((c) & 1) * CH_T + ls) * RW_LD; float f_[4]; \
        unpack4(kkr, f_); *(LAS f32x4*)(q_ + lp * 4) = (f32x4){f_[0], f_[1], f_[2], f_[3]}; \
        unpack4(br, f_);  *(LAS f32x4*)(q_ + 64 + lp * 4) = (f32x4){f_[0], f_[1], f_[2], f_[3]}; \
        *(LAS f32x4*)(q_ + 128 + lp * 4) = (f32x4){__expf(-0.60653066f * fsigm(wreg.x + w0r.x)), __expf(-0.60653066f * fsigm(wreg.y + w0r.y)), __expf(-0.60653066f * fsigm(wreg.z + w0r.z)), __expf(-0.60653066f * fsigm(wreg.w + w0r.w))}; \
        unpack4(kr, f_);  *(LAS f32x4*)(q_ + 192 + lp * 4) = (f32x4){f_[0], f_[1], f_[2], f_[3]}; \
        unpack4(rr, f_);  *(LAS f32x4*)(q_ + 256 + lp * 4) = (f32x4){f_[0], f_[1], f_[2], f_[3]}; \
        unpack4(vr, f_);  *(LAS f32x4*)(q_ + 320 + lp * 4) = (f32x4){f_[0], f_[1], f_[2], f_[3]}; } while (0)
    __syncthreads();
    RW_LOAD(0); RW_STORE(0);
    __syncthreads();
    for (int c = 0; c < CH_NC; ++c) {
        if (c + 1 < CH_NC) RW_LOAD(c + 1);
        if (c > 0) {
            const int row = chain_row((c - 1) * CH_T + ls, b, dir);
            *(f32x4*)(Y + (size_t)row * 512 + h * 64 + lp * 4) = *(const LAS f32x4*)(buf + RW_YOFF + (((c - 1) & 1) * CH_T + ls) * 64 + lp * 4);
        }
        const LAS float* cb = buf + ((c & 1) * CH_T) * RW_LD; LAS float* yb = buf + RW_YOFF + ((c & 1) * CH_T) * 64;
#pragma unroll 2
        for (int s = 0; s < CH_T; ++s) {
            const LAS float* q = cb + s * RW_LD;
            const f32x4 kk4 = *(const LAS f32x4*)(q + j0), b4 = *(const LAS f32x4*)(q + 64 + j0), w4 = *(const LAS f32x4*)(q + 128 + j0), k4 = *(const LAS f32x4*)(q + 192 + j0), r4 = *(const LAS f32x4*)(q + 256 + j0);
            const f32x2 v2 = *(const LAS f32x2*)(q + 320 + 2 * rp);
            const f32x2 kkA = {kk4[0], kk4[1]}, kkB = {kk4[2], kk4[3]}, bA = {b4[0], b4[1]}, bB = {b4[2], b4[3]}, wA = {w4[0], w4[1]}, wB = {w4[2], w4[3]}, kA = {k4[0], k4[1]}, kB = {k4[2], k4[3]}, rA = {r4[0], r4[1]}, rB = {r4[2], r4[3]};
            f32x2 t0 = S00 * kkA + S01 * kkB, t1 = S10 * kkA + S11 * kkB;
            const float sa0 = -red16(t0[0] + t0[1]), sa1 = -red16(t1[0] + t1[1]);
            S00 = S00 * wA + (bA * sa0 + kA * v2[0]); S01 = S01 * wB + (bB * sa0 + kB * v2[0]);
            S10 = S10 * wA + (bA * sa1 + kA * v2[1]); S11 = S11 * wB + (bB * sa1 + kB * v2[1]);
            t0 = S00 * rA + S01 * rB; t1 = S10 * rA + S11 * rB;
            const float p0 = t0[0] + t0[1], p1 = t1[0] + t1[1];
            float ym = odd ? p1 : p0; const float yo = odd ? p0 : p1;
            ym += dppf<0xB1>(yo); ym += dppf<0x4E>(ym); ym += dppf<0x124>(ym); ym += dppf<0x128>(ym);
            if (js < 2) yb[s * 64 + 2 * rp + js] = ym;
        }
        if (c + 1 < CH_NC) RW_STORE(c + 1);
        __syncthreads();
    }
    { const int row = chain_row((CH_NC - 1) * CH_T + ls, b, dir);
      *(f32x4*)(Y + (size_t)row * 512 + h * 64 + lp * 4) = *(const LAS f32x4*)(buf + RW_YOFF + (((CH_NC - 1) & 1) * CH_T + ls) * 64 + lp * 4); }
#undef RW_LOAD
#undef RW_STORE
}

constexpr int AT_KP = 136, AT_VP = 144;
constexpr int AT_KB = 64 * AT_KP * 2, AT_VB = 64 * AT_VP * 2, AT_BUF = AT_KB + AT_VB;
__device__ __forceinline__ void attn_item(const Ctx& a, LAS unsigned char* lds, int l, int b, int h, int qt, bool ctxq, float lam, float post) {
    unsigned char* ws = opqp(a.ws); const int tid = ((a.wv << 6) | lane_v()), lane = tid & 63, wid = tid >> 6, fr = lane & 15, fq = lane >> 4, q4 = (lane & 15) >> 2, p4 = lane & 3;
    const bf16* QK = (const bf16*)(ws + WS_QK); const bf16* U = (const bf16*)(ws + WS_U); bf16* A2 = (bf16*)(ws + WS_HA);
    const int qrow = (ctxq ? MLAT + b * CTXL : b * SEQ) + qt * 128 + wid * 16 + fr;
    const int nkt = ctxq ? 4 : 36;
    bf16x8 qf[2][2];
#pragma unroll
    for (int c = 0; c < 2; ++c)
#pragma unroll
        for (int ks = 0; ks < 2; ++ks) qf[c][ks] = *(const bf16x8*)(QK + (size_t)qrow * 1024 + h * 128 + c * 64 + ks * 32 + fq * 8);
    f32x4 O[2][8];
#pragma unroll
    for (int c = 0; c < 2; ++c)
#pragma unroll
        for (int d = 0; d < 8; ++d) O[c][d] = (f32x4){0.f, 0.f, 0.f, 0.f};
    float mrun[2] = {-3.0e38f, -3.0e38f}, lrun[2] = {0.f, 0.f};
    uint4 kreg[2], vreg[2];
#define AT_LOAD(kt) do { const int kr0_ = ((kt) < 4 ? MLAT + b * CTXL + (kt) * 64 : b * SEQ + ((kt) - 4) * 64); \
        _Pragma("unroll") for (int j_ = 0; j_ < 2; ++j_) { const int id_ = tid + j_ * NT, key_ = id_ >> 4, part_ = id_ & 15; \
            kreg[j_] = *(const uint4*)(QK + (size_t)(kr0_ + key_) * 1024 + 512 + h * 128 + part_ * 8); \
            vreg[j_] = *(const uint4*)(U + (size_t)(kr0_ + key_) * NINP + C_DA_V + h * 128 + part_ * 8); } } while (0)
#define AT_STORE(kt) do { LAS bf16* Ks_ = (LAS bf16*)(lds + ((kt) & 1) * AT_BUF); LAS bf16* Vs_ = (LAS bf16*)(lds + ((kt) & 1) * AT_BUF + AT_KB); \
        _Pragma("unroll") for (int j_ = 0; j_ < 2; ++j_) { const int id_ = tid + j_ * NT, key_ = id_ >> 4, part_ = id_ & 15; \
            *(LAS u32x4*)(Ks_ + key_ * AT_KP + part_ * 8) = (u32x4){kreg[j_].x, kreg[j_].y, kreg[j_].z, kreg[j_].w}; \
            *(LAS u32x4*)(Vs_ + key_ * AT_VP + part_ * 8) = (u32x4){vreg[j_].x, vreg[j_].y, vreg[j_].z, vreg[j_].w}; } } while (0)
    __syncthreads();
    AT_LOAD(0); AT_STORE(0);
    __syncthreads();
    for (int kt = 0; kt < nkt; ++kt) {
        if (kt + 1 < nkt) AT_LOAD(kt + 1);
        const LAS bf16* Ks = (const LAS bf16*)(lds + (kt & 1) * AT_BUF); const LAS bf16* Vs = (const LAS bf16*)(lds + (kt & 1) * AT_BUF + AT_KB);
        f32x4 S[2][4];
#pragma unroll
        for (int c = 0; c < 2; ++c)
#pragma unroll
            for (int sb = 0; sb < 4; ++sb) { f32x4 acc = (f32x4){0.f, 0.f, 0.f, 0.f};
#pragma unroll
                for (int ks = 0; ks < 2; ++ks) { const bf16x8 kf = *(const LAS bf16x8*)(Ks + (sb * 16 + fr) * AT_KP + c * 64 + ks * 32 + fq * 8);
                    acc = __builtin_amdgcn_mfma_f32_16x16x32_bf16(kf, qf[c][ks], acc, 0, 0, 0); }
                S[c][sb] = acc; }
        bf16x8 pf[2][2];
#pragma unroll
        for (int c = 0; c < 2; ++c) {
            float mx = S[c][0][0];
#pragma unroll
            for (int sb = 0; sb < 4; ++sb)
#pragma unroll
                for (int e = 0; e < 4; ++e) mx = fmaxf(mx, S[c][sb][e]);
            mx = fmaxf(mx, swz16(mx)); mx = fmaxf(mx, shx32(mx, lane));
            const float mnew = fmaxf(mrun[c], mx), alpha = __builtin_amdgcn_exp2f(mrun[c] - mnew); mrun[c] = mnew;
            float ps = 0.f;
#pragma unroll
            for (int sb = 0; sb < 4; ++sb)
#pragma unroll
                for (int e = 0; e < 4; ++e) { const float pv = __builtin_amdgcn_exp2f(S[c][sb][e] - mnew); S[c][sb][e] = pv; ps += pv; }
            lrun[c] = lrun[c] * alpha + ps;
#pragma unroll
            for (int d = 0; d < 8; ++d) O[c][d] *= alpha;
#pragma unroll
            for (int kc = 0; kc < 2; ++kc) { u32x4 w; w.x = pk2(S[c][2 * kc][0], S[c][2 * kc][1]); w.y = pk2(S[c][2 * kc][2], S[c][2 * kc][3]); w.z = pk2(S[c][2 * kc + 1][0], S[c][2 * kc + 1][1]); w.w = pk2(S[c][2 * kc + 1][2], S[c][2 * kc + 1][3]);
                pf[c][kc] = __builtin_bit_cast(bf16x8, w); }
        }
#pragma unroll
        for (int kc = 0; kc < 2; ++kc)
#pragma unroll
            for (int d = 0; d < 8; ++d) {
                const LAS bf16* pa = Vs + (kc * 32 + 4 * fq + q4) * AT_VP + d * 16 + 4 * p4;
                const bf16x8 vf = trfrag(pa, pa + 16 * AT_VP);
                O[0][d] = __builtin_amdgcn_mfma_f32_16x16x32_bf16(vf, pf[0][kc], O[0][d], 0, 0, 0);
                O[1][d] = __builtin_amdgcn_mfma_f32_16x16x32_bf16(vf, pf[1][kc], O[1][d], 0, 0, 0);
            }
        if (kt + 1 < nkt) AT_STORE(kt + 1);
        __syncthreads();
    }
#undef AT_LOAD
#undef AT_STORE
    float l0 = lrun[0], l1 = lrun[1];
    l0 += swz16(l0); l0 += shx32(l0, lane); l1 += swz16(l1); l1 += shx32(l1, lane);
    const float i0 = 1.0f / l0, i1 = lam / l1;
    float ss = 0.f;
#pragma unroll
    for (int d = 0; d < 8; ++d)
#pragma unroll
        for (int e = 0; e < 4; ++e) { const float o = O[0][d][e] * i0 - O[1][d][e] * i1; O[0][d][e] = o; ss += o * o; }
    ss += swz16(ss); ss += shx32(ss, lane);
    const float rs = rsqrtf(ss * (1.0f / 128.0f) + 1e-5f) * post;
    const float* sw = ldin(30) + l * 128;
#pragma unroll
    for (int d = 0; d < 8; ++d) { const int dc = d * 16 + 4 * fq; const float4 w4 = *(const float4*)(sw + dc);
        uint2 pk; pk.x = pk2(O[0][d][0] * rs * w4.x, O[0][d][1] * rs * w4.y); pk.y = pk2(O[0][d][2] * rs * w4.z, O[0][d][3] * rs * w4.w);
        *(uint2*)(A2 + (size_t)qrow * DM + 1536 + h * 128 + dc) = pk; }
}

__device__ __forceinline__ int q_pull(unsigned* ctr, volatile LAS unsigned* slot, int tid) {
    __syncthreads();
    if (tid == 0) *slot = __hip_atomic_fetch_add(ctr, 1u, __ATOMIC_RELAXED, __HIP_MEMORY_SCOPE_AGENT);
    __syncthreads();
    return (int)*slot;
}
__device__ __forceinline__ void p6_mixers(const Ctx& a, LAS unsigned char* lds, int l, int bid, int G) {
    unsigned char* ws = opqp(a.ws); const int tid = ((a.wv << 6) | lane_v());
    volatile LAS unsigned* slot = (volatile LAS unsigned*)(lds + LDS_STAGE + 8);
    unsigned* qm = (unsigned*)(ws + WS_CTL) + CW_Q + (l * 2 + 0) * 64; unsigned* qa = (unsigned*)(ws + WS_CTL) + CW_Q + (l * 2 + 1) * 64;
    if (a.sub & 1) for (int it = bid; it < 32; it += G) rwkv_r2(a, l, it);
    if (a.sub & 4) {
    const float* lp = ldin(29) + l * 256; float s01 = 0.f, s23 = 0.f;
    for (int i = 0; i < 64; ++i) { s01 += lp[i] * lp[64 + i]; s23 += lp[128 + i] * lp[192 + i]; }
    const float lam_init = l == 0 ? 0.2f : (0.8f - 0.6f * 0.74081822068f);
    const float lam = expf(s01) - expf(s23) + lam_init, post = 1.0f - lam_init;
    const int nat = l == 0 ? 576 : 512;
    for (;;) { const int it = q_pull(qa, slot, tid); if (it >= nat) break;
        if (it < 512) { const int qt = it & 15, h = (it >> 4) & 3, b = it >> 6; attn_item(a, lds, l, b, h, qt, false, lam, post); }
        else { const int i2 = it - 512; const int qt = i2 & 1, h = (i2 >> 1) & 3, b = i2 >> 3; attn_item(a, lds, l, b, h, qt, true, lam, post); } }
    }
    if (a.sub & 2) { const int nit = l == 0 ? 8 * MB_NCH * 2 : 8 * 16 * 2;
        for (;;) { const int it = q_pull(qm, slot, tid); if (it >= nit) break;
            const int g = it & 1; int cc, b; if (l == 0) { cc = (it >> 1) % MB_NCH; b = (it >> 1) / MB_NCH; } else { cc = 2 + ((it >> 1) & 15); b = it >> 5; } mamba_m3(a, lds, b, cc, g); } }
}


constexpr int N_PHASES = 27;
__global__ void __launch_bounds__(NT, 2) fwd(Args args) {
    extern __shared__ __attribute__((aligned(16))) unsigned char lds_dyn[];
    LAS unsigned char* lds = (LAS unsigned char*)lds_dyn;
    volatile LAS unsigned* MISC = (volatile LAS unsigned*)(lds + LDS_STAGE);
    const int wv = __builtin_amdgcn_readfirstlane((int)threadIdx.x >> 6);
    const int tid = (wv << 6) | lane_v(), bid = blockIdx.x, G = gridDim.x;
    unsigned char* ws = args.ws;
    const Ctx cx{ws, wv, args.sub};
    for (int u = tid; u < LDS_MISC / 4; u += NT) MISC[u] = 0u;
    __syncthreads();
    if (tid == 0) {
#pragma unroll
        for (int i = 0; i < 38; ++i) *(LAS unsigned long long*)(lds + LDS_PTRS + 8 * i) = (unsigned long long)args.in[i];
    }
    __syncthreads();
#if MK_PER_PHASE
#define GRID_BAR() do { } while (0)
#else
    XcdBarrier bar = xcd_barrier_post((unsigned*)(ws + WS_CTL) + CW_BAR, MISC);
#define GRID_BAR() do { XcdBarrier b_ = bar; b_.bar = opqp(b_.bar); b_.x = (unsigned)opqs((int)b_.x); xcd_barrier(b_); } while (0)
#endif
    const int lo = args.ph_lo, hi = args.ph_hi;
#define IN(k) (opqs(lo) <= (k) && (k) < opqs(hi))
#define SEAM(k) do { if (IN((k) + 1)) GRID_BAR(); } while (0)

#define XS (args.out)
#define XSB ((float*)(wsq + WS_XSB))
#define XC ((float*)(wsq + WS_XC))
#define HA ((bf16*)(wsq + WS_HA))
#define Ub ((bf16*)(wsq + WS_U))
#define MIX ((float*)(wsq + WS_MIX))
#define HID ((bf16*)(wsq + WS_BIG))
#define PH_LOCALS unsigned char* const wsq = opqp(ws); const int bidq = opqs(bid), Gq = opqs(G); (void)wsq; (void)bidq; (void)Gq

    if (IN(0)) { PH_LOCALS; if (args.sub & 64) bg_convert(cx, lds, nullptr, Gq); else p0_prologue(cx, lds,  bidq, Gq); SEAM(0); }
    if (IN(1)) { PH_LOCALS;
        thin_phase<0, 1>(cx, lds,  bidq, Gq, MTOT, ldin(0), ldin(2), nullptr, nullptr, nullptr, nullptr, 0, 0, ldin(6), 0, 1, 0);
        SEAM(1);
    }
    for (int l = 0; l < 2; ++l) {
        const int pb = 2 + 12 * l;
        const int Mo = l == 0 ? MTOT : MLAT;
        if (IN(pb + 0)) { PH_LOCALS;
            pg8::Gemm g{HA, (const bf16*)(wsq + WS_WIN) + (size_t)l * NINP * DM, MTOT, NINP, DM}; pg8::StaticOrder S; S.init(MTOT, NINP, Gq, bidq);
            pg8::EpiBf16P E{Ub, NINP, 0, 1.0f};
            pg8::gemm_phase<pg8::EpiBf16P, pg8::StaticOrder>(lds, g, S, E, nullptr, (wv << 6) | lane_v());
            bg_tail(cx, lds, l * 8 + 0, Gq);
            SEAM(pb + 0);
        }
        if (IN(pb + 1)) { PH_LOCALS; feat_a(cx, l,  bidq, Gq); SEAM(pb + 1); }
        if (IN(pb + 2)) { PH_LOCALS;
            pg8::Gemm g{(const bf16*)(wsq + WS_ASM), (const bf16*)(wsq + WS_WSM) + (size_t)l * 2048 * 256, MTOT, 2048, 256}; pg8::StaticOrder S; S.init(MTOT, 2048, Gq, bidq);
            pg8::EpiF32 E{MIX, 2048, nullptr};
            pg8::gemm_phase<pg8::EpiF32, pg8::StaticOrder>(lds, g, S, E, nullptr, (wv << 6) | lane_v());
            for (int it = bidq; it < 8 * MB_NCH * 2; it += Gq) mamba_m1(cx, lds, it);
            bg_tail(cx, lds, l * 8 + 1, Gq);
            SEAM(pb + 2);
        }
        if (IN(pb + 4)) { PH_LOCALS; for (int it = bidq; it < 256; it += Gq) mamba_m2(cx, it);
            rc_consts(lds, l, (wv << 6) | lane_v());
            for (int u = bidq * NW + wv; u < RC_UNITS; u += Gq * NW) rwkv_r1(cx, lds, l, u); SEAM(pb + 4); }
        if (IN(pb + 5)) { PH_LOCALS; p6_mixers(cx, lds, l,  bidq, Gq); if (!(args.sub & 32)) bg_tail(cx, lds, l * 8 + 5, Gq); SEAM(pb + 5); }
        if (IN(pb + 6)) { PH_LOCALS; mix_out(cx, l, Mo,  bidq, Gq); SEAM(pb + 6); }
        if (IN(pb + 7)) { PH_LOCALS;
            pg8::Gemm g{HA, (const bf16*)(wsq + WS_WOUT) + (size_t)l * DM * DM, Mo, DM, DM}; pg8::StaticOrder S; S.init(Mo, DM, Gq, bidq);
            pg8::EpiBf16P E{(bf16*)MIX, DM, 0, 1.0f};
            pg8::gemm_phase<pg8::EpiBf16P, pg8::StaticOrder>(lds, g, S, E, nullptr, (wv << 6) | lane_v());
            bg_tail(cx, lds, l * 8 + 2, Gq);
            SEAM(pb + 7);
        }
        if (l == 0) {
            if (IN(pb + 8)) { PH_LOCALS;
                thin_phase<1, DENSE_GU8 ? 3 : 1, 0, 1>(cx, lds,  bidq, Gq, MTOT, ldin(0), ldin(2), XSB, XC, MIX, ldin(7), 0, 2, ldin(8), 0, 4, 3);
                SEAM(pb + 8);
            }
            if (IN(pb + 9)) { PH_LOCALS;
                pg8::StaticOrder S; S.init(MTOT, 2 * FF, Gq, bidq);
#if DENSE_GU8 && DENSE_D8
                pg8::Gemm g{HA, (const bf16*)(wsq + WS_WGU), MTOT, 2 * FF, DM / 2};
                pg8::EpiSwiGLU8 E{(unsigned char*)(wsq + WS_BIG), FF, 0, 1.0f / MOE_SGU, MOE_SH};
                pg8::gemm_phase<pg8::EpiSwiGLU8, pg8::StaticOrder, false, true>(lds, g, S, E, nullptr, (wv << 6) | lane_v());
#elif DENSE_GU8
                pg8::Gemm g{HA, (const bf16*)(wsq + WS_WGU), MTOT, 2 * FF, DM / 2};
                pg8::EpiSwiGLUS E{HID, FF, 0, 1.0f / MOE_SGU};
                pg8::gemm_phase<pg8::EpiSwiGLUS, pg8::StaticOrder, false, true>(lds, g, S, E, nullptr, (wv << 6) | lane_v());
#elif DENSE_D8
                pg8::Gemm g{HA, (const bf16*)(wsq + WS_WGU), MTOT, 2 * FF, DM};
                pg8::EpiSwiGLU8 E{(unsigned char*)(wsq + WS_BIG), FF, 0, 1.0f, MOE_SH};
                pg8::gemm_phase<pg8::EpiSwiGLU8, pg8::StaticOrder>(lds, g, S, E, nullptr, (wv << 6) | lane_v());
#else
                pg8::Gemm g{HA, (const bf16*)(wsq + WS_WGU), MTOT, 2 * FF, DM};
                pg8::EpiSwiGLU E{HID, FF, 0};
                pg8::gemm_phase<pg8::EpiSwiGLU, pg8::StaticOrder>(lds, g, S, E, nullptr, (wv << 6) | lane_v());
#endif
                bg_tail(cx, lds, 3, Gq);
                SEAM(pb + 9);
            }
            if (IN(pb + 10)) { PH_LOCALS;
                pg8::StaticOrder S; S.init(MTOT, DM, Gq, bidq);
#if DENSE_D8
                pg8::Gemm g{HID, (const bf16*)(wsq + WS_WD), MTOT, DM, FF / 2};
                pg8::EpiBf16P E{(bf16*)MIX, DM, 0, 1.0f / (MOE_SD * MOE_SH)};
                pg8::gemm_phase<pg8::EpiBf16P, pg8::StaticOrder, false, true>(lds, g, S, E, nullptr, (wv << 6) | lane_v());
#else
                pg8::Gemm g{HID, (const bf16*)(wsq + WS_WD), MTOT, DM, FF};
                pg8::EpiBf16P E{(bf16*)MIX, DM, 0, 1.0f};
                pg8::gemm_phase<pg8::EpiBf16P, pg8::StaticOrder>(lds, g, S, E, nullptr, (wv << 6) | lane_v());
#endif
                bg_tail(cx, lds, 4, Gq);
                SEAM(pb + 10);
            }
            if (IN(pb + 11)) { PH_LOCALS;
                thin_phase<1, 1, 1, 1>(cx, lds,  bidq, Gq, MTOT, XSB, XC, XSB, XC, MIX, ldin(9), 0, 5, ldin(6) + DM, 1, 1, 0);
                SEAM(pb + 11);
            }
        } else {
            if (IN(pb + 8)) { PH_LOCALS;
                thin_phase<1, 2, 1, 1>(cx, lds,  bidq, Gq, MLAT, XSB, XC, XSB, XC, MIX, ldin(7) + DM, 1, 2, ldin(8) + DM, 1, 4, 3);
                SEAM(pb + 8);
            }
            if (IN(pb + 9)) { PH_LOCALS; moe_gather(cx,  bidq, Gq); bg_convert(cx, lds, nullptr, Gq); SEAM(pb + 9); }
            if (IN(pb + 10) || IN(pb + 11)) { PH_LOCALS;
                if (((wv << 6) | lane_v()) == 0) { const unsigned* cnt = (const unsigned*)(wsq + WS_CTL) + CW_CNT; int run = 0;
                    for (int e = 0; e < 8; ++e) { const int t = (int)((cnt[e * 64] + 255u) >> 8); MISC[16 + e] = (unsigned)t; MISC[24 + e] = (unsigned)run; run += t; } }
                __syncthreads();
            }
            if (IN(pb + 10)) { PH_LOCALS;
                pg8::MoeOrder S{(const LAS int*)(lds + LDS_STAGE + 64), (2 * FE) / 256, Gq, bidq};
#if MOE_FP8
                pg8::Gemm g{(const bf16*)(wsq + WS_U), (const bf16*)(wsq + WS_MGU), MOE_ROWS, 2 * FE, DM / 2};
                pg8::EpiSwiGLU8 E{(unsigned char*)(wsq + WS_BIG), FE, (2 * FE) / 256, 1.0f / MOE_SGU, MOE_SH};
                pg8::gemm_phase<pg8::EpiSwiGLU8, pg8::MoeOrder, false, true>(lds, g, S, E, nullptr, (wv << 6) | lane_v());
#else
                pg8::Gemm g{(const bf16*)(wsq + WS_U), (const bf16*)(wsq + WS_MGU), MOE_ROWS, 2 * FE, DM};
                pg8::EpiSwiGLU E{HID, FE, (2 * FE) / 256};
                pg8::gemm_phase<pg8::EpiSwiGLU, pg8::MoeOrder>(lds, g, S, E, nullptr, (wv << 6) | lane_v());
#endif
                SEAM(pb + 10);
            }
            if (IN(pb + 11)) { PH_LOCALS;
                pg8::MoeOrder S{(const LAS int*)(lds + LDS_STAGE + 64), DM / 256, Gq, bidq};
#if MOE_FP8
                pg8::Gemm g{HID, (const bf16*)(wsq + WS_MD), MOE_ROWS, DM, FE / 2};
                pg8::EpiBf16P E{(bf16*)(wsq + WS_MIX), DM, DM / 256, 1.0f / (MOE_SD * MOE_SH)};
                pg8::gemm_phase<pg8::EpiBf16P, pg8::MoeOrder, false, true>(lds, g, S, E, nullptr, (wv << 6) | lane_v());
#else
                pg8::Gemm g{HID, (const bf16*)(wsq + WS_MD), MOE_ROWS, DM, FE};
                pg8::EpiBf16P E{(bf16*)(wsq + WS_MIX), DM, DM / 256, 1.0f};
                pg8::gemm_phase<pg8::EpiBf16P, pg8::MoeOrder>(lds, g, S, E, nullptr, (wv << 6) | lane_v());
#endif
                SEAM(pb + 11);
            }
            if (IN(pb + 12)) { PH_LOCALS;
                thin_phase<2, 0, 1, 0>(cx, lds,  bidq, Gq, MLAT, XSB, XC, XS, XC, nullptr, ldin(9) + DM, 1, 5, nullptr, 0, 0, 0);
            }
        }
    }
#undef IN
#undef SEAM
}

extern "C" void kernel_launch(void* const* d_in, const int* in_sizes, int n_in, void* d_out, int out_size, void* d_ws, size_t ws_size, hipStream_t stream) {
    static int grid = 0;
    if (grid == 0) {
        if (n_in != 38 || out_size != MLAT * DM || ws_size < WS_END) { fprintf(stderr, "kernel_launch: unexpected shapes (n_in %d out %d ws %zu need %zu)\n", n_in, out_size, ws_size, (size_t)WS_END); grid = -1; return; }
        int dev = 0, cus = 0, per_cu = 0;
        if (hipGetDevice(&dev) != hipSuccess || hipDeviceGetAttribute(&cus, hipDeviceAttributeMultiprocessorCount, dev) != hipSuccess) { grid = -1; return; }
        if (hipFuncSetAttribute((const void*)fwd, hipFuncAttributeMaxDynamicSharedMemorySize, LDS_BYTES) != hipSuccess) { fprintf(stderr, "kernel_launch: hipFuncSetAttribute failed\n"); grid = -1; return; }
        if (hipOccupancyMaxActiveBlocksPerMultiprocessor(&per_cu, (const void*)fwd, NT, LDS_BYTES) != hipSuccess || per_cu < 1) { fprintf(stderr, "kernel_launch: occupancy query says %d\n", per_cu); per_cu = 1; }
        (void)hipGetLastError();
        grid = cus;
    }
    if (grid < 0) return;
    if (hipMemsetAsync((char*)d_ws + WS_CTL, 0, CTL_BYTES, stream) != hipSuccess) return;
    Args a{};
    for (int i = 0; i < 38; ++i) a.in[i] = (const float*)d_in[i];
    a.out = (float*)d_out; a.ws = (unsigned char*)d_ws; a.sub = 7;
#if MK_PER_PHASE
#ifndef PROBE_SUB
#define PROBE_SUB 7
#endif
#ifndef PROBE_MASK
#define PROBE_MASK 0u
#endif
#ifndef PROBE_SPLIT
#define PROBE_SPLIT 0
#endif
#ifndef PROBE_REP
#define PROBE_REP 1
#endif
    for (int p = 0; p < N_PHASES; ++p) { a.ph_lo = p; a.ph_hi = p + 1;
        if (PROBE_SPLIT && (p == 7 || p == 19)) {
            a.sub = 1; hipLaunchKernelGGL(fwd, dim3(grid), dim3(NT), LDS_BYTES, stream, a);
            if (PROBE_SPLIT == 1) { a.sub = 2; hipLaunchKernelGGL(fwd, dim3(grid), dim3(NT), LDS_BYTES, stream, a); a.sub = 4; hipLaunchKernelGGL(fwd, dim3(grid), dim3(NT), LDS_BYTES, stream, a); }
            else if (PROBE_SPLIT == 2) { a.sub = 6; hipLaunchKernelGGL(fwd, dim3(grid), dim3(NT), LDS_BYTES, stream, a); }
            else { a.sub = 2; hipLaunchKernelGGL(fwd, dim3(grid), dim3(NT), LDS_BYTES, stream, a); a.sub = 5; hipLaunchKernelGGL(fwd, dim3(grid), dim3(NT), LDS_BYTES, stream, a); }
            a.sub = 7; continue; }
        if ((PROBE_MASK >> p) & 1u) { a.sub = PROBE_SUB;
            for (int rep = 0; rep < PROBE_REP; ++rep) { if (rep) (void)hipMemsetAsync((char*)d_ws + WS_CTL + CW_BG * 4, 0, 256, stream); hipLaunchKernelGGL(fwd, dim3(grid), dim3(NT), LDS_BYTES, stream, a); }
            a.sub = 7;
            (void)hipMemsetAsync((char*)d_ws + WS_CTL + CW_Q * 4, 0, 4 * 256, stream); }
        hipLaunchKernelGGL(fwd, dim3(grid), dim3(NT), LDS_BYTES, stream, a); }
#else
    a.ph_lo = 0; a.ph_hi = N_PHASES; hipLaunchKernelGGL(fwd, dim3(grid), dim3(NT), LDS_BYTES, stream, a);
#endif
}
```

```cpp
#include <hip/hip_runtime.h>
#include <cstdio>
#include <cstdint>

#ifndef MK_PER_PHASE
#define MK_PER_PHASE 0
#endif

#define GAS __attribute__((address_space(1)))
#define LAS __attribute__((address_space(3)))
typedef GAS unsigned gu32;
typedef GAS unsigned long long gu64;

__device__ __forceinline__ int opq(int x) { asm volatile("" : "+v"(x)); return x; }
template <class T> __device__ __forceinline__ T* opqp(T* p) { int z = 0; asm volatile("" : "+s"(z)); return (T*)((unsigned char*)p + z); }
__device__ __forceinline__ int opqs(int x) { asm volatile("" : "+s"(x)); return x; }

__device__ __forceinline__ int lane_v() { int l; asm volatile("v_mbcnt_lo_u32_b32 %0, -1, 0\n\tv_mbcnt_hi_u32_b32 %0, -1, %0" : "=v"(l)); return l; }

namespace pg8 {
#define PG8_LAS __attribute__((address_space(3)))
typedef unsigned short bf16_t;
typedef short bf16x8 __attribute__((ext_vector_type(8)));
typedef float f32x4 __attribute__((ext_vector_type(4)));
typedef unsigned u32x4 __attribute__((ext_vector_type(4)));
typedef int i32x4 __attribute__((ext_vector_type(4)));
typedef int i32x8 __attribute__((ext_vector_type(8)));
constexpr int BM = 256, BK = 64, HALF = 128, HTB = HALF * BK * 2  , STAGE_BYTES = 8 * HTB, NXCD = 8, WGM = 8;

__host__ __device__ __forceinline__ int lds_byte(int r, int c) { const int st = (r >> 4) * 2 + (c >> 5), rr = r & 15, cc = c & 31, ob = rr * 64 + cc * 2; return st * 1024 + (ob ^ (((ob >> 9) & 1) << 5)); }
__host__ __device__ __forceinline__ void stage_rc(int b, int& R, int& C) { const int st = b / 1024, sb = b % 1024, swz = sb ^ (((sb >> 9) & 1) << 5); R = (st >> 1) * 16 + swz / 64; C = (st & 1) * 32 + (swz % 64) / 2; }
__host__ __device__ __forceinline__ int perm32(int rho) { const int n = rho >> 4, i = rho & 15; return 8 * (i >> 2) + 4 * n + (i & 3); }

struct Unit { int pm, pn; };
struct Gemm { const bf16_t* A; const bf16_t* Bt; int M, N, K; };

struct StaticOrder {
    int nM, nN, nwg, G, c;
    __host__ __device__ void init(int M, int N, int G_, int c_) { nM = M / BM; nN = N / BM; nwg = nM * nN; G = G_; c = c_; }
    __host__ __device__ bool next(int i, Unit& u) const {
        const long L = (long)i * G + c; if (L >= nwg) return false;
        int wgid = (int)L; { const int q = nwg / NXCD, r = nwg % NXCD, xcd = wgid % NXCD, off = wgid / NXCD; wgid = (xcd < r ? xcd * (q + 1) : r * (q + 1) + (xcd - r) * q) + off; }
        const int nig = WGM * nN, gid = wgid / nig, fm = gid * WGM, gsz = (nM - fm) < WGM ? (nM - fm) : WGM;
        u.pm = fm + ((wgid % nig) % gsz); u.pn = (wgid % nig) / gsz; return true;
    }
    __device__ __forceinline__ void a_ready(const Unit&) const {}
    __device__ __forceinline__ void done(const Unit&) const {}
};
__device__ __forceinline__ unsigned cvt_pk_bf16(float lo, float hi) { unsigned r; asm volatile("v_cvt_pk_bf16_f32 %0, %1, %2" : "=v"(r) : "v"(lo), "v"(hi)); return r; }
struct EpiF32 {
    static constexpr bool PERM = false, AFTER_DRAIN = false;
    float* C; int ldc; const float* bias;
    __device__ __forceinline__ void operator()(const f32x4 (&acc)[2][2][4][2], const Unit& u, int wr, int wc, int fr, int fq) const {
        const int row0 = u.pm * BM + wr * 64 + fr, col0 = u.pn * BM + wc * 32 + 4 * fq;
        f32x4 bv[2][2];
#pragma unroll
        for (int bj = 0; bj < 2; ++bj)
#pragma unroll
            for (int n = 0; n < 2; ++n) bv[bj][n] = bias ? *(const f32x4*)(bias + col0 + bj * HALF + n * 16) : (f32x4){0.f, 0.f, 0.f, 0.f};
#pragma unroll
        for (int ai = 0; ai < 2; ++ai)
#pragma unroll
            for (int m = 0; m < 4; ++m) { float* rowp = C + (size_t)(row0 + ai * HALF + m * 16) * ldc + col0;
#pragma unroll
                for (int bj = 0; bj < 2; ++bj)
#pragma unroll
                    for (int n = 0; n < 2; ++n) *(f32x4*)(rowp + bj * HALF + n * 16) = acc[ai][bj][m][n] + bv[bj][n]; }
    }
};

__device__ __forceinline__ float fsilu(float x) { return x * __builtin_amdgcn_rcpf(1.0f + __expf(-x)); }
__device__ __forceinline__ float fsigm(float x) { return __builtin_amdgcn_rcpf(1.0f + __expf(-x)); }

struct MoeOrder {
    const PG8_LAS int* tab; int nN, G, c;
    __device__ __forceinline__ bool next(int i, Unit& u) const {
        long L = (long)i * G + c;
#pragma unroll
        for (int e = 0; e < 8; ++e) { const int te = tab[e]; const long n = (long)te * nN; if (L < n) { u.pn = e * nN + (int)(L / te); u.pm = tab[8 + e] + (int)(L % te); return true; } L -= n; }
        return false;
    }
    __device__ __forceinline__ void a_ready(const Unit&) const {}
    __device__ __forceinline__ void done(const Unit&) const {}
};

struct EpiBf16P {
    static constexpr bool PERM = true, AFTER_DRAIN = false;
    bf16_t* O; int ldc; int nN; float scale;
    __device__ __forceinline__ void operator()(const f32x4 (&acc)[2][2][4][2], const Unit& u, int wr, int wc, int fr, int fq) const {
        const int row0 = u.pm * BM + wr * 64 + fr; const int pnr = nN ? (u.pn % nN) : u.pn; const int col0 = pnr * BM + wc * 32 + 8 * fq;
#pragma unroll
        for (int ai = 0; ai < 2; ++ai)
#pragma unroll
            for (int m = 0; m < 4; ++m) { bf16_t* rowp = O + (size_t)(row0 + ai * HALF + m * 16) * ldc + col0;
#pragma unroll
                for (int bj = 0; bj < 2; ++bj) { const f32x4 v0 = acc[ai][bj][m][0] * scale, v1 = acc[ai][bj][m][1] * scale;
                    u32x4 w; w.x = cvt_pk_bf16(v0[0], v0[1]); w.y = cvt_pk_bf16(v0[2], v0[3]); w.z = cvt_pk_bf16(v1[0], v1[1]); w.w = cvt_pk_bf16(v1[2], v1[3]);
                    *(u32x4*)(rowp + bj * HALF) = w; } }
    }
};

struct EpiSwiGLU {
    static constexpr bool PERM = true, AFTER_DRAIN = false;
    bf16_t* O; int ldc; int nN;
    __device__ __forceinline__ void operator()(const f32x4 (&acc)[2][2][4][2], const Unit& u, int wr, int wc, int fr, int fq) const {
        const int row0 = u.pm * BM + wr * 64 + fr; const int pnr = nN ? (u.pn % nN) : u.pn; const int col0 = pnr * HALF + wc * 32 + 8 * fq;
#pragma unroll
        for (int ai = 0; ai < 2; ++ai)
#pragma unroll
            for (int m = 0; m < 4; ++m) { bf16_t* rowp = O + (size_t)(row0 + ai * HALF + m * 16) * ldc + col0;
                const f32x4 g0 = acc[ai][0][m][0], g1 = acc[ai][0][m][1], u0 = acc[ai][1][m][0], u1 = acc[ai][1][m][1];
                f32x4 v0, v1;
#pragma unroll
                for (int j = 0; j < 4; ++j) { v0[j] = fsilu(g0[j]) * u0[j]; v1[j] = fsilu(g1[j]) * u1[j]; }
                u32x4 w; w.x = cvt_pk_bf16(v0[0], v0[1]); w.y = cvt_pk_bf16(v0[2], v0[3]); w.z = cvt_pk_bf16(v1[0], v1[1]); w.w = cvt_pk_bf16(v1[2], v1[3]);
                *(u32x4*)rowp = w; }
    }
};


__device__ __forceinline__ float clamp8(float x) { return fminf(fmaxf(x, -448.0f), 448.0f); }
__device__ __forceinline__ unsigned pk_fp8x4(float a, float b, float c, float d) { int w = __builtin_amdgcn_cvt_pk_fp8_f32(clamp8(a), clamp8(b), 0, false); w = __builtin_amdgcn_cvt_pk_fp8_f32(clamp8(c), clamp8(d), w, true); return (unsigned)w; }
struct EpiSwiGLUS {
    static constexpr bool PERM = true, AFTER_DRAIN = false;
    bf16_t* O; int ldc; int nN; float sin;
    __device__ __forceinline__ void operator()(const f32x4 (&acc)[2][2][4][2], const Unit& u, int wr, int wc, int fr, int fq) const {
        const int row0 = u.pm * BM + wr * 64 + fr; const int pnr = nN ? (u.pn % nN) : u.pn; const int col0 = pnr * HALF + wc * 32 + 8 * fq;
#pragma unroll
        for (int ai = 0; ai < 2; ++ai)
#pragma unroll
            for (int m = 0; m < 4; ++m) { bf16_t* rowp = O + (size_t)(row0 + ai * HALF + m * 16) * ldc + col0;
                const f32x4 g0 = acc[ai][0][m][0] * sin, g1 = acc[ai][0][m][1] * sin, u0 = acc[ai][1][m][0] * sin, u1 = acc[ai][1][m][1] * sin;
                f32x4 v0, v1;
#pragma unroll
                for (int j = 0; j < 4; ++j) { v0[j] = fsilu(g0[j]) * u0[j]; v1[j] = fsilu(g1[j]) * u1[j]; }
                u32x4 w; w.x = cvt_pk_bf16(v0[0], v0[1]); w.y = cvt_pk_bf16(v0[2], v0[3]); w.z = cvt_pk_bf16(v1[0], v1[1]); w.w = cvt_pk_bf16(v1[2], v1[3]);
                *(u32x4*)rowp = w; }
    }
};


struct EpiSwiGLU8 {
    static constexpr bool PERM = true, AFTER_DRAIN = false;
    unsigned char* O; int ldc; int nN; float sin, sout;
    __device__ __forceinline__ void operator()(const f32x4 (&acc)[2][2][4][2], const Unit& u, int wr, int wc, int fr, int fq) const {
        const int row0 = u.pm * BM + wr * 64 + fr; const int pnr = nN ? (u.pn % nN) : u.pn; const int col0 = pnr * HALF + wc * 32 + 8 * fq;
#pragma unroll
        for (int ai = 0; ai < 2; ++ai)
#pragma unroll
            for (int m = 0; m < 4; ++m) { unsigned char* rowp = O + (size_t)(row0 + ai * HALF + m * 16) * ldc + col0;
                const f32x4 g0 = acc[ai][0][m][0] * sin, g1 = acc[ai][0][m][1] * sin, u0 = acc[ai][1][m][0] * (sin * sout), u1 = acc[ai][1][m][1] * (sin * sout);
                f32x4 v0, v1;
#pragma unroll
                for (int j = 0; j < 4; ++j) { v0[j] = fsilu(g0[j]) * u0[j]; v1[j] = fsilu(g1[j]) * u1[j]; }
                uint2 w; w.x = pk_fp8x4(v0[0], v0[1], v0[2], v0[3]); w.y = pk_fp8x4(v1[0], v1[1], v1[2], v1[3]);
                *(uint2*)rowp = w; }
    }
};


struct EpiF32S {
    static constexpr bool PERM = false, AFTER_DRAIN = false;
    float* C; int ldc; float scale;
    __device__ __forceinline__ void operator()(const f32x4 (&acc)[2][2][4][2], const Unit& u, int wr, int wc, int fr, int fq) const {
        const int row0 = u.pm * BM + wr * 64 + fr, col0 = u.pn * BM + wc * 32 + 4 * fq;
#pragma unroll
        for (int ai = 0; ai < 2; ++ai)
#pragma unroll
            for (int m = 0; m < 4; ++m) { float* rowp = C + (size_t)(row0 + ai * HALF + m * 16) * ldc + col0;
#pragma unroll
                for (int bj = 0; bj < 2; ++bj)
#pragma unroll
                    for (int n = 0; n < 2; ++n) *(f32x4*)(rowp + bj * HALF + n * 16) = acc[ai][bj][m][n] * scale; }
    }
};

template <class Epi, class Sched, bool STAMP = false, bool F8 = false>
__device__ __forceinline__ void gemm_phase(PG8_LAS unsigned char* lds, const Gemm g, const Sched& S, const Epi& E, unsigned long long* stamps, const int tid_in) {
    const int tid = opq(tid_in), wid = __builtin_amdgcn_readfirstlane(tid >> 6), lane = tid & 63, wr = wid >> 2, wc = wid & 3, fr = lane & 15, fq = lane >> 4;
    const int K = g.K, nt = K / BK;
    int ts_lo = 0, ts_hi = 0, nts = 0; const unsigned long long rt_entry = STAMP ? (unsigned long long)wall_clock64() : 0ull;
#define PG8_STAMP() do { if (STAMP && wid == 0 && nts < 64) { const unsigned long long _c = (unsigned long long)clock64(); \
        ts_lo = (lane == nts) ? (int)(unsigned)_c : ts_lo; ts_hi = (lane == nts) ? (int)(unsigned)(_c >> 32) : ts_hi; ++nts; } } while (0)
    PG8_STAMP();
    unsigned voffA[2], voffB[2];
#pragma unroll
    for (int i = 0; i < 2; ++i) { int R, C; stage_rc(tid * 16 + i * 8192, R, C); const int Rb = Epi::PERM ? ((R & ~31) + perm32(R & 31)) : R;
        voffA[i] = (unsigned)(R * K + C) * 2u; voffB[i] = (unsigned)(Rb * K + C) * 2u; }
    const size_t kstep = (size_t)(BK * 2);
    const size_t qstep = (size_t)64 * K * 2;
    const size_t hstep = (size_t)HALF * K * 2;
    const size_t tstep = 2 * hstep;
    const unsigned ldsw = (unsigned)wid * 1024u;
    const int aoff = lds_byte(wr * 64 + fr, fq * 8), boff = lds_byte(wc * 32 + fr, fq * 8);
#define PG8_SA(b, h) (((b) * 2 + (h)) * HTB)
#define PG8_SB(b, h) ((4 + (b) * 2 + (h)) * HTB)
#define PG8_STAGE(bufoff, gbase, voff) do { _Pragma("unroll") for (int _i = 0; _i < 2; ++_i) \
        __builtin_amdgcn_global_load_lds((const unsigned*)((const char*)(gbase) + (size_t)_i * qstep + (voff)[0]), (PG8_LAS unsigned*)(lds + (bufoff) + ldsw + _i * 8192), 16, 0, 0); } while (0)
#define PG8_LDA(dst, b, h) do { _Pragma("unroll") for (int m = 0; m < 4; ++m) { if constexpr (F8) { const i32x4 lo_ = *(const PG8_LAS i32x4*)(lds + PG8_SA(b, h) + aoff + m * 2048), hi_ = *(const PG8_LAS i32x4*)(lds + PG8_SA(b, h) + aoff + m * 2048 + 1024); \
            dst##8[m] = __builtin_shufflevector(lo_, hi_, 0, 1, 2, 3, 4, 5, 6, 7); } else { _Pragma("unroll") for (int k = 0; k < 2; ++k) dst[m][k] = *(const PG8_LAS bf16x8*)(lds + PG8_SA(b, h) + aoff + m * 2048 + k * 1024); } } } while (0)
#define PG8_LDB(dst, b, h) do { _Pragma("unroll") for (int n = 0; n < 2; ++n) { if constexpr (F8) { const i32x4 lo_ = *(const PG8_LAS i32x4*)(lds + PG8_SB(b, h) + boff + n * 2048), hi_ = *(const PG8_LAS i32x4*)(lds + PG8_SB(b, h) + boff + n * 2048 + 1024); \
            dst##8[n] = __builtin_shufflevector(lo_, hi_, 0, 1, 2, 3, 4, 5, 6, 7); } else { _Pragma("unroll") for (int k = 0; k < 2; ++k) dst[n][k] = *(const PG8_LAS bf16x8*)(lds + PG8_SB(b, h) + boff + n * 2048 + k * 1024); } } } while (0)
#define PG8_MMA(ai, bj, At, Bt) do { __builtin_amdgcn_s_setprio(1); _Pragma("unroll") for (int m = 0; m < 4; ++m) _Pragma("unroll") for (int n = 0; n < 2; ++n) { \
        if constexpr (F8) {   \
            asm volatile("v_mfma_scale_f32_16x16x128_f8f6f4 %0, %1, %2, %0, %3, %3 op_sel_hi:[0,0,0]" : "+v"(acc[ai][bj][m][n]) : "v"(Bt##8[n]), "v"(At##8[m]), "v"(f8scale)); } \
        else { _Pragma("unroll") for (int k = 0; k < 2; ++k) acc[ai][bj][m][n] = __builtin_amdgcn_mfma_f32_16x16x32_bf16(Bt[n][k], At[m][k], acc[ai][bj][m][n], 0, 0, 0); } } \
        __builtin_amdgcn_s_setprio(0); } while (0)
#define PG8_WAIT_V(n) asm volatile("s_waitcnt vmcnt(" #n ")" ::: "memory")
#define PG8_WAIT_L(n) asm volatile("s_waitcnt lgkmcnt(" #n ")" ::: "memory")
#define PG8_BAR __builtin_amdgcn_s_barrier()
#define PG8_SCHED __builtin_amdgcn_sched_barrier(0)
    float zf_ = 0.f; asm volatile("" : "+v"(zf_));
    Unit cur, nxt; int ui = 0;
    if (!S.next(0, cur)) return;
    f32x4 acc[2][2][4][2];
#pragma unroll
    for (int a = 0; a < 2; ++a)
#pragma unroll
        for (int b = 0; b < 2; ++b)
#pragma unroll
            for (int m = 0; m < 4; ++m)
#pragma unroll
                for (int n = 0; n < 2; ++n) acc[a][b][m][n] = (f32x4){zf_, zf_, zf_, zf_};
    int f8scale = 0x7F7F7F7F; asm volatile("" : "+v"(f8scale));
    bf16x8 At[4][2], B0[2][2], B1[2][2]; i32x8 At8[4], B08[2], B18[2]; (void)At; (void)B0; (void)B1; (void)At8; (void)B08; (void)B18;
    const char* cA = (const char*)g.A + (size_t)cur.pm * tstep; const char* cB = (const char*)g.Bt + (size_t)cur.pn * tstep;
    S.a_ready(cur);
    PG8_STAGE(PG8_SB(0, 0), cB, voffB); PG8_STAGE(PG8_SA(0, 0), cA, voffA); PG8_STAGE(PG8_SB(0, 1), cB + hstep, voffB); PG8_STAGE(PG8_SA(0, 1), cA + hstep, voffA);
    if (wr == 1) PG8_BAR;
    PG8_WAIT_V(4); PG8_BAR;
    PG8_STAGE(PG8_SB(1, 0), cB + kstep, voffB); PG8_STAGE(PG8_SA(1, 0), cA + kstep, voffA); PG8_STAGE(PG8_SB(1, 1), cB + hstep + kstep, voffB);
    PG8_WAIT_V(6); PG8_BAR;
    PG8_STAMP();
    for (;;) {
        const bool has_next = S.next(ui + 1, nxt);
        const char* nA = has_next ? (const char*)g.A + (size_t)nxt.pm * tstep : cA; const char* nB = has_next ? (const char*)g.Bt + (size_t)nxt.pn * tstep : cB;
        for (int t = 0; t < nt; t += 2) {
            const bool last = (t == nt - 2);
            const char* a1 = cA + (size_t)(t + 1) * kstep;
            const char* a2 = last ? nA : cA + (size_t)(t + 2) * kstep; const char* b2 = last ? nB : cB + (size_t)(t + 2) * kstep;
            const char* a3 = a2 + kstep; const char* b3 = b2 + kstep;
            if (last && has_next) S.a_ready(nxt);
            PG8_LDB(B0, 0, 0); PG8_SCHED; PG8_LDA(At, 0, 0); PG8_STAGE(PG8_SA(1, 1), a1 + hstep, voffA);
            PG8_WAIT_L(8); PG8_BAR; PG8_WAIT_L(0); PG8_MMA(0, 0, At, B0); PG8_BAR; PG8_SCHED;
            PG8_LDB(B1, 0, 1); PG8_STAGE(PG8_SB(0, 0), b2, voffB);
            PG8_BAR; PG8_WAIT_L(0); PG8_MMA(0, 1, At, B1); PG8_BAR;
            PG8_LDA(At, 0, 1); PG8_STAGE(PG8_SA(0, 0), a2, voffA);
            PG8_BAR; PG8_WAIT_L(0); PG8_MMA(1, 0, At, B0); PG8_BAR; PG8_SCHED;
            PG8_STAGE(PG8_SB(0, 1), b2 + hstep, voffB);
            PG8_WAIT_V(6); PG8_BAR; PG8_MMA(1, 1, At, B1); PG8_BAR;
            PG8_LDB(B0, 1, 0); PG8_SCHED; PG8_LDA(At, 1, 0); PG8_STAGE(PG8_SA(0, 1), a2 + hstep, voffA);
            PG8_WAIT_L(8); PG8_BAR; PG8_WAIT_L(0); PG8_MMA(0, 0, At, B0); PG8_BAR; PG8_SCHED;
            PG8_LDB(B1, 1, 1); PG8_STAGE(PG8_SB(1, 0), b3, voffB);
            PG8_BAR; PG8_WAIT_L(0); PG8_MMA(0, 1, At, B1); PG8_BAR;
            PG8_LDA(At, 1, 1); PG8_STAGE(PG8_SA(1, 0), a3, voffA);
            PG8_BAR; PG8_WAIT_L(0); PG8_MMA(1, 0, At, B0); PG8_BAR; PG8_SCHED;
            PG8_STAGE(PG8_SB(1, 1), b3 + hstep, voffB);
            PG8_WAIT_V(6); PG8_BAR; PG8_MMA(1, 1, At, B1); PG8_BAR;
        }
        PG8_STAMP();
        if constexpr (F8) { asm volatile("s_nop 15\n\ts_nop 15" ::: "memory"); }
        if constexpr (!Epi::AFTER_DRAIN) { E(acc, cur, wr, wc, fr, fq); S.done(cur); }
        PG8_STAMP();
        if (!has_next) break;
#pragma unroll
        for (int a = 0; a < 2; ++a)
#pragma unroll
            for (int b = 0; b < 2; ++b)
#pragma unroll
                for (int m = 0; m < 4; ++m)
#pragma unroll
                    for (int n = 0; n < 2; ++n) acc[a][b][m][n] = (f32x4){zf_, zf_, zf_, zf_};
        cur = nxt; cA = nA; cB = nB; ++ui;
    }
    PG8_WAIT_V(0);
    if (wr == 0) PG8_BAR;
    PG8_BAR;
    if constexpr (Epi::AFTER_DRAIN) { E.fused(acc, cur, wr, wc, fr, fq, lds, wid, lane); S.done(cur); }
    PG8_STAMP();
    if (STAMP && wid == 0) { stamps[lane] = lane < nts ? (((unsigned long long)(unsigned)ts_hi << 32) | (unsigned)ts_lo) : 0ull;
        if (lane == 62) stamps[62] = rt_entry; if (lane == 63) stamps[63] = (unsigned long long)wall_clock64(); }
#undef PG8_STAMP
#undef PG8_SA
#undef PG8_SB
#undef PG8_STAGE
#undef PG8_LDA
#undef PG8_LDB
#undef PG8_MMA
#undef PG8_WAIT_V
#undef PG8_WAIT_L
#undef PG8_BAR
#undef PG8_SCHED
}
}
#define RLX_AGENT __ATOMIC_RELAXED, __HIP_MEMORY_SCOPE_AGENT
#define XB_TMO      128
#define XB_XCNT(j)  (256  + 64 * (j))
#define XB_XSUB(j)  (1280 + 64 * (j))
#define XB_XGEN(j)  (2304 + 64 * (j))
#define XB_TOP      3328
#define XB_TOPGEN   3392
#define XCD_BAR_WORDS 3456
#define XB_SPIN_CAP (1u << 18)

__device__ __forceinline__ unsigned xb_ld(unsigned* p)              { return __hip_atomic_load(p, __ATOMIC_RELAXED, __HIP_MEMORY_SCOPE_AGENT); }
__device__ __forceinline__ unsigned xb_add(unsigned* p, unsigned v) { return __hip_atomic_fetch_add(p, v, __ATOMIC_RELAXED, __HIP_MEMORY_SCOPE_AGENT); }
__device__ __forceinline__ unsigned xb_xcc_id() { return (unsigned)__builtin_amdgcn_s_getreg((3 << 11) | 20) & 0xFu; }
#define XB_SPIN(cond, bar) do { unsigned _sp = 0; while (cond) { __builtin_amdgcn_s_sleep(1); \
    if ((++_sp & 255u) == 0u) { if (xb_ld(&(bar)[XB_TMO])) break; if (_sp > XB_SPIN_CAP) { atomicAdd(&(bar)[XB_TMO], 1u); break; } } } } while (0)

struct XcdBarrier {
    unsigned* bar; unsigned x; int wv;
    volatile LAS unsigned* st;
};

__device__ __forceinline__ XcdBarrier xcd_barrier_post(unsigned* bar, volatile LAS unsigned* st) {
    XcdBarrier b; b.bar = bar; b.x = xb_xcc_id(); b.st = st; b.wv = __builtin_amdgcn_readfirstlane((int)threadIdx.x >> 6);
    if (threadIdx.x == 0) (void)xb_add(&bar[XB_XCNT(b.x)], 1u);
    return b;
}
__device__ __forceinline__ void xcd_barrier_complete(unsigned* bar, unsigned x, unsigned& nloc, unsigned& nx) {
    const unsigned G = gridDim.x * gridDim.y * gridDim.z;
    unsigned sum, cnt, mine, sp = 0u;
    for (;;) {
        sum = 0u; cnt = 0u; mine = 0u;
#pragma unroll
        for (unsigned j = 0; j < 16; ++j) { const unsigned c = xb_ld(&bar[XB_XCNT(j)]); sum += c; cnt += (c > 0u) ? 1u : 0u; mine = (j == x) ? c : mine; }
        if (sum == G) break;
        __builtin_amdgcn_s_sleep(1);
        if ((++sp & 255u) == 0u) { if (xb_ld(&bar[XB_TMO])) break; if (sp > XB_SPIN_CAP) { atomicAdd(&bar[XB_TMO], 1u); break; } }
    }
    nloc = mine > 0u ? mine : 1u; nx = cnt > 0u ? cnt : 1u;
}

__device__ __forceinline__ void xcd_barrier(const XcdBarrier& b) {
    asm volatile("s_waitcnt vmcnt(0)" ::: "memory");
    __syncthreads();
    if (((b.wv << 6) | lane_v()) == 0) {
        unsigned* bar = b.bar;
        __builtin_amdgcn_s_waitcnt(0);
        unsigned nloc = b.st[0], nx = b.st[1];
        if (nloc == 0u) { xcd_barrier_complete(bar, b.x, nloc, nx); b.st[0] = nloc; b.st[1] = nx; }
        const unsigned old = xb_add(&bar[XB_XSUB(b.x)], 1u);
        const unsigned gen = old / nloc;
        if (old + 1u == (gen + 1u) * nloc) {
            __builtin_amdgcn_fence(__ATOMIC_RELEASE, "agent");
            asm volatile("s_waitcnt vmcnt(0)" ::: "memory");
            const unsigned og = xb_add(&bar[XB_TOP], 1u);
            const unsigned tg = og / nx;
            if (og + 1u == (tg + 1u) * nx) xb_add(&bar[XB_TOPGEN], 1u);
            else XB_SPIN(xb_ld(&bar[XB_TOPGEN]) == tg, bar);
            __builtin_amdgcn_fence(__ATOMIC_ACQUIRE, "agent");
            xb_add(&bar[XB_XGEN(b.x)], 1u);
            asm volatile("s_waitcnt vmcnt(0)" ::: "memory");
        } else {
            XB_SPIN(xb_ld(&bar[XB_XGEN(b.x)]) == gen, bar);
            __builtin_amdgcn_fence(__ATOMIC_ACQUIRE, "agent");
            asm volatile("s_waitcnt vmcnt(0)" ::: "memory");
        }
    }
    __syncthreads();
}

typedef unsigned short bf16;
using pg8::bf16x8; using pg8::f32x4; using pg8::u32x4;
typedef unsigned u32x2 __attribute__((ext_vector_type(2)));
constexpr int NT = 512, NW = 8;
constexpr int DM = 2048, NB = 8, SEQ = 2048, CTXL = 256;
constexpr int MLAT = NB * SEQ, MCTX = NB * CTXL, MTOT = MLAT + MCTX;
constexpr int NIN = 5920, NINP = 6144;
constexpr int C_RW_R = 0, C_RW_K = 512, C_RW_V = 1024, C_RW_XW = 1536;
constexpr int C_MB_Z = 1792, C_MB_XBC = 2816, C_MB_DT = 4352;
constexpr int C_DA_Q = 4384, C_DA_V = 5408;
constexpr int FF = 5632, FE = 7168, NE = 8;
constexpr int MOE_ROWS = 34816;
constexpr int LDS_STAGE = 131072, LDS_MISC = 1024, LDS_BYTES = LDS_STAGE + LDS_MISC;

#ifndef MOE_FP8
#define MOE_FP8 1
#endif
#ifndef DENSE_GU8
#define DENSE_GU8 1
#endif
#ifndef DENSE_D8
#define DENSE_D8 0
#endif
constexpr float MOE_SGU = 32.0f, MOE_SD = 64.0f, MOE_SH = 4.0f;
constexpr size_t MiB = 1048576;
constexpr size_t WS_CTL   = 0;
constexpr size_t CTL_BYTES = 65536;
constexpr size_t CW_BAR = 0, CW_CNT = 4096  , CW_Q = 8192  , CW_BG = 8704  , CW_DONE = 9216  ;
constexpr size_t WS_ADA   = 1 * MiB;
constexpr size_t WS_ROPE  = 2 * MiB;
constexpr size_t WS_TOK   = 3 * MiB;
constexpr size_t WS_WIN   = 4 * MiB;
constexpr size_t WS_WOUT  = WS_WIN  + 48 * MiB;
constexpr size_t WS_WSM   = WS_WOUT + 16 * MiB;
constexpr size_t WS_WGU   = WS_WSM  + 2 * MiB;
constexpr size_t WS_WD    = WS_WGU  + 44 * MiB;
constexpr size_t WS_MGU   = WS_WD   + 22 * MiB;
constexpr size_t WS_MD    = WS_MGU  + 448 * MiB;
constexpr size_t WS_XC    = WS_MD   + 224 * MiB;
constexpr size_t WS_HA    = WS_XC   + 16 * MiB;
constexpr size_t WS_U     = WS_HA   + 72 * MiB;
constexpr size_t WS_MIX   = WS_U    + 216 * MiB;
constexpr size_t WS_BIG   = WS_MIX  + 144 * MiB;
constexpr size_t WS_XSB   = WS_BIG  + 476 * MiB;
constexpr size_t WS_END   = WS_XSB  + 64 * MiB;
constexpr size_t WS_ASM   = WS_BIG;
constexpr size_t WS_XBC   = WS_ASM  + 9 * MiB;
constexpr size_t WS_DT    = WS_XBC  + 54 * MiB;
constexpr size_t WS_QK    = WS_DT   + 5 * MiB;
constexpr size_t WS_RW5   = WS_QK   + 36 * MiB;
constexpr size_t WS_YR    = WS_RW5  + 90 * MiB;
constexpr size_t WS_YM    = WS_YR   + 72 * MiB;
constexpr size_t WS_ST    = WS_YM   + 72 * MiB;
constexpr size_t WS_AC    = WS_ST   + 72 * MiB;
static_assert(WS_AC + 1 * MiB <= WS_END, "mixer intermediates overflow BIG");
static_assert((size_t)MOE_ROWS * FE * 2 <= 476 * MiB && (size_t)MOE_ROWS * DM * 2 <= 144 * MiB, "moe buffers");

struct Args { const float* in[38]; float* out; unsigned char* ws; int ph_lo, ph_hi, sub, pad; };
struct Ctx { unsigned char* ws; int wv; int sub; };

constexpr int LDS_PTRS = LDS_STAGE + 128;
__device__ __forceinline__ const float* ldin(int k) {
    extern __shared__ __attribute__((aligned(16))) unsigned char lds_dyn[];
    const int base = opqs((int)(unsigned)(unsigned long long)(LAS unsigned char*)lds_dyn);
    const LAS unsigned* p = (const LAS unsigned*)(unsigned long long)(unsigned)(base + LDS_PTRS + 8 * k);
    const unsigned lo = __builtin_amdgcn_readfirstlane(p[0]), hi = __builtin_amdgcn_readfirstlane(p[1]);
    return (const float*)(const GAS float*)(((unsigned long long)hi << 32) | (unsigned long long)lo);
}
__device__ __forceinline__ float bf2f(unsigned short b) { return __uint_as_float(((unsigned)b) << 16); }
typedef float f32x2_t __attribute__((ext_vector_type(2)));
typedef __bf16 bf16x2_t __attribute__((ext_vector_type(2)));
__device__ __forceinline__ unsigned pk2(float lo, float hi) { const f32x2_t v = {lo, hi}; return __builtin_bit_cast(unsigned, __builtin_convertvector(v, bf16x2_t)); }
__device__ __forceinline__ unsigned f2bf(float f) { return pk2(f, f) & 0xffffu; }
__device__ __forceinline__ void unpack8(const uint4 w, float (&f)[8]) {
    f[0] = __uint_as_float(w.x << 16); f[1] = __uint_as_float(w.x & 0xffff0000u); f[2] = __uint_as_float(w.y << 16); f[3] = __uint_as_float(w.y & 0xffff0000u);
    f[4] = __uint_as_float(w.z << 16); f[5] = __uint_as_float(w.z & 0xffff0000u); f[6] = __uint_as_float(w.w << 16); f[7] = __uint_as_float(w.w & 0xffff0000u); }
__device__ __forceinline__ uint4 pack8(const float (&f)[8]) { uint4 w; w.x = pk2(f[0], f[1]); w.y = pk2(f[2], f[3]); w.z = pk2(f[4], f[5]); w.w = pk2(f[6], f[7]); return w; }
__device__ __forceinline__ void unpack4(const uint2 w, float (&f)[4]) {
    f[0] = __uint_as_float(w.x << 16); f[1] = __uint_as_float(w.x & 0xffff0000u); f[2] = __uint_as_float(w.y << 16); f[3] = __uint_as_float(w.y & 0xffff0000u); }
template <int CTRL> __device__ __forceinline__ float dppf(float v) { return __int_as_float(__builtin_amdgcn_update_dpp(0, __float_as_int(v), CTRL, 0xf, 0xf, false)); }
__device__ __forceinline__ float red8(float v)  { v += dppf<0xB1>(v); v += dppf<0x4E>(v); v += dppf<0x141>(v); return v; }
__device__ __forceinline__ float red16(float v) { v += dppf<0xB1>(v); v += dppf<0x4E>(v); v += dppf<0x141>(v); v += dppf<0x140>(v); return v; }
__device__ __forceinline__ float swz16(float v) { return __int_as_float(__builtin_amdgcn_ds_swizzle(__float_as_int(v), 0x401F)); }
__device__ __forceinline__ float red32(float v) { v = red16(v); v += swz16(v); return v; }
__device__ __forceinline__ float wsum(float v) { v = red32(v); return __int_as_float(__builtin_amdgcn_readlane(__float_as_int(v), 0)) + __int_as_float(__builtin_amdgcn_readlane(__float_as_int(v), 32)); }
__device__ __forceinline__ float shx32(float v, int lane) { return __int_as_float(__builtin_amdgcn_ds_bpermute((lane ^ 32) << 2, __float_as_int(v))); }
__device__ __forceinline__ float fsilu(float x) { return pg8::fsilu(x); }
__device__ __forceinline__ float fsigm(float x) { return pg8::fsigm(x); }
__device__ __forceinline__ float softplusf(float x) { return fmaxf(x, 0.f) + log1pf(__expf(-fabsf(x))); }


template <bool F8>
__device__ __forceinline__ void cvt_job_t(const float* __restrict__ src, int ld, int ncols_valid, int ncols_total, void* __restrict__ dstv, int K, int mode, float scale, LAS float* tile, int bid, int G, const int tid, int t_end = 0x7fffffff) {
    const int ntn = ncols_total >> 6, ntk = K >> 7; const int nt = (ntn * ntk) < t_end ? (ntn * ntk) : t_end;
    const int lk = tid >> 4, lc = (tid & 15) * 4;
    constexpr int TP = 65;
    float4 r[4]; int buf = 0;
    const float4 z4 = make_float4(0.f, 0.f, 0.f, 0.f);
#define CVT_LOAD(t_, dst_) do { const int tn_ = (t_) % ntn, tk_ = (t_) / ntn; const int n_ = tn_ * 64 + lc; const float* p_ = src + (size_t)(tk_ * 128 + lk) * ld + n_; \
        _Pragma("unroll") for (int i_ = 0; i_ < 4; ++i_) dst_[i_] = (n_ < ncols_valid) ? *(const float4*)(p_ + (size_t)(32 * i_) * ld) : z4; } while (0)
    int t = bid;
    if (t < nt) CVT_LOAD(t, r);
    __syncthreads();
    for (; t < nt; t += G) {
        float4 nx[4] = {z4, z4, z4, z4};
        if (t + G < nt) CVT_LOAD(t + G, nx);
        LAS float* tl = tile + buf * (128 * TP);
#pragma unroll
        for (int i = 0; i < 4; ++i) { LAS float* q = tl + (lk + 32 * i) * TP + lc; q[0] = r[i].x; q[1] = r[i].y; q[2] = r[i].z; q[3] = r[i].w; }
        __syncthreads();
        const int tn = t % ntn, tk = t / ntn, k0 = tk * 128, nb = tn * 64;
        const int kq = tid & 7, nl = tid >> 3, nn = nb + nl;
        const int drow = mode == 0 ? nn : ((nn >> 7) * 256 + (nn & 127) + (mode == 2 ? 128 : 0));
        const LAS float* c = tl + (kq * 16) * TP + nl;
        if (F8) {
            uint4 w;
            w.x = pg8::pk_fp8x4(c[0 * TP] * scale, c[1 * TP] * scale, c[2 * TP] * scale, c[3 * TP] * scale); w.y = pg8::pk_fp8x4(c[4 * TP] * scale, c[5 * TP] * scale, c[6 * TP] * scale, c[7 * TP] * scale);
            w.z = pg8::pk_fp8x4(c[8 * TP] * scale, c[9 * TP] * scale, c[10 * TP] * scale, c[11 * TP] * scale); w.w = pg8::pk_fp8x4(c[12 * TP] * scale, c[13 * TP] * scale, c[14 * TP] * scale, c[15 * TP] * scale);
            *(uint4*)((unsigned char*)dstv + (size_t)drow * K + k0 + kq * 16) = w;
        } else {
            uint4 w0, w1;
            w0.x = pk2(c[0 * TP], c[1 * TP]); w0.y = pk2(c[2 * TP], c[3 * TP]); w0.z = pk2(c[4 * TP], c[5 * TP]); w0.w = pk2(c[6 * TP], c[7 * TP]);
            w1.x = pk2(c[8 * TP], c[9 * TP]); w1.y = pk2(c[10 * TP], c[11 * TP]); w1.z = pk2(c[12 * TP], c[13 * TP]); w1.w = pk2(c[14 * TP], c[15 * TP]);
            uint4* q = (uint4*)((bf16*)dstv + (size_t)drow * K + k0 + kq * 16); q[0] = w0; q[1] = w1;
        }
#pragma unroll
        for (int i = 0; i < 4; ++i) r[i] = nx[i];
        buf ^= 1;
    }
#undef CVT_LOAD
}
__device__ __forceinline__ void cvt_job_f8(const float* __restrict__ src, int ld, int ncols, unsigned char* __restrict__ dst, int K, int mode, float scale, LAS unsigned char* tile, int t_begin, int t_end, const int tid) {
    const int ntn = ncols >> 6;
    const int q = tid >> 4, i4 = tid & 15;
    constexpr int TP = 144;
    float4 r[4]; int buf = 0;
#define CVT8_LOAD(t_, dst_) do { const int tn_ = (t_) % ntn, tk_ = (t_) / ntn; const float* p_ = src + (size_t)(tk_ * 128 + 4 * q) * ld + tn_ * 64 + 4 * i4; \
        _Pragma("unroll") for (int j_ = 0; j_ < 4; ++j_) dst_[j_] = *(const float4*)(p_ + (size_t)j_ * ld); } while (0)
    int t = t_begin;
    if (t < t_end) CVT8_LOAD(t, r);
    __syncthreads();
    for (; t < t_end; ++t) {
        float4 nx[4];
#pragma unroll
        for (int j = 0; j < 4; ++j) nx[j] = r[j];
        if (t + 1 < t_end) CVT8_LOAD(t + 1, nx);
        unsigned w[4];
#pragma unroll
        for (int j = 0; j < 4; ++j) w[j] = pg8::pk_fp8x4(r[j].x * scale, r[j].y * scale, r[j].z * scale, r[j].w * scale);
        const unsigned a_lo = __builtin_amdgcn_perm(w[1], w[0], 0x05010400u), a_hi = __builtin_amdgcn_perm(w[1], w[0], 0x07030602u);
        const unsigned b_lo = __builtin_amdgcn_perm(w[3], w[2], 0x05010400u), b_hi = __builtin_amdgcn_perm(w[3], w[2], 0x07030602u);
        unsigned o[4];
        o[0] = __builtin_amdgcn_perm(b_lo, a_lo, 0x05040100u); o[1] = __builtin_amdgcn_perm(b_lo, a_lo, 0x07060302u);
        o[2] = __builtin_amdgcn_perm(b_hi, a_hi, 0x05040100u); o[3] = __builtin_amdgcn_perm(b_hi, a_hi, 0x07060302u);
        LAS unsigned char* tl = tile + buf * (64 * TP);
        const int cw = ((q >> 2) ^ (i4 & 7)) * 16 + (q & 3) * 4;
#pragma unroll
        for (int m = 0; m < 4; ++m) *(LAS unsigned*)(tl + (4 * i4 + m) * TP + cw) = o[m];
        __syncthreads();
        const int tn = t % ntn, tk = t / ntn, k0 = tk * 128, nb = tn * 64;
        const int kq = tid & 7, nl = tid >> 3, nn = nb + nl;
        const int drow = mode == 0 ? nn : ((nn >> 7) * 256 + (nn & 127) + (mode == 2 ? 128 : 0));
        const u32x4 v = *(const LAS u32x4*)(tl + nl * TP + ((kq ^ ((nl >> 2) & 7)) * 16));
        *(uint4*)(dst + (size_t)drow * K + k0 + kq * 16) = make_uint4(v.x, v.y, v.z, v.w);
#pragma unroll
        for (int j = 0; j < 4; ++j) r[j] = nx[j];
        buf ^= 1;
    }
#undef CVT8_LOAD
}
__device__ __forceinline__ void cvt_job_b16(const float* __restrict__ src, int ld, int ncols_valid, int ncols_total, bf16* __restrict__ dst, int K, int mode, LAS unsigned char* tile, int t_begin, int t_end, const int tid) {
    const int ntn = ncols_total >> 6;
    const int q = tid >> 4, i4 = tid & 15;
    constexpr int TP = 272;
    const float4 z4 = make_float4(0.f, 0.f, 0.f, 0.f);
    float4 r[4]; int buf = 0;
#define CVTB_LOAD(t_, dst_) do { const int tn_ = (t_) % ntn, tk_ = (t_) / ntn; const int n_ = tn_ * 64 + 4 * i4; const float* p_ = src + (size_t)(tk_ * 128 + 4 * q) * ld + n_; \
        _Pragma("unroll") for (int j_ = 0; j_ < 4; ++j_) dst_[j_] = (n_ < ncols_valid) ? *(const float4*)(p_ + (size_t)j_ * ld) : z4; } while (0)
    int t = t_begin;
    if (t < t_end) CVTB_LOAD(t, r);
    __syncthreads();
    for (; t < t_end; ++t) {
        float4 nx[4];
#pragma unroll
        for (int j = 0; j < 4; ++j) nx[j] = r[j];
        if (t + 1 < t_end) CVTB_LOAD(t + 1, nx);
        LAS unsigned char* tl = tile + buf * (64 * TP);
        *(LAS u32x2*)(tl + (4 * i4 + 0) * TP + 8 * q) = (u32x2){pk2(r[0].x, r[1].x), pk2(r[2].x, r[3].x)};
        *(LAS u32x2*)(tl + (4 * i4 + 1) * TP + 8 * q) = (u32x2){pk2(r[0].y, r[1].y), pk2(r[2].y, r[3].y)};
        *(LAS u32x2*)(tl + (4 * i4 + 2) * TP + 8 * q) = (u32x2){pk2(r[0].z, r[1].z), pk2(r[2].z, r[3].z)};
        *(LAS u32x2*)(tl + (4 * i4 + 3) * TP + 8 * q) = (u32x2){pk2(r[0].w, r[1].w), pk2(r[2].w, r[3].w)};
        __syncthreads();
        const int tn = t % ntn, tk = t / ntn, k0 = tk * 128, nb = tn * 64;
        const int kq = tid & 7, nl = tid >> 3, nn = nb + nl;
        const int drow = mode == 0 ? nn : ((nn >> 7) * 256 + (nn & 127) + (mode == 2 ? 128 : 0));
        const u32x4 v0 = *(const LAS u32x4*)(tl + nl * TP + kq * 16), v1 = *(const LAS u32x4*)(tl + nl * TP + 128 + kq * 16);
        bf16* o = dst + (size_t)drow * K + k0 + kq * 8;
        *(uint4*)o = make_uint4(v0.x, v0.y, v0.z, v0.w); *(uint4*)(o + 64) = make_uint4(v1.x, v1.y, v1.z, v1.w);
#pragma unroll
        for (int j = 0; j < 4; ++j) r[j] = nx[j];
        buf ^= 1;
    }
#undef CVTB_LOAD
}
template <int NTB, int D>
__device__ __forceinline__ void cvt_job_f8d(const float* __restrict__ src, int ld, int ncols, unsigned char* __restrict__ dst, int K, int mode, float scale, LAS unsigned char* tile, int t_begin, const int tid) {
    const int ntn = ncols >> 6;
    const int q = tid >> 4, i4 = tid & 15;
    constexpr int TP = 144;
    float4 r[D][4];
#define CVT8_LOAD(t_, dst_) do { const int tn_ = (t_) % ntn, tk_ = (t_) / ntn; const float* p_ = src + (size_t)(tk_ * 128 + 4 * q) * ld + tn_ * 64 + 4 * i4; \
        _Pragma("unroll") for (int j_ = 0; j_ < 4; ++j_) dst_[j_] = *(const float4*)(p_ + (size_t)j_ * ld); } while (0)
#pragma unroll
    for (int d = 0; d < D; ++d) CVT8_LOAD(t_begin + d, r[d]);
    __syncthreads();
#pragma unroll
    for (int i = 0; i < NTB; ++i) {
        const int t = t_begin + i;
        unsigned w[4];
#pragma unroll
        for (int j = 0; j < 4; ++j) w[j] = pg8::pk_fp8x4(r[i % D][j].x * scale, r[i % D][j].y * scale, r[i % D][j].z * scale, r[i % D][j].w * scale);
        if (i + D < NTB) CVT8_LOAD(t + D, r[i % D]);
        const unsigned a_lo = __builtin_amdgcn_perm(w[1], w[0], 0x05010400u), a_hi = __builtin_amdgcn_perm(w[1], w[0], 0x07030602u);
        const unsigned b_lo = __builtin_amdgcn_perm(w[3], w[2], 0x05010400u), b_hi = __builtin_amdgcn_perm(w[3], w[2], 0x07030602u);
        unsigned o[4];
        o[0] = __builtin_amdgcn_perm(b_lo, a_lo, 0x05040100u); o[1] = __builtin_amdgcn_perm(b_lo, a_lo, 0x07060302u);
        o[2] = __builtin_amdgcn_perm(b_hi, a_hi, 0x05040100u); o[3] = __builtin_amdgcn_perm(b_hi, a_hi, 0x07060302u);
        LAS unsigned char* tl = tile + (i & 1) * (64 * TP);
        const int cw = ((q >> 2) ^ (i4 & 7)) * 16 + (q & 3) * 4;
#pragma unroll
        for (int m = 0; m < 4; ++m) *(LAS unsigned*)(tl + (4 * i4 + m) * TP + cw) = o[m];
        __syncthreads();
        const int tn = t % ntn, tk = t / ntn, k0 = tk * 128, nb = tn * 64;
        const int kq = tid & 7, nl = tid >> 3, nn = nb + nl;
        const int drow = mode == 0 ? nn : ((nn >> 7) * 256 + (nn & 127) + (mode == 2 ? 128 : 0));
        const u32x4 v = *(const LAS u32x4*)(tl + nl * TP + ((kq ^ ((nl >> 2) & 7)) * 16));
        *(uint4*)(dst + (size_t)drow * K + k0 + kq * 16) = make_uint4(v.x, v.y, v.z, v.w);
    }
#undef CVT8_LOAD
}
__device__ __forceinline__ void cvt_job8(const float* src, int ld, int ncols, unsigned char* dst, int K, int mode, float scale, LAS float* tile, int bid, int G, const int tid) { cvt_job_t<true>(src, ld, ncols, ncols, dst, K, mode, scale, tile, bid, G, tid); }
__device__ __forceinline__ void cvt_job(const float* src, int ld, int ncols_valid, int ncols_total, bf16* dst, int K, int mode, LAS float* tile, int bid, int G, const int tid) { cvt_job_t<false>(src, ld, ncols_valid, ncols_total, dst, K, mode, 1.0f, tile, bid, G, tid); }

__device__ __forceinline__ void p0_prologue(const Ctx& a, LAS unsigned char* lds, int bid, int G) {
    unsigned char* ws = opqp(a.ws); const int tid = ((a.wv << 6) | lane_v());
    LAS float* tile = (LAS float*)lds;
    if (!(a.sub & 512)) {
#define P0_RANGE(nt_) const int nt__ = (nt_); const int tb = (int)((long)bid * nt__ / G), te = (int)((long)(bid + 1) * nt__ / G)
        for (int l = 0; l < 2; ++l) {
            { P0_RANGE((NINP >> 6) * (DM >> 7)); cvt_job_b16(ldin(10) + (size_t)l * DM * NIN, NIN, NIN, NINP, (bf16*)(ws + WS_WIN) + (size_t)l * NINP * DM, DM, 0, (LAS unsigned char*)lds, tb, te, tid); }
            { P0_RANGE((DM >> 6) * (DM >> 7)); cvt_job_b16(ldin(11) + (size_t)l * DM * DM, DM, DM, DM, (bf16*)(ws + WS_WOUT) + (size_t)l * DM * DM, DM, 0, (LAS unsigned char*)lds, tb, te, tid); }
        }
#if DENSE_GU8
        { P0_RANGE((FF >> 6) * (DM >> 7)); cvt_job_f8(ldin(31), FF, FF, ws + WS_WGU, DM, 1, MOE_SGU, (LAS unsigned char*)lds, tb, te, tid);
          cvt_job_f8(ldin(32), FF, FF, ws + WS_WGU, DM, 2, MOE_SGU, (LAS unsigned char*)lds, tb, te, tid); }
#else
        { P0_RANGE((FF >> 6) * (DM >> 7)); cvt_job_b16(ldin(31), FF, FF, FF, (bf16*)(ws + WS_WGU), DM, 1, (LAS unsigned char*)lds, tb, te, tid);
          cvt_job_b16(ldin(32), FF, FF, FF, (bf16*)(ws + WS_WGU), DM, 2, (LAS unsigned char*)lds, tb, te, tid); }
#endif
#if DENSE_D8
        { P0_RANGE((DM >> 6) * (FF >> 7)); cvt_job_f8(ldin(33), DM, DM, ws + WS_WD, FF, 0, MOE_SD, (LAS unsigned char*)lds, tb, te, tid); }
#else
        { P0_RANGE((DM >> 6) * (FF >> 7)); cvt_job_b16(ldin(33), DM, DM, DM, (bf16*)(ws + WS_WD), FF, 0, (LAS unsigned char*)lds, tb, te, tid); }
#endif
#undef P0_RANGE
    }
#if !MOE_FP8
    for (int e = 0; e < NE; ++e) {
        cvt_job(ldin(35) + (size_t)e * DM * FE, FE, FE, FE, (bf16*)(ws + WS_MGU) + (size_t)e * 2 * FE * DM, DM, 1, tile, bid, G, tid);
        cvt_job(ldin(36) + (size_t)e * DM * FE, FE, FE, FE, (bf16*)(ws + WS_MGU) + (size_t)e * 2 * FE * DM, DM, 2, tile, bid, G, tid);
        cvt_job(ldin(37) + (size_t)e * FE * DM, DM, DM, DM, (bf16*)(ws + WS_MD) + (size_t)e * DM * FE, FE, 0, tile, bid, G, tid);
    }
#endif
    {
        bf16* wsm = (bf16*)(ws + WS_WSM);
        for (size_t i = (size_t)bid * NT + tid; i < (size_t)2 * 2048 * 256; i += (size_t)G * NT) {
            const int l = (int)(i >> 19), n = (int)((i >> 8) & 2047), k = (int)(i & 255); float v = 0.f;
            if (n < 1024) { if (k < 64) v = ldin(14)[(((size_t)l * 2 + (n >> 9)) * 64 + k) * 512 + (n & 511)]; }
            else if (n < 1536) { if (k >= 64 && k < 128) v = ldin(16)[((size_t)l * 64 + (k - 64)) * 512 + (n - 1024)]; }
            else { if (k >= 128) v = ldin(17)[((size_t)l * 128 + (k - 128)) * 512 + (n - 1536)]; }
            wsm[i] = (bf16)f2bf(v);
        }
    }
    {
        float* rope = (float*)(ws + WS_ROPE);
        for (int i = bid * NT + tid; i < SEQ * 32; i += G * NT) {
            const int t = i >> 5, j = i & 31, half = j >> 4, f = j & 15;
            const float pos = (float)(half ? (t & 63) : (t >> 6));
            const float inv = powf(10000.0f, -(float)f / 16.0f);
            const float ang = pos * inv;
            double ad = (double)ang; const double twopi = 6.283185307179586476925; ad -= twopi * floor(ad / twopi);
            const float ar = (float)ad;
            rope[t * 64 + half * 32 + f] = cosf(ar); rope[t * 64 + half * 32 + 16 + f] = sinf(ar);
        }
    }
    if (!(a.sub & 256)) {
        LAS float* sil = (LAS float*)lds;
        LAS float* red = sil + 9 * 2048;
        __syncthreads();
        for (int i = tid; i < 9 * 2048; i += NT) { const float v = i < 8 * 2048 ? ldin(1)[i] : ldin(3)[i - 8 * 2048]; sil[i] = v / (1.0f + __expf(-v)); }
        __syncthreads();
        float* ada = (float*)(ws + WS_ADA);
        const int lane = tid & 63, wid = tid >> 6;
        for (int it = bid; it < 2 * 96; it += G) {
            const int l = it / 96, col0 = (it % 96) * 128;
            const float* w = ldin(4) + (size_t)l * DM * 12288 + (size_t)(wid * 256) * 12288 + col0 + 2 * lane;
            const LAS float* sl = sil + wid * 256;
            float2 acc[9];
#pragma unroll
            for (int v = 0; v < 9; ++v) acc[v] = make_float2(0.f, 0.f);
            float2 cur[16];
#pragma unroll
            for (int j = 0; j < 16; ++j) cur[j] = *(const float2*)(w + (size_t)j * 12288);
            for (int k0 = 0; k0 < 256; k0 += 16) {
                float2 nx[16];
#pragma unroll
                for (int j = 0; j < 16; ++j) nx[j] = cur[j];
                if (k0 + 16 < 256) {
#pragma unroll
                    for (int j = 0; j < 16; ++j) nx[j] = *(const float2*)(w + (size_t)(k0 + 16 + j) * 12288); }
#pragma unroll
                for (int v = 0; v < 9; ++v)
#pragma unroll
                    for (int q = 0; q < 4; ++q) { const f32x4 sv = *(const LAS f32x4*)(sl + v * 2048 + k0 + 4 * q);
#pragma unroll
                        for (int e = 0; e < 4; ++e) { acc[v].x += sv[e] * cur[4 * q + e].x; acc[v].y += sv[e] * cur[4 * q + e].y; } }
#pragma unroll
                for (int j = 0; j < 16; ++j) cur[j] = nx[j];
            }
#pragma unroll
            for (int v = 0; v < 9; ++v) *(LAS f32x2_t*)(red + (wid * 9 + v) * 128 + 2 * lane) = (f32x2_t){acc[v].x, acc[v].y};
            __syncthreads();
            for (int o = tid; o < 9 * 128; o += NT) { const int v = o >> 7, cn = o & 127; float sum = ldin(5)[(size_t)l * 12288 + col0 + cn];
#pragma unroll
                for (int g8 = 0; g8 < 8; ++g8) sum += red[(g8 * 9 + v) * 128 + cn];
                ada[((size_t)l * 9 + v) * 12288 + col0 + cn] = sum; }
            __syncthreads();
        }
    }
}


constexpr int BG_TPJ = 1792, BG_NT = 24 * BG_TPJ, BG_B = 8, BG_D = 1;
__device__ __forceinline__ void bg_convert(const Ctx& a, LAS unsigned char* lds, unsigned* until_done, int G) {
#if MOE_FP8
    unsigned char* ws = opqp(a.ws); const int tid = ((a.wv << 6) | lane_v());
    unsigned* ctr = (unsigned*)(ws + WS_CTL) + CW_BG; volatile LAS unsigned* slot = (volatile LAS unsigned*)(lds + LDS_STAGE + 8);
    LAS float* tile = (LAS float*)lds;
    for (;;) {
        __syncthreads();
        if (tid == 0) { unsigned v = 0xffffffffu;
            if (!until_done || __hip_atomic_load(until_done, __ATOMIC_RELAXED, __HIP_MEMORY_SCOPE_AGENT) < (unsigned)G) v = __hip_atomic_fetch_add(ctr, (unsigned)BG_B, __ATOMIC_RELAXED, __HIP_MEMORY_SCOPE_AGENT);
            *slot = v; }
        __syncthreads();
        const unsigned t0 = *slot;
        if (t0 >= (unsigned)BG_NT) break;
        const int job = (int)t0 / BG_TPJ, tl = (int)t0 % BG_TPJ; const int e = job / 3, kind = job % 3;
        if (kind < 2) cvt_job_f8d<BG_B, BG_D>(ldin(35 + kind) + (size_t)e * DM * FE, FE, FE, ws + WS_MGU + (size_t)e * 2 * FE * DM, DM, 1 + kind, MOE_SGU, (LAS unsigned char*)lds, tl, tid);
        else cvt_job_f8d<BG_B, BG_D>(ldin(37) + (size_t)e * FE * DM, DM, DM, ws + WS_MD + (size_t)e * DM * FE, FE, 0, MOE_SD, (LAS unsigned char*)lds, tl, tid);
    }
    __syncthreads();
#endif
}
#ifndef BG_MASK
#define BG_MASK 0x2020u
#endif
__device__ __forceinline__ void bg_tail(const Ctx& a, LAS unsigned char* lds, int slotid, int G) {
#if MOE_FP8
    unsigned char* ws = opqp(a.ws); const int tid = ((a.wv << 6) | lane_v());
    if (!((BG_MASK >> slotid) & 1u)) return;
    unsigned* done = (unsigned*)(ws + WS_CTL) + CW_DONE + slotid * 64;
    __syncthreads();
    if (tid == 0) (void)__hip_atomic_fetch_add(done, 1u, __ATOMIC_RELAXED, __HIP_MEMORY_SCOPE_AGENT);
    bg_convert(a, lds, done, G);
#endif
}

__device__ __forceinline__ void ld_row(const float* p, int lane, float (&x)[32]) {
#pragma unroll
    for (int i = 0; i < 8; ++i) { const float4 v = *(const float4*)(p + i * 256 + lane * 4); x[i * 4] = v.x; x[i * 4 + 1] = v.y; x[i * 4 + 2] = v.z; x[i * 4 + 3] = v.w; }
}
__device__ __forceinline__ void st_row(float* p, int lane, const float (&x)[32]) {
#pragma unroll
    for (int i = 0; i < 8; ++i) *(float4*)(p + i * 256 + lane * 4) = make_float4(x[i * 4], x[i * 4 + 1], x[i * 4 + 2], x[i * 4 + 3]);
}
__device__ __forceinline__ float sumsq(const float (&x)[32]) { float s = 0.f;
#pragma unroll
    for (int i = 0; i < 32; ++i) s += x[i] * x[i];
    return wsum(s); }

template <int TMODE, int HMODE, int XIN = 0, int XOUT = 0>
__device__ __forceinline__ void thin_phase(const Ctx& a, LAS unsigned char* lds, int bid, int G, int M,
                           const float* xlat, const float* xctx, float* olat, float* octx,
                           const float* T, const float* postw, int lg, int kg,
                           const float* prew, int lm, int ksc, int ksh) {
    unsigned char* ws = opqp(a.ws); const int tid = ((a.wv << 6) | lane_v()), lane = tid & 63, wid = tid >> 6;
    const float* ada = (const float*)(ws + WS_ADA);
    bf16* HA = (bf16*)(ws + WS_HA);
    LAS float* rt = (LAS float*)lds;
    if (HMODE == 2) { __syncthreads(); for (int i = tid; i < DM * NE; i += NT) rt[i] = ldin(34)[i]; __syncthreads(); }
    for (int r = bid * NW + wid; r < M; r += G * NW) {
        const int vec = r < MLAT ? r / SEQ : 8;
        float x[32];
        if (XIN == 1 && r < MLAT) { const bf16* xb = (const bf16*)xlat + (size_t)r * DM;
#pragma unroll
            for (int i = 0; i < 8; ++i) { const uint2 p1 = *(const uint2*)(xb + i * 256 + lane * 4); float f1[4]; unpack4(p1, f1); x[i * 4] = f1[0]; x[i * 4 + 1] = f1[1]; x[i * 4 + 2] = f1[2]; x[i * 4 + 3] = f1[3]; } }
        else { const float* xs = r < MLAT ? xlat + (size_t)r * DM : xctx + (size_t)(r - MLAT) * DM; ld_row(xs, lane, x); }
        if (TMODE != 0) {
            float t[32];
            if (TMODE == 1) { const bf16* tb = (const bf16*)T + (size_t)r * DM;
#pragma unroll
                for (int i = 0; i < 8; ++i) { const uint2 p1 = *(const uint2*)(tb + i * 256 + lane * 4); float f1[4]; unpack4(p1, f1); t[i * 4] = f1[0]; t[i * 4 + 1] = f1[1]; t[i * 4 + 2] = f1[2]; t[i * 4 + 3] = f1[3]; } }
            else {
                const unsigned* tok = (const unsigned*)(ws + WS_TOK) + (size_t)r * 8;
                const float w1 = __uint_as_float(tok[4]), w2 = __uint_as_float(tok[5]); const unsigned d1 = tok[6], d2 = tok[7];
                const bf16* y1 = (const bf16*)(ws + WS_MIX) + (size_t)d1 * DM; const bf16* y2 = (const bf16*)(ws + WS_MIX) + (size_t)d2 * DM;
#pragma unroll
                for (int i = 0; i < 8; ++i) { const uint2 p1 = *(const uint2*)(y1 + i * 256 + lane * 4), p2 = *(const uint2*)(y2 + i * 256 + lane * 4);
                    float f1[4], f2[4]; unpack4(p1, f1); unpack4(p2, f2);
#pragma unroll
                    for (int j = 0; j < 4; ++j) t[i * 4 + j] = w1 * f1[j] + w2 * f2[j]; }
            }
            const float rs = rsqrtf(sumsq(t) * (1.0f / DM) + 1e-6f);
            float pw[32], gg[32]; ld_row(postw, lane, pw); ld_row(ada + ((size_t)lg * 9 + vec) * 12288 + kg * DM, lane, gg);
#pragma unroll
            for (int i = 0; i < 32; ++i) x[i] += gg[i] * (t[i] * rs * pw[i]);
            if (XOUT == 1 && r < MLAT) { bf16* xd = (bf16*)olat + (size_t)r * DM;
#pragma unroll
                for (int i = 0; i < 8; ++i) { uint2 p; p.x = pk2(x[i * 4], x[i * 4 + 1]); p.y = pk2(x[i * 4 + 2], x[i * 4 + 3]); *(uint2*)(xd + i * 256 + lane * 4) = p; } }
            else { float* xd = r < MLAT ? olat + (size_t)r * DM : octx + (size_t)(r - MLAT) * DM; st_row(xd, lane, x); }
        }
        if (HMODE != 0) {
            const float rs = rsqrtf(sumsq(x) * (1.0f / DM) + 1e-6f);
            float pw[32], sc[32], sh[32]; ld_row(prew, lane, pw);
            ld_row(ada + ((size_t)lm * 9 + vec) * 12288 + ksc * DM, lane, sc); ld_row(ada + ((size_t)lm * 9 + vec) * 12288 + ksh * DM, lane, sh);
            float h[32];
#pragma unroll
            for (int i = 0; i < 32; ++i) h[i] = x[i] * rs * pw[i] * (1.0f + sc[i]) + sh[i];
            if ((HMODE == 2 && MOE_FP8) || HMODE == 3) { unsigned char* hd8 = (unsigned char*)HA + (size_t)r * DM;
#pragma unroll
                for (int i = 0; i < 8; ++i) *(unsigned*)(hd8 + i * 256 + lane * 4) = pg8::pk_fp8x4(h[i * 4], h[i * 4 + 1], h[i * 4 + 2], h[i * 4 + 3]); }
            else { bf16* hd = HA + (size_t)r * DM;
#pragma unroll
                for (int i = 0; i < 8; ++i) { uint2 p; p.x = pk2(h[i * 4], h[i * 4 + 1]); p.y = pk2(h[i * 4 + 2], h[i * 4 + 3]); *(uint2*)(hd + i * 256 + lane * 4) = p; } }
            if (HMODE == 2) {
                float lg8[8];
#pragma unroll
                for (int e = 0; e < 8; ++e) lg8[e] = 0.f;
#pragma unroll 1
                for (int i = 0; i < 8; ++i) {
                    float hv4[4];
#pragma unroll
                    for (int j = 0; j < 4; ++j) hv4[j] = 0.f;
#pragma unroll
                    for (int ii = 0; ii < 8; ++ii) if (ii == i) { hv4[0] = h[ii * 4]; hv4[1] = h[ii * 4 + 1]; hv4[2] = h[ii * 4 + 2]; hv4[3] = h[ii * 4 + 3]; }
#pragma unroll
                    for (int j = 0; j < 4; ++j) { const int c = i * 256 + lane * 4 + j; const f32x4 r0 = *(const LAS f32x4*)(rt + c * 8), r1 = *(const LAS f32x4*)(rt + c * 8 + 4); const float hv = hv4[j];
                        lg8[0] += hv * r0[0]; lg8[1] += hv * r0[1]; lg8[2] += hv * r0[2]; lg8[3] += hv * r0[3]; lg8[4] += hv * r1[0]; lg8[5] += hv * r1[1]; lg8[6] += hv * r1[2]; lg8[7] += hv * r1[3]; }
                }
#pragma unroll
                for (int e = 0; e < 8; ++e) lg8[e] = wsum(lg8[e]);
                if (lane == 0) {
                    int e1 = 0; float v1 = lg8[0];
#pragma unroll
                    for (int e = 1; e < 8; ++e) if (lg8[e] > v1) { v1 = lg8[e]; e1 = e; }
                    int e2 = -1; float v2 = -3.0e38f;
#pragma unroll
                    for (int e = 0; e < 8; ++e) if (e != e1 && lg8[e] > v2) { v2 = lg8[e]; e2 = e; }
                    const float ex = __expf(v2 - v1); const float w1 = 1.0f / (1.0f + ex), w2 = ex / (1.0f + ex);
                    unsigned* cnt = (unsigned*)(ws + WS_CTL) + CW_CNT;
                    const unsigned p1 = atomicAdd(cnt + e1 * 64, 1u), p2 = atomicAdd(cnt + e2 * 64, 1u);
                    unsigned* tok = (unsigned*)(ws + WS_TOK) + (size_t)r * 8;
                    tok[0] = (unsigned)e1; tok[1] = (unsigned)e2; tok[2] = p1; tok[3] = p2; tok[4] = __float_as_uint(w1); tok[5] = __float_as_uint(w2);
                }
            }
        }
    }
}

__device__ __forceinline__ void moe_gather(const Ctx& a, int bid, int G) {
    unsigned char* ws = opqp(a.ws); const int tid = ((a.wv << 6) | lane_v()), lane = tid & 63, wid = tid >> 6;
    const unsigned* cnt = (const unsigned*)(ws + WS_CTL) + CW_CNT;
    const bf16* HA = (const bf16*)(ws + WS_HA); bf16* AG = (bf16*)(ws + WS_U);
    for (int r = bid * NW + wid; r < MLAT; r += G * NW) {
        unsigned* tok = (unsigned*)(ws + WS_TOK) + (size_t)r * 8;
        const int e1 = (int)tok[0], e2 = (int)tok[1]; const unsigned p1 = tok[2], p2 = tok[3];
        unsigned run = 0, s1 = 0, s2 = 0;
#pragma unroll
        for (int e = 0; e < 8; ++e) { const unsigned t = (cnt[e * 64] + 255u) >> 8; if (e == e1) s1 = run; if (e == e2) s2 = run; run += t; }
        const unsigned d1 = s1 * 256u + p1, d2 = s2 * 256u + p2;
#if MOE_FP8
        const uint4* src = (const uint4*)((const unsigned char*)HA + (size_t)r * DM); uint4* q1 = (uint4*)((unsigned char*)AG + (size_t)d1 * DM); uint4* q2 = (uint4*)((unsigned char*)AG + (size_t)d2 * DM);
#pragma unroll
        for (int i = 0; i < 2; ++i) { const uint4 v = src[i * 64 + lane]; q1[i * 64 + lane] = v; q2[i * 64 + lane] = v; }
#else
        const uint4* src = (const uint4*)(HA + (size_t)r * DM); uint4* q1 = (uint4*)(AG + (size_t)d1 * DM); uint4* q2 = (uint4*)(AG + (size_t)d2 * DM);
#pragma unroll
        for (int i = 0; i < 4; ++i) { const uint4 v = src[i * 64 + lane]; q1[i * 64 + lane] = v; q2[i * 64 + lane] = v; }
#endif
        if (lane == 0) { tok[6] = d1; tok[7] = d2; }
    }
    unsigned zq = 0u; asm volatile("" : "+v"(zq));
    unsigned run = 0;
    for (int e = 0; e < 8; ++e) { const unsigned c = cnt[e * 64], t = (c + 255u) >> 8; const unsigned lo = run * 256u + c, hi = (run + t) * 256u; run += t;
        for (unsigned r = lo + bid * NW + wid; r < hi; r += G * NW) { uint4* q = (uint4*)((unsigned char*)AG + (size_t)r * DM * (MOE_FP8 ? 1 : 2));
#pragma unroll
            for (int i = 0; i < (MOE_FP8 ? 2 : 4); ++i) q[i * 64 + lane] = make_uint4(zq, zq, zq, zq); } }
}


__device__ __forceinline__ uint4 ldg16(const bf16* p) { return *(const uint4*)p; }
__device__ __forceinline__ uint4 zero16() { return make_uint4(0u, 0u, 0u, 0u); }

__device__ __forceinline__ void feat_a(const Ctx& a, LAS unsigned char* lds, int l, int bid, int G) {
    unsigned char* ws = opqp(a.ws); const int tid = ((a.wv << 6) | lane_v()), lane = tid & 63, wid = tid >> 6;
    const bf16* U = (const bf16*)(ws + WS_U); bf16* ASM = (bf16*)(ws + WS_ASM); bf16* XBC = (bf16*)(ws + WS_XBC); bf16* QK = (bf16*)(ws + WS_QK);
    float* DT = (float*)(ws + WS_DT); const float* rope = (const float*)(ws + WS_ROPE);
    const float* dtb = ldin(25) + l * 32; const float* alog = ldin(26) + l * 32;
    LAS float* CT = (LAS float*)lds;
    {   const float* mu = ldin(12) + (size_t)l * 2 * 1792; const float* cw = ldin(23) + (size_t)l * 3 * 1536; const float* cb = ldin(24) + (size_t)l * 1536;
        __syncthreads();
        for (int i = tid; i < 3584; i += NT) CT[i] = mu[i];
        for (int i = tid; i < 4608; i += NT) CT[3584 + i] = cw[i];
        for (int i = tid; i < 1536; i += NT) CT[8192 + i] = cb[i];
        __syncthreads(); }
    constexpr int RPW = MTOT / (256 * NW);
    static_assert(RPW * 256 * NW == MTOT, "feat_a rows per wave");
    const int nwv = G * NW, wv_id = bid * NW + wid;
    const int rows_per = (MTOT + nwv - 1) / nwv; const int r0 = wv_id * rows_per, r1 = (r0 + rows_per) < MTOT ? (r0 + rows_per) : MTOT;
    if (r0 >= MTOT) return;
    const int ca = C_RW_XW + (lane & 31) * 8;
#define FA_LOADW(W_, row_) do { const int rr_ = (row_) < 0 ? 0 : ((row_) >= MTOT ? MTOT - 1 : (row_)); const bf16* q_ = U + (size_t)rr_ * NINP; \
        W_[0] = ldg16(q_ + ca); W_[1] = ldg16(q_ + C_MB_XBC + lane * 8); W_[2] = ldg16(q_ + C_MB_XBC + (64 + lane) * 8); W_[3] = ldg16(q_ + C_MB_XBC + (128 + lane) * 8); } while (0)
    const int blk = lane >> 1, sub = lane & 1, c1 = C_DA_Q + blk * 32 + sub * 8; const int half = blk & 1; const float qscale = blk < 16 ? 0.125f * 1.44269504f : 1.0f;
#define FA_LOADX(Q1_, Q2_, D_, row_) do { const int rr_ = (row_) >= MTOT ? MTOT - 1 : (row_); const bf16* q_ = U + (size_t)rr_ * NINP; Q1_ = ldg16(q_ + c1); Q2_ = ldg16(q_ + c1 + 16); D_ = q_[C_MB_DT + (lane & 31)]; } while (0)
    uint4 wp[4], wu[4], wn[4];
    FA_LOADW(wp, r0 - 1); FA_LOADW(wu, r0); FA_LOADW(wn, r0 + 1);
    uint4 q1, q2; bf16 dr;
    FA_LOADX(q1, q2, dr, r0);
    for (int r = r0; r < r1; ++r) {
        const bool lat = r < MLAT; const int t = lat ? (r & (SEQ - 1)) : ((r - MLAT) & (CTXL - 1)); const int L = lat ? SEQ : CTXL;
        const bool hp = t > 0, hn = t < L - 1;
        uint4 wx[4]; FA_LOADW(wx, r + 2);
        uint4 q1n, q2n; bf16 drn; FA_LOADX(q1n, q2n, drn, r + 1);
        float4 rp[4]; { const float* rp_ = rope + (lat ? t : 0) * 64 + half * 32 + sub * 8; rp[0] = *(const float4*)rp_; rp[1] = *(const float4*)(rp_ + 4); rp[2] = *(const float4*)(rp_ + 16); rp[3] = *(const float4*)(rp_ + 20); }
        if (lane < 32) {
            float u[8], p[8], n[8], o[8];
            unpack8(wu[0], u); unpack8(hp ? wp[0] : zero16(), p); unpack8(hn ? wn[0] : zero16(), n);
            const f32x4 m0 = *(const LAS f32x4*)(CT + ca), m1 = *(const LAS f32x4*)(CT + ca + 4), m2 = *(const LAS f32x4*)(CT + 1792 + ca), m3 = *(const LAS f32x4*)(CT + 1792 + ca + 4);
#pragma unroll
            for (int e = 0; e < 8; ++e) { const float mp = e < 4 ? m0[e & 3] : m1[e & 3], mn = e < 4 ? m2[e & 3] : m3[e & 3];
                const float s = u[e] + mp * (p[e] - u[e]) + mn * (n[e] - u[e]); const int k = lane * 8 + e;
                o[e] = k < 64 ? (1.0f - 2.0f / (__expf(2.0f * s) + 1.0f)) : (k < 128 ? s : fsigm(s)); }
            *(uint4*)(ASM + (size_t)r * 256 + lane * 8) = pack8(o);
        }
#pragma unroll
        for (int it = 0; it < 3; ++it) {
            const int cc = (it * 64 + lane) * 8; float u[8], p[8], n[8], o[8];
            unpack8(wu[1 + it], u); unpack8(hp ? wp[1 + it] : zero16(), p); unpack8(hn ? wn[1 + it] : zero16(), n);
            const LAS float* cwp = CT + 3584 + cc;
#pragma unroll
            for (int hf = 0; hf < 2; ++hf) { const f32x4 k0 = *(const LAS f32x4*)(cwp + hf * 4), k1 = *(const LAS f32x4*)(cwp + 1536 + hf * 4), k2 = *(const LAS f32x4*)(cwp + 3072 + hf * 4), kb = *(const LAS f32x4*)(CT + 8192 + cc + hf * 4);
#pragma unroll
                for (int e = 0; e < 4; ++e) o[hf * 4 + e] = fsilu(k0[e] * p[hf * 4 + e] + k1[e] * u[hf * 4 + e] + k2[e] * n[hf * 4 + e] + kb[e]); }
            *(uint4*)(XBC + (size_t)r * 1536 + cc) = pack8(o);
        }
        if (lane < 32) {
            const float raw = bf2f(dr); const float dtv = softplusf(raw + dtb[lane]); const float A = -__expf(alog[lane]);
            DT[(size_t)r * 64 + lane] = dtv; DT[(size_t)r * 64 + 32 + lane] = dtv * A;
        }
        {
            float u1[8], u2[8], o1[8], o2[8];
            unpack8(q1, u1); unpack8(q2, u2);
#pragma unroll
            for (int e = 0; e < 8; ++e) {
                const float cs = lat ? (e < 4 ? rp[0] : rp[1])[e & 3] : 1.0f, sn = lat ? (e < 4 ? rp[2] : rp[3])[e & 3] : 0.0f;
                o1[e] = (u1[e] * cs - u2[e] * sn) * qscale; o2[e] = (u2[e] * cs + u1[e] * sn) * qscale; }
            *(uint4*)(QK + (size_t)r * 1024 + blk * 32 + sub * 8) = pack8(o1); *(uint4*)(QK + (size_t)r * 1024 + blk * 32 + 16 + sub * 8) = pack8(o2);
        }
#pragma unroll
        for (int i = 0; i < 4; ++i) { wp[i] = wu[i]; wu[i] = wn[i]; wn[i] = wx[i]; }
        q1 = q1n; q2 = q2n; dr = drn;
    }
#undef FA_LOADW
#undef FA_LOADX
}

__device__ __forceinline__ void feat_b(const Ctx& a, int l, int bid, int G) {
    unsigned char* ws = opqp(a.ws); const int tid = ((a.wv << 6) | lane_v()), lane = tid & 63, wid = tid >> 6;
    const bf16* U = (const bf16*)(ws + WS_U); const float* F = (const float*)(ws + WS_MIX); bf16* R5 = (bf16*)(ws + WS_RW5);
    const float* mu = ldin(12) + (size_t)l * 2 * 1792; const float* k_k = ldin(18) + l * 512; const float* k_a = ldin(19) + l * 512; const float* a0 = ldin(15) + l * 512;
    for (int r = bid * NW + wid; r < MTOT; r += G * NW) {
        const bool lat = r < MLAT; const int t = lat ? (r & (SEQ - 1)) : ((r - MLAT) & (CTXL - 1)); const int L = lat ? SEQ : CTXL;
        const bool hp = t > 0, hn = t < L - 1;
        const bf16* up = U + (size_t)r * NINP; const int c = lane * 8;
        float s[3][8];
#pragma unroll
        for (int q = 0; q < 3; ++q) { const int col = q * 512 + c; float u[8], p[8], n[8];
            unpack8(ldg16(up + col), u); unpack8(hp ? ldg16(up - NINP + col) : zero16(), p); unpack8(hn ? ldg16(up + NINP + col) : zero16(), n);
#pragma unroll
            for (int e = 0; e < 8; ++e) s[q][e] = u[e] + mu[col + e] * (p[e] - u[e]) + mu[1792 + col + e] * (n[e] - u[e]); }
        float av[8]; { const float4 q0 = *(const float4*)(F + (size_t)r * 2048 + 1024 + c), a1 = *(const float4*)(F + (size_t)r * 2048 + 1024 + c + 4);
            av[0] = q0.x; av[1] = q0.y; av[2] = q0.z; av[3] = q0.w; av[4] = a1.x; av[5] = a1.y; av[6] = a1.z; av[7] = a1.w; }
#pragma unroll
        for (int e = 0; e < 8; ++e) av[e] = fsigm(av[e] + a0[c + e]);
        float kkv[8], k2[8], bv[8]; float ss = 0.f;
#pragma unroll
        for (int e = 0; e < 8; ++e) { kkv[e] = s[1][e] * k_k[c + e]; ss += kkv[e] * kkv[e]; }
        ss = red8(ss); const float inv = 1.0f / fmaxf(sqrtf(ss), 1e-12f);
#pragma unroll
        for (int e = 0; e < 8; ++e) { kkv[e] *= inv; k2[e] = s[1][e] * (1.0f + (av[e] - 1.0f) * k_a[c + e]); bv[e] = kkv[e] * av[e]; }
        const size_t o = (size_t)r * 512 + c, st = (size_t)MTOT * 512;
        *(uint4*)(R5 + o) = pack8(s[0]); *(uint4*)(R5 + st + o) = pack8(k2); *(uint4*)(R5 + 2 * st + o) = pack8(s[2]); *(uint4*)(R5 + 3 * st + o) = pack8(kkv); *(uint4*)(R5 + 4 * st + o) = pack8(bv);
    }
}

__device__ __forceinline__ void mix_out(const Ctx& a, int l, int M, int bid, int G) {
    unsigned char* ws = opqp(a.ws); const int tid = ((a.wv << 6) | lane_v()), lane = tid & 63, wid = tid >> 6;
    const bf16* U = (const bf16*)(ws + WS_U); const float* F = (const float*)(ws + WS_MIX); const bf16* R5 = (const bf16*)(ws + WS_RW5); const bf16* XBC = (const bf16*)(ws + WS_XBC);
    const bf16* YR = (const bf16*)(ws + WS_YR); const bf16* YM = (const bf16*)(ws + WS_YM); bf16* A2 = (bf16*)(ws + WS_HA);
    const float* r_k = ldin(20) + l * 512; const float* ln_w = ldin(21) + l * 512; const float* ln_b = ldin(22) + l * 512;
    const float* Dsk = ldin(27) + l * 16; const float* nw = ldin(28) + l * 1024;
    for (int r = bid * NW + wid; r < M; r += G * NW) {
        {
            const int c = lane * 8; const size_t o = (size_t)r * 512 + c, st = (size_t)MTOT * 512;
            float y[8];
            { float yf[8], yb[8]; unpack8(ldg16(YR + o), yf); unpack8(ldg16(YR + st + o), yb);
#pragma unroll
              for (int e = 0; e < 8; ++e) y[e] = yf[e] + yb[e]; }
            float sm = 0.f;
#pragma unroll
            for (int e = 0; e < 8; ++e) sm += y[e];
            const float mean = red8(sm) * (1.0f / 64.0f); float sv = 0.f;
#pragma unroll
            for (int e = 0; e < 8; ++e) { y[e] -= mean; sv += y[e] * y[e]; }
            const float rs = rsqrtf(red8(sv) * (1.0f / 64.0f) + 64e-5f);
            float rr[8], kk[8], vv[8]; unpack8(ldg16(R5 + o), rr); unpack8(ldg16(R5 + st + o), kk); unpack8(ldg16(R5 + 2 * st + o), vv);
            float dot = 0.f;
#pragma unroll
            for (int e = 0; e < 8; ++e) dot += rr[e] * kk[e] * r_k[c + e];
            dot = red8(dot);
            const float4 g0 = *(const float4*)(F + (size_t)r * 2048 + 1536 + c), g1 = *(const float4*)(F + (size_t)r * 2048 + 1536 + c + 4);
            const float g[8] = {g0.x, g0.y, g0.z, g0.w, g1.x, g1.y, g1.z, g1.w}; float ov[8];
#pragma unroll
            for (int e = 0; e < 8; ++e) ov[e] = (y[e] * rs * ln_w[c + e] + ln_b[c + e] + dot * vv[e]) * g[e];
            *(uint4*)(A2 + (size_t)r * DM + c) = pack8(ov);
        }
        {
            const int m0 = lane * 16, hh = m0 >> 6; const float dsk = Dsk[hh]; float y[16]; float ss = 0.f;
#pragma unroll
            for (int q = 0; q < 2; ++q) { const int m = m0 + q * 8; const size_t o = (size_t)r * 1024 + m;
                float ys[8]; unpack8(ldg16(YM + o), ys);
                float xs[8], z[8]; unpack8(ldg16(XBC + (size_t)r * 1536 + m), xs); unpack8(ldg16(U + (size_t)r * NINP + C_MB_Z + m), z);
#pragma unroll
                for (int e = 0; e < 8; ++e) { const float v = (ys[e] + dsk * xs[e]) * fsilu(z[e]); y[q * 8 + e] = v; ss += v * v; } }
            ss = red32(ss);
            const float rs = rsqrtf(ss * (1.0f / 512.0f) + 1e-5f);
#pragma unroll
            for (int q = 0; q < 2; ++q) { const int m = m0 + q * 8; float ov[8];
#pragma unroll
                for (int e = 0; e < 8; ++e) ov[e] = y[q * 8 + e] * rs * nw[m + e];
                *(uint4*)(A2 + (size_t)r * DM + 512 + m) = pack8(ov); }
        }
    }
}

__device__ __forceinline__ int chain_row(int s, int b, int dir) {
    if (s < CTXL) return MLAT + b * CTXL + (dir ? (CTXL - 1 - s) : s);
    const int t = s - CTXL; return b * SEQ + (dir ? (SEQ - 1 - t) : t);
}
constexpr int CH_STEPS = CTXL + SEQ, CH_T = 32, CH_NC = CH_STEPS / CH_T;


typedef short s16x4 __attribute__((ext_vector_type(4)));
constexpr int MB_NCH = 18;
__device__ __forceinline__ int mb_row0(int b, int cc) { return cc < 2 ? MLAT + b * CTXL + cc * 128 : b * SEQ + (cc - 2) * 128; }
__device__ __forceinline__ bf16x8 trfrag(const LAS bf16* pA, const LAS bf16* pB) {
    const s16x4 v0 = __builtin_amdgcn_ds_read_tr16_b64_v4i16((LAS s16x4*)pA), v1 = __builtin_amdgcn_ds_read_tr16_b64_v4i16((LAS s16x4*)pB);
    return __builtin_shufflevector(v0, v1, 0, 1, 2, 3, 4, 5, 6, 7);
}
constexpr int MB_PB = 144, MB_PX = 72;
constexpr int MB_OFF_C = 0, MB_OFF_B = 36864, MB_OFF_X = 73728  , MB_OFF_V = 110592  ;

__device__ __forceinline__ void mb_vectors(const float* DT, int row0, int g, LAS float* tmp, LAS float* vec, int tid) {
    for (int i = tid; i < 128 * 16; i += NT) { const int l = i >> 4, q4 = i & 15; *(LAS f32x4*)(tmp + l * 64 + q4 * 4) = *(const f32x4*)(DT + (size_t)(row0 + l) * 64 + q4 * 4); }
    __syncthreads();
    LAS float* tot = tmp + 128 * 64;
    const int seq = tid >> 5, j = tid & 31, hh = seq & 7, dir = seq >> 3;
    float v[4], run = 0.f;
#pragma unroll
    for (int e = 0; e < 4; ++e) { const int l = dir ? 127 - (4 * j + e) : 4 * j + e; run += tmp[l * 64 + 32 + dir * 16 + g * 8 + hh]; v[e] = run; }
    tot[seq * 32 + j] = run;
    __syncthreads();
    float off = 0.f;
    for (int q = 0; q < 32; ++q) { const float tq = tot[seq * 32 + q]; off += q < j ? tq : 0.f; }
#pragma unroll
    for (int e = 0; e < 4; ++e) { const int l = dir ? 127 - (4 * j + e) : 4 * j + e; vec[dir * 1024 + hh * 128 + l] = v[e] + off; }
    __syncthreads();
    for (int i = tid; i < 2048; i += NT) { const int d2 = i >> 10, h2 = (i >> 7) & 7, l = i & 127; const int ref = d2 ? (l & ~15) : (l | 15);
        vec[2048 + i] = __expf(fmaxf(vec[d2 * 1024 + h2 * 128 + ref] - vec[d2 * 1024 + h2 * 128 + l], -80.f)) * tmp[l * 64 + d2 * 16 + g * 8 + h2]; }
    __syncthreads();
}

__device__ __forceinline__ void mamba_m1(const Ctx& a, LAS unsigned char* lds, int item) {
    unsigned char* ws = opqp(a.ws); const int tid = ((a.wv << 6) | lane_v()), lane = tid & 63, wid = tid >> 6, fr = lane & 15, fq = lane >> 4, q4 = (lane & 15) >> 2, p4 = lane & 3;
    const int g = item & 1, cc = (item >> 1) % MB_NCH, b = (item >> 1) / MB_NCH; const int row0 = mb_row0(b, cc);
    const bf16* XBC = (const bf16*)(ws + WS_XBC); const float* DT = (const float*)(ws + WS_DT); bf16* ST = (bf16*)(ws + WS_ST); float* AC = (float*)(ws + WS_AC);
    LAS bf16* Bs = (LAS bf16*)(lds + MB_OFF_B); LAS float* vec = (LAS float*)(lds + MB_OFF_V);
    __syncthreads();
    mb_vectors(DT, row0, g, (LAS float*)(lds + MB_OFF_C), vec, tid);
    if (tid < 16) { const int hh = tid & 7, dir = tid >> 3; AC[((size_t)(b * MB_NCH + cc) * 16 + g * 8 + hh) * 2 + dir] = dir ? vec[1024 + hh * 128] : vec[hh * 128 + 127]; }
    for (int i = tid; i < 2048; i += NT) { const int l = i >> 4, ch = i & 15; *(LAS u32x4*)(Bs + l * MB_PB + ch * 8) = *(const u32x4*)(XBC + (size_t)(row0 + l) * 1536 + 1024 + g * 128 + ch * 8); }
    uint4 xq[2];
#pragma unroll
    for (int j = 0; j < 2; ++j) { const int id = tid + j * NT; xq[j] = *(const uint4*)(XBC + (size_t)(row0 + (id >> 3)) * 1536 + (g * 8) * 64 + (id & 7) * 8); }
    for (int hh = 0; hh < 8; ++hh) {
        const int h = g * 8 + hh;
        LAS bf16* Yf = (LAS bf16*)(lds + ((hh & 1) ? MB_OFF_X : MB_OFF_C)); LAS bf16* Yb = Yf + 128 * MB_PX;
        const float tf = vec[hh * 128 + 127];
        uint4 xc[2] = {xq[0], xq[1]};
        if (hh + 1 < 8) {
#pragma unroll
            for (int j = 0; j < 2; ++j) { const int id = tid + j * NT; xq[j] = *(const uint4*)(XBC + (size_t)(row0 + (id >> 3)) * 1536 + (h + 1) * 64 + (id & 7) * 8); } }
#pragma unroll
        for (int j = 0; j < 2; ++j) { const int id = tid + j * NT, l = id >> 3, ch = id & 7; float x8[8], of[8], ob[8];
            unpack8(xc[j], x8);
            const float sf = __expf(tf - vec[hh * 128 + (l | 15)]) * vec[2048 + hh * 128 + l], sb = __expf(vec[1024 + hh * 128] - vec[1024 + hh * 128 + (l & ~15)]) * vec[3072 + hh * 128 + l];
#pragma unroll
            for (int e = 0; e < 8; ++e) { of[e] = x8[e] * sf; ob[e] = x8[e] * sb; }
            const uint4 pf = pack8(of), pb = pack8(ob);
            *(LAS u32x4*)(Yf + l * MB_PX + ch * 8) = (u32x4){pf.x, pf.y, pf.z, pf.w}; *(LAS u32x4*)(Yb + l * MB_PX + ch * 8) = (u32x4){pb.x, pb.y, pb.z, pb.w}; }
        __syncthreads();
        const int pt = wid & 3, nh = wid >> 2;
#pragma unroll
        for (int dir = 0; dir < 2; ++dir) { const LAS bf16* Xd = dir ? Yb : Yf;
            bf16x8 yf4[4];
#pragma unroll
            for (int ks = 0; ks < 4; ++ks) { const LAS bf16* pa = Xd + (ks * 32 + 8 * fq + q4) * MB_PX + pt * 16 + 4 * p4; yf4[ks] = trfrag(pa, pa + 4 * MB_PX); }
#pragma unroll
            for (int ns = 0; ns < 4; ++ns) { f32x4 acc = (f32x4){0.f, 0.f, 0.f, 0.f};
#pragma unroll
                for (int ks = 0; ks < 4; ++ks) { const LAS bf16* pa = Bs + (ks * 32 + 8 * fq + q4) * MB_PB + (nh * 4 + ns) * 16 + 4 * p4;
                    acc = __builtin_amdgcn_mfma_f32_16x16x32_bf16(trfrag(pa, pa + 4 * MB_PB), yf4[ks], acc, 0, 0, 0); }
                uint2 pk; pk.x = pk2(acc[0], acc[1]); pk.y = pk2(acc[2], acc[3]);
                *(uint2*)(ST + ((((size_t)(b * MB_NCH + cc) * 16 + h) * 2 + dir) * 64 + pt * 16 + fr) * 128 + (nh * 4 + ns) * 16 + 4 * fq) = pk; } }
    }
}

__device__ __forceinline__ void mamba_m2(const Ctx& a, int item) {
    unsigned char* ws = opqp(a.ws); const int tid = ((a.wv << 6) | lane_v());
    const int dir = item & 1, h = (item >> 1) & 15, b = item >> 5;
    bf16* ST = (bf16*)(ws + WS_ST); const float* AC = (const float*)(ws + WS_AC);
    float H[16];
#pragma unroll
    for (int i = 0; i < 16; ++i) H[i] = 0.f;
#define M2_CC(st_) (dir == 0 ? (st_) : ((st_) < 2 ? 1 - (st_) : 19 - (st_)))
#define M2_PTR(st_) (ST + ((((size_t)(b * MB_NCH + M2_CC(st_)) * 16 + h) * 2 + dir) * 64) * 128 + tid * 16)
    uint4 s0 = *(const uint4*)M2_PTR(0), s1 = *(const uint4*)(M2_PTR(0) + 8); float la = AC[((size_t)(b * MB_NCH + M2_CC(0)) * 16 + h) * 2 + dir];
    for (int st = 0; st < MB_NCH; ++st) {
        bf16* p = M2_PTR(st);
        const int sn = st + 1 < MB_NCH ? st + 1 : st;
        const uint4 n0 = *(const uint4*)M2_PTR(sn), n1 = *(const uint4*)(M2_PTR(sn) + 8); const float ln = AC[((size_t)(b * MB_NCH + M2_CC(sn)) * 16 + h) * 2 + dir];
        float f0[8], f1[8]; unpack8(s0, f0); unpack8(s1, f1);
        const float ea = __expf(la);
        float o0[8], o1[8];
#pragma unroll
        for (int e = 0; e < 8; ++e) { o0[e] = H[e]; o1[e] = H[8 + e]; H[e] = ea * H[e] + f0[e]; H[8 + e] = ea * H[8 + e] + f1[e]; }
        *(uint4*)p = pack8(o0); *(uint4*)(p + 8) = pack8(o1);
        s0 = n0; s1 = n1; la = ln;
    }
#undef M2_CC
#undef M2_PTR
}

__device__ __forceinline__ void mamba_m3(const Ctx& a, LAS unsigned char* lds, int b, int cc, int g) {
    unsigned char* ws = opqp(a.ws); const int tid = ((a.wv << 6) | lane_v()), lane = tid & 63, wid = tid >> 6, fr = lane & 15, fq = lane >> 4, q4 = (lane & 15) >> 2, p4 = lane & 3;
    const int row0 = mb_row0(b, cc);
    const bf16* XBC = (const bf16*)(ws + WS_XBC); const float* DT = (const float*)(ws + WS_DT); const bf16* ST = (const bf16*)(ws + WS_ST); bf16* YM = (bf16*)(ws + WS_YM);
    LAS bf16* Cs = (LAS bf16*)(lds + MB_OFF_C); LAS bf16* Bs = (LAS bf16*)(lds + MB_OFF_B); LAS float* vec = (LAS float*)(lds + MB_OFF_V);
    __syncthreads();
    mb_vectors(DT, row0, g, (LAS float*)(lds + MB_OFF_C), vec, tid);
    for (int i = tid; i < 2048; i += NT) { const int l = i >> 4, ch = i & 15; const bf16* src = XBC + (size_t)(row0 + l) * 1536 + g * 128 + ch * 8;
        *(LAS u32x4*)(Bs + l * MB_PB + ch * 8) = *(const u32x4*)(src + 1024); *(LAS u32x4*)(Cs + l * MB_PB + ch * 8) = *(const u32x4*)(src + 1280); }
    uint4 xr[2];
#define M3_XLOAD(hh_) do { _Pragma("unroll") for (int j_ = 0; j_ < 2; ++j_) { const int id_ = tid + j_ * NT; xr[j_] = *(const uint4*)(XBC + (size_t)(row0 + (id_ >> 3)) * 1536 + (g * 8 + (hh_)) * 64 + (id_ & 7) * 8); } } while (0)
#define M3_XSTORE(hh_) do { LAS bf16* X_ = (LAS bf16*)(lds + MB_OFF_X) + ((hh_) & 1) * 128 * MB_PX; _Pragma("unroll") for (int j_ = 0; j_ < 2; ++j_) { const int id_ = tid + j_ * NT; \
        *(LAS u32x4*)(X_ + (id_ >> 3) * MB_PX + (id_ & 7) * 8) = (u32x4){xr[j_].x, xr[j_].y, xr[j_].z, xr[j_].w}; } } while (0)
    M3_XLOAD(0); M3_XSTORE(0);
    __syncthreads();
    const int l0 = wid * 16;
    bf16x8 cf[4];
#pragma unroll
    for (int ks = 0; ks < 4; ++ks) cf[ks] = *(const LAS bf16x8*)(Cs + (l0 + fr) * MB_PB + ks * 32 + fq * 8);
    f32x4 CB[8];
#pragma unroll
    for (int sb = 0; sb < 8; ++sb) { f32x4 acc = (f32x4){0.f, 0.f, 0.f, 0.f};
#pragma unroll
        for (int ks = 0; ks < 4; ++ks) acc = __builtin_amdgcn_mfma_f32_16x16x32_bf16(*(const LAS bf16x8*)(Bs + (sb * 16 + fr) * MB_PB + ks * 32 + fq * 8), cf[ks], acc, 0, 0, 0);
        CB[sb] = acc; }
    bf16x8 hs0[8], hs1[8];
#define M3_HLOAD(SET_, hh_, pt_) do { const bf16* Hf_ = ST + ((((size_t)(b * MB_NCH + cc) * 16 + g * 8 + (hh_)) * 2 + 0) * 64) * 128 + (size_t)((pt_) * 16 + fr) * 128 + fq * 8; \
        _Pragma("unroll") for (int ks_ = 0; ks_ < 4; ++ks_) { SET_[ks_] = *(const bf16x8*)(Hf_ + ks_ * 32); SET_[4 + ks_] = *(const bf16x8*)(Hf_ + 64 * 128 + ks_ * 32); } } while (0)
    M3_HLOAD(hs0, 0, 0);
    float mfd[4], mbd[4];
#pragma unroll
    for (int e = 0; e < 4; ++e) { const int dd = 4 * fq + e - fr; mfd[e] = dd <= 0 ? 1.f : 0.f; mbd[e] = dd >= 0 ? 1.f : 0.f; }
    const int nhh = (a.sub & 16) ? 0 : ((a.sub & 8) ? 1 : 8);
    for (int hh = 0; hh < nhh; ++hh) {
        const int h = g * 8 + hh;
        if (hh + 1 < 8) M3_XLOAD(hh + 1);
        const LAS bf16* X = (const LAS bf16*)(lds + MB_OFF_X) + (hh & 1) * 128 * MB_PX;
        const LAS float* vf = vec + hh * 128; const LAS float* vb = vec + 1024 + hh * 128; const LAS float* cF = vec + 2048 + hh * 128; const LAS float* cB = vec + 3072 + hh * 128;
        const float afl = vf[l0 + fr], abl = vb[l0 + fr];
        bf16x8 wf[4];
#pragma unroll
        for (int kc = 0; kc < 4; ++kc) { float wv[8];
#pragma unroll
            for (int hs = 0; hs < 2; ++hs) { const int sb = 2 * kc + hs, s0 = sb * 16 + 4 * fq;
                float rf = 0.f, rb = 0.f;
                if (sb <= wid) rf = __expf(fminf(afl - vf[sb * 16 + 15], 80.f));
                if (sb >= wid) rb = __expf(fminf(abl - vb[sb * 16], 80.f));
                const f32x4 c_f = *(const LAS f32x4*)(cF + s0), c_b = *(const LAS f32x4*)(cB + s0);
#pragma unroll
                for (int e = 0; e < 4; ++e) { float m;
                    if (sb < wid) m = rf * c_f[e]; else if (sb > wid) m = rb * c_b[e]; else m = rf * c_f[e] * mfd[e] + rb * c_b[e] * mbd[e];
                    wv[hs * 4 + e] = CB[sb][e] * m; } }
            u32x4 w; w.x = pk2(wv[0], wv[1]); w.y = pk2(wv[2], wv[3]); w.z = pk2(wv[4], wv[5]); w.w = pk2(wv[6], wv[7]); wf[kc] = __builtin_bit_cast(bf16x8, w); }
        const float ef = __expf(afl), eb = __expf(abl);
#define M3_STEP(SET_, NXT_, pt_, hn_, ptn_, do_load_) do { \
            if (do_load_) M3_HLOAD(NXT_, hn_, ptn_); \
            f32x4 yd = (f32x4){0.f, 0.f, 0.f, 0.f}, y1 = yd, y2 = yd; \
            _Pragma("unroll") for (int kc = 0; kc < 4; ++kc) { const LAS bf16* pa = X + (kc * 32 + 4 * fq + q4) * MB_PX + (pt_) * 16 + 4 * p4; \
                yd = __builtin_amdgcn_mfma_f32_16x16x32_bf16(trfrag(pa, pa + 16 * MB_PX), wf[kc], yd, 0, 0, 0); } \
            _Pragma("unroll") for (int ks = 0; ks < 4; ++ks) { y1 = __builtin_amdgcn_mfma_f32_16x16x32_bf16(SET_[ks], cf[ks], y1, 0, 0, 0); y2 = __builtin_amdgcn_mfma_f32_16x16x32_bf16(SET_[4 + ks], cf[ks], y2, 0, 0, 0); } \
            f32x4 o; \
            _Pragma("unroll") for (int e = 0; e < 4; ++e) o[e] = yd[e] + ef * y1[e] + eb * y2[e]; \
            { uint2 pk; pk.x = pk2(o[0], o[1]); pk.y = pk2(o[2], o[3]); *(uint2*)(YM + (size_t)(row0 + l0 + fr) * 1024 + h * 64 + (pt_) * 16 + 4 * fq) = pk; } } while (0)
        M3_STEP(hs0, hs1, 0, hh, 1, true);
        M3_STEP(hs1, hs0, 1, hh, 2, true);
        M3_STEP(hs0, hs1, 2, hh, 3, true);
        M3_STEP(hs1, hs0, 3, hh + 1, 0, hh + 1 < 8);
#undef M3_STEP
        if (hh + 1 < 8) { M3_XSTORE(hh + 1); }
        __syncthreads();
    }
#undef M3_XLOAD
#undef M3_XSTORE
#undef M3_HLOAD
}


constexpr int RC_NCH = CH_STEPS / 16;
constexpr int RC_UNITS = 128 * RC_NCH;
constexpr int RC_TP = 72;
constexpr int RC_WAVE_LDS = 5 * 16 * RC_TP * 2 + 16 * 17 * 4 + 16 * 24 * 2;
constexpr int RC_CT_FLOATS = 6 * 512 + 3 * 512;
static_assert(8 * RC_WAVE_LDS + RC_CT_FLOATS * 4 <= LDS_STAGE, "rwkv R1 LDS");
__device__ __forceinline__ void rc_consts(LAS unsigned char* lds, int l, int tid) {
    LAS float* CT = (LAS float*)(lds + 8 * RC_WAVE_LDS);
    const float* mu = ldin(12) + (size_t)l * 2 * 1792; const float* a0 = ldin(15) + l * 512; const float* k_k = ldin(18) + l * 512; const float* k_a = ldin(19) + l * 512;
    for (int i = tid; i < 1536; i += NT) { CT[i] = mu[i]; CT[1536 + i] = mu[1792 + i]; }
    for (int i = tid; i < 512; i += NT) { CT[3072 + i] = a0[i]; CT[3584 + i] = k_k[i]; CT[4096 + i] = k_a[i]; }
    __syncthreads();
}
constexpr size_t RC_REC = 16 * 64 + 16 * 64 + 16 * 64 + 64 * 32 + 16 * 64;
constexpr size_t WS_RC1 = WS_MGU + 224 * MiB;
constexpr size_t WS_RC2 = WS_MD + 112 * MiB;
static_assert(MOE_FP8 == 1 && (size_t)RC_UNITS * RC_REC * 2 <= 224 * MiB && (size_t)RC_UNITS * (4096 + 256) <= 112 * MiB, "rwkv chunk records");

__device__ __forceinline__ bf16x8 pack_lo4(const f32x4 v) { u32x4 w; w.x = pk2(v[0], v[1]); w.y = pk2(v[2], v[3]); w.z = 0u; w.w = 0u; return __builtin_bit_cast(bf16x8, w); }

__device__ __forceinline__ void rwkv_r1(const Ctx& a, LAS unsigned char* lds, int l, int unit) {
    unsigned char* ws = opqp(a.ws); const int tid = ((a.wv << 6) | lane_v()), lane = tid & 63, wid = tid >> 6, fr = lane & 15, fq = lane >> 4, q4 = (lane & 15) >> 2, p4 = lane & 3;
    const int chain = unit / RC_NCH, c = unit % RC_NCH; const int dir = chain & 1, h = (chain >> 1) & 7, b = chain >> 4;
    const bf16* R5 = (const bf16*)(ws + WS_RW5); const float* F = (const float*)(ws + WS_MIX); const size_t st = (size_t)MTOT * 512;
    bf16* rec = (bf16*)(ws + WS_RC1) + (size_t)unit * RC_REC; float* Ycg = (float*)(ws + WS_RC2) + (size_t)unit * 1024; float* PCg = (float*)(ws + WS_RC2) + (size_t)RC_UNITS * 1024 + (size_t)unit * 64;
    LAS bf16* tA = (LAS bf16*)(lds + wid * RC_WAVE_LDS); LAS bf16* tR = tA + 16 * RC_TP; LAS bf16* tB = tR + 16 * RC_TP; LAS bf16* tK = tB + 16 * RC_TP; LAS bf16* tV = tK + 16 * RC_TP;
    LAS float* L1s = (LAS float*)(tV + 16 * RC_TP); LAS bf16* Ts = (LAS bf16*)(L1s + 16 * 17);
    {   const int t = lane >> 2, part = lane & 3; const int row = chain_row(c * 16 + t, b, dir);
        const bool lat = row < MLAT; const int pos = lat ? (row & (SEQ - 1)) : ((row - MLAT) & (CTXL - 1)); const bool hp = pos > 0, hn = pos < (lat ? SEQ : CTXL) - 1;
        const bf16* U = (const bf16*)(ws + WS_U); const bf16* up = U + (size_t)row * NINP + h * 64 + part * 16; const int ch = h * 64 + part * 16;
        const LAS float* CT = (const LAS float*)(lds + 8 * RC_WAVE_LDS);
        float sv[3][16];
#pragma unroll
        for (int q = 0; q < 3; ++q)
#pragma unroll
            for (int hf = 0; hf < 2; ++hf) { float u[8], p[8], n[8];
                unpack8(*(const uint4*)(up + q * 512 + hf * 8), u); unpack8(hp ? *(const uint4*)(up - NINP + q * 512 + hf * 8) : make_uint4(0u, 0u, 0u, 0u), p); unpack8(hn ? *(const uint4*)(up + NINP + q * 512 + hf * 8) : make_uint4(0u, 0u, 0u, 0u), n);
#pragma unroll
                for (int e = 0; e < 8; ++e) { const int cc = ch + hf * 8 + e; sv[q][hf * 8 + e] = u[e] + CT[q * 512 + cc] * (p[e] - u[e]) + CT[1536 + q * 512 + cc] * (n[e] - u[e]); } }
        float av[16];
#pragma unroll
        for (int q4_ = 0; q4_ < 4; ++q4_) { const f32x4 f = *(const f32x4*)(F + (size_t)row * 2048 + 1024 + ch + q4_ * 4);
#pragma unroll
            for (int e = 0; e < 4; ++e) av[q4_ * 4 + e] = fsigm(f[e] + CT[3072 + ch + q4_ * 4 + e]); }
        float kkv[16], k2[16], bv[16], ss = 0.f;
#pragma unroll
        for (int e = 0; e < 16; ++e) { kkv[e] = sv[1][e] * CT[3584 + ch + e]; ss += kkv[e] * kkv[e]; }
        ss += dppf<0xB1>(ss); ss += dppf<0x4E>(ss);
        const float inv = 1.0f / fmaxf(sqrtf(ss), 1e-12f);
#pragma unroll
        for (int e = 0; e < 16; ++e) { kkv[e] *= inv; k2[e] = sv[1][e] * (1.0f + (av[e] - 1.0f) * CT[4096 + ch + e]); bv[e] = kkv[e] * av[e]; }
        const int lo = t * RC_TP + part * 16;
#define RC_PUT(T_, A_) do { *(LAS u32x4*)(T_ + lo) = (u32x4){pk2(A_[0], A_[1]), pk2(A_[2], A_[3]), pk2(A_[4], A_[5]), pk2(A_[6], A_[7])}; \
            *(LAS u32x4*)(T_ + lo + 8) = (u32x4){pk2(A_[8], A_[9]), pk2(A_[10], A_[11]), pk2(A_[12], A_[13]), pk2(A_[14], A_[15])}; } while (0)
        RC_PUT(tR, sv[0]); RC_PUT(tK, k2); RC_PUT(tV, sv[2]); RC_PUT(tA, kkv); RC_PUT(tB, bv);
#undef RC_PUT
        if (dir == 0) {
            bf16* R5w = (bf16*)(ws + WS_RW5); const size_t o = (size_t)row * 512 + ch;
            *(u32x4*)(R5w + o) = *(const LAS u32x4*)(tR + lo); *(u32x4*)(R5w + o + 8) = *(const LAS u32x4*)(tR + lo + 8);
            *(u32x4*)(R5w + st + o) = *(const LAS u32x4*)(tK + lo); *(u32x4*)(R5w + st + o + 8) = *(const LAS u32x4*)(tK + lo + 8);
            *(u32x4*)(R5w + 2 * st + o) = *(const LAS u32x4*)(tV + lo); *(u32x4*)(R5w + 2 * st + o + 8) = *(const LAS u32x4*)(tV + lo + 8); }
    }
    const int j = lane; const float w0j = ldin(13)[l * 1024 + dir * 512 + h * 64 + j];
    float wraw[16];
#pragma unroll
    for (int t = 0; t < 16; ++t) wraw[t] = F[(size_t)chain_row(c * 16 + t, b, dir) * 2048 + dir * 512 + h * 64 + j];
    __builtin_amdgcn_sched_barrier(0);
    float Lc = 0.f, Pprev = 1.0f, Lct[16], bq[16], kq[16];
#pragma unroll
    for (int t = 0; t < 16; ++t) {
        const float rv = bf2f(tR[t * RC_TP + j]), kv = bf2f(tK[t * RC_TP + j]), kkv = bf2f(tA[t * RC_TP + j]), bv = bf2f(tB[t * RC_TP + j]);
        const float lw = (-0.60653066f * 1.44269504f) * fsigm(wraw[t] + w0j);
        const float Pm1 = Pprev; Lc += lw; const float P = __builtin_amdgcn_exp2f(Lc), iP = __builtin_amdgcn_rcpf(P); Pprev = P;
        Lct[t] = Lc; bq[t] = bv; kq[t] = kv;
        tA[t * RC_TP + j] = (bf16)f2bf(-kkv * Pm1); tR[t * RC_TP + j] = (bf16)f2bf(rv * P); tB[t * RC_TP + j] = (bf16)f2bf(bv * iP); tK[t * RC_TP + j] = (bf16)f2bf(kv * iP);
    }
    PCg[j] = Pprev;
    {   unsigned vw[8];
#pragma unroll
        for (int t2 = 0; t2 < 8; ++t2) vw[t2] = (unsigned)tV[(2 * t2) * RC_TP + j] | ((unsigned)tV[(2 * t2 + 1) * RC_TP + j] << 16);
        *(uint4*)(rec + 5120 + (size_t)j * 16) = make_uint4(vw[0], vw[1], vw[2], vw[3]); *(uint4*)(rec + 5120 + (size_t)j * 16 + 8) = make_uint4(vw[4], vw[5], vw[6], vw[7]); }
    {   bf16* BK = rec + 3072 + (size_t)j * 32;
#pragma unroll
        for (int g = 0; g < 4; ++g) { float o8[8];
#pragma unroll
            for (int e = 0; e < 4; ++e) { const float d = __builtin_amdgcn_exp2f(Lc - Lct[4 * g + e]); o8[e] = bq[4 * g + e] * d; o8[4 + e] = kq[4 * g + e] * d; }
            *(uint4*)(BK + g * 8) = pack8(o8); } }
    f32x4 L1 = (f32x4){0.f, 0.f, 0.f, 0.f}, L2 = L1, M1 = L1, M2 = L1;
#pragma unroll
    for (int ks = 0; ks < 2; ++ks) {
        const bf16x8 ya = *(const LAS bf16x8*)(tA + fr * RC_TP + ks * 32 + fq * 8), yr = *(const LAS bf16x8*)(tR + fr * RC_TP + ks * 32 + fq * 8);
        const bf16x8 xb = *(const LAS bf16x8*)(tB + fr * RC_TP + ks * 32 + fq * 8), xk = *(const LAS bf16x8*)(tK + fr * RC_TP + ks * 32 + fq * 8);
        L1 = __builtin_amdgcn_mfma_f32_16x16x32_bf16(xb, ya, L1, 0, 0, 0); L2 = __builtin_amdgcn_mfma_f32_16x16x32_bf16(xk, ya, L2, 0, 0, 0);
        M1 = __builtin_amdgcn_mfma_f32_16x16x32_bf16(xb, yr, M1, 0, 0, 0); M2 = __builtin_amdgcn_mfma_f32_16x16x32_bf16(xk, yr, M2, 0, 0, 0);
    }
#pragma unroll
    for (int e = 0; e < 4; ++e) { const int s = 4 * fq + e, t = fr;
        if (!(s < t)) { L1[e] = 0.f; L2[e] = 0.f; } if (!(s <= t)) { M1[e] = 0.f; M2[e] = 0.f; }
        }
    {   const int cc = lane & 15; float Tc[16];
#pragma unroll
        for (int t = 0; t < 16; ++t) { float acc = (t == cc) ? 1.f : 0.f;
#pragma unroll
            for (int s = 0; s < t; ++s) { const float lts = __int_as_float(__builtin_amdgcn_readlane(__float_as_int(L1[s & 3]), 16 * (s >> 2) + t)); acc += lts * Tc[s]; }
            Tc[t] = acc; }
        if (lane < 16) {
#pragma unroll
            for (int t = 0; t < 16; ++t) Ts[t * 24 + cc] = (bf16)f2bf(Tc[t]); } }
    const bf16x8 Top = __builtin_bit_cast(bf16x8, (u32x4){((const LAS unsigned*)(Ts + fr * 24 + 4 * fq))[0], ((const LAS unsigned*)(Ts + fr * 24 + 4 * fq))[1], 0u, 0u});
    const bf16x8 L2op = pack_lo4(L2), M1op = pack_lo4(M1), M2op = pack_lo4(M2);
#pragma unroll
    for (int kt = 0; kt < 4; ++kt) { const LAS bf16* pa = tA + (4 * fq + q4) * RC_TP + kt * 16 + 4 * p4;
        const f32x4 ta = __builtin_amdgcn_mfma_f32_16x16x32_bf16(trfrag(pa, pa), Top, (f32x4){0.f, 0.f, 0.f, 0.f}, 0, 0, 0);
        uint2 pk; pk.x = pk2(ta[0], ta[1]); pk.y = pk2(ta[2], ta[3]);
        *(uint2*)(rec + fr * 64 + 32 * (kt >> 1) + 8 * fq + 4 * (kt & 1)) = pk;
        *(LAS u32x2*)(tB + fr * RC_TP + kt * 16 + 4 * fq) = (u32x2){pk.x, pk.y}; }
#pragma unroll
    for (int vt = 0; vt < 4; ++vt) { const LAS bf16* pa = tV + (4 * fq + q4) * RC_TP + vt * 16 + 4 * p4;
        const f32x4 x = __builtin_amdgcn_mfma_f32_16x16x32_bf16(trfrag(pa, pa), L2op, (f32x4){0.f, 0.f, 0.f, 0.f}, 0, 0, 0);
        *(LAS u32x2*)(tK + fr * RC_TP + vt * 16 + 4 * fq) = (u32x2){pk2(x[0], x[1]), pk2(x[2], x[3])}; }
#pragma unroll
    for (int kt = 0; kt < 4; ++kt) { const LAS bf16* pa = tB + (4 * fq + q4) * RC_TP + kt * 16 + 4 * p4;
        const u32x2 r2 = *(const LAS u32x2*)(tR + fr * RC_TP + kt * 16 + 4 * fq);
        f32x4 ra = (f32x4){__uint_as_float(r2.x << 16), __uint_as_float(r2.x & 0xffff0000u), __uint_as_float(r2.y << 16), __uint_as_float(r2.y & 0xffff0000u)};
        ra = __builtin_amdgcn_mfma_f32_16x16x32_bf16(trfrag(pa, pa), M1op, ra, 0, 0, 0);
        uint2 pk; pk.x = pk2(ra[0], ra[1]); pk.y = pk2(ra[2], ra[3]);
        *(uint2*)(rec + 1024 + fr * 64 + 32 * (kt >> 1) + 8 * fq + 4 * (kt & 1)) = pk; }
#pragma unroll
    for (int vt = 0; vt < 4; ++vt) { const LAS bf16* pa = tK + (4 * fq + q4) * RC_TP + vt * 16 + 4 * p4;
        const f32x4 x = __builtin_amdgcn_mfma_f32_16x16x32_bf16(trfrag(pa, pa), Top, (f32x4){0.f, 0.f, 0.f, 0.f}, 0, 0, 0);
        uint2 pk; pk.x = pk2(x[0], x[1]); pk.y = pk2(x[2], x[3]);
#pragma unroll
        for (int e = 0; e < 4; ++e) rec[2048 + (size_t)(vt * 16 + 4 * fq + e) * 16 + fr] = (bf16)f2bf(x[e]);
        *(LAS u32x2*)(tA + fr * RC_TP + vt * 16 + 4 * fq) = (u32x2){pk.x, pk.y}; }
#pragma unroll
    for (int vt = 0; vt < 4; ++vt) { const LAS bf16* pg = tA + (4 * fq + q4) * RC_TP + vt * 16 + 4 * p4; const LAS bf16* pv = tV + (4 * fq + q4) * RC_TP + vt * 16 + 4 * p4;
        f32x4 x = __builtin_amdgcn_mfma_f32_16x16x32_bf16(trfrag(pg, pg), M1op, (f32x4){0.f, 0.f, 0.f, 0.f}, 0, 0, 0);
        x = __builtin_amdgcn_mfma_f32_16x16x32_bf16(trfrag(pv, pv), M2op, x, 0, 0, 0);
#pragma unroll
        for (int e = 0; e < 4; ++e) Ycg[(size_t)(vt * 16 + 4 * fq + e) * 16 + fr] = x[e]; }
}

constexpr int R2_NV = 2;
__device__ __forceinline__ void rwkv_r2(const Ctx& a, int l, int item) {
    unsigned char* ws = opqp(a.ws); const int tid = ((a.wv << 6) | lane_v()), lane = tid & 63, wid = tid >> 6, fr = lane & 15, fq = lane >> 4;
    const int chain = 4 * item + (wid >> 1), v0 = 32 * (wid & 1); const int dir = chain & 1, h = (chain >> 1) & 7, b = chain >> 4;
    bf16* Y = (bf16*)(ws + WS_YR) + (size_t)dir * MTOT * 512;
    f32x4 S[R2_NV][4];
#pragma unroll
    for (int vg = 0; vg < R2_NV; ++vg)
#pragma unroll
        for (int kt = 0; kt < 4; ++kt) S[vg][kt] = (f32x4){0.f, 0.f, 0.f, 0.f};
    struct Rec { bf16x8 taf[2], raf[2], bkf[4]; f32x4 pc[4]; uint2 g2[R2_NV], v2[R2_NV]; f32x4 yc[R2_NV]; int r0; };
    Rec cur, nxt;
#define R2_LOAD(R_, c_) do { const size_t unit_ = (size_t)chain * RC_NCH + (c_); \
        const bf16* rec_ = (const bf16*)(ws + WS_RC1) + unit_ * RC_REC; const float* Ycg_ = (const float*)(ws + WS_RC2) + unit_ * 1024; const float* PCg_ = (const float*)(ws + WS_RC2) + (size_t)RC_UNITS * 1024 + unit_ * 64; \
        _Pragma("unroll") for (int jj = 0; jj < 2; ++jj) { R_.taf[jj] = *(const bf16x8*)(rec_ + fr * 64 + jj * 32 + fq * 8); R_.raf[jj] = *(const bf16x8*)(rec_ + 1024 + fr * 64 + jj * 32 + fq * 8); } \
        _Pragma("unroll") for (int kt = 0; kt < 4; ++kt) { R_.bkf[kt] = *(const bf16x8*)(rec_ + 3072 + (size_t)(kt * 16 + fr) * 32 + fq * 8); R_.pc[kt] = *(const f32x4*)(PCg_ + kt * 16 + 4 * fq); } \
        _Pragma("unroll") for (int vg = 0; vg < R2_NV; ++vg) { const size_t vo_ = (size_t)(v0 + 16 * vg + fr) * 16 + 4 * fq; \
            R_.g2[vg] = *(const uint2*)(rec_ + 2048 + vo_); R_.v2[vg] = *(const uint2*)(rec_ + 5120 + vo_); R_.yc[vg] = *(const f32x4*)(Ycg_ + vo_); } \
        const int s0_ = (c_) * 16; const int inc_ = s0_ < CTXL ? 1 : 0; const int t0_ = s0_ - (inc_ ? 0 : CTXL), L_ = inc_ ? CTXL : SEQ, base_ = inc_ ? MLAT + b * CTXL : b * SEQ; \
        R_.r0 = base_ + (dir ? L_ - 1 - t0_ : t0_); } while (0)
#define R2_STEP(R_, c_) do { _Pragma("unroll") for (int vg = 0; vg < R2_NV; ++vg) { \
        bf16x8 sb[2]; \
        _Pragma("unroll") for (int jj = 0; jj < 2; ++jj) { u32x4 w; w.x = pk2(S[vg][2 * jj][0], S[vg][2 * jj][1]); w.y = pk2(S[vg][2 * jj][2], S[vg][2 * jj][3]); w.z = pk2(S[vg][2 * jj + 1][0], S[vg][2 * jj + 1][1]); w.w = pk2(S[vg][2 * jj + 1][2], S[vg][2 * jj + 1][3]); sb[jj] = __builtin_bit_cast(bf16x8, w); } \
        f32x4 xt = (f32x4){0.f, 0.f, 0.f, 0.f}, yt = xt; \
        _Pragma("unroll") for (int jj = 0; jj < 2; ++jj) { xt = __builtin_amdgcn_mfma_f32_16x16x32_bf16(R_.taf[jj], sb[jj], xt, 0, 0, 0); yt = __builtin_amdgcn_mfma_f32_16x16x32_bf16(R_.raf[jj], sb[jj], yt, 0, 0, 0); }     \
        _Pragma("unroll") for (int e = 0; e < 4; ++e) Y[(size_t)(R_.r0 + (dir ? -(4 * fq + e) : (4 * fq + e))) * 512 + h * 64 + v0 + 16 * vg + fr] = (bf16)f2bf(yt[e] + R_.yc[vg][e]); \
        float g4_[4]; unpack4(R_.g2[vg], g4_); \
        u32x4 w; w.x = pk2(xt[0] + g4_[0], xt[1] + g4_[1]); w.y = pk2(xt[2] + g4_[2], xt[3] + g4_[3]); w.z = R_.v2[vg].x; w.w = R_.v2[vg].y; \
        const bf16x8 yop = __builtin_bit_cast(bf16x8, w);                    \
        _Pragma("unroll") for (int kt = 0; kt < 4; ++kt) { S[vg][kt] = S[vg][kt] * R_.pc[kt]; S[vg][kt] = __builtin_amdgcn_mfma_f32_16x16x32_bf16(R_.bkf[kt], yop, S[vg][kt], 0, 0, 0); } } } while (0)
#define R2_CL(x_) ((x_) < RC_NCH ? (x_) : RC_NCH - 1)
    R2_LOAD(cur, 0);
    for (int c = 0; c < RC_NCH; c += 2) {
        R2_LOAD(nxt, R2_CL(c + 1)); R2_STEP(cur, c);
        R2_LOAD(cur, R2_CL(c + 2)); R2_STEP(nxt, c + 1);
    }
#undef R2_STEP
#undef R2_CL
#undef R2_LOAD
}

constexpr int RW_LD = 384;
constexpr int RW_YOFF = 2 * CH_T * RW_LD;
__device__ __forceinline__ void rwkv_chain(const Ctx& a, LAS unsigned char* lds, int l, int item) {
    unsigned char* ws = opqp(a.ws); const int tid = ((a.wv << 6) | lane_v());
    const int dir = item & 1, h = (item >> 1) & 7, b = item >> 4;
    const int rp = tid >> 4, js = tid & 15, j0 = js * 4; const bool odd = js & 1;
    const bf16* R5 = (const bf16*)(ws + WS_RW5); const float* F = (const float*)(ws + WS_MIX); float* Y = (float*)(ws + WS_YR) + (size_t)dir * MTOT * 512;
    const size_t st = (size_t)MTOT * 512;
    LAS float* buf = (LAS float*)lds;
    const int ls = tid >> 4, lp = tid & 15;
    typedef float f32x2 __attribute__((ext_vector_type(2)));
    f32x2 S00 = {0.f, 0.f}, S01 = {0.f, 0.f}, S10 = {0.f, 0.f}, S11 = {0.f, 0.f};
    float4 wreg; uint2 kkr, br, kr, rr, vr;
    const float4 w0r = *(const float4*)(ldin(13) + l * 1024 + dir * 512 + h * 64 + lp * 4);
#define RW_LOAD(c) do { const int row_ = chain_row((c) * CH_T + ls, b, dir); const size_t o_ = (size_t)row_ * 512 + h * 64 + lp * 4; \
        wreg = *(const float4*)(F + (size_t)row_ * 2048 + dir * 512 + h * 64 + lp * 4); \
        rr = *(const uint2*)(R5 + o_); kr = *(const uint2*)(R5 + st + o_); vr = *(const uint2*)(R5 + 2 * st + o_); kkr = *(const uint2*)(R5 + 3 * st + o_); br = *(const uint2*)(R5 + 4 * st + o_); } while (0)
#define RW_STORE(c) do { LAS float* q_ = buf + (((c) & 1) * CH_T + ls) * RW_LD; float f_[4]; \
        unpack4(kkr, f_); *(LAS f32x4*)(q_ + lp * 4) = (f32x4){f_[0], f_[1], f_[2], f_[3]}; \
        unpack4(br, f_);  *(LAS f32x4*)(q_ + 64 + lp * 4) = (f32x4){f_[0], f_[1], f_[2], f_[3]}; \
        *(LAS f32x4*)(q_ + 128 + lp * 4) = (f32x4){__expf(-0.60653066f * fsigm(wreg.x + w0r.x)), __expf(-0.60653066f * fsigm(wreg.y + w0r.y)), __expf(-0.60653066f * fsigm(wreg.z + w0r.z)), __expf(-0.60653066f * fsigm(wreg.w + w0r.w))}; \
        unpack4(kr, f_);  *(LAS f32x4*)(q_ + 192 + lp * 4) = (f32x4){f_[0], f_[1], f_[2], f_[3]}; \
        unpack4(rr, f_);  *(LAS f32x4*)(q_ + 256 + lp * 4) = (f32x4){f_[0], f_[1], f_[2], f_[3]}; \
        unpack4(vr, f_);  *(LAS f32x4*)(q_ + 320 + lp * 4) = (f32x4){f_[0], f_[1], f_[2], f_[3]}; } while (0)
    __syncthreads();
    RW_LOAD(0); RW_STORE(0);
    __syncthreads();
    for (int c = 0; c < CH_NC; ++c) {
        if (c + 1 < CH_NC) RW_LOAD(c + 1);
        if (c > 0) {
            const int row = chain_row((c - 1) * CH_T + ls, b, dir);
            *(f32x4*)(Y + (size_t)row * 512 + h * 64 + lp * 4) = *(const LAS f32x4*)(buf + RW_YOFF + (((c - 1) & 1) * CH_T + ls) * 64 + lp * 4);
        }
        const LAS float* cb = buf + ((c & 1) * CH_T) * RW_LD; LAS float* yb = buf + RW_YOFF + ((c & 1) * CH_T) * 64;
#pragma unroll 2
        for (int s = 0; s < CH_T; ++s) {
            const LAS float* q = cb + s * RW_LD;
            const f32x4 kk4 = *(const LAS f32x4*)(q + j0), b4 = *(const LAS f32x4*)(q + 64 + j0), w4 = *(const LAS f32x4*)(q + 128 + j0), k4 = *(const LAS f32x4*)(q + 192 + j0), r4 = *(const LAS f32x4*)(q + 256 + j0);
            const f32x2 v2 = *(const LAS f32x2*)(q + 320 + 2 * rp);
            const f32x2 kkA = {kk4[0], kk4[1]}, kkB = {kk4[2], kk4[3]}, bA = {b4[0], b4[1]}, bB = {b4[2], b4[3]}, wA = {w4[0], w4[1]}, wB = {w4[2], w4[3]}, kA = {k4[0], k4[1]}, kB = {k4[2], k4[3]}, rA = {r4[0], r4[1]}, rB = {r4[2], r4[3]};
            f32x2 t0 = S00 * kkA + S01 * kkB, t1 = S10 * kkA + S11 * kkB;
            const float sa0 = -red16(t0[0] + t0[1]), sa1 = -red16(t1[0] + t1[1]);
            S00 = S00 * wA + (bA * sa0 + kA * v2[0]); S01 = S01 * wB + (bB * sa0 + kB * v2[0]);
            S10 = S10 * wA + (bA * sa1 + kA * v2[1]); S11 = S11 * wB + (bB * sa1 + kB * v2[1]);
            t0 = S00 * rA + S01 * rB; t1 = S10 * rA + S11 * rB;
            const float p0 = t0[0] + t0[1], p1 = t1[0] + t1[1];
            float ym = odd ? p1 : p0; const float yo = odd ? p0 : p1;
            ym += dppf<0xB1>(yo); ym += dppf<0x4E>(ym); ym += dppf<0x124>(ym); ym += dppf<0x128>(ym);
            if (js < 2) yb[s * 64 + 2 * rp + js] = ym;
        }
        if (c + 1 < CH_NC) RW_STORE(c + 1);
        __syncthreads();
    }
    { const int row = chain_row((CH_NC - 1) * CH_T + ls, b, dir);
      *(f32x4*)(Y + (size_t)row * 512 + h * 64 + lp * 4) = *(const LAS f32x4*)(buf + RW_YOFF + (((CH_NC - 1) & 1) * CH_T + ls) * 64 + lp * 4); }
#undef RW_LOAD
#undef RW_STORE
}

constexpr int AT_KP = 136, AT_VP = 144;
constexpr int AT_KB = 64 * AT_KP * 2, AT_VB = 64 * AT_VP * 2, AT_BUF = AT_KB + AT_VB;
__device__ __forceinline__ void attn_item(const Ctx& a, LAS unsigned char* lds, int l, int b, int h, int qt, bool ctxq, float lam, float post) {
    unsigned char* ws = opqp(a.ws); const int tid = ((a.wv << 6) | lane_v()), lane = tid & 63, wid = tid >> 6, fr = lane & 15, fq = lane >> 4, q4 = (lane & 15) >> 2, p4 = lane & 3;
    const bf16* QK = (const bf16*)(ws + WS_QK); const bf16* U = (const bf16*)(ws + WS_U); bf16* A2 = (bf16*)(ws + WS_HA);
    const int qrow = (ctxq ? MLAT + b * CTXL : b * SEQ) + qt * 128 + wid * 16 + fr;
    const int nkt = ctxq ? 4 : 36;
    bf16x8 qf[2][2];
#pragma unroll
    for (int c = 0; c < 2; ++c)
#pragma unroll
        for (int ks = 0; ks < 2; ++ks) qf[c][ks] = *(const bf16x8*)(QK + (size_t)qrow * 1024 + h * 128 + c * 64 + ks * 32 + fq * 8);
    f32x4 O[2][8];
#pragma unroll
    for (int c = 0; c < 2; ++c)
#pragma unroll
        for (int d = 0; d < 8; ++d) O[c][d] = (f32x4){0.f, 0.f, 0.f, 0.f};
    float mrun[2] = {-3.0e38f, -3.0e38f}, lrun[2] = {0.f, 0.f};
    uint4 kreg[2], vreg[2];
#define AT_LOAD(kt) do { const int kr0_ = ((kt) < 4 ? MLAT + b * CTXL + (kt) * 64 : b * SEQ + ((kt) - 4) * 64); \
        _Pragma("unroll") for (int j_ = 0; j_ < 2; ++j_) { const int id_ = tid + j_ * NT, key_ = id_ >> 4, part_ = id_ & 15; \
            kreg[j_] = *(const uint4*)(QK + (size_t)(kr0_ + key_) * 1024 + 512 + h * 128 + part_ * 8); \
            vreg[j_] = *(const uint4*)(U + (size_t)(kr0_ + key_) * NINP + C_DA_V + h * 128 + part_ * 8); } } while (0)
#define AT_STORE(kt) do { LAS bf16* Ks_ = (LAS bf16*)(lds + ((kt) & 1) * AT_BUF); LAS bf16* Vs_ = (LAS bf16*)(lds + ((kt) & 1) * AT_BUF + AT_KB); \
        _Pragma("unroll") for (int j_ = 0; j_ < 2; ++j_) { const int id_ = tid + j_ * NT, key_ = id_ >> 4, part_ = id_ & 15; \
            *(LAS u32x4*)(Ks_ + key_ * AT_KP + part_ * 8) = (u32x4){kreg[j_].x, kreg[j_].y, kreg[j_].z, kreg[j_].w}; \
            *(LAS u32x4*)(Vs_ + key_ * AT_VP + part_ * 8) = (u32x4){vreg[j_].x, vreg[j_].y, vreg[j_].z, vreg[j_].w}; } } while (0)
    __syncthreads();
    AT_LOAD(0); AT_STORE(0);
    __syncthreads();
    for (int kt = 0; kt < nkt; ++kt) {
        if (kt + 1 < nkt) AT_LOAD(kt + 1);
        const LAS bf16* Ks = (const LAS bf16*)(lds + (kt & 1) * AT_BUF); const LAS bf16* Vs = (const LAS bf16*)(lds + (kt & 1) * AT_BUF + AT_KB);
        f32x4 S[2][4];
#pragma unroll
        for (int c = 0; c < 2; ++c)
#pragma unroll
            for (int sb = 0; sb < 4; ++sb) { f32x4 acc = (f32x4){0.f, 0.f, 0.f, 0.f};
#pragma unroll
                for (int ks = 0; ks < 2; ++ks) { const bf16x8 kf = *(const LAS bf16x8*)(Ks + (sb * 16 + fr) * AT_KP + c * 64 + ks * 32 + fq * 8);
                    acc = __builtin_amdgcn_mfma_f32_16x16x32_bf16(kf, qf[c][ks], acc, 0, 0, 0); }
                S[c][sb] = acc; }
        bf16x8 pf[2][2];
#pragma unroll
        for (int c = 0; c < 2; ++c) {
            float mx = S[c][0][0];
#pragma unroll
            for (int sb = 0; sb < 4; ++sb)
#pragma unroll
                for (int e = 0; e < 4; ++e) mx = fmaxf(mx, S[c][sb][e]);
            mx = fmaxf(mx, swz16(mx)); mx = fmaxf(mx, shx32(mx, lane));
            const float mnew = fmaxf(mrun[c], mx), alpha = __builtin_amdgcn_exp2f(mrun[c] - mnew); mrun[c] = mnew;
            float ps = 0.f;
#pragma unroll
            for (int sb = 0; sb < 4; ++sb)
#pragma unroll
                for (int e = 0; e < 4; ++e) { const float pv = __builtin_amdgcn_exp2f(S[c][sb][e] - mnew); S[c][sb][e] = pv; ps += pv; }
            lrun[c] = lrun[c] * alpha + ps;
#pragma unroll
            for (int d = 0; d < 8; ++d) O[c][d] *= alpha;
#pragma unroll
            for (int kc = 0; kc < 2; ++kc) { u32x4 w; w.x = pk2(S[c][2 * kc][0], S[c][2 * kc][1]); w.y = pk2(S[c][2 * kc][2], S[c][2 * kc][3]); w.z = pk2(S[c][2 * kc + 1][0], S[c][2 * kc + 1][1]); w.w = pk2(S[c][2 * kc + 1][2], S[c][2 * kc + 1][3]);
                pf[c][kc] = __builtin_bit_cast(bf16x8, w); }
        }
#pragma unroll
        for (int kc = 0; kc < 2; ++kc)
#pragma unroll
            for (int d = 0; d < 8; ++d) {
                const LAS bf16* pa = Vs + (kc * 32 + 4 * fq + q4) * AT_VP + d * 16 + 4 * p4;
                const bf16x8 vf = trfrag(pa, pa + 16 * AT_VP);
                O[0][d] = __builtin_amdgcn_mfma_f32_16x16x32_bf16(vf, pf[0][kc], O[0][d], 0, 0, 0);
                O[1][d] = __builtin_amdgcn_mfma_f32_16x16x32_bf16(vf, pf[1][kc], O[1][d], 0, 0, 0);
            }
        if (kt + 1 < nkt) AT_STORE(kt + 1);
        __syncthreads();
    }
#undef AT_LOAD
#undef AT_STORE
    float l0 = lrun[0], l1 = lrun[1];
    l0 += swz16(l0); l0 += shx32(l0, lane); l1 += swz16(l1); l1 += shx32(l1, lane);
    const float i0 = 1.0f / l0, i1 = lam / l1;
    float ss = 0.f;
#pragma unroll
    for (int d = 0; d < 8; ++d)
#pragma unroll
        for (int e = 0; e < 4; ++e) { const float o = O[0][d][e] * i0 - O[1][d][e] * i1; O[0][d][e] = o; ss += o * o; }
    ss += swz16(ss); ss += shx32(ss, lane);
    const float rs = rsqrtf(ss * (1.0f / 128.0f) + 1e-5f) * post;
    const float* sw = ldin(30) + l * 128;
#pragma unroll
    for (int d = 0; d < 8; ++d) { const int dc = d * 16 + 4 * fq; const float4 w4 = *(const float4*)(sw + dc);
        uint2 pk; pk.x = pk2(O[0][d][0] * rs * w4.x, O[0][d][1] * rs * w4.y); pk.y = pk2(O[0][d][2] * rs * w4.z, O[0][d][3] * rs * w4.w);
        *(uint2*)(A2 + (size_t)qrow * DM + 1536 + h * 128 + dc) = pk; }
}

__device__ __forceinline__ int q_pull(unsigned* ctr, volatile LAS unsigned* slot, int tid) {
    __syncthreads();
    if (tid == 0) *slot = __hip_atomic_fetch_add(ctr, 1u, __ATOMIC_RELAXED, __HIP_MEMORY_SCOPE_AGENT);
    __syncthreads();
    return (int)*slot;
}
__device__ __forceinline__ void p6_mixers(const Ctx& a, LAS unsigned char* lds, int l, int bid, int G) {
    unsigned char* ws = opqp(a.ws); const int tid = ((a.wv << 6) | lane_v());
    volatile LAS unsigned* slot = (volatile LAS unsigned*)(lds + LDS_STAGE + 8);
    unsigned* qm = (unsigned*)(ws + WS_CTL) + CW_Q + (l * 2 + 0) * 64; unsigned* qa = (unsigned*)(ws + WS_CTL) + CW_Q + (l * 2 + 1) * 64;
    if (a.sub & 1) for (int it = bid; it < 32; it += G) rwkv_r2(a, l, it);
    if (a.sub & 4) {
    const float* lp = ldin(29) + l * 256; float s01 = 0.f, s23 = 0.f;
    for (int i = 0; i < 64; ++i) { s01 += lp[i] * lp[64 + i]; s23 += lp[128 + i] * lp[192 + i]; }
    const float lam_init = l == 0 ? 0.2f : (0.8f - 0.6f * 0.74081822068f);
    const float lam = expf(s01) - expf(s23) + lam_init, post = 1.0f - lam_init;
    const int nat = l == 0 ? 576 : 512;
    for (;;) { const int it = q_pull(qa, slot, tid); if (it >= nat) break;
        if (it < 512) { const int qt = it & 15, h = (it >> 4) & 3, b = it >> 6; attn_item(a, lds, l, b, h, qt, false, lam, post); }
        else { const int i2 = it - 512; const int qt = i2 & 1, h = (i2 >> 1) & 3, b = i2 >> 3; attn_item(a, lds, l, b, h, qt, true, lam, post); } }
    }
    if (a.sub & 2) { const int nit = l == 0 ? 8 * MB_NCH * 2 : 8 * 16 * 2;
        for (;;) { const int it = q_pull(qm, slot, tid); if (it >= nit) break;
            const int g = it & 1; int cc, b; if (l == 0) { cc = (it >> 1) % MB_NCH; b = (it >> 1) / MB_NCH; } else { cc = 2 + ((it >> 1) & 15); b = it >> 5; } mamba_m3(a, lds, b, cc, g); } }
}


constexpr int N_PHASES = 27;
__global__ void __launch_bounds__(NT, 2) fwd(Args args) {
    extern __shared__ __attribute__((aligned(16))) unsigned char lds_dyn[];
    LAS unsigned char* lds = (LAS unsigned char*)lds_dyn;
    volatile LAS unsigned* MISC = (volatile LAS unsigned*)(lds + LDS_STAGE);
    const int wv = __builtin_amdgcn_readfirstlane((int)threadIdx.x >> 6);
    const int tid = (wv << 6) | lane_v(), bid = blockIdx.x, G = gridDim.x;
    unsigned char* ws = args.ws;
    const Ctx cx{ws, wv, args.sub};
    for (int u = tid; u < LDS_MISC / 4; u += NT) MISC[u] = 0u;
    __syncthreads();
    if (tid == 0) {
#pragma unroll
        for (int i = 0; i < 38; ++i) *(LAS unsigned long long*)(lds + LDS_PTRS + 8 * i) = (unsigned long long)args.in[i];
    }
    __syncthreads();
#if MK_PER_PHASE
#define GRID_BAR() do { } while (0)
#else
    XcdBarrier bar = xcd_barrier_post((unsigned*)(ws + WS_CTL) + CW_BAR, MISC);
#define GRID_BAR() do { XcdBarrier b_ = bar; b_.bar = opqp(b_.bar); b_.x = (unsigned)opqs((int)b_.x); xcd_barrier(b_); } while (0)
#endif
    const int lo = args.ph_lo, hi = args.ph_hi;
#define IN(k) (opqs(lo) <= (k) && (k) < opqs(hi))
#define SEAM(k) do { if (IN((k) + 1)) GRID_BAR(); } while (0)

#define XS (args.out)
#define XSB ((float*)(wsq + WS_XSB))
#define XC ((float*)(wsq + WS_XC))
#define HA ((bf16*)(wsq + WS_HA))
#define Ub ((bf16*)(wsq + WS_U))
#define MIX ((float*)(wsq + WS_MIX))
#define HID ((bf16*)(wsq + WS_BIG))
#define PH_LOCALS unsigned char* const wsq = opqp(ws); const int bidq = opqs(bid), Gq = opqs(G); (void)wsq; (void)bidq; (void)Gq

    if (IN(0)) { PH_LOCALS; if (args.sub & 64) bg_convert(cx, lds, nullptr, Gq); else p0_prologue(cx, lds,  bidq, Gq); SEAM(0); }
    if (IN(1)) { PH_LOCALS;
        thin_phase<0, 1>(cx, lds,  bidq, Gq, MTOT, ldin(0), ldin(2), nullptr, nullptr, nullptr, nullptr, 0, 0, ldin(6), 0, 1, 0);
        SEAM(1);
    }
    for (int l = 0; l < 2; ++l) {
        const int pb = 2 + 12 * l;
        const int Mo = l == 0 ? MTOT : MLAT;
        if (IN(pb + 0)) { PH_LOCALS;
            pg8::Gemm g{HA, (const bf16*)(wsq + WS_WIN) + (size_t)l * NINP * DM, MTOT, NINP, DM}; pg8::StaticOrder S; S.init(MTOT, NINP, Gq, bidq);
            pg8::EpiBf16P E{Ub, NINP, 0, 1.0f};
            pg8::gemm_phase<pg8::EpiBf16P, pg8::StaticOrder>(lds, g, S, E, nullptr, (wv << 6) | lane_v());
            bg_tail(cx, lds, l * 8 + 0, Gq);
            SEAM(pb + 0);
        }
        if (IN(pb + 1)) { PH_LOCALS; feat_a(cx, lds, l,  bidq, Gq); SEAM(pb + 1); }
        if (IN(pb + 2)) { PH_LOCALS;
            pg8::Gemm g{(const bf16*)(wsq + WS_ASM), (const bf16*)(wsq + WS_WSM) + (size_t)l * 2048 * 256, MTOT, 2048, 256}; pg8::StaticOrder S; S.init(MTOT, 2048, Gq, bidq);
            pg8::EpiF32 E{MIX, 2048, nullptr};
            pg8::gemm_phase<pg8::EpiF32, pg8::StaticOrder>(lds, g, S, E, nullptr, (wv << 6) | lane_v());
            for (int it = bidq; it < 8 * MB_NCH * 2; it += Gq) mamba_m1(cx, lds, it);
            bg_tail(cx, lds, l * 8 + 1, Gq);
            SEAM(pb + 2);
        }
        if (IN(pb + 4)) { PH_LOCALS; for (int it = bidq; it < 256; it += Gq) mamba_m2(cx, it);
            rc_consts(lds, l, (wv << 6) | lane_v());
            for (int u = bidq * NW + wv; u < RC_UNITS; u += Gq * NW) rwkv_r1(cx, lds, l, u); SEAM(pb + 4); }
        if (IN(pb + 5)) { PH_LOCALS; p6_mixers(cx, lds, l,  bidq, Gq); if (!(args.sub & 32)) bg_tail(cx, lds, l * 8 + 5, Gq); SEAM(pb + 5); }
        if (IN(pb + 6)) { PH_LOCALS; mix_out(cx, l, Mo,  bidq, Gq); SEAM(pb + 6); }
        if (IN(pb + 7)) { PH_LOCALS;
            pg8::Gemm g{HA, (const bf16*)(wsq + WS_WOUT) + (size_t)l * DM * DM, Mo, DM, DM}; pg8::StaticOrder S; S.init(Mo, DM, Gq, bidq);
            pg8::EpiBf16P E{(bf16*)MIX, DM, 0, 1.0f};
            pg8::gemm_phase<pg8::EpiBf16P, pg8::StaticOrder>(lds, g, S, E, nullptr, (wv << 6) | lane_v());
            bg_tail(cx, lds, l * 8 + 2, Gq);
            SEAM(pb + 7);
        }
        if (l == 0) {
            if (IN(pb + 8)) { PH_LOCALS;
                thin_phase<1, DENSE_GU8 ? 3 : 1, 0, 1>(cx, lds,  bidq, Gq, MTOT, ldin(0), ldin(2), XSB, XC, MIX, ldin(7), 0, 2, ldin(8), 0, 4, 3);
                SEAM(pb + 8);
            }
            if (IN(pb + 9)) { PH_LOCALS;
                pg8::StaticOrder S; S.init(MTOT, 2 * FF, Gq, bidq);
#if DENSE_GU8 && DENSE_D8
                pg8::Gemm g{HA, (const bf16*)(wsq + WS_WGU), MTOT, 2 * FF, DM / 2};
                pg8::EpiSwiGLU8 E{(unsigned char*)(wsq + WS_BIG), FF, 0, 1.0f / MOE_SGU, MOE_SH};
                pg8::gemm_phase<pg8::EpiSwiGLU8, pg8::StaticOrder, false, true>(lds, g, S, E, nullptr, (wv << 6) | lane_v());
#elif DENSE_GU8
                pg8::Gemm g{HA, (const bf16*)(wsq + WS_WGU), MTOT, 2 * FF, DM / 2};
                pg8::EpiSwiGLUS E{HID, FF, 0, 1.0f / MOE_SGU};
                pg8::gemm_phase<pg8::EpiSwiGLUS, pg8::StaticOrder, false, true>(lds, g, S, E, nullptr, (wv << 6) | lane_v());
#elif DENSE_D8
                pg8::Gemm g{HA, (const bf16*)(wsq + WS_WGU), MTOT, 2 * FF, DM};
                pg8::EpiSwiGLU8 E{(unsigned char*)(wsq + WS_BIG), FF, 0, 1.0f, MOE_SH};
                pg8::gemm_phase<pg8::EpiSwiGLU8, pg8::StaticOrder>(lds, g, S, E, nullptr, (wv << 6) | lane_v());
#else
                pg8::Gemm g{HA, (const bf16*)(wsq + WS_WGU), MTOT, 2 * FF, DM};
                pg8::EpiSwiGLU E{HID, FF, 0};
                pg8::gemm_phase<pg8::EpiSwiGLU, pg8::StaticOrder>(lds, g, S, E, nullptr, (wv << 6) | lane_v());
#endif
                bg_tail(cx, lds, 3, Gq);
                SEAM(pb + 9);
            }
            if (IN(pb + 10)) { PH_LOCALS;
                pg8::StaticOrder S; S.init(MTOT, DM, Gq, bidq);
#if DENSE_D8
                pg8::Gemm g{HID, (const bf16*)(wsq + WS_WD), MTOT, DM, FF / 2};
                pg8::EpiBf16P E{(bf16*)MIX, DM, 0, 1.0f / (MOE_SD * MOE_SH)};
                pg8::gemm_phase<pg8::EpiBf16P, pg8::StaticOrder, false, true>(lds, g, S, E, nullptr, (wv << 6) | lane_v());
#else
                pg8::Gemm g{HID, (const bf16*)(wsq + WS_WD), MTOT, DM, FF};
                pg8::EpiBf16P E{(bf16*)MIX, DM, 0, 1.0f};
                pg8::gemm_phase<pg8::EpiBf16P, pg8::StaticOrder>(lds, g, S, E, nullptr, (wv << 6) | lane_v());
#endif
                bg_tail(cx, lds, 4, Gq);
                SEAM(pb + 10);
            }
            if (IN(pb + 11)) { PH_LOCALS;
                thin_phase<1, 1, 1, 1>(cx, lds,  bidq, Gq, MTOT, XSB, XC, XSB, XC, MIX, ldin(9), 0, 5, ldin(6) + DM, 1, 1, 0);
                SEAM(pb + 11);
            }
        } else {
            if (IN(pb + 8)) { PH_LOCALS;
                thin_phase<1, 2, 1, 1>(cx, lds,  bidq, Gq, MLAT, XSB, XC, XSB, XC, MIX, ldin(7) + DM, 1, 2, ldin(8) + DM, 1, 4, 3);
                SEAM(pb + 8);
            }
            if (IN(pb + 9)) { PH_LOCALS; moe_gather(cx,  bidq, Gq); bg_convert(cx, lds, nullptr, Gq); SEAM(pb + 9); }
            if (IN(pb + 10) || IN(pb + 11)) { PH_LOCALS;
                if (((wv << 6) | lane_v()) == 0) { const unsigned* cnt = (const unsigned*)(wsq + WS_CTL) + CW_CNT; int run = 0;
                    for (int e = 0; e < 8; ++e) { const int t = (int)((cnt[e * 64] + 255u) >> 8); MISC[16 + e] = (unsigned)t; MISC[24 + e] = (unsigned)run; run += t; } }
                __syncthreads();
            }
            if (IN(pb + 10)) { PH_LOCALS;
                pg8::MoeOrder S{(const LAS int*)(lds + LDS_STAGE + 64), (2 * FE) / 256, Gq, bidq};
#if MOE_FP8
                pg8::Gemm g{(const bf16*)(wsq + WS_U), (const bf16*)(wsq + WS_MGU), MOE_ROWS, 2 * FE, DM / 2};
                pg8::EpiSwiGLU8 E{(unsigned char*)(wsq + WS_BIG), FE, (2 * FE) / 256, 1.0f / MOE_SGU, MOE_SH};
                pg8::gemm_phase<pg8::EpiSwiGLU8, pg8::MoeOrder, false, true>(lds, g, S, E, nullptr, (wv << 6) | lane_v());
#else
                pg8::Gemm g{(const bf16*)(wsq + WS_U), (const bf16*)(wsq + WS_MGU), MOE_ROWS, 2 * FE, DM};
                pg8::EpiSwiGLU E{HID, FE, (2 * FE) / 256};
                pg8::gemm_phase<pg8::EpiSwiGLU, pg8::MoeOrder>(lds, g, S, E, nullptr, (wv << 6) | lane_v());
#endif
                SEAM(pb + 10);
            }
            if (IN(pb + 11)) { PH_LOCALS;
                pg8::MoeOrder S{(const LAS int*)(lds + LDS_STAGE + 64), DM / 256, Gq, bidq};
#if MOE_FP8
                pg8::Gemm g{HID, (const bf16*)(wsq + WS_MD), MOE_ROWS, DM, FE / 2};
                pg8::EpiBf16P E{(bf16*)(wsq + WS_MIX), DM, DM / 256, 1.0f / (MOE_SD * MOE_SH)};
                pg8::gemm_phase<pg8::EpiBf16P, pg8::MoeOrder, false, true>(lds, g, S, E, nullptr, (wv << 6) | lane_v());
#else
                pg8::Gemm g{HID, (const bf16*)(wsq + WS_MD), MOE_ROWS, DM, FE};
                pg8::EpiBf16P E{(bf16*)(wsq + WS_MIX), DM, DM / 256, 1.0f};
                pg8::gemm_phase<pg8::EpiBf16P, pg8::MoeOrder>(lds, g, S, E, nullptr, (wv << 6) | lane_v());
#endif
                SEAM(pb + 11);
            }
            if (IN(pb + 12)) { PH_LOCALS;
                thin_phase<2, 0, 1, 0>(cx, lds,  bidq, Gq, MLAT, XSB, XC, XS, XC, nullptr, ldin(9) + DM, 1, 5, nullptr, 0, 0, 0);
            }
        }
    }
#undef IN
#undef SEAM
}

extern "C" void kernel_launch(void* const* d_in, const int* in_sizes, int n_in, void* d_out, int out_size, void* d_ws, size_t ws_size, hipStream_t stream) {
    static int grid = 0;
    if (grid == 0) {
        if (n_in != 38 || out_size != MLAT * DM || ws_size < WS_END) { fprintf(stderr, "kernel_launch: unexpected shapes (n_in %d out %d ws %zu need %zu)\n", n_in, out_size, ws_size, (size_t)WS_END); grid = -1; return; }
        int dev = 0, cus = 0, per_cu = 0;
        if (hipGetDevice(&dev) != hipSuccess || hipDeviceGetAttribute(&cus, hipDeviceAttributeMultiprocessorCount, dev) != hipSuccess) { grid = -1; return; }
        if (hipFuncSetAttribute((const void*)fwd, hipFuncAttributeMaxDynamicSharedMemorySize, LDS_BYTES) != hipSuccess) { fprintf(stderr, "kernel_launch: hipFuncSetAttribute failed\n"); grid = -1; return; }
        if (hipOccupancyMaxActiveBlocksPerMultiprocessor(&per_cu, (const void*)fwd, NT, LDS_BYTES) != hipSuccess || per_cu < 1) { fprintf(stderr, "kernel_launch: occupancy query says %d\n", per_cu); per_cu = 1; }
        (void)hipGetLastError();
        grid = cus;
    }
    if (grid < 0) return;
    if (hipMemsetAsync((char*)d_ws + WS_CTL, 0, CTL_BYTES, stream) != hipSuccess) return;
    Args a{};
    for (int i = 0; i < 38; ++i) a.in[i] = (const float*)d_in[i];
    a.out = (float*)d_out; a.ws = (unsigned char*)d_ws; a.sub = 7;
#if MK_PER_PHASE
#ifndef PROBE_SUB
#define PROBE_SUB 7
#endif
#ifndef PROBE_MASK
#define PROBE_MASK 0u
#endif
#ifndef PROBE_SPLIT
#define PROBE_SPLIT 0
#endif
#ifndef PROBE_REP
#define PROBE_REP 1
#endif
    for (int p = 0; p < N_PHASES; ++p) { a.ph_lo = p; a.ph_hi = p + 1;
        if (PROBE_SPLIT && (p == 7 || p == 19)) {
            a.sub = 1; hipLaunchKernelGGL(fwd, dim3(grid), dim3(NT), LDS_BYTES, stream, a);
            if (PROBE_SPLIT == 1) { a.sub = 2; hipLaunchKernelGGL(fwd, dim3(grid), dim3(NT), LDS_BYTES, stream, a); a.sub = 4; hipLaunchKernelGGL(fwd, dim3(grid), dim3(NT), LDS_BYTES, stream, a); }
            else if (PROBE_SPLIT == 2) { a.sub = 6; hipLaunchKernelGGL(fwd, dim3(grid), dim3(NT), LDS_BYTES, stream, a); }
            else { a.sub = 2; hipLaunchKernelGGL(fwd, dim3(grid), dim3(NT), LDS_BYTES, stream, a); a.sub = 5; hipLaunchKernelGGL(fwd, dim3(grid), dim3(NT), LDS_BYTES, stream, a); }
            a.sub = 7; continue; }
        if ((PROBE_MASK >> p) & 1u) { a.sub = PROBE_SUB;
            for (int rep = 0; rep < PROBE_REP; ++rep) { if (rep) (void)hipMemsetAsync((char*)d_ws + WS_CTL + CW_BG * 4, 0, 256, stream); hipLaunchKernelGGL(fwd, dim3(grid), dim3(NT), LDS_BYTES, stream, a); }
            a.sub = 7;
            (void)hipMemsetAsync((char*)d_ws + WS_CTL + CW_Q * 4, 0, 4 * 256, stream); }
        hipLaunchKernelGGL(fwd, dim3(grid), dim3(NT), LDS_BYTES, stream, a); }
#else
    a.ph_lo = 0; a.ph_hi = N_PHASES; hipLaunchKernelGGL(fwd, dim3(grid), dim3(NT), LDS_BYTES, stream, a);
#endif
}
```

```cpp
#include <hip/hip_runtime.h>
#include <cstdio>
#include <cstdint>

#ifndef MK_PER_PHASE
#define MK_PER_PHASE 0
#endif

#define GAS __attribute__((address_space(1)))
#define LAS __attribute__((address_space(3)))
typedef GAS unsigned gu32;
typedef GAS unsigned long long gu64;

__device__ __forceinline__ int opq(int x) { asm volatile("" : "+v"(x)); return x; }
template <class T> __device__ __forceinline__ T* opqp(T* p) { int z = 0; asm volatile("" : "+s"(z)); return (T*)((unsigned char*)p + z); }
__device__ __forceinline__ int opqs(int x) { asm volatile("" : "+s"(x)); return x; }

__device__ __forceinline__ int lane_v() { int l; asm volatile("v_mbcnt_lo_u32_b32 %0, -1, 0\n\tv_mbcnt_hi_u32_b32 %0, -1, %0" : "=v"(l)); return l; }

namespace pg8 {
#define PG8_LAS __attribute__((address_space(3)))
typedef unsigned short bf16_t;
typedef short bf16x8 __attribute__((ext_vector_type(8)));
typedef float f32x4 __attribute__((ext_vector_type(4)));
typedef unsigned u32x4 __attribute__((ext_vector_type(4)));
typedef int i32x4 __attribute__((ext_vector_type(4)));
typedef int i32x8 __attribute__((ext_vector_type(8)));
constexpr int BM = 256, BK = 64, HALF = 128, HTB = HALF * BK * 2  , STAGE_BYTES = 8 * HTB, NXCD = 8, WGM = 8;

__host__ __device__ __forceinline__ int lds_byte(int r, int c) { const int st = (r >> 4) * 2 + (c >> 5), rr = r & 15, cc = c & 31, ob = rr * 64 + cc * 2; return st * 1024 + (ob ^ (((ob >> 9) & 1) << 5)); }
__host__ __device__ __forceinline__ void stage_rc(int b, int& R, int& C) { const int st = b / 1024, sb = b % 1024, swz = sb ^ (((sb >> 9) & 1) << 5); R = (st >> 1) * 16 + swz / 64; C = (st & 1) * 32 + (swz % 64) / 2; }
__host__ __device__ __forceinline__ int perm32(int rho) { const int n = rho >> 4, i = rho & 15; return 8 * (i >> 2) + 4 * n + (i & 3); }

struct Unit { int pm, pn; };
struct Gemm { const bf16_t* A; const bf16_t* Bt; int M, N, K; };

struct StaticOrder {
    int nM, nN, nwg, G, c;
    __host__ __device__ void init(int M, int N, int G_, int c_) { nM = M / BM; nN = N / BM; nwg = nM * nN; G = G_; c = c_; }
    __host__ __device__ bool next(int i, Unit& u) const {
        const long L = (long)i * G + c; if (L >= nwg) return false;
        int wgid = (int)L; { const int q = nwg / NXCD, r = nwg % NXCD, xcd = wgid % NXCD, off = wgid / NXCD; wgid = (xcd < r ? xcd * (q + 1) : r * (q + 1) + (xcd - r) * q) + off; }
        const int nig = WGM * nN, gid = wgid / nig, fm = gid * WGM, gsz = (nM - fm) < WGM ? (nM - fm) : WGM;
        u.pm = fm + ((wgid % nig) % gsz); u.pn = (wgid % nig) / gsz; return true;
    }
    __device__ __forceinline__ void a_ready(const Unit&) const {}
    __device__ __forceinline__ void done(const Unit&) const {}
};
__device__ __forceinline__ unsigned cvt_pk_bf16(float lo, float hi) { unsigned r; asm volatile("v_cvt_pk_bf16_f32 %0, %1, %2" : "=v"(r) : "v"(lo), "v"(hi)); return r; }
struct EpiF32 {
    static constexpr bool PERM = false, AFTER_DRAIN = false;
    float* C; int ldc; const float* bias;
    __device__ __forceinline__ void operator()(const f32x4 (&acc)[2][2][4][2], const Unit& u, int wr, int wc, int fr, int fq) const {
        const int row0 = u.pm * BM + wr * 64 + fr, col0 = u.pn * BM + wc * 32 + 4 * fq;
        f32x4 bv[2][2];
#pragma unroll
        for (int bj = 0; bj < 2; ++bj)
#pragma unroll
            for (int n = 0; n < 2; ++n) bv[bj][n] = bias ? *(const f32x4*)(bias + col0 + bj * HALF + n * 16) : (f32x4){0.f, 0.f, 0.f, 0.f};
#pragma unroll
        for (int ai = 0; ai < 2; ++ai)
#pragma unroll
            for (int m = 0; m < 4; ++m) { float* rowp = C + (size_t)(row0 + ai * HALF + m * 16) * ldc + col0;
#pragma unroll
                for (int bj = 0; bj < 2; ++bj)
#pragma unroll
                    for (int n = 0; n < 2; ++n) *(f32x4*)(rowp + bj * HALF + n * 16) = acc[ai][bj][m][n] + bv[bj][n]; }
    }
};

__device__ __forceinline__ float fsilu(float x) { return x * __builtin_amdgcn_rcpf(1.0f + __expf(-x)); }
__device__ __forceinline__ float fsigm(float x) { return __builtin_amdgcn_rcpf(1.0f + __expf(-x)); }

struct MoeOrder {
    const PG8_LAS int* tab; int nN, G, c;
    __device__ __forceinline__ bool next(int i, Unit& u) const {
        long L = (long)i * G + c;
#pragma unroll
        for (int e = 0; e < 8; ++e) { const int te = tab[e]; const long n = (long)te * nN; if (L < n) { u.pn = e * nN + (int)(L / te); u.pm = tab[8 + e] + (int)(L % te); return true; } L -= n; }
        return false;
    }
    __device__ __forceinline__ void a_ready(const Unit&) const {}
    __device__ __forceinline__ void done(const Unit&) const {}
};

struct EpiBf16P {
    static constexpr bool PERM = true, AFTER_DRAIN = false;
    bf16_t* O; int ldc; int nN; float scale;
    __device__ __forceinline__ void operator()(const f32x4 (&acc)[2][2][4][2], const Unit& u, int wr, int wc, int fr, int fq) const {
        const int row0 = u.pm * BM + wr * 64 + fr; const int pnr = nN ? (u.pn % nN) : u.pn; const int col0 = pnr * BM + wc * 32 + 8 * fq;
#pragma unroll
        for (int ai = 0; ai < 2; ++ai)
#pragma unroll
            for (int m = 0; m < 4; ++m) { bf16_t* rowp = O + (size_t)(row0 + ai * HALF + m * 16) * ldc + col0;
#pragma unroll
                for (int bj = 0; bj < 2; ++bj) { const f32x4 v0 = acc[ai][bj][m][0] * scale, v1 = acc[ai][bj][m][1] * scale;
                    u32x4 w; w.x = cvt_pk_bf16(v0[0], v0[1]); w.y = cvt_pk_bf16(v0[2], v0[3]); w.z = cvt_pk_bf16(v1[0], v1[1]); w.w = cvt_pk_bf16(v1[2], v1[3]);
                    *(u32x4*)(rowp + bj * HALF) = w; } }
    }
};

struct EpiSwiGLU {
    static constexpr bool PERM = true, AFTER_DRAIN = false;
    bf16_t* O; int ldc; int nN;
    __device__ __forceinline__ void operator()(const f32x4 (&acc)[2][2][4][2], const Unit& u, int wr, int wc, int fr, int fq) const {
        const int row0 = u.pm * BM + wr * 64 + fr; const int pnr = nN ? (u.pn % nN) : u.pn; const int col0 = pnr * HALF + wc * 32 + 8 * fq;
#pragma unroll
        for (int ai = 0; ai < 2; ++ai)
#pragma unroll
            for (int m = 0; m < 4; ++m) { bf16_t* rowp = O + (size_t)(row0 + ai * HALF + m * 16) * ldc + col0;
                const f32x4 g0 = acc[ai][0][m][0], g1 = acc[ai][0][m][1], u0 = acc[ai][1][m][0], u1 = acc[ai][1][m][1];
                f32x4 v0, v1;
#pragma unroll
                for (int j = 0; j < 4; ++j) { v0[j] = fsilu(g0[j]) * u0[j]; v1[j] = fsilu(g1[j]) * u1[j]; }
                u32x4 w; w.x = cvt_pk_bf16(v0[0], v0[1]); w.y = cvt_pk_bf16(v0[2], v0[3]); w.z = cvt_pk_bf16(v1[0], v1[1]); w.w = cvt_pk_bf16(v1[2], v1[3]);
                *(u32x4*)rowp = w; }
    }
};


__device__ __forceinline__ float clamp8(float x) { return fminf(fmaxf(x, -448.0f), 448.0f); }
__device__ __forceinline__ unsigned pk_fp8x4(float a, float b, float c, float d) { int w = __builtin_amdgcn_cvt_pk_fp8_f32(clamp8(a), clamp8(b), 0, false); w = __builtin_amdgcn_cvt_pk_fp8_f32(clamp8(c), clamp8(d), w, true); return (unsigned)w; }
struct EpiSwiGLUS {
    static constexpr bool PERM = true, AFTER_DRAIN = false;
    bf16_t* O; int ldc; int nN; float sin;
    __device__ __forceinline__ void operator()(const f32x4 (&acc)[2][2][4][2], const Unit& u, int wr, int wc, int fr, int fq) const {
        const int row0 = u.pm * BM + wr * 64 + fr; const int pnr = nN ? (u.pn % nN) : u.pn; const int col0 = pnr * HALF + wc * 32 + 8 * fq;
#pragma unroll
        for (int ai = 0; ai < 2; ++ai)
#pragma unroll
            for (int m = 0; m < 4; ++m) { bf16_t* rowp = O + (size_t)(row0 + ai * HALF + m * 16) * ldc + col0;
                const f32x4 g0 = acc[ai][0][m][0] * sin, g1 = acc[ai][0][m][1] * sin, u0 = acc[ai][1][m][0] * sin, u1 = acc[ai][1][m][1] * sin;
                f32x4 v0, v1;
#pragma unroll
                for (int j = 0; j < 4; ++j) { v0[j] = fsilu(g0[j]) * u0[j]; v1[j] = fsilu(g1[j]) * u1[j]; }
                u32x4 w; w.x = cvt_pk_bf16(v0[0], v0[1]); w.y = cvt_pk_bf16(v0[2], v0[3]); w.z = cvt_pk_bf16(v1[0], v1[1]); w.w = cvt_pk_bf16(v1[2], v1[3]);
                *(u32x4*)rowp = w; }
    }
};


struct EpiSwiGLU8 {
    static constexpr bool PERM = true, AFTER_DRAIN = false;
    unsigned char* O; int ldc; int nN; float sin, sout;
    __device__ __forceinline__ void operator()(const f32x4 (&acc)[2][2][4][2], const Unit& u, int wr, int wc, int fr, int fq) const {
        const int row0 = u.pm * BM + wr * 64 + fr; const int pnr = nN ? (u.pn % nN) : u.pn; const int col0 = pnr * HALF + wc * 32 + 8 * fq;
#pragma unroll
        for (int ai = 0; ai < 2; ++ai)
#pragma unroll
            for (int m = 0; m < 4; ++m) { unsigned char* rowp = O + (size_t)(row0 + ai * HALF + m * 16) * ldc + col0;
                const f32x4 g0 = acc[ai][0][m][0] * sin, g1 = acc[ai][0][m][1] * sin, u0 = acc[ai][1][m][0] * (sin * sout), u1 = acc[ai][1][m][1] * (sin * sout);
                f32x4 v0, v1;
#pragma unroll
                for (int j = 0; j < 4; ++j) { v0[j] = fsilu(g0[j]) * u0[j]; v1[j] = fsilu(g1[j]) * u1[j]; }
                uint2 w; w.x = pk_fp8x4(v0[0], v0[1], v0[2], v0[3]); w.y = pk_fp8x4(v1[0], v1[1], v1[2], v1[3]);
                *(uint2*)rowp = w; }
    }
};


struct EpiF32S {
    static constexpr bool PERM = false, AFTER_DRAIN = false;
    float* C; int ldc; float scale;
    __device__ __forceinline__ void operator()(const f32x4 (&acc)[2][2][4][2], const Unit& u, int wr, int wc, int fr, int fq) const {
        const int row0 = u.pm * BM + wr * 64 + fr, col0 = u.pn * BM + wc * 32 + 4 * fq;
#pragma unroll
        for (int ai = 0; ai < 2; ++ai)
#pragma unroll
            for (int m = 0; m < 4; ++m) { float* rowp = C + (size_t)(row0 + ai * HALF + m * 16) * ldc + col0;
#pragma unroll
                for (int bj = 0; bj < 2; ++bj)
#pragma unroll
                    for (int n = 0; n < 2; ++n) *(f32x4*)(rowp + bj * HALF + n * 16) = acc[ai][bj][m][n] * scale; }
    }
};

template <class Epi, class Sched, bool STAMP = false, bool F8 = false>
__device__ __forceinline__ void gemm_phase(PG8_LAS unsigned char* lds, const Gemm g, const Sched& S, const Epi& E, unsigned long long* stamps, const int tid_in) {
    const int tid = opq(tid_in), wid = __builtin_amdgcn_readfirstlane(tid >> 6), lane = tid & 63, wr = wid >> 2, wc = wid & 3, fr = lane & 15, fq = lane >> 4;
    const int K = g.K, nt = K / BK;
    int ts_lo = 0, ts_hi = 0, nts = 0; const unsigned long long rt_entry = STAMP ? (unsigned long long)wall_clock64() : 0ull;
#define PG8_STAMP() do { if (STAMP && wid == 0 && nts < 64) { const unsigned long long _c = (unsigned long long)clock64(); \
        ts_lo = (lane == nts) ? (int)(unsigned)_c : ts_lo; ts_hi = (lane == nts) ? (int)(unsigned)(_c >> 32) : ts_hi; ++nts; } } while (0)
    PG8_STAMP();
    unsigned voffA[2], voffB[2];
#pragma unroll
    for (int i = 0; i < 2; ++i) { int R, C; stage_rc(tid * 16 + i * 8192, R, C); const int Rb = Epi::PERM ? ((R & ~31) + perm32(R & 31)) : R;
        voffA[i] = (unsigned)(R * K + C) * 2u; voffB[i] = (unsigned)(Rb * K + C) * 2u; }
    const size_t kstep = (size_t)(BK * 2);
    const size_t qstep = (size_t)64 * K * 2;
    const size_t hstep = (size_t)HALF * K * 2;
    const size_t tstep = 2 * hstep;
    const unsigned ldsw = (unsigned)wid * 1024u;
    const int aoff = lds_byte(wr * 64 + fr, fq * 8), boff = lds_byte(wc * 32 + fr, fq * 8);
#define PG8_SA(b, h) (((b) * 2 + (h)) * HTB)
#define PG8_SB(b, h) ((4 + (b) * 2 + (h)) * HTB)
#define PG8_STAGE(bufoff, gbase, voff) do { _Pragma("unroll") for (int _i = 0; _i < 2; ++_i) \
        __builtin_amdgcn_global_load_lds((const unsigned*)((const char*)(gbase) + (size_t)_i * qstep + (voff)[0]), (PG8_LAS unsigned*)(lds + (bufoff) + ldsw + _i * 8192), 16, 0, 0); } while (0)
#define PG8_LDA(dst, b, h) do { _Pragma("unroll") for (int m = 0; m < 4; ++m) { if constexpr (F8) { const i32x4 lo_ = *(const PG8_LAS i32x4*)(lds + PG8_SA(b, h) + aoff + m * 2048), hi_ = *(const PG8_LAS i32x4*)(lds + PG8_SA(b, h) + aoff + m * 2048 + 1024); \
            dst##8[m] = __builtin_shufflevector(lo_, hi_, 0, 1, 2, 3, 4, 5, 6, 7); } else { _Pragma("unroll") for (int k = 0; k < 2; ++k) dst[m][k] = *(const PG8_LAS bf16x8*)(lds + PG8_SA(b, h) + aoff + m * 2048 + k * 1024); } } } while (0)
#define PG8_LDB(dst, b, h) do { _Pragma("unroll") for (int n = 0; n < 2; ++n) { if constexpr (F8) { const i32x4 lo_ = *(const PG8_LAS i32x4*)(lds + PG8_SB(b, h) + boff + n * 2048), hi_ = *(const PG8_LAS i32x4*)(lds + PG8_SB(b, h) + boff + n * 2048 + 1024); \
            dst##8[n] = __builtin_shufflevector(lo_, hi_, 0, 1, 2, 3, 4, 5, 6, 7); } else { _Pragma("unroll") for (int k = 0; k < 2; ++k) dst[n][k] = *(const PG8_LAS bf16x8*)(lds + PG8_SB(b, h) + boff + n * 2048 + k * 1024); } } } while (0)
#define PG8_MMA(ai, bj, At, Bt) do { __builtin_amdgcn_s_setprio(1); _Pragma("unroll") for (int m = 0; m < 4; ++m) _Pragma("unroll") for (int n = 0; n < 2; ++n) { \
        if constexpr (F8) {   \
            asm volatile("v_mfma_scale_f32_16x16x128_f8f6f4 %0, %1, %2, %0, %3, %3 op_sel_hi:[0,0,0]" : "+v"(acc[ai][bj][m][n]) : "v"(Bt##8[n]), "v"(At##8[m]), "v"(f8scale)); } \
        else { _Pragma("unroll") for (int k = 0; k < 2; ++k) acc[ai][bj][m][n] = __builtin_amdgcn_mfma_f32_16x16x32_bf16(Bt[n][k], At[m][k], acc[ai][bj][m][n], 0, 0, 0); } } \
        __builtin_amdgcn_s_setprio(0); } while (0)
#define PG8_WAIT_V(n) asm volatile("s_waitcnt vmcnt(" #n ")" ::: "memory")
#define PG8_WAIT_L(n) asm volatile("s_waitcnt lgkmcnt(" #n ")" ::: "memory")
#define PG8_BAR __builtin_amdgcn_s_barrier()
#define PG8_SCHED __builtin_amdgcn_sched_barrier(0)
    float zf_ = 0.f; asm volatile("" : "+v"(zf_));
    Unit cur, nxt; int ui = 0;
    if (!S.next(0, cur)) return;
    f32x4 acc[2][2][4][2];
#pragma unroll
    for (int a = 0; a < 2; ++a)
#pragma unroll
        for (int b = 0; b < 2; ++b)
#pragma unroll
            for (int m = 0; m < 4; ++m)
#pragma unroll
                for (int n = 0; n < 2; ++n) acc[a][b][m][n] = (f32x4){zf_, zf_, zf_, zf_};
    int f8scale = 0x7F7F7F7F; asm volatile("" : "+v"(f8scale));
    bf16x8 At[4][2], B0[2][2], B1[2][2]; i32x8 At8[4], B08[2], B18[2]; (void)At; (void)B0; (void)B1; (void)At8; (void)B08; (void)B18;
    const char* cA = (const char*)g.A + (size_t)cur.pm * tstep; const char* cB = (const char*)g.Bt + (size_t)cur.pn * tstep;
    S.a_ready(cur);
    PG8_STAGE(PG8_SB(0, 0), cB, voffB); PG8_STAGE(PG8_SA(0, 0), cA, voffA); PG8_STAGE(PG8_SB(0, 1), cB + hstep, voffB); PG8_STAGE(PG8_SA(0, 1), cA + hstep, voffA);
    if (wr == 1) PG8_BAR;
    PG8_WAIT_V(4); PG8_BAR;
    PG8_STAGE(PG8_SB(1, 0), cB + kstep, voffB); PG8_STAGE(PG8_SA(1, 0), cA + kstep, voffA); PG8_STAGE(PG8_SB(1, 1), cB + hstep + kstep, voffB);
    PG8_WAIT_V(6); PG8_BAR;
    PG8_STAMP();
    for (;;) {
        const bool has_next = S.next(ui + 1, nxt);
        const char* nA = has_next ? (const char*)g.A + (size_t)nxt.pm * tstep : cA; const char* nB = has_next ? (const char*)g.Bt + (size_t)nxt.pn * tstep : cB;
        for (int t = 0; t < nt; t += 2) {
            const bool last = (t == nt - 2);
            const char* a1 = cA + (size_t)(t + 1) * kstep;
            const char* a2 = last ? nA : cA + (size_t)(t + 2) * kstep; const char* b2 = last ? nB : cB + (size_t)(t + 2) * kstep;
            const char* a3 = a2 + kstep; const char* b3 = b2 + kstep;
            if (last && has_next) S.a_ready(nxt);
            PG8_LDB(B0, 0, 0); PG8_SCHED; PG8_LDA(At, 0, 0); PG8_STAGE(PG8_SA(1, 1), a1 + hstep, voffA);
            PG8_WAIT_L(8); PG8_BAR; PG8_WAIT_L(0); PG8_MMA(0, 0, At, B0); PG8_BAR; PG8_SCHED;
            PG8_LDB(B1, 0, 1); PG8_STAGE(PG8_SB(0, 0), b2, voffB);
            PG8_BAR; PG8_WAIT_L(0); PG8_MMA(0, 1, At, B1); PG8_BAR;
            PG8_LDA(At, 0, 1); PG8_STAGE(PG8_SA(0, 0), a2, voffA);
            PG8_BAR; PG8_WAIT_L(0); PG8_MMA(1, 0, At, B0); PG8_BAR; PG8_SCHED;
            PG8_STAGE(PG8_SB(0, 1), b2 + hstep, voffB);
            PG8_WAIT_V(6); PG8_BAR; PG8_MMA(1, 1, At, B1); PG8_BAR;
            PG8_LDB(B0, 1, 0); PG8_SCHED; PG8_LDA(At, 1, 0); PG8_STAGE(PG8_SA(0, 1), a2 + hstep, voffA);
            PG8_WAIT_L(8); PG8_BAR; PG8_WAIT_L(0); PG8_MMA(0, 0, At, B0); PG8_BAR; PG8_SCHED;
            PG8_LDB(B1, 1, 1); PG8_STAGE(PG8_SB(1, 0), b3, voffB);
            PG8_BAR; PG8_WAIT_L(0); PG8_MMA(0, 1, At, B1); PG8_BAR;
            PG8_LDA(At, 1, 1); PG8_STAGE(PG8_SA(1, 0), a3, voffA);
            PG8_BAR; PG8_WAIT_L(0); PG8_MMA(1, 0, At, B0); PG8_BAR; PG8_SCHED;
            PG8_STAGE(PG8_SB(1, 1), b3 + hstep, voffB);
            PG8_WAIT_V(6); PG8_BAR; PG8_MMA(1, 1, At, B1); PG8_BAR;
        }
        PG8_STAMP();
        if constexpr (F8) { asm volatile("s_nop 15\n\ts_nop 15" ::: "memory"); }
        if constexpr (!Epi::AFTER_DRAIN) { E(acc, cur, wr, wc, fr, fq); S.done(cur); }
        PG8_STAMP();
        if (!has_next) break;
#pragma unroll
        for (int a = 0; a < 2; ++a)
#pragma unroll
            for (int b = 0; b < 2; ++b)
#pragma unroll
                for (int m = 0; m < 4; ++m)
#pragma unroll
                    for (int n = 0; n < 2; ++n) acc[a][b][m][n] = (f32x4){zf_, zf_, zf_, zf_};
        cur = nxt; cA = nA; cB = nB; ++ui;
    }
    PG8_WAIT_V(0);
    if (wr == 0) PG8_BAR;
    PG8_BAR;
    if constexpr (Epi::AFTER_DRAIN) { E.fused(acc, cur, wr, wc, fr, fq, lds, wid, lane); S.done(cur); }
    PG8_STAMP();
    if (STAMP && wid == 0) { stamps[lane] = lane < nts ? (((unsigned long long)(unsigned)ts_hi << 32) | (unsigned)ts_lo) : 0ull;
        if (lane == 62) stamps[62] = rt_entry; if (lane == 63) stamps[63] = (unsigned long long)wall_clock64(); }
#undef PG8_STAMP
#undef PG8_SA
#undef PG8_SB
#undef PG8_STAGE
#undef PG8_LDA
#undef PG8_LDB
#undef PG8_MMA
#undef PG8_WAIT_V
#undef PG8_WAIT_L
#undef PG8_BAR
#undef PG8_SCHED
}
}
#define RLX_AGENT __ATOMIC_RELAXED, __HIP_MEMORY_SCOPE_AGENT
#define XB_TMO      128
#define XB_XCNT(j)  (256  + 64 * (j))
#define XB_XSUB(j)  (1280 + 64 * (j))
#define XB_XGEN(j)  (2304 + 64 * (j))
#define XB_TOP      3328
#define XB_TOPGEN   3392
#define XCD_BAR_WORDS 3456
#define XB_SPIN_CAP (1u << 18)

__device__ __forceinline__ unsigned xb_ld(unsigned* p)              { return __hip_atomic_load(p, __ATOMIC_RELAXED, __HIP_MEMORY_SCOPE_AGENT); }
__device__ __forceinline__ unsigned xb_add(unsigned* p, unsigned v) { return __hip_atomic_fetch_add(p, v, __ATOMIC_RELAXED, __HIP_MEMORY_SCOPE_AGENT); }
__device__ __forceinline__ unsigned xb_xcc_id() { return (unsigned)__builtin_amdgcn_s_getreg((3 << 11) | 20) & 0xFu; }
#define XB_SPIN(cond, bar) do { unsigned _sp = 0; while (cond) { __builtin_amdgcn_s_sleep(1); \
    if ((++_sp & 255u) == 0u) { if (xb_ld(&(bar)[XB_TMO])) break; if (_sp > XB_SPIN_CAP) { atomicAdd(&(bar)[XB_TMO], 1u); break; } } } } while (0)

struct XcdBarrier {
    unsigned* bar; unsigned x; int wv;
    volatile LAS unsigned* st;
};

__device__ __forceinline__ XcdBarrier xcd_barrier_post(unsigned* bar, volatile LAS unsigned* st) {
    XcdBarrier b; b.bar = bar; b.x = xb_xcc_id(); b.st = st; b.wv = __builtin_amdgcn_readfirstlane((int)threadIdx.x >> 6);
    if (threadIdx.x == 0) (void)xb_add(&bar[XB_XCNT(b.x)], 1u);
    return b;
}
__device__ __forceinline__ void xcd_barrier_complete(unsigned* bar, unsigned x, unsigned& nloc, unsigned& nx) {
    const unsigned G = gridDim.x * gridDim.y * gridDim.z;
    unsigned sum, cnt, mine, sp = 0u;
    for (;;) {
        sum = 0u; cnt = 0u; mine = 0u;
#pragma unroll
        for (unsigned j = 0; j < 16; ++j) { const unsigned c = xb_ld(&bar[XB_XCNT(j)]); sum += c; cnt += (c > 0u) ? 1u : 0u; mine = (j == x) ? c : mine; }
        if (sum == G) break;
        __builtin_amdgcn_s_sleep(1);
        if ((++sp & 255u) == 0u) { if (xb_ld(&bar[XB_TMO])) break; if (sp > XB_SPIN_CAP) { atomicAdd(&bar[XB_TMO], 1u); break; } }
    }
    nloc = mine > 0u ? mine : 1u; nx = cnt > 0u ? cnt : 1u;
}

__device__ __forceinline__ void xcd_barrier(const XcdBarrier& b) {
    asm volatile("s_waitcnt vmcnt(0)" ::: "memory");
    __syncthreads();
    if (((b.wv << 6) | lane_v()) == 0) {
        unsigned* bar = b.bar;
        __builtin_amdgcn_s_waitcnt(0);
        unsigned nloc = b.st[0], nx = b.st[1];
        if (nloc == 0u) { xcd_barrier_complete(bar, b.x, nloc, nx); b.st[0] = nloc; b.st[1] = nx; }
        const unsigned old = xb_add(&bar[XB_XSUB(b.x)], 1u);
        const unsigned gen = old / nloc;
        if (old + 1u == (gen + 1u) * nloc) {
            __builtin_amdgcn_fence(__ATOMIC_RELEASE, "agent");
            asm volatile("s_waitcnt vmcnt(0)" ::: "memory");
            const unsigned og = xb_add(&bar[XB_TOP], 1u);
            const unsigned tg = og / nx;
            if (og + 1u == (tg + 1u) * nx) xb_add(&bar[XB_TOPGEN], 1u);
            else XB_SPIN(xb_ld(&bar[XB_TOPGEN]) == tg, bar);
            __builtin_amdgcn_fence(__ATOMIC_ACQUIRE, "agent");
            xb_add(&bar[XB_XGEN(b.x)], 1u);
            asm volatile("s_waitcnt vmcnt(0)" ::: "memory");
        } else {
            XB_SPIN(xb_ld(&bar[XB_XGEN(b.x)]) == gen, bar);
            __builtin_amdgcn_fence(__ATOMIC_ACQUIRE, "agent");
            asm volatile("s_waitcnt vmcnt(0)" ::: "memory");
        }
    }
    __syncthreads();
}

typedef unsigned short bf16;
using pg8::bf16x8; using pg8::f32x4; using pg8::u32x4;
typedef unsigned u32x2 __attribute__((ext_vector_type(2)));
constexpr int NT = 512, NW = 8;
constexpr int DM = 2048, NB = 8, SEQ = 2048, CTXL = 256;
constexpr int MLAT = NB * SEQ, MCTX = NB * CTXL, MTOT = MLAT + MCTX;
constexpr int NIN = 5920, NINP = 6144;
constexpr int C_RW_R = 0, C_RW_K = 512, C_RW_V = 1024, C_RW_XW = 1536;
constexpr int C_MB_Z = 1792, C_MB_XBC = 2816, C_MB_DT = 4352;
constexpr int C_DA_Q = 4384, C_DA_V = 5408;
constexpr int FF = 5632, FE = 7168, NE = 8;
constexpr int MOE_ROWS = 34816;
constexpr int LDS_STAGE = 131072, LDS_MISC = 1024, LDS_BYTES = LDS_STAGE + LDS_MISC;

#ifndef MOE_FP8
#define MOE_FP8 1
#endif
#ifndef DENSE_GU8
#define DENSE_GU8 1
#endif
#ifndef DENSE_D8
#define DENSE_D8 0
#endif
constexpr float MOE_SGU = 32.0f, MOE_SD = 64.0f, MOE_SH = 4.0f;
constexpr size_t MiB = 1048576;
constexpr size_t WS_CTL   = 0;
constexpr size_t CTL_BYTES = 65536;
constexpr size_t CW_BAR = 0, CW_CNT = 4096  , CW_Q = 8192  , CW_BG = 8704  , CW_DONE = 9216  ;
constexpr size_t WS_ADA   = 1 * MiB;
constexpr size_t WS_ROPE  = 2 * MiB;
constexpr size_t WS_TOK   = 3 * MiB;
constexpr size_t WS_WIN   = 4 * MiB;
constexpr size_t WS_WOUT  = WS_WIN  + 48 * MiB;
constexpr size_t WS_WSM   = WS_WOUT + 16 * MiB;
constexpr size_t WS_WGU   = WS_WSM  + 2 * MiB;
constexpr size_t WS_WD    = WS_WGU  + 44 * MiB;
constexpr size_t WS_MGU   = WS_WD   + 22 * MiB;
constexpr size_t WS_MD    = WS_MGU  + 448 * MiB;
constexpr size_t WS_XC    = WS_MD   + 224 * MiB;
constexpr size_t WS_HA    = WS_XC   + 16 * MiB;
constexpr size_t WS_U     = WS_HA   + 72 * MiB;
constexpr size_t WS_MIX   = WS_U    + 216 * MiB;
constexpr size_t WS_BIG   = WS_MIX  + 144 * MiB;
constexpr size_t WS_XSB   = WS_BIG  + 476 * MiB;
constexpr size_t WS_END   = WS_XSB  + 64 * MiB;
constexpr size_t WS_ASM   = WS_BIG;
constexpr size_t WS_XBC   = WS_ASM  + 9 * MiB;
constexpr size_t WS_DT    = WS_XBC  + 54 * MiB;
constexpr size_t WS_QK    = WS_DT   + 5 * MiB;
constexpr size_t WS_RW5   = WS_QK   + 36 * MiB;
constexpr size_t WS_YR    = WS_RW5  + 90 * MiB;
constexpr size_t WS_YM    = WS_YR   + 72 * MiB;
constexpr size_t WS_ST    = WS_YM   + 72 * MiB;
constexpr size_t WS_AC    = WS_ST   + 72 * MiB;
static_assert(WS_AC + 1 * MiB <= WS_END, "mixer intermediates overflow BIG");
static_assert((size_t)MOE_ROWS * FE * 2 <= 476 * MiB && (size_t)MOE_ROWS * DM * 2 <= 144 * MiB, "moe buffers");

struct Args { const float* in[38]; float* out; unsigned char* ws; int ph_lo, ph_hi, sub, pad; };
struct Ctx { unsigned char* ws; int wv; int sub; };

constexpr int LDS_PTRS = LDS_STAGE + 128;
__device__ __forceinline__ const float* ldin(int k) {
    extern __shared__ __attribute__((aligned(16))) unsigned char lds_dyn[];
    const int base = opqs((int)(unsigned)(unsigned long long)(LAS unsigned char*)lds_dyn);
    const LAS unsigned* p = (const LAS unsigned*)(unsigned long long)(unsigned)(base + LDS_PTRS + 8 * k);
    const unsigned lo = __builtin_amdgcn_readfirstlane(p[0]), hi = __builtin_amdgcn_readfirstlane(p[1]);
    return (const float*)(const GAS float*)(((unsigned long long)hi << 32) | (unsigned long long)lo);
}
__device__ __forceinline__ float bf2f(unsigned short b) { return __uint_as_float(((unsigned)b) << 16); }
typedef float f32x2_t __attribute__((ext_vector_type(2)));
typedef __bf16 bf16x2_t __attribute__((ext_vector_type(2)));
__device__ __forceinline__ unsigned pk2(float lo, float hi) { const f32x2_t v = {lo, hi}; return __builtin_bit_cast(unsigned, __builtin_convertvector(v, bf16x2_t)); }
__device__ __forceinline__ unsigned f2bf(float f) { return pk2(f, f) & 0xffffu; }
__device__ __forceinline__ void unpack8(const uint4 w, float (&f)[8]) {
    f[0] = __uint_as_float(w.x << 16); f[1] = __uint_as_float(w.x & 0xffff0000u); f[2] = __uint_as_float(w.y << 16); f[3] = __uint_as_float(w.y & 0xffff0000u);
    f[4] = __uint_as_float(w.z << 16); f[5] = __uint_as_float(w.z & 0xffff0000u); f[6] = __uint_as_float(w.w << 16); f[7] = __uint_as_float(w.w & 0xffff0000u); }
__device__ __forceinline__ uint4 pack8(const float (&f)[8]) { uint4 w; w.x = pk2(f[0], f[1]); w.y = pk2(f[2], f[3]); w.z = pk2(f[4], f[5]); w.w = pk2(f[6], f[7]); return w; }
__device__ __forceinline__ void unpack4(const uint2 w, float (&f)[4]) {
    f[0] = __uint_as_float(w.x << 16); f[1] = __uint_as_float(w.x & 0xffff0000u); f[2] = __uint_as_float(w.y << 16); f[3] = __uint_as_float(w.y & 0xffff0000u); }
template <int CTRL> __device__ __forceinline__ float dppf(float v) { return __int_as_float(__builtin_amdgcn_update_dpp(0, __float_as_int(v), CTRL, 0xf, 0xf, false)); }
__device__ __forceinline__ float red8(float v)  { v += dppf<0xB1>(v); v += dppf<0x4E>(v); v += dppf<0x141>(v); return v; }
__device__ __forceinline__ float red16(float v) { v += dppf<0xB1>(v); v += dppf<0x4E>(v); v += dppf<0x141>(v); v += dppf<0x140>(v); return v; }
__device__ __forceinline__ float swz16(float v) { return __int_as_float(__builtin_amdgcn_ds_swizzle(__float_as_int(v), 0x401F)); }
__device__ __forceinline__ float red32(float v) { v = red16(v); v += swz16(v); return v; }
__device__ __forceinline__ float wsum(float v) { v = red32(v); return __int_as_float(__builtin_amdgcn_readlane(__float_as_int(v), 0)) + __int_as_float(__builtin_amdgcn_readlane(__float_as_int(v), 32)); }
__device__ __forceinline__ float shx32(float v, int lane) { return __int_as_float(__builtin_amdgcn_ds_bpermute((lane ^ 32) << 2, __float_as_int(v))); }
__device__ __forceinline__ float fsilu(float x) { return pg8::fsilu(x); }
__device__ __forceinline__ float fsigm(float x) { return pg8::fsigm(x); }
__device__ __forceinline__ float softplusf(float x) { return fmaxf(x, 0.f) + log1pf(__expf(-fabsf(x))); }


template <bool F8>
__device__ __forceinline__ void cvt_job_t(const float* __restrict__ src, int ld, int ncols_valid, int ncols_total, void* __restrict__ dstv, int K, int mode, float scale, LAS float* tile, int bid, int G, const int tid, int t_end = 0x7fffffff) {
    const int ntn = ncols_total >> 6, ntk = K >> 7; const int nt = (ntn * ntk) < t_end ? (ntn * ntk) : t_end;
    const int lk = tid >> 4, lc = (tid & 15) * 4;
    constexpr int TP = 65;
    float4 r[4]; int buf = 0;
    const float4 z4 = make_float4(0.f, 0.f, 0.f, 0.f);
#define CVT_LOAD(t_, dst_) do { const int tn_ = (t_) % ntn, tk_ = (t_) / ntn; const int n_ = tn_ * 64 + lc; const float* p_ = src + (size_t)(tk_ * 128 + lk) * ld + n_; \
        _Pragma("unroll") for (int i_ = 0; i_ < 4; ++i_) dst_[i_] = (n_ < ncols_valid) ? *(const float4*)(p_ + (size_t)(32 * i_) * ld) : z4; } while (0)
    int t = bid;
    if (t < nt) CVT_LOAD(t, r);
    __syncthreads();
    for (; t < nt; t += G) {
        float4 nx[4] = {z4, z4, z4, z4};
        if (t + G < nt) CVT_LOAD(t + G, nx);
        LAS float* tl = tile + buf * (128 * TP);
#pragma unroll
        for (int i = 0; i < 4; ++i) { LAS float* q = tl + (lk + 32 * i) * TP + lc; q[0] = r[i].x; q[1] = r[i].y; q[2] = r[i].z; q[3] = r[i].w; }
        __syncthreads();
        const int tn = t % ntn, tk = t / ntn, k0 = tk * 128, nb = tn * 64;
        const int kq = tid & 7, nl = tid >> 3, nn = nb + nl;
        const int drow = mode == 0 ? nn : ((nn >> 7) * 256 + (nn & 127) + (mode == 2 ? 128 : 0));
        const LAS float* c = tl + (kq * 16) * TP + nl;
        if (F8) {
            uint4 w;
            w.x = pg8::pk_fp8x4(c[0 * TP] * scale, c[1 * TP] * scale, c[2 * TP] * scale, c[3 * TP] * scale); w.y = pg8::pk_fp8x4(c[4 * TP] * scale, c[5 * TP] * scale, c[6 * TP] * scale, c[7 * TP] * scale);
            w.z = pg8::pk_fp8x4(c[8 * TP] * scale, c[9 * TP] * scale, c[10 * TP] * scale, c[11 * TP] * scale); w.w = pg8::pk_fp8x4(c[12 * TP] * scale, c[13 * TP] * scale, c[14 * TP] * scale, c[15 * TP] * scale);
            *(uint4*)((unsigned char*)dstv + (size_t)drow * K + k0 + kq * 16) = w;
        } else {
            uint4 w0, w1;
            w0.x = pk2(c[0 * TP], c[1 * TP]); w0.y = pk2(c[2 * TP], c[3 * TP]); w0.z = pk2(c[4 * TP], c[5 * TP]); w0.w = pk2(c[6 * TP], c[7 * TP]);
            w1.x = pk2(c[8 * TP], c[9 * TP]); w1.y = pk2(c[10 * TP], c[11 * TP]); w1.z = pk2(c[12 * TP], c[13 * TP]); w1.w = pk2(c[14 * TP], c[15 * TP]);
            uint4* q = (uint4*)((bf16*)dstv + (size_t)drow * K + k0 + kq * 16); q[0] = w0; q[1] = w1;
        }
#pragma unroll
        for (int i = 0; i < 4; ++i) r[i] = nx[i];
        buf ^= 1;
    }
#undef CVT_LOAD
}
__device__ __forceinline__ void cvt_job_f8(const float* __restrict__ src, int ld, int ncols, unsigned char* __restrict__ dst, int K, int mode, float scale, LAS unsigned char* tile, int t_begin, int t_end, const int tid) {
    const int ntn = ncols >> 6;
    const int q = tid >> 4, i4 = tid & 15;
    constexpr int TP = 144;
    float4 r[4]; int buf = 0;
#define CVT8_LOAD(t_, dst_) do { const int tn_ = (t_) % ntn, tk_ = (t_) / ntn; const float* p_ = src + (size_t)(tk_ * 128 + 4 * q) * ld + tn_ * 64 + 4 * i4; \
        _Pragma("unroll") for (int j_ = 0; j_ < 4; ++j_) dst_[j_] = *(const float4*)(p_ + (size_t)j_ * ld); } while (0)
    int t = t_begin;
    if (t < t_end) CVT8_LOAD(t, r);
    __syncthreads();
    for (; t < t_end; ++t) {
        float4 nx[4];
#pragma unroll
        for (int j = 0; j < 4; ++j) nx[j] = r[j];
        if (t + 1 < t_end) CVT8_LOAD(t + 1, nx);
        unsigned w[4];
#pragma unroll
        for (int j = 0; j < 4; ++j) w[j] = pg8::pk_fp8x4(r[j].x * scale, r[j].y * scale, r[j].z * scale, r[j].w * scale);
        const unsigned a_lo = __builtin_amdgcn_perm(w[1], w[0], 0x05010400u), a_hi = __builtin_amdgcn_perm(w[1], w[0], 0x07030602u);
        const unsigned b_lo = __builtin_amdgcn_perm(w[3], w[2], 0x05010400u), b_hi = __builtin_amdgcn_perm(w[3], w[2], 0x07030602u);
        unsigned o[4];
        o[0] = __builtin_amdgcn_perm(b_lo, a_lo, 0x05040100u); o[1] = __builtin_amdgcn_perm(b_lo, a_lo, 0x07060302u);
        o[2] = __builtin_amdgcn_perm(b_hi, a_hi, 0x05040100u); o[3] = __builtin_amdgcn_perm(b_hi, a_hi, 0x07060302u);
        LAS unsigned char* tl = tile + buf * (64 * TP);
        const int cw = ((q >> 2) ^ (i4 & 7)) * 16 + (q & 3) * 4;
#pragma unroll
        for (int m = 0; m < 4; ++m) *(LAS unsigned*)(tl + (4 * i4 + m) * TP + cw) = o[m];
        __syncthreads();
        const int tn = t % ntn, tk = t / ntn, k0 = tk * 128, nb = tn * 64;
        const int kq = tid & 7, nl = tid >> 3, nn = nb + nl;
        const int drow = mode == 0 ? nn : ((nn >> 7) * 256 + (nn & 127) + (mode == 2 ? 128 : 0));
        const u32x4 v = *(const LAS u32x4*)(tl + nl * TP + ((kq ^ ((nl >> 2) & 7)) * 16));
        *(uint4*)(dst + (size_t)drow * K + k0 + kq * 16) = make_uint4(v.x, v.y, v.z, v.w);
#pragma unroll
        for (int j = 0; j < 4; ++j) r[j] = nx[j];
        buf ^= 1;
    }
#undef CVT8_LOAD
}
__device__ __forceinline__ void cvt_job_b16(const float* __restrict__ src, int ld, int ncols_valid, int ncols_total, bf16* __restrict__ dst, int K, int mode, LAS unsigned char* tile, int t_begin, int t_end, const int tid) {
    const int ntn = ncols_total >> 6;
    const int q = tid >> 4, i4 = tid & 15;
    constexpr int TP = 272;
    const float4 z4 = make_float4(0.f, 0.f, 0.f, 0.f);
    float4 r[4]; int buf = 0;
#define CVTB_LOAD(t_, dst_) do { const int tn_ = (t_) % ntn, tk_ = (t_) / ntn; const int n_ = tn_ * 64 + 4 * i4; const float* p_ = src + (size_t)(tk_ * 128 + 4 * q) * ld + n_; \
        _Pragma("unroll") for (int j_ = 0; j_ < 4; ++j_) dst_[j_] = (n_ < ncols_valid) ? *(const float4*)(p_ + (size_t)j_ * ld) : z4; } while (0)
    int t = t_begin;
    if (t < t_end) CVTB_LOAD(t, r);
    __syncthreads();
    for (; t < t_end; ++t) {
        float4 nx[4];
#pragma unroll
        for (int j = 0; j < 4; ++j) nx[j] = r[j];
        if (t + 1 < t_end) CVTB_LOAD(t + 1, nx);
        LAS unsigned char* tl = tile + buf * (64 * TP);
        *(LAS u32x2*)(tl + (4 * i4 + 0) * TP + 8 * q) = (u32x2){pk2(r[0].x, r[1].x), pk2(r[2].x, r[3].x)};
        *(LAS u32x2*)(tl + (4 * i4 + 1) * TP + 8 * q) = (u32x2){pk2(r[0].y, r[1].y), pk2(r[2].y, r[3].y)};
        *(LAS u32x2*)(tl + (4 * i4 + 2) * TP + 8 * q) = (u32x2){pk2(r[0].z, r[1].z), pk2(r[2].z, r[3].z)};
        *(LAS u32x2*)(tl + (4 * i4 + 3) * TP + 8 * q) = (u32x2){pk2(r[0].w, r[1].w), pk2(r[2].w, r[3].w)};
        __syncthreads();
        const int tn = t % ntn, tk = t / ntn, k0 = tk * 128, nb = tn * 64;
        const int kq = tid & 7, nl = tid >> 3, nn = nb + nl;
        const int drow = mode == 0 ? nn : ((nn >> 7) * 256 + (nn & 127) + (mode == 2 ? 128 : 0));
        const u32x4 v0 = *(const LAS u32x4*)(tl + nl * TP + kq * 16), v1 = *(const LAS u32x4*)(tl + nl * TP + 128 + kq * 16);
        bf16* o = dst + (size_t)drow * K + k0 + kq * 8;
        *(uint4*)o = make_uint4(v0.x, v0.y, v0.z, v0.w); *(uint4*)(o + 64) = make_uint4(v1.x, v1.y, v1.z, v1.w);
#pragma unroll
        for (int j = 0; j < 4; ++j) r[j] = nx[j];
        buf ^= 1;
    }
#undef CVTB_LOAD
}
template <int NTB, int D>
__device__ __forceinline__ void cvt_job_f8d(const float* __restrict__ src, int ld, int ncols, unsigned char* __restrict__ dst, int K, int mode, float scale, LAS unsigned char* tile, int t_begin, const int tid) {
    const int ntn = ncols >> 6;
    const int q = tid >> 4, i4 = tid & 15;
    constexpr int TP = 144;
    float4 r[D][4];
#define CVT8_LOAD(t_, dst_) do { const int tn_ = (t_) % ntn, tk_ = (t_) / ntn; const float* p_ = src + (size_t)(tk_ * 128 + 4 * q) * ld + tn_ * 64 + 4 * i4; \
        _Pragma("unroll") for (int j_ = 0; j_ < 4; ++j_) dst_[j_] = *(const float4*)(p_ + (size_t)j_ * ld); } while (0)
#pragma unroll
    for (int d = 0; d < D; ++d) CVT8_LOAD(t_begin + d, r[d]);
    __syncthreads();
#pragma unroll
    for (int i = 0; i < NTB; ++i) {
        const int t = t_begin + i;
        unsigned w[4];
#pragma unroll
        for (int j = 0; j < 4; ++j) w[j] = pg8::pk_fp8x4(r[i % D][j].x * scale, r[i % D][j].y * scale, r[i % D][j].z * scale, r[i % D][j].w * scale);
        if (i + D < NTB) CVT8_LOAD(t + D, r[i % D]);
        const unsigned a_lo = __builtin_amdgcn_perm(w[1], w[0], 0x05010400u), a_hi = __builtin_amdgcn_perm(w[1], w[0], 0x07030602u);
        const unsigned b_lo = __builtin_amdgcn_perm(w[3], w[2], 0x05010400u), b_hi = __builtin_amdgcn_perm(w[3], w[2], 0x07030602u);
        unsigned o[4];
        o[0] = __builtin_amdgcn_perm(b_lo, a_lo, 0x05040100u); o[1] = __builtin_amdgcn_perm(b_lo, a_lo, 0x07060302u);
        o[2] = __builtin_amdgcn_perm(b_hi, a_hi, 0x05040100u); o[3] = __builtin_amdgcn_perm(b_hi, a_hi, 0x07060302u);
        LAS unsigned char* tl = tile + (i & 1) * (64 * TP);
        const int cw = ((q >> 2) ^ (i4 & 7)) * 16 + (q & 3) * 4;
#pragma unroll
        for (int m = 0; m < 4; ++m) *(LAS unsigned*)(tl + (4 * i4 + m) * TP + cw) = o[m];
        __syncthreads();
        const int tn = t % ntn, tk = t / ntn, k0 = tk * 128, nb = tn * 64;
        const int kq = tid & 7, nl = tid >> 3, nn = nb + nl;
        const int drow = mode == 0 ? nn : ((nn >> 7) * 256 + (nn & 127) + (mode == 2 ? 128 : 0));
        const u32x4 v = *(const LAS u32x4*)(tl + nl * TP + ((kq ^ ((nl >> 2) & 7)) * 16));
        *(uint4*)(dst + (size_t)drow * K + k0 + kq * 16) = make_uint4(v.x, v.y, v.z, v.w);
    }
#undef CVT8_LOAD
}
__device__ __forceinline__ void cvt_job8(const float* src, int ld, int ncols, unsigned char* dst, int K, int mode, float scale, LAS float* tile, int bid, int G, const int tid) { cvt_job_t<true>(src, ld, ncols, ncols, dst, K, mode, scale, tile, bid, G, tid); }
__device__ __forceinline__ void cvt_job(const float* src, int ld, int ncols_valid, int ncols_total, bf16* dst, int K, int mode, LAS float* tile, int bid, int G, const int tid) { cvt_job_t<false>(src, ld, ncols_valid, ncols_total, dst, K, mode, 1.0f, tile, bid, G, tid); }

__device__ __forceinline__ void p0_prologue(const Ctx& a, LAS unsigned char* lds, int bid, int G) {
    unsigned char* ws = opqp(a.ws); const int tid = ((a.wv << 6) | lane_v());
    LAS float* tile = (LAS float*)lds;
    if (!(a.sub & 512)) {
#define P0_RANGE(nt_) const int nt__ = (nt_); const int tb = (int)((long)bid * nt__ / G), te = (int)((long)(bid + 1) * nt__ / G)
        for (int l = 0; l < 2; ++l) {
            { P0_RANGE((NINP >> 6) * (DM >> 7)); cvt_job_b16(ldin(10) + (size_t)l * DM * NIN, NIN, NIN, NINP, (bf16*)(ws + WS_WIN) + (size_t)l * NINP * DM, DM, 0, (LAS unsigned char*)lds, tb, te, tid); }
            { P0_RANGE((DM >> 6) * (DM >> 7)); cvt_job_b16(ldin(11) + (size_t)l * DM * DM, DM, DM, DM, (bf16*)(ws + WS_WOUT) + (size_t)l * DM * DM, DM, 0, (LAS unsigned char*)lds, tb, te, tid); }
        }
#if DENSE_GU8
        { P0_RANGE((FF >> 6) * (DM >> 7)); cvt_job_f8(ldin(31), FF, FF, ws + WS_WGU, DM, 1, MOE_SGU, (LAS unsigned char*)lds, tb, te, tid);
          cvt_job_f8(ldin(32), FF, FF, ws + WS_WGU, DM, 2, MOE_SGU, (LAS unsigned char*)lds, tb, te, tid); }
#else
        { P0_RANGE((FF >> 6) * (DM >> 7)); cvt_job_b16(ldin(31), FF, FF, FF, (bf16*)(ws + WS_WGU), DM, 1, (LAS unsigned char*)lds, tb, te, tid);
          cvt_job_b16(ldin(32), FF, FF, FF, (bf16*)(ws + WS_WGU), DM, 2, (LAS unsigned char*)lds, tb, te, tid); }
#endif
#if DENSE_D8
        { P0_RANGE((DM >> 6) * (FF >> 7)); cvt_job_f8(ldin(33), DM, DM, ws + WS_WD, FF, 0, MOE_SD, (LAS unsigned char*)lds, tb, te, tid); }
#else
        { P0_RANGE((DM >> 6) * (FF >> 7)); cvt_job_b16(ldin(33), DM, DM, DM, (bf16*)(ws + WS_WD), FF, 0, (LAS unsigned char*)lds, tb, te, tid); }
#endif
#undef P0_RANGE
    }
#if !MOE_FP8
    for (int e = 0; e < NE; ++e) {
        cvt_job(ldin(35) + (size_t)e * DM * FE, FE, FE, FE, (bf16*)(ws + WS_MGU) + (size_t)e * 2 * FE * DM, DM, 1, tile, bid, G, tid);
        cvt_job(ldin(36) + (size_t)e * DM * FE, FE, FE, FE, (bf16*)(ws + WS_MGU) + (size_t)e * 2 * FE * DM, DM, 2, tile, bid, G, tid);
        cvt_job(ldin(37) + (size_t)e * FE * DM, DM, DM, DM, (bf16*)(ws + WS_MD) + (size_t)e * DM * FE, FE, 0, tile, bid, G, tid);
    }
#endif
    {
        bf16* wsm = (bf16*)(ws + WS_WSM);
        for (size_t i = (size_t)bid * NT + tid; i < (size_t)2 * 2048 * 256; i += (size_t)G * NT) {
            const int l = (int)(i >> 19), n = (int)((i >> 8) & 2047), k = (int)(i & 255); float v = 0.f;
            if (n < 1024) { if (k < 64) v = ldin(14)[(((size_t)l * 2 + (n >> 9)) * 64 + k) * 512 + (n & 511)]; }
            else if (n < 1536) { if (k >= 64 && k < 128) v = ldin(16)[((size_t)l * 64 + (k - 64)) * 512 + (n - 1024)]; }
            else { if (k >= 128) v = ldin(17)[((size_t)l * 128 + (k - 128)) * 512 + (n - 1536)]; }
            wsm[i] = (bf16)f2bf(v);
        }
    }
    {
        float* rope = (float*)(ws + WS_ROPE);
        for (int i = bid * NT + tid; i < SEQ * 32; i += G * NT) {
            const int t = i >> 5, j = i & 31, half = j >> 4, f = j & 15;
            const float pos = (float)(half ? (t & 63) : (t >> 6));
            const float inv = powf(10000.0f, -(float)f / 16.0f);
            const float ang = pos * inv;
            double ad = (double)ang; const double twopi = 6.283185307179586476925; ad -= twopi * floor(ad / twopi);
            const float ar = (float)ad;
            rope[t * 64 + half * 32 + f] = cosf(ar); rope[t * 64 + half * 32 + 16 + f] = sinf(ar);
        }
    }
    if (!(a.sub & 256)) {
        LAS float* sil = (LAS float*)lds;
        LAS float* red = sil + 9 * 2048;
        __syncthreads();
        for (int i = tid; i < 9 * 2048; i += NT) { const float v = i < 8 * 2048 ? ldin(1)[i] : ldin(3)[i - 8 * 2048]; sil[i] = v / (1.0f + __expf(-v)); }
        __syncthreads();
        float* ada = (float*)(ws + WS_ADA);
        const int lane = tid & 63, wid = tid >> 6;
        for (int it = bid; it < 2 * 96; it += G) {
            const int l = it / 96, col0 = (it % 96) * 128;
            const float* w = ldin(4) + (size_t)l * DM * 12288 + (size_t)(wid * 256) * 12288 + col0 + 2 * lane;
            const LAS float* sl = sil + wid * 256;
            float2 acc[9];
#pragma unroll
            for (int v = 0; v < 9; ++v) acc[v] = make_float2(0.f, 0.f);
            float2 cur[16];
#pragma unroll
            for (int j = 0; j < 16; ++j) cur[j] = *(const float2*)(w + (size_t)j * 12288);
            for (int k0 = 0; k0 < 256; k0 += 16) {
                float2 nx[16];
#pragma unroll
                for (int j = 0; j < 16; ++j) nx[j] = cur[j];
                if (k0 + 16 < 256) {
#pragma unroll
                    for (int j = 0; j < 16; ++j) nx[j] = *(const float2*)(w + (size_t)(k0 + 16 + j) * 12288); }
#pragma unroll
                for (int v = 0; v < 9; ++v)
#pragma unroll
                    for (int q = 0; q < 4; ++q) { const f32x4 sv = *(const LAS f32x4*)(sl + v * 2048 + k0 + 4 * q);
#pragma unroll
                        for (int e = 0; e < 4; ++e) { acc[v].x += sv[e] * cur[4 * q + e].x; acc[v].y += sv[e] * cur[4 * q + e].y; } }
#pragma unroll
                for (int j = 0; j < 16; ++j) cur[j] = nx[j];
            }
#pragma unroll
            for (int v = 0; v < 9; ++v) *(LAS f32x2_t*)(red + (wid * 9 + v) * 128 + 2 * lane) = (f32x2_t){acc[v].x, acc[v].y};
            __syncthreads();
            for (int o = tid; o < 9 * 128; o += NT) { const int v = o >> 7, cn = o & 127; float sum = ldin(5)[(size_t)l * 12288 + col0 + cn];
#pragma unroll
                for (int g8 = 0; g8 < 8; ++g8) sum += red[(g8 * 9 + v) * 128 + cn];
                ada[((size_t)l * 9 + v) * 12288 + col0 + cn] = sum; }
            __syncthreads();
        }
    }
}


constexpr int BG_TPJ = 1792, BG_NT = 24 * BG_TPJ, BG_B = 8, BG_D = 1;
__device__ __forceinline__ void bg_convert(const Ctx& a, LAS unsigned char* lds, unsigned* until_done, int G) {
#if MOE_FP8
    unsigned char* ws = opqp(a.ws); const int tid = ((a.wv << 6) | lane_v());
    unsigned* ctr = (unsigned*)(ws + WS_CTL) + CW_BG; volatile LAS unsigned* slot = (volatile LAS unsigned*)(lds + LDS_STAGE + 8);
    LAS float* tile = (LAS float*)lds;
    for (;;) {
        __syncthreads();
        if (tid == 0) { unsigned v = 0xffffffffu;
            if (!until_done || __hip_atomic_load(until_done, __ATOMIC_RELAXED, __HIP_MEMORY_SCOPE_AGENT) < (unsigned)G) v = __hip_atomic_fetch_add(ctr, (unsigned)BG_B, __ATOMIC_RELAXED, __HIP_MEMORY_SCOPE_AGENT);
            *slot = v; }
        __syncthreads();
        const unsigned t0 = *slot;
        if (t0 >= (unsigned)BG_NT) break;
        const int job = (int)t0 / BG_TPJ, tl = (int)t0 % BG_TPJ; const int e = job / 3, kind = job % 3;
        if (kind < 2) cvt_job_f8d<BG_B, BG_D>(ldin(35 + kind) + (size_t)e * DM * FE, FE, FE, ws + WS_MGU + (size_t)e * 2 * FE * DM, DM, 1 + kind, MOE_SGU, (LAS unsigned char*)lds, tl, tid);
        else cvt_job_f8d<BG_B, BG_D>(ldin(37) + (size_t)e * FE * DM, DM, DM, ws + WS_MD + (size_t)e * DM * FE, FE, 0, MOE_SD, (LAS unsigned char*)lds, tl, tid);
    }
    __syncthreads();
#endif
}
#ifndef BG_MASK
#define BG_MASK 0x2030u
#endif
__device__ __forceinline__ void bg_tail(const Ctx& a, LAS unsigned char* lds, int slotid, int G) {
#if MOE_FP8
    unsigned char* ws = opqp(a.ws); const int tid = ((a.wv << 6) | lane_v());
    if (!((BG_MASK >> slotid) & 1u)) return;
    unsigned* done = (unsigned*)(ws + WS_CTL) + CW_DONE + slotid * 64;
    __syncthreads();
    if (tid == 0) (void)__hip_atomic_fetch_add(done, 1u, __ATOMIC_RELAXED, __HIP_MEMORY_SCOPE_AGENT);
    bg_convert(a, lds, done, G);
#endif
}

__device__ __forceinline__ void ld_row(const float* p, int lane, float (&x)[32]) {
#pragma unroll
    for (int i = 0; i < 8; ++i) { const float4 v = *(const float4*)(p + i * 256 + lane * 4); x[i * 4] = v.x; x[i * 4 + 1] = v.y; x[i * 4 + 2] = v.z; x[i * 4 + 3] = v.w; }
}
__device__ __forceinline__ void st_row(float* p, int lane, const float (&x)[32]) {
#pragma unroll
    for (int i = 0; i < 8; ++i) *(float4*)(p + i * 256 + lane * 4) = make_float4(x[i * 4], x[i * 4 + 1], x[i * 4 + 2], x[i * 4 + 3]);
}
__device__ __forceinline__ float sumsq(const float (&x)[32]) { float s = 0.f;
#pragma unroll
    for (int i = 0; i < 32; ++i) s += x[i] * x[i];
    return wsum(s); }

template <int TMODE, int HMODE, int XIN = 0, int XOUT = 0>
__device__ __forceinline__ void thin_phase(const Ctx& a, LAS unsigned char* lds, int bid, int G, int M,
                           const float* xlat, const float* xctx, float* olat, float* octx,
                           const float* T, const float* postw, int lg, int kg,
                           const float* prew, int lm, int ksc, int ksh) {
    unsigned char* ws = opqp(a.ws); const int tid = ((a.wv << 6) | lane_v()), lane = tid & 63, wid = tid >> 6;
    const float* ada = (const float*)(ws + WS_ADA);
    bf16* HA = (bf16*)(ws + WS_HA);
    LAS float* rt = (LAS float*)lds;
    LAS float* CT = (LAS float*)(lds + 65536);
    const int rpb = (M + G - 1) / G; const int rb0 = bid * rpb, rb1 = (rb0 + rpb) < M ? (rb0 + rpb) : M;
    const int v_lo = rb0 < MLAT ? rb0 / SEQ : 8, v_hi = (rb1 - 1) < MLAT ? ((rb1 - 1) < 0 ? 0 : (rb1 - 1) / SEQ) : 8;
    __syncthreads();
    if (HMODE == 2) { for (int i = tid; i < DM * NE; i += NT) rt[i] = ldin(34)[i]; }
    for (int i = tid; i < DM; i += NT) {
        if (TMODE != 0) { CT[i] = postw[i]; CT[4096 + i] = ada[((size_t)lg * 9 + v_lo) * 12288 + kg * DM + i]; CT[4096 + 6144 + i] = ada[((size_t)lg * 9 + v_hi) * 12288 + kg * DM + i]; }
        if (HMODE != 0) { CT[2048 + i] = prew[i];
            CT[4096 + 2048 + i] = ada[((size_t)lm * 9 + v_lo) * 12288 + ksc * DM + i]; CT[4096 + 4096 + i] = ada[((size_t)lm * 9 + v_lo) * 12288 + ksh * DM + i];
            CT[4096 + 6144 + 2048 + i] = ada[((size_t)lm * 9 + v_hi) * 12288 + ksc * DM + i]; CT[4096 + 6144 + 4096 + i] = ada[((size_t)lm * 9 + v_hi) * 12288 + ksh * DM + i]; }
    }
    __syncthreads();
#define TH_LDS(base_, out_) do { _Pragma("unroll") for (int i_ = 0; i_ < 8; ++i_) { const f32x4 v_ = *(const LAS f32x4*)((base_) + i_ * 256 + lane * 4); out_[i_ * 4] = v_[0]; out_[i_ * 4 + 1] = v_[1]; out_[i_ * 4 + 2] = v_[2]; out_[i_ * 4 + 3] = v_[3]; } } while (0)
#define TH_LOADX(row_) do { const int rw_ = (row_); if (XIN == 1 && rw_ < MLAT) { const bf16* xb_ = (const bf16*)xlat + (size_t)rw_ * DM; \
            _Pragma("unroll") for (int i_ = 0; i_ < 8; ++i_) { const uint2 p_ = *(const uint2*)(xb_ + i_ * 256 + lane * 4); xr[i_].x = p_.x; xr[i_].y = p_.y; } } \
        else { const float* xs_ = rw_ < MLAT ? xlat + (size_t)rw_ * DM : xctx + (size_t)(rw_ - MLAT) * DM; _Pragma("unroll") for (int i_ = 0; i_ < 8; ++i_) xr[i_] = *(const uint4*)(xs_ + i_ * 256 + lane * 4); } \
        if (TMODE == 1) { const bf16* tb_ = (const bf16*)T + (size_t)rw_ * DM; _Pragma("unroll") for (int i_ = 0; i_ < 8; ++i_) tr[i_] = *(const uint2*)(tb_ + i_ * 256 + lane * 4); } } while (0)
    uint4 xr[8]; uint2 tr[8];
#pragma unroll
    for (int i = 0; i < 8; ++i) { xr[i] = make_uint4(0u, 0u, 0u, 0u); tr[i] = make_uint2(0u, 0u); }
    int r = rb0 + wid;
    if (r < rb1) TH_LOADX(r);
    uint2 yr1[8], yr2[8]; uint4 tkc = make_uint4(0u, 0u, 0u, 0u), tkn = tkc;
#pragma unroll
    for (int i = 0; i < 8; ++i) { yr1[i] = make_uint2(0u, 0u); yr2[i] = make_uint2(0u, 0u); }
#define TH_LOADY() do { const bf16* y1_ = (const bf16*)(ws + WS_MIX) + (size_t)tkc.z * DM; const bf16* y2_ = (const bf16*)(ws + WS_MIX) + (size_t)tkc.w * DM; \
        _Pragma("unroll") for (int i_ = 0; i_ < 8; ++i_) { yr1[i_] = *(const uint2*)(y1_ + i_ * 256 + lane * 4); yr2[i_] = *(const uint2*)(y2_ + i_ * 256 + lane * 4); } } while (0)
    if (TMODE == 2) {
        if (r < rb1) { tkc = *(const uint4*)((const unsigned*)(ws + WS_TOK) + (size_t)r * 8 + 4); TH_LOADY(); }
        if (r + NW < rb1) tkn = *(const uint4*)((const unsigned*)(ws + WS_TOK) + (size_t)(r + NW) * 8 + 4);
    }
    for (; r < rb1; r += NW) {
        const int vec = r < MLAT ? r / SEQ : 8;
        const LAS float* cset = CT + 4096 + (vec == v_lo ? 0 : 6144);
        float x[32];
        if (XIN == 1 && r < MLAT) {
#pragma unroll
            for (int i = 0; i < 8; ++i) { float f1[4]; unpack4(make_uint2(xr[i].x, xr[i].y), f1); x[i * 4] = f1[0]; x[i * 4 + 1] = f1[1]; x[i * 4 + 2] = f1[2]; x[i * 4 + 3] = f1[3]; } }
        else {
#pragma unroll
            for (int i = 0; i < 8; ++i) { x[i * 4] = __uint_as_float(xr[i].x); x[i * 4 + 1] = __uint_as_float(xr[i].y); x[i * 4 + 2] = __uint_as_float(xr[i].z); x[i * 4 + 3] = __uint_as_float(xr[i].w); } }
        float t1[32];
        if (TMODE == 1) {
#pragma unroll
            for (int i = 0; i < 8; ++i) { float f1[4]; unpack4(tr[i], f1); t1[i * 4] = f1[0]; t1[i * 4 + 1] = f1[1]; t1[i * 4 + 2] = f1[2]; t1[i * 4 + 3] = f1[3]; } }
        if (TMODE == 2) { const float w1 = __uint_as_float(tkc.x), w2 = __uint_as_float(tkc.y);
#pragma unroll
            for (int i = 0; i < 8; ++i) { float f1[4], f2[4]; unpack4(yr1[i], f1); unpack4(yr2[i], f2);
#pragma unroll
                for (int j = 0; j < 4; ++j) t1[i * 4 + j] = w1 * f1[j] + w2 * f2[j]; } }
        if (r + NW < rb1) { TH_LOADX(r + NW);
            if (TMODE == 2) { tkc = tkn; TH_LOADY(); if (r + 2 * NW < rb1) tkn = *(const uint4*)((const unsigned*)(ws + WS_TOK) + (size_t)(r + 2 * NW) * 8 + 4); } }
        if (TMODE != 0) {
            float t[32];
            if (TMODE == 1) {
#pragma unroll
                for (int i = 0; i < 32; ++i) t[i] = t1[i]; }
            else {
#pragma unroll
                for (int i = 0; i < 32; ++i) t[i] = t1[i]; }
            const float rs = rsqrtf(sumsq(t) * (1.0f / DM) + 1e-6f);
#pragma unroll
            for (int i = 0; i < 8; ++i) { const f32x4 pw = *(const LAS f32x4*)(CT + i * 256 + lane * 4), gg = *(const LAS f32x4*)(cset + i * 256 + lane * 4);
#pragma unroll
                for (int j = 0; j < 4; ++j) x[i * 4 + j] += gg[j] * (t[i * 4 + j] * rs * pw[j]);
                if (i & 1) __builtin_amdgcn_sched_barrier(0); }
            if (XOUT == 1 && r < MLAT) { bf16* xd = (bf16*)olat + (size_t)r * DM;
#pragma unroll
                for (int i = 0; i < 8; ++i) { uint2 p; p.x = pk2(x[i * 4], x[i * 4 + 1]); p.y = pk2(x[i * 4 + 2], x[i * 4 + 3]); *(uint2*)(xd + i * 256 + lane * 4) = p; } }
            else { float* xd = r < MLAT ? olat + (size_t)r * DM : octx + (size_t)(r - MLAT) * DM; st_row(xd, lane, x); }
        }
        if (HMODE != 0) {
            const float rs = rsqrtf(sumsq(x) * (1.0f / DM) + 1e-6f);
            float h[32];
#pragma unroll
            for (int i = 0; i < 8; ++i) { const f32x4 pw = *(const LAS f32x4*)(CT + 2048 + i * 256 + lane * 4), sc = *(const LAS f32x4*)(cset + 2048 + i * 256 + lane * 4), sh = *(const LAS f32x4*)(cset + 4096 + i * 256 + lane * 4);
#pragma unroll
                for (int j = 0; j < 4; ++j) h[i * 4 + j] = x[i * 4 + j] * rs * pw[j] * (1.0f + sc[j]) + sh[j];
                if (i & 1) __builtin_amdgcn_sched_barrier(0); }
            if ((HMODE == 2 && MOE_FP8) || HMODE == 3) { unsigned char* hd8 = (unsigned char*)HA + (size_t)r * DM;
#pragma unroll
                for (int i = 0; i < 8; ++i) *(unsigned*)(hd8 + i * 256 + lane * 4) = pg8::pk_fp8x4(h[i * 4], h[i * 4 + 1], h[i * 4 + 2], h[i * 4 + 3]); }
            else { bf16* hd = HA + (size_t)r * DM;
#pragma unroll
                for (int i = 0; i < 8; ++i) { uint2 p; p.x = pk2(h[i * 4], h[i * 4 + 1]); p.y = pk2(h[i * 4 + 2], h[i * 4 + 3]); *(uint2*)(hd + i * 256 + lane * 4) = p; } }
            if (HMODE == 2) {
                float lg8[8];
#pragma unroll
                for (int e = 0; e < 8; ++e) lg8[e] = 0.f;
#pragma unroll 1
                for (int i = 0; i < 8; ++i) {
                    float hv4[4];
#pragma unroll
                    for (int j = 0; j < 4; ++j) hv4[j] = 0.f;
#pragma unroll
                    for (int ii = 0; ii < 8; ++ii) if (ii == i) { hv4[0] = h[ii * 4]; hv4[1] = h[ii * 4 + 1]; hv4[2] = h[ii * 4 + 2]; hv4[3] = h[ii * 4 + 3]; }
#pragma unroll
                    for (int j = 0; j < 4; ++j) { const int c = i * 256 + lane * 4 + j; const f32x4 r0 = *(const LAS f32x4*)(rt + c * 8), r1 = *(const LAS f32x4*)(rt + c * 8 + 4); const float hv = hv4[j];
                        lg8[0] += hv * r0[0]; lg8[1] += hv * r0[1]; lg8[2] += hv * r0[2]; lg8[3] += hv * r0[3]; lg8[4] += hv * r1[0]; lg8[5] += hv * r1[1]; lg8[6] += hv * r1[2]; lg8[7] += hv * r1[3]; }
                }
#pragma unroll
                for (int e = 0; e < 8; ++e) lg8[e] = wsum(lg8[e]);
                if (lane == 0) {
                    int e1 = 0; float v1 = lg8[0];
#pragma unroll
                    for (int e = 1; e < 8; ++e) if (lg8[e] > v1) { v1 = lg8[e]; e1 = e; }
                    int e2 = -1; float v2 = -3.0e38f;
#pragma unroll
                    for (int e = 0; e < 8; ++e) if (e != e1 && lg8[e] > v2) { v2 = lg8[e]; e2 = e; }
                    const float ex = __expf(v2 - v1); const float w1 = 1.0f / (1.0f + ex), w2 = ex / (1.0f + ex);
                    unsigned* cnt = (unsigned*)(ws + WS_CTL) + CW_CNT;
                    const unsigned p1 = atomicAdd(cnt + e1 * 64, 1u), p2 = atomicAdd(cnt + e2 * 64, 1u);
                    unsigned* tok = (unsigned*)(ws + WS_TOK) + (size_t)r * 8;
                    tok[0] = (unsigned)e1; tok[1] = (unsigned)e2; tok[2] = p1; tok[3] = p2; tok[4] = __float_as_uint(w1); tok[5] = __float_as_uint(w2);
                }
            }
        }
    }
}

#undef TH_LDS
#undef TH_LOADX
#undef TH_LOADY
__device__ __forceinline__ void moe_gather(const Ctx& a, int bid, int G) {
    unsigned char* ws = opqp(a.ws); const int tid = ((a.wv << 6) | lane_v()), lane = tid & 63, wid = tid >> 6;
    const unsigned* cnt = (const unsigned*)(ws + WS_CTL) + CW_CNT;
    const bf16* HA = (const bf16*)(ws + WS_HA); bf16* AG = (bf16*)(ws + WS_U);
    unsigned est[8];
    { unsigned run0 = 0;
#pragma unroll
      for (int e = 0; e < 8; ++e) { est[e] = run0; run0 += (cnt[e * 64] + 255u) >> 8; } }
    constexpr int GN = MOE_FP8 ? 2 : 4;
    int r = bid * NW + wid; const int stride = G * NW;
    uint4 tk = make_uint4(0u, 0u, 0u, 0u), sv[GN];
#pragma unroll
    for (int i = 0; i < GN; ++i) sv[i] = tk;
#define MG_LOAD(row_) do { tk = *(const uint4*)((const unsigned*)(ws + WS_TOK) + (size_t)(row_) * 8); const uint4* src_ = (const uint4*)((const unsigned char*)HA + (size_t)(row_) * DM * (MOE_FP8 ? 1 : 2)); \
        _Pragma("unroll") for (int i_ = 0; i_ < GN; ++i_) sv[i_] = src_[i_ * 64 + lane]; } while (0)
    if (r < MLAT) MG_LOAD(r);
    for (; r < MLAT; r += stride) {
        const int e1 = (int)tk.x, e2 = (int)tk.y; const unsigned p1 = tk.z, p2 = tk.w;
        uint4 cv[GN];
#pragma unroll
        for (int i = 0; i < GN; ++i) cv[i] = sv[i];
        if (r + stride < MLAT) MG_LOAD(r + stride);
        unsigned s1 = 0, s2 = 0;
#pragma unroll
        for (int e = 0; e < 8; ++e) { if (e == e1) s1 = est[e]; if (e == e2) s2 = est[e]; }
        const unsigned d1 = s1 * 256u + p1, d2 = s2 * 256u + p2;
        uint4* q1 = (uint4*)((unsigned char*)AG + (size_t)d1 * DM * (MOE_FP8 ? 1 : 2)); uint4* q2 = (uint4*)((unsigned char*)AG + (size_t)d2 * DM * (MOE_FP8 ? 1 : 2));
#pragma unroll
        for (int i = 0; i < GN; ++i) { q1[i * 64 + lane] = cv[i]; q2[i * 64 + lane] = cv[i]; }
        if (lane == 0) { unsigned* tok = (unsigned*)(ws + WS_TOK) + (size_t)r * 8; tok[6] = d1; tok[7] = d2; }
    }
#undef MG_LOAD
    unsigned zq = 0u; asm volatile("" : "+v"(zq));
    unsigned run = 0;
    for (int e = 0; e < 8; ++e) { const unsigned c = cnt[e * 64], t = (c + 255u) >> 8; const unsigned lo = run * 256u + c, hi = (run + t) * 256u; run += t;
        for (unsigned r = lo + bid * NW + wid; r < hi; r += G * NW) { uint4* q = (uint4*)((unsigned char*)AG + (size_t)r * DM * (MOE_FP8 ? 1 : 2));
#pragma unroll
            for (int i = 0; i < (MOE_FP8 ? 2 : 4); ++i) q[i * 64 + lane] = make_uint4(zq, zq, zq, zq); } }
}


__device__ __forceinline__ uint4 ldg16(const bf16* p) { return *(const uint4*)p; }
__device__ __forceinline__ uint4 zero16() { return make_uint4(0u, 0u, 0u, 0u); }

__device__ __forceinline__ void feat_a(const Ctx& a, LAS unsigned char* lds, int l, int bid, int G) {
    unsigned char* ws = opqp(a.ws); const int tid = ((a.wv << 6) | lane_v()), lane = tid & 63, wid = tid >> 6;
    const bf16* U = (const bf16*)(ws + WS_U); bf16* ASM = (bf16*)(ws + WS_ASM); bf16* XBC = (bf16*)(ws + WS_XBC); bf16* QK = (bf16*)(ws + WS_QK);
    float* DT = (float*)(ws + WS_DT); const float* rope = (const float*)(ws + WS_ROPE);
    const float* dtb = ldin(25) + l * 32; const float* alog = ldin(26) + l * 32;
    LAS float* CT = (LAS float*)lds;
    {   const float* mu = ldin(12) + (size_t)l * 2 * 1792; const float* cw = ldin(23) + (size_t)l * 3 * 1536; const float* cb = ldin(24) + (size_t)l * 1536;
        __syncthreads();
        for (int i = tid; i < 3584; i += NT) CT[i] = mu[i];
        for (int i = tid; i < 4608; i += NT) CT[3584 + i] = cw[i];
        for (int i = tid; i < 1536; i += NT) CT[8192 + i] = cb[i];
        __syncthreads(); }
    constexpr int RPW = MTOT / (256 * NW);
    static_assert(RPW * 256 * NW == MTOT, "feat_a rows per wave");
    const int nwv = G * NW, wv_id = bid * NW + wid;
    const int rows_per = (MTOT + nwv - 1) / nwv; const int r0 = wv_id * rows_per, r1 = (r0 + rows_per) < MTOT ? (r0 + rows_per) : MTOT;
    if (r0 >= MTOT) return;
    const int ca = C_RW_XW + (lane & 31) * 8;
#define FA_LOADW(W_, row_) do { const int rr_ = (row_) < 0 ? 0 : ((row_) >= MTOT ? MTOT - 1 : (row_)); const bf16* q_ = U + (size_t)rr_ * NINP; \
        W_[0] = ldg16(q_ + ca); W_[1] = ldg16(q_ + C_MB_XBC + lane * 8); W_[2] = ldg16(q_ + C_MB_XBC + (64 + lane) * 8); W_[3] = ldg16(q_ + C_MB_XBC + (128 + lane) * 8); } while (0)
    const int blk = lane >> 1, sub = lane & 1, c1 = C_DA_Q + blk * 32 + sub * 8; const int half = blk & 1; const float qscale = blk < 16 ? 0.125f * 1.44269504f : 1.0f;
#define FA_LOADX(Q1_, Q2_, D_, row_) do { const int rr_ = (row_) >= MTOT ? MTOT - 1 : (row_); const bf16* q_ = U + (size_t)rr_ * NINP; Q1_ = ldg16(q_ + c1); Q2_ = ldg16(q_ + c1 + 16); D_ = q_[C_MB_DT + (lane & 31)]; } while (0)
    uint4 wp[4], wu[4], wn[4];
    FA_LOADW(wp, r0 - 1); FA_LOADW(wu, r0); FA_LOADW(wn, r0 + 1);
    uint4 q1, q2; bf16 dr;
    FA_LOADX(q1, q2, dr, r0);
    for (int r = r0; r < r1; ++r) {
        const bool lat = r < MLAT; const int t = lat ? (r & (SEQ - 1)) : ((r - MLAT) & (CTXL - 1)); const int L = lat ? SEQ : CTXL;
        const bool hp = t > 0, hn = t < L - 1;
        uint4 wx[4]; FA_LOADW(wx, r + 2);
        uint4 q1n, q2n; bf16 drn; FA_LOADX(q1n, q2n, drn, r + 1);
        float4 rp[4]; { const float* rp_ = rope + (lat ? t : 0) * 64 + half * 32 + sub * 8; rp[0] = *(const float4*)rp_; rp[1] = *(const float4*)(rp_ + 4); rp[2] = *(const float4*)(rp_ + 16); rp[3] = *(const float4*)(rp_ + 20); }
        if (lane < 32) {
            float u[8], p[8], n[8], o[8];
            unpack8(wu[0], u); unpack8(hp ? wp[0] : zero16(), p); unpack8(hn ? wn[0] : zero16(), n);
            const f32x4 m0 = *(const LAS f32x4*)(CT + ca), m1 = *(const LAS f32x4*)(CT + ca + 4), m2 = *(const LAS f32x4*)(CT + 1792 + ca), m3 = *(const LAS f32x4*)(CT + 1792 + ca + 4);
#pragma unroll
            for (int e = 0; e < 8; ++e) { const float mp = e < 4 ? m0[e & 3] : m1[e & 3], mn = e < 4 ? m2[e & 3] : m3[e & 3];
                const float s = u[e] + mp * (p[e] - u[e]) + mn * (n[e] - u[e]); const int k = lane * 8 + e;
                o[e] = k < 64 ? (1.0f - 2.0f / (__expf(2.0f * s) + 1.0f)) : (k < 128 ? s : fsigm(s)); }
            *(uint4*)(ASM + (size_t)r * 256 + lane * 8) = pack8(o);
        }
#pragma unroll
        for (int it = 0; it < 3; ++it) {
            const int cc = (it * 64 + lane) * 8; float u[8], p[8], n[8], o[8];
            unpack8(wu[1 + it], u); unpack8(hp ? wp[1 + it] : zero16(), p); unpack8(hn ? wn[1 + it] : zero16(), n);
            const LAS float* cwp = CT + 3584 + cc;
#pragma unroll
            for (int hf = 0; hf < 2; ++hf) { const f32x4 k0 = *(const LAS f32x4*)(cwp + hf * 4), k1 = *(const LAS f32x4*)(cwp + 1536 + hf * 4), k2 = *(const LAS f32x4*)(cwp + 3072 + hf * 4), kb = *(const LAS f32x4*)(CT + 8192 + cc + hf * 4);
#pragma unroll
                for (int e = 0; e < 4; ++e) o[hf * 4 + e] = fsilu(k0[e] * p[hf * 4 + e] + k1[e] * u[hf * 4 + e] + k2[e] * n[hf * 4 + e] + kb[e]); }
            *(uint4*)(XBC + (size_t)r * 1536 + cc) = pack8(o);
        }
        if (lane < 32) {
            const float raw = bf2f(dr); const float dtv = softplusf(raw + dtb[lane]); const float A = -__expf(alog[lane]);
            DT[(size_t)r * 64 + lane] = dtv; DT[(size_t)r * 64 + 32 + lane] = dtv * A;
        }
        {
            float u1[8], u2[8], o1[8], o2[8];
            unpack8(q1, u1); unpack8(q2, u2);
#pragma unroll
            for (int e = 0; e < 8; ++e) {
                const float cs = lat ? (e < 4 ? rp[0] : rp[1])[e & 3] : 1.0f, sn = lat ? (e < 4 ? rp[2] : rp[3])[e & 3] : 0.0f;
                o1[e] = (u1[e] * cs - u2[e] * sn) * qscale; o2[e] = (u2[e] * cs + u1[e] * sn) * qscale; }
            *(uint4*)(QK + (size_t)r * 1024 + blk * 32 + sub * 8) = pack8(o1); *(uint4*)(QK + (size_t)r * 1024 + blk * 32 + 16 + sub * 8) = pack8(o2);
        }
#pragma unroll
        for (int i = 0; i < 4; ++i) { wp[i] = wu[i]; wu[i] = wn[i]; wn[i] = wx[i]; }
        q1 = q1n; q2 = q2n; dr = drn;
    }
#undef FA_LOADW
#undef FA_LOADX
}

__device__ __forceinline__ void feat_b(const Ctx& a, int l, int bid, int G) {
    unsigned char* ws = opqp(a.ws); const int tid = ((a.wv << 6) | lane_v()), lane = tid & 63, wid = tid >> 6;
    const bf16* U = (const bf16*)(ws + WS_U); const float* F = (const float*)(ws + WS_MIX); bf16* R5 = (bf16*)(ws + WS_RW5);
    const float* mu = ldin(12) + (size_t)l * 2 * 1792; const float* k_k = ldin(18) + l * 512; const float* k_a = ldin(19) + l * 512; const float* a0 = ldin(15) + l * 512;
    for (int r = bid * NW + wid; r < MTOT; r += G * NW) {
        const bool lat = r < MLAT; const int t = lat ? (r & (SEQ - 1)) : ((r - MLAT) & (CTXL - 1)); const int L = lat ? SEQ : CTXL;
        const bool hp = t > 0, hn = t < L - 1;
        const bf16* up = U + (size_t)r * NINP; const int c = lane * 8;
        float s[3][8];
#pragma unroll
        for (int q = 0; q < 3; ++q) { const int col = q * 512 + c; float u[8], p[8], n[8];
            unpack8(ldg16(up + col), u); unpack8(hp ? ldg16(up - NINP + col) : zero16(), p); unpack8(hn ? ldg16(up + NINP + col) : zero16(), n);
#pragma unroll
            for (int e = 0; e < 8; ++e) s[q][e] = u[e] + mu[col + e] * (p[e] - u[e]) + mu[1792 + col + e] * (n[e] - u[e]); }
        float av[8]; { const float4 q0 = *(const float4*)(F + (size_t)r * 2048 + 1024 + c), a1 = *(const float4*)(F + (size_t)r * 2048 + 1024 + c + 4);
            av[0] = q0.x; av[1] = q0.y; av[2] = q0.z; av[3] = q0.w; av[4] = a1.x; av[5] = a1.y; av[6] = a1.z; av[7] = a1.w; }
#pragma unroll
        for (int e = 0; e < 8; ++e) av[e] = fsigm(av[e] + a0[c + e]);
        float kkv[8], k2[8], bv[8]; float ss = 0.f;
#pragma unroll
        for (int e = 0; e < 8; ++e) { kkv[e] = s[1][e] * k_k[c + e]; ss += kkv[e] * kkv[e]; }
        ss = red8(ss); const float inv = 1.0f / fmaxf(sqrtf(ss), 1e-12f);
#pragma unroll
        for (int e = 0; e < 8; ++e) { kkv[e] *= inv; k2[e] = s[1][e] * (1.0f + (av[e] - 1.0f) * k_a[c + e]); bv[e] = kkv[e] * av[e]; }
        const size_t o = (size_t)r * 512 + c, st = (size_t)MTOT * 512;
        *(uint4*)(R5 + o) = pack8(s[0]); *(uint4*)(R5 + st + o) = pack8(k2); *(uint4*)(R5 + 2 * st + o) = pack8(s[2]); *(uint4*)(R5 + 3 * st + o) = pack8(kkv); *(uint4*)(R5 + 4 * st + o) = pack8(bv);
    }
}

__device__ __forceinline__ void mix_out(const Ctx& a, LAS unsigned char* lds, int l, int M, int bid, int G) {
    unsigned char* ws = opqp(a.ws); const int tid = ((a.wv << 6) | lane_v()), lane = tid & 63, wid = tid >> 6;
    const bf16* U = (const bf16*)(ws + WS_U); const float* F = (const float*)(ws + WS_MIX); const bf16* R5 = (const bf16*)(ws + WS_RW5); const bf16* XBC = (const bf16*)(ws + WS_XBC);
    const bf16* YR = (const bf16*)(ws + WS_YR); const bf16* YM = (const bf16*)(ws + WS_YM); bf16* A2 = (bf16*)(ws + WS_HA);
    const float* Dsk = ldin(27) + l * 16;
    LAS float* CT = (LAS float*)lds;
    {   const float* r_k = ldin(20) + l * 512; const float* ln_w = ldin(21) + l * 512; const float* ln_b = ldin(22) + l * 512; const float* nw = ldin(28) + l * 1024;
        __syncthreads();
        for (int i = tid; i < 512; i += NT) { CT[i] = r_k[i]; CT[512 + i] = ln_w[i]; CT[1024 + i] = ln_b[i]; }
        for (int i = tid; i < 1024; i += NT) CT[1536 + i] = nw[i];
        __syncthreads(); }
    const int c = lane * 8, m0 = lane * 16, hh = m0 >> 6; const size_t st = (size_t)MTOT * 512; const float dsk = Dsk[hh];
#define MO_LOAD(R_, row_) do { const size_t rw_ = (size_t)(row_); const size_t o_ = rw_ * 512 + c; \
        R_[0] = ldg16(YR + o_); R_[1] = ldg16(YR + st + o_); R_[2] = ldg16(R5 + o_); R_[3] = ldg16(R5 + st + o_); R_[4] = ldg16(R5 + 2 * st + o_); \
        R_[5] = *(const uint4*)(F + rw_ * 2048 + 1536 + c); R_[6] = *(const uint4*)(F + rw_ * 2048 + 1536 + c + 4); \
        R_[7] = ldg16(YM + rw_ * 1024 + m0); R_[8] = ldg16(YM + rw_ * 1024 + m0 + 8); R_[9] = ldg16(XBC + rw_ * 1536 + m0); R_[10] = ldg16(XBC + rw_ * 1536 + m0 + 8); \
        R_[11] = ldg16(U + rw_ * NINP + C_MB_Z + m0); R_[12] = ldg16(U + rw_ * NINP + C_MB_Z + m0 + 8); } while (0)
    uint4 cur[13];
    int r = bid * NW + wid; const int stride = G * NW;
    if (r < M) MO_LOAD(cur, r);
    for (; r < M; r += stride) {
        uint4 nx[13];
#pragma unroll
        for (int i = 0; i < 13; ++i) nx[i] = cur[i];
        if (r + stride < M) MO_LOAD(nx, r + stride);
        {
            float y[8];
            { float yf[8], yb[8]; unpack8(cur[0], yf); unpack8(cur[1], yb);
#pragma unroll
              for (int e = 0; e < 8; ++e) y[e] = yf[e] + yb[e]; }
            float sm = 0.f;
#pragma unroll
            for (int e = 0; e < 8; ++e) sm += y[e];
            const float mean = red8(sm) * (1.0f / 64.0f); float sv = 0.f;
#pragma unroll
            for (int e = 0; e < 8; ++e) { y[e] -= mean; sv += y[e] * y[e]; }
            const float rs = rsqrtf(red8(sv) * (1.0f / 64.0f) + 64e-5f);
            float rr[8], kk[8], vv[8]; unpack8(cur[2], rr); unpack8(cur[3], kk); unpack8(cur[4], vv);
            const f32x4 rk0 = *(const LAS f32x4*)(CT + c), rk1 = *(const LAS f32x4*)(CT + c + 4), lw0 = *(const LAS f32x4*)(CT + 512 + c), lw1 = *(const LAS f32x4*)(CT + 512 + c + 4), lb0 = *(const LAS f32x4*)(CT + 1024 + c), lb1 = *(const LAS f32x4*)(CT + 1024 + c + 4);
            float dot = 0.f;
#pragma unroll
            for (int e = 0; e < 8; ++e) dot += rr[e] * kk[e] * (e < 4 ? rk0[e & 3] : rk1[e & 3]);
            dot = red8(dot);
            const float g[8] = {__uint_as_float(cur[5].x), __uint_as_float(cur[5].y), __uint_as_float(cur[5].z), __uint_as_float(cur[5].w), __uint_as_float(cur[6].x), __uint_as_float(cur[6].y), __uint_as_float(cur[6].z), __uint_as_float(cur[6].w)}; float ov[8];
#pragma unroll
            for (int e = 0; e < 8; ++e) ov[e] = (y[e] * rs * (e < 4 ? lw0[e & 3] : lw1[e & 3]) + (e < 4 ? lb0[e & 3] : lb1[e & 3]) + dot * vv[e]) * g[e];
            *(uint4*)(A2 + (size_t)r * DM + c) = pack8(ov);
        }
        {
            float y[16]; float ss = 0.f;
#pragma unroll
            for (int q = 0; q < 2; ++q) {
                float ys[8]; unpack8(cur[7 + q], ys);
                float xs[8], z[8]; unpack8(cur[9 + q], xs); unpack8(cur[11 + q], z);
#pragma unroll
                for (int e = 0; e < 8; ++e) { const float v = (ys[e] + dsk * xs[e]) * fsilu(z[e]); y[q * 8 + e] = v; ss += v * v; } }
            ss = red32(ss);
            const float rs = rsqrtf(ss * (1.0f / 512.0f) + 1e-5f);
#pragma unroll
            for (int q = 0; q < 2; ++q) { const int m = m0 + q * 8; float ov[8];
                const f32x4 n0 = *(const LAS f32x4*)(CT + 1536 + m), n1 = *(const LAS f32x4*)(CT + 1536 + m + 4);
#pragma unroll
                for (int e = 0; e < 8; ++e) ov[e] = y[q * 8 + e] * rs * (e < 4 ? n0[e & 3] : n1[e & 3]);
                *(uint4*)(A2 + (size_t)r * DM + 512 + m) = pack8(ov); }
        }
#pragma unroll
        for (int i = 0; i < 13; ++i) cur[i] = nx[i];
    }
#undef MO_LOAD
}

__device__ __forceinline__ int chain_row(int s, int b, int dir) {
    if (s < CTXL) return MLAT + b * CTXL + (dir ? (CTXL - 1 - s) : s);
    const int t = s - CTXL; return b * SEQ + (dir ? (SEQ - 1 - t) : t);
}
constexpr int CH_STEPS = CTXL + SEQ, CH_T = 32, CH_NC = CH_STEPS / CH_T;


typedef short s16x4 __attribute__((ext_vector_type(4)));
constexpr int MB_NCH = 18;
__device__ __forceinline__ int mb_row0(int b, int cc) { return cc < 2 ? MLAT + b * CTXL + cc * 128 : b * SEQ + (cc - 2) * 128; }
__device__ __forceinline__ bf16x8 trfrag(const LAS bf16* pA, const LAS bf16* pB) {
    const s16x4 v0 = __builtin_amdgcn_ds_read_tr16_b64_v4i16((LAS s16x4*)pA), v1 = __builtin_amdgcn_ds_read_tr16_b64_v4i16((LAS s16x4*)pB);
    return __builtin_shufflevector(v0, v1, 0, 1, 2, 3, 4, 5, 6, 7);
}
constexpr int MB_PB = 144, MB_PX = 72;
constexpr int MB_OFF_C = 0, MB_OFF_B = 36864, MB_OFF_X = 73728  , MB_OFF_V = 110592  ;

__device__ __forceinline__ void mb_vectors(const float* DT, int row0, int g, LAS float* tmp, LAS float* vec, int tid) {
    for (int i = tid; i < 128 * 16; i += NT) { const int l = i >> 4, q4 = i & 15; *(LAS f32x4*)(tmp + l * 64 + q4 * 4) = *(const f32x4*)(DT + (size_t)(row0 + l) * 64 + q4 * 4); }
    __syncthreads();
    LAS float* tot = tmp + 128 * 64;
    const int seq = tid >> 5, j = tid & 31, hh = seq & 7, dir = seq >> 3;
    float v[4], run = 0.f;
#pragma unroll
    for (int e = 0; e < 4; ++e) { const int l = dir ? 127 - (4 * j + e) : 4 * j + e; run += tmp[l * 64 + 32 + dir * 16 + g * 8 + hh]; v[e] = run; }
    tot[seq * 32 + j] = run;
    __syncthreads();
    float off = 0.f;
    for (int q = 0; q < 32; ++q) { const float tq = tot[seq * 32 + q]; off += q < j ? tq : 0.f; }
#pragma unroll
    for (int e = 0; e < 4; ++e) { const int l = dir ? 127 - (4 * j + e) : 4 * j + e; vec[dir * 1024 + hh * 128 + l] = v[e] + off; }
    __syncthreads();
    for (int i = tid; i < 2048; i += NT) { const int d2 = i >> 10, h2 = (i >> 7) & 7, l = i & 127; const int ref = d2 ? (l & ~15) : (l | 15);
        vec[2048 + i] = __expf(fmaxf(vec[d2 * 1024 + h2 * 128 + ref] - vec[d2 * 1024 + h2 * 128 + l], -80.f)) * tmp[l * 64 + d2 * 16 + g * 8 + h2]; }
    __syncthreads();
}

__device__ __forceinline__ void mamba_m1(const Ctx& a, LAS unsigned char* lds, int item) {
    unsigned char* ws = opqp(a.ws); const int tid = ((a.wv << 6) | lane_v()), lane = tid & 63, wid = tid >> 6, fr = lane & 15, fq = lane >> 4, q4 = (lane & 15) >> 2, p4 = lane & 3;
    const int g = item & 1, cc = (item >> 1) % MB_NCH, b = (item >> 1) / MB_NCH; const int row0 = mb_row0(b, cc);
    const bf16* XBC = (const bf16*)(ws + WS_XBC); const float* DT = (const float*)(ws + WS_DT); bf16* ST = (bf16*)(ws + WS_ST); float* AC = (float*)(ws + WS_AC);
    LAS bf16* Bs = (LAS bf16*)(lds + MB_OFF_B); LAS float* vec = (LAS float*)(lds + MB_OFF_V);
    __syncthreads();
    mb_vectors(DT, row0, g, (LAS float*)(lds + MB_OFF_C), vec, tid);
    if (tid < 16) { const int hh = tid & 7, dir = tid >> 3; AC[((size_t)(b * MB_NCH + cc) * 16 + g * 8 + hh) * 2 + dir] = dir ? vec[1024 + hh * 128] : vec[hh * 128 + 127]; }
    for (int i = tid; i < 2048; i += NT) { const int l = i >> 4, ch = i & 15; *(LAS u32x4*)(Bs + l * MB_PB + ch * 8) = *(const u32x4*)(XBC + (size_t)(row0 + l) * 1536 + 1024 + g * 128 + ch * 8); }
    uint4 xq[2];
#pragma unroll
    for (int j = 0; j < 2; ++j) { const int id = tid + j * NT; xq[j] = *(const uint4*)(XBC + (size_t)(row0 + (id >> 3)) * 1536 + (g * 8) * 64 + (id & 7) * 8); }
    for (int hh = 0; hh < 8; ++hh) {
        const int h = g * 8 + hh;
        LAS bf16* Yf = (LAS bf16*)(lds + ((hh & 1) ? MB_OFF_X : MB_OFF_C)); LAS bf16* Yb = Yf + 128 * MB_PX;
        const float tf = vec[hh * 128 + 127];
        uint4 xc[2] = {xq[0], xq[1]};
        if (hh + 1 < 8) {
#pragma unroll
            for (int j = 0; j < 2; ++j) { const int id = tid + j * NT; xq[j] = *(const uint4*)(XBC + (size_t)(row0 + (id >> 3)) * 1536 + (h + 1) * 64 + (id & 7) * 8); } }
#pragma unroll
        for (int j = 0; j < 2; ++j) { const int id = tid + j * NT, l = id >> 3, ch = id & 7; float x8[8], of[8], ob[8];
            unpack8(xc[j], x8);
            const float sf = __expf(tf - vec[hh * 128 + (l | 15)]) * vec[2048 + hh * 128 + l], sb = __expf(vec[1024 + hh * 128] - vec[1024 + hh * 128 + (l & ~15)]) * vec[3072 + hh * 128 + l];
#pragma unroll
            for (int e = 0; e < 8; ++e) { of[e] = x8[e] * sf; ob[e] = x8[e] * sb; }
            const uint4 pf = pack8(of), pb = pack8(ob);
            *(LAS u32x4*)(Yf + l * MB_PX + ch * 8) = (u32x4){pf.x, pf.y, pf.z, pf.w}; *(LAS u32x4*)(Yb + l * MB_PX + ch * 8) = (u32x4){pb.x, pb.y, pb.z, pb.w}; }
        __syncthreads();
        const int pt = wid & 3, nh = wid >> 2;
#pragma unroll
        for (int dir = 0; dir < 2; ++dir) { const LAS bf16* Xd = dir ? Yb : Yf;
            bf16x8 yf4[4];
#pragma unroll
            for (int ks = 0; ks < 4; ++ks) { const LAS bf16* pa = Xd + (ks * 32 + 8 * fq + q4) * MB_PX + pt * 16 + 4 * p4; yf4[ks] = trfrag(pa, pa + 4 * MB_PX); }
#pragma unroll
            for (int ns = 0; ns < 4; ++ns) { f32x4 acc = (f32x4){0.f, 0.f, 0.f, 0.f};
#pragma unroll
                for (int ks = 0; ks < 4; ++ks) { const LAS bf16* pa = Bs + (ks * 32 + 8 * fq + q4) * MB_PB + (nh * 4 + ns) * 16 + 4 * p4;
                    acc = __builtin_amdgcn_mfma_f32_16x16x32_bf16(trfrag(pa, pa + 4 * MB_PB), yf4[ks], acc, 0, 0, 0); }
                uint2 pk; pk.x = pk2(acc[0], acc[1]); pk.y = pk2(acc[2], acc[3]);
                *(uint2*)(ST + ((((size_t)(b * MB_NCH + cc) * 16 + h) * 2 + dir) * 64 + pt * 16 + fr) * 128 + (nh * 4 + ns) * 16 + 4 * fq) = pk; } }
    }
}

__device__ __forceinline__ void mamba_m2(const Ctx& a, int item) {
    unsigned char* ws = opqp(a.ws); const int tid = ((a.wv << 6) | lane_v());
    const int dir = item & 1, h = (item >> 1) & 15, b = item >> 5;
    bf16* ST = (bf16*)(ws + WS_ST); const float* AC = (const float*)(ws + WS_AC);
    float H[16];
#pragma unroll
    for (int i = 0; i < 16; ++i) H[i] = 0.f;
#define M2_CC(st_) (dir == 0 ? (st_) : ((st_) < 2 ? 1 - (st_) : 19 - (st_)))
#define M2_PTR(st_) (ST + ((((size_t)(b * MB_NCH + M2_CC(st_)) * 16 + h) * 2 + dir) * 64) * 128 + tid * 16)
    uint4 s0 = *(const uint4*)M2_PTR(0), s1 = *(const uint4*)(M2_PTR(0) + 8); float la = AC[((size_t)(b * MB_NCH + M2_CC(0)) * 16 + h) * 2 + dir];
    for (int st = 0; st < MB_NCH; ++st) {
        bf16* p = M2_PTR(st);
        const int sn = st + 1 < MB_NCH ? st + 1 : st;
        const uint4 n0 = *(const uint4*)M2_PTR(sn), n1 = *(const uint4*)(M2_PTR(sn) + 8); const float ln = AC[((size_t)(b * MB_NCH + M2_CC(sn)) * 16 + h) * 2 + dir];
        float f0[8], f1[8]; unpack8(s0, f0); unpack8(s1, f1);
        const float ea = __expf(la);
        float o0[8], o1[8];
#pragma unroll
        for (int e = 0; e < 8; ++e) { o0[e] = H[e]; o1[e] = H[8 + e]; H[e] = ea * H[e] + f0[e]; H[8 + e] = ea * H[8 + e] + f1[e]; }
        *(uint4*)p = pack8(o0); *(uint4*)(p + 8) = pack8(o1);
        s0 = n0; s1 = n1; la = ln;
    }
#undef M2_CC
#undef M2_PTR
}

__device__ __forceinline__ void mamba_m3(const Ctx& a, LAS unsigned char* lds, int b, int cc, int g) {
    unsigned char* ws = opqp(a.ws); const int tid = ((a.wv << 6) | lane_v()), lane = tid & 63, wid = tid >> 6, fr = lane & 15, fq = lane >> 4, q4 = (lane & 15) >> 2, p4 = lane & 3;
    const int row0 = mb_row0(b, cc);
    const bf16* XBC = (const bf16*)(ws + WS_XBC); const float* DT = (const float*)(ws + WS_DT); const bf16* ST = (const bf16*)(ws + WS_ST); bf16* YM = (bf16*)(ws + WS_YM);
    LAS bf16* Cs = (LAS bf16*)(lds + MB_OFF_C); LAS bf16* Bs = (LAS bf16*)(lds + MB_OFF_B); LAS float* vec = (LAS float*)(lds + MB_OFF_V);
    __syncthreads();
    mb_vectors(DT, row0, g, (LAS float*)(lds + MB_OFF_C), vec, tid);
    for (int i = tid; i < 2048; i += NT) { const int l = i >> 4, ch = i & 15; const bf16* src = XBC + (size_t)(row0 + l) * 1536 + g * 128 + ch * 8;
        *(LAS u32x4*)(Bs + l * MB_PB + ch * 8) = *(const u32x4*)(src + 1024); *(LAS u32x4*)(Cs + l * MB_PB + ch * 8) = *(const u32x4*)(src + 1280); }
    uint4 xr[2];
#define M3_XLOAD(hh_) do { _Pragma("unroll") for (int j_ = 0; j_ < 2; ++j_) { const int id_ = tid + j_ * NT; xr[j_] = *(const uint4*)(XBC + (size_t)(row0 + (id_ >> 3)) * 1536 + (g * 8 + (hh_)) * 64 + (id_ & 7) * 8); } } while (0)
#define M3_XSTORE(hh_) do { LAS bf16* X_ = (LAS bf16*)(lds + MB_OFF_X) + ((hh_) & 1) * 128 * MB_PX; _Pragma("unroll") for (int j_ = 0; j_ < 2; ++j_) { const int id_ = tid + j_ * NT; \
        *(LAS u32x4*)(X_ + (id_ >> 3) * MB_PX + (id_ & 7) * 8) = (u32x4){xr[j_].x, xr[j_].y, xr[j_].z, xr[j_].w}; } } while (0)
    M3_XLOAD(0); M3_XSTORE(0);
    __syncthreads();
    const int l0 = wid * 16;
    bf16x8 cf[4];
#pragma unroll
    for (int ks = 0; ks < 4; ++ks) cf[ks] = *(const LAS bf16x8*)(Cs + (l0 + fr) * MB_PB + ks * 32 + fq * 8);
    f32x4 CB[8];
#pragma unroll
    for (int sb = 0; sb < 8; ++sb) { f32x4 acc = (f32x4){0.f, 0.f, 0.f, 0.f};
#pragma unroll
        for (int ks = 0; ks < 4; ++ks) acc = __builtin_amdgcn_mfma_f32_16x16x32_bf16(*(const LAS bf16x8*)(Bs + (sb * 16 + fr) * MB_PB + ks * 32 + fq * 8), cf[ks], acc, 0, 0, 0);
        CB[sb] = acc; }
    constexpr int M3_HP = 272;
    static_assert(2 * 64 * M3_HP <= 128 * MB_PB * 2, "M3 H staging fits the B tile");
    LAS unsigned char* HB = lds + MB_OFF_B;
    uint4 hq[4];
#define M3_HGLOAD(hh_) do { const bf16* H_ = ST + (((size_t)(b * MB_NCH + cc) * 16 + g * 8 + (hh_)) * 2) * 64 * 128; \
        _Pragma("unroll") for (int j_ = 0; j_ < 4; ++j_) { const int id_ = tid + j_ * NT; hq[j_] = *(const uint4*)(H_ + (size_t)id_ * 8); } } while (0)
#define M3_HGSTORE() do { _Pragma("unroll") for (int j_ = 0; j_ < 4; ++j_) { const int id_ = tid + j_ * NT; \
        *(LAS u32x4*)(HB + (id_ >> 4) * M3_HP + (id_ & 15) * 16) = (u32x4){hq[j_].x, hq[j_].y, hq[j_].z, hq[j_].w}; } } while (0)
    M3_HGLOAD(0);
    float mfd[4], mbd[4];
#pragma unroll
    for (int e = 0; e < 4; ++e) { const int dd = 4 * fq + e - fr; mfd[e] = dd <= 0 ? 1.f : 0.f; mbd[e] = dd >= 0 ? 1.f : 0.f; }
    const int nhh = (a.sub & 16) ? 0 : ((a.sub & 8) ? 1 : 8);
    __syncthreads();
    for (int hh = 0; hh < nhh; ++hh) {
        const int h = g * 8 + hh;
        M3_HGSTORE();
        if (hh + 1 < 8) { M3_HGLOAD(hh + 1); M3_XLOAD(hh + 1); }
        __syncthreads();
        const LAS bf16* X = (const LAS bf16*)(lds + MB_OFF_X) + (hh & 1) * 128 * MB_PX;
        const LAS float* vf = vec + hh * 128; const LAS float* vb = vec + 1024 + hh * 128; const LAS float* cF = vec + 2048 + hh * 128; const LAS float* cB = vec + 3072 + hh * 128;
        const float afl = vf[l0 + fr], abl = vb[l0 + fr];
        bf16x8 wf[4];
#pragma unroll
        for (int kc = 0; kc < 4; ++kc) { float wv[8];
#pragma unroll
            for (int hs = 0; hs < 2; ++hs) { const int sb = 2 * kc + hs, s0 = sb * 16 + 4 * fq;
                float rf = 0.f, rb = 0.f;
                if (sb <= wid) rf = __expf(fminf(afl - vf[sb * 16 + 15], 80.f));
                if (sb >= wid) rb = __expf(fminf(abl - vb[sb * 16], 80.f));
                const f32x4 c_f = *(const LAS f32x4*)(cF + s0), c_b = *(const LAS f32x4*)(cB + s0);
#pragma unroll
                for (int e = 0; e < 4; ++e) { float m;
                    if (sb < wid) m = rf * c_f[e]; else if (sb > wid) m = rb * c_b[e]; else m = rf * c_f[e] * mfd[e] + rb * c_b[e] * mbd[e];
                    wv[hs * 4 + e] = CB[sb][e] * m; } }
            u32x4 w; w.x = pk2(wv[0], wv[1]); w.y = pk2(wv[2], wv[3]); w.z = pk2(wv[4], wv[5]); w.w = pk2(wv[6], wv[7]); wf[kc] = __builtin_bit_cast(bf16x8, w); }
        const float ef = __expf(afl), eb = __expf(abl);
#define M3_STEP(pt_) do { \
            f32x4 yd = (f32x4){0.f, 0.f, 0.f, 0.f}, y1 = yd, y2 = yd; \
            _Pragma("unroll") for (int kc = 0; kc < 4; ++kc) { const LAS bf16* pa = X + (kc * 32 + 4 * fq + q4) * MB_PX + (pt_) * 16 + 4 * p4; \
                yd = __builtin_amdgcn_mfma_f32_16x16x32_bf16(trfrag(pa, pa + 16 * MB_PX), wf[kc], yd, 0, 0, 0); } \
            const LAS unsigned char* hf_ = HB + ((pt_) * 16 + fr) * M3_HP + fq * 16; \
            _Pragma("unroll") for (int ks = 0; ks < 4; ++ks) { y1 = __builtin_amdgcn_mfma_f32_16x16x32_bf16(*(const LAS bf16x8*)(hf_ + ks * 64), cf[ks], y1, 0, 0, 0); \
                y2 = __builtin_amdgcn_mfma_f32_16x16x32_bf16(*(const LAS bf16x8*)(hf_ + 64 * M3_HP + ks * 64), cf[ks], y2, 0, 0, 0); } \
            f32x4 o; \
            _Pragma("unroll") for (int e = 0; e < 4; ++e) o[e] = yd[e] + ef * y1[e] + eb * y2[e]; \
            { uint2 pk; pk.x = pk2(o[0], o[1]); pk.y = pk2(o[2], o[3]); *(uint2*)(YM + (size_t)(row0 + l0 + fr) * 1024 + h * 64 + (pt_) * 16 + 4 * fq) = pk; } } while (0)
        M3_STEP(0); M3_STEP(1); M3_STEP(2); M3_STEP(3);
#undef M3_STEP
        if (hh + 1 < 8) { M3_XSTORE(hh + 1); }
        __syncthreads();
    }
#undef M3_XLOAD
#undef M3_XSTORE
#undef M3_HGLOAD
#undef M3_HGSTORE
}


constexpr int RC_NCH = CH_STEPS / 16;
constexpr int RC_UNITS = 128 * RC_NCH;
constexpr int RC_TP = 72;
constexpr int RC_WAVE_LDS = 5 * 16 * RC_TP * 2 + 16 * 17 * 4 + 16 * 24 * 2;
constexpr int RC_CT_FLOATS = 6 * 512 + 3 * 512;
static_assert(8 * RC_WAVE_LDS + RC_CT_FLOATS * 4 <= LDS_STAGE, "rwkv R1 LDS");
__device__ __forceinline__ void rc_consts(LAS unsigned char* lds, int l, int tid) {
    LAS float* CT = (LAS float*)(lds + 8 * RC_WAVE_LDS);
    const float* mu = ldin(12) + (size_t)l * 2 * 1792; const float* a0 = ldin(15) + l * 512; const float* k_k = ldin(18) + l * 512; const float* k_a = ldin(19) + l * 512;
    for (int i = tid; i < 1536; i += NT) { CT[i] = mu[i]; CT[1536 + i] = mu[1792 + i]; }
    for (int i = tid; i < 512; i += NT) { CT[3072 + i] = a0[i]; CT[3584 + i] = k_k[i]; CT[4096 + i] = k_a[i]; }
    __syncthreads();
}
constexpr size_t RC_REC = 16 * 64 + 16 * 64 + 16 * 64 + 64 * 32 + 16 * 64;
constexpr size_t WS_RC1 = WS_MGU + 224 * MiB;
constexpr size_t WS_RC2 = WS_MD + 112 * MiB;
static_assert(MOE_FP8 == 1 && (size_t)RC_UNITS * RC_REC * 2 <= 224 * MiB && (size_t)RC_UNITS * (4096 + 256) <= 112 * MiB, "rwkv chunk records");

__device__ __forceinline__ bf16x8 pack_lo4(const f32x4 v) { u32x4 w; w.x = pk2(v[0], v[1]); w.y = pk2(v[2], v[3]); w.z = 0u; w.w = 0u; return __builtin_bit_cast(bf16x8, w); }

__device__ __forceinline__ void rwkv_r1(const Ctx& a, LAS unsigned char* lds, int l, int unit) {
    unsigned char* ws = opqp(a.ws); const int tid = ((a.wv << 6) | lane_v()), lane = tid & 63, wid = tid >> 6, fr = lane & 15, fq = lane >> 4, q4 = (lane & 15) >> 2, p4 = lane & 3;
    const int chain = unit / RC_NCH, c = unit % RC_NCH; const int dir = chain & 1, h = (chain >> 1) & 7, b = chain >> 4;
    const bf16* R5 = (const bf16*)(ws + WS_RW5); const float* F = (const float*)(ws + WS_MIX); const size_t st = (size_t)MTOT * 512;
    bf16* rec = (bf16*)(ws + WS_RC1) + (size_t)unit * RC_REC; bf16* Ycg = (bf16*)(ws + WS_RC2) + (size_t)unit * 1024; float* PCg = (float*)(ws + WS_RC2) + (size_t)RC_UNITS * 1024 + (size_t)unit * 64;
    LAS bf16* tA = (LAS bf16*)(lds + wid * RC_WAVE_LDS); LAS bf16* tR = tA + 16 * RC_TP; LAS bf16* tB = tR + 16 * RC_TP; LAS bf16* tK = tB + 16 * RC_TP; LAS bf16* tV = tK + 16 * RC_TP;
    LAS float* L1s = (LAS float*)(tV + 16 * RC_TP); LAS bf16* Ts = (LAS bf16*)(L1s + 16 * 17);
    {   const int t = lane >> 2, part = lane & 3; const int row = chain_row(c * 16 + t, b, dir);
        const bool lat = row < MLAT; const int pos = lat ? (row & (SEQ - 1)) : ((row - MLAT) & (CTXL - 1)); const bool hp = pos > 0, hn = pos < (lat ? SEQ : CTXL) - 1;
        const bf16* U = (const bf16*)(ws + WS_U); const bf16* up = U + (size_t)row * NINP + h * 64 + part * 16; const int ch = h * 64 + part * 16;
        const LAS float* CT = (const LAS float*)(lds + 8 * RC_WAVE_LDS);
        float sv[3][16];
#pragma unroll
        for (int q = 0; q < 3; ++q)
#pragma unroll
            for (int hf = 0; hf < 2; ++hf) { float u[8], p[8], n[8];
                unpack8(*(const uint4*)(up + q * 512 + hf * 8), u); unpack8(hp ? *(const uint4*)(up - NINP + q * 512 + hf * 8) : make_uint4(0u, 0u, 0u, 0u), p); unpack8(hn ? *(const uint4*)(up + NINP + q * 512 + hf * 8) : make_uint4(0u, 0u, 0u, 0u), n);
#pragma unroll
                for (int e = 0; e < 8; ++e) { const int cc = ch + hf * 8 + e; sv[q][hf * 8 + e] = u[e] + CT[q * 512 + cc] * (p[e] - u[e]) + CT[1536 + q * 512 + cc] * (n[e] - u[e]); } }
        float av[16];
#pragma unroll
        for (int q4_ = 0; q4_ < 4; ++q4_) { const f32x4 f = *(const f32x4*)(F + (size_t)row * 2048 + 1024 + ch + q4_ * 4);
#pragma unroll
            for (int e = 0; e < 4; ++e) av[q4_ * 4 + e] = fsigm(f[e] + CT[3072 + ch + q4_ * 4 + e]); }
        float kkv[16], k2[16], bv[16], ss = 0.f;
#pragma unroll
        for (int e = 0; e < 16; ++e) { kkv[e] = sv[1][e] * CT[3584 + ch + e]; ss += kkv[e] * kkv[e]; }
        ss += dppf<0xB1>(ss); ss += dppf<0x4E>(ss);
        const float inv = 1.0f / fmaxf(sqrtf(ss), 1e-12f);
#pragma unroll
        for (int e = 0; e < 16; ++e) { kkv[e] *= inv; k2[e] = sv[1][e] * (1.0f + (av[e] - 1.0f) * CT[4096 + ch + e]); bv[e] = kkv[e] * av[e]; }
        const int lo = t * RC_TP + part * 16;
#define RC_PUT(T_, A_) do { *(LAS u32x4*)(T_ + lo) = (u32x4){pk2(A_[0], A_[1]), pk2(A_[2], A_[3]), pk2(A_[4], A_[5]), pk2(A_[6], A_[7])}; \
            *(LAS u32x4*)(T_ + lo + 8) = (u32x4){pk2(A_[8], A_[9]), pk2(A_[10], A_[11]), pk2(A_[12], A_[13]), pk2(A_[14], A_[15])}; } while (0)
        RC_PUT(tR, sv[0]); RC_PUT(tK, k2); RC_PUT(tV, sv[2]); RC_PUT(tA, kkv); RC_PUT(tB, bv);
#undef RC_PUT
        if (dir == 0) {
            bf16* R5w = (bf16*)(ws + WS_RW5); const size_t o = (size_t)row * 512 + ch;
            *(u32x4*)(R5w + o) = *(const LAS u32x4*)(tR + lo); *(u32x4*)(R5w + o + 8) = *(const LAS u32x4*)(tR + lo + 8);
            *(u32x4*)(R5w + st + o) = *(const LAS u32x4*)(tK + lo); *(u32x4*)(R5w + st + o + 8) = *(const LAS u32x4*)(tK + lo + 8);
            *(u32x4*)(R5w + 2 * st + o) = *(const LAS u32x4*)(tV + lo); *(u32x4*)(R5w + 2 * st + o + 8) = *(const LAS u32x4*)(tV + lo + 8); }
    }
    const int j = lane; const float w0j = ldin(13)[l * 1024 + dir * 512 + h * 64 + j];
    float wraw[16];
#pragma unroll
    for (int t = 0; t < 16; ++t) wraw[t] = F[(size_t)chain_row(c * 16 + t, b, dir) * 2048 + dir * 512 + h * 64 + j];
    __builtin_amdgcn_sched_barrier(0);
    float Lc = 0.f, Pprev = 1.0f, Lct[16], bq[16], kq[16];
#pragma unroll
    for (int t = 0; t < 16; ++t) {
        const float rv = bf2f(tR[t * RC_TP + j]), kv = bf2f(tK[t * RC_TP + j]), kkv = bf2f(tA[t * RC_TP + j]), bv = bf2f(tB[t * RC_TP + j]);
        const float lw = (-0.60653066f * 1.44269504f) * fsigm(wraw[t] + w0j);
        const float Pm1 = Pprev; Lc += lw; const float P = __builtin_amdgcn_exp2f(Lc), iP = __builtin_amdgcn_rcpf(P); Pprev = P;
        Lct[t] = Lc; bq[t] = bv; kq[t] = kv;
        tA[t * RC_TP + j] = (bf16)f2bf(-kkv * Pm1); tR[t * RC_TP + j] = (bf16)f2bf(rv * P); tB[t * RC_TP + j] = (bf16)f2bf(bv * iP); tK[t * RC_TP + j] = (bf16)f2bf(kv * iP);
    }
    PCg[j] = Pprev;
    {   unsigned vw[8];
#pragma unroll
        for (int t2 = 0; t2 < 8; ++t2) vw[t2] = (unsigned)tV[(2 * t2) * RC_TP + j] | ((unsigned)tV[(2 * t2 + 1) * RC_TP + j] << 16);
        *(uint4*)(rec + 5120 + (size_t)j * 16) = make_uint4(vw[0], vw[1], vw[2], vw[3]); *(uint4*)(rec + 5120 + (size_t)j * 16 + 8) = make_uint4(vw[4], vw[5], vw[6], vw[7]); }
    {   bf16* BK = rec + 3072 + (size_t)j * 32;
#pragma unroll
        for (int g = 0; g < 4; ++g) { float o8[8];
#pragma unroll
            for (int e = 0; e < 4; ++e) { const float d = __builtin_amdgcn_exp2f(Lc - Lct[4 * g + e]); o8[e] = bq[4 * g + e] * d; o8[4 + e] = kq[4 * g + e] * d; }
            *(uint4*)(BK + g * 8) = pack8(o8); } }
    f32x4 L1 = (f32x4){0.f, 0.f, 0.f, 0.f}, L2 = L1, M1 = L1, M2 = L1;
#pragma unroll
    for (int ks = 0; ks < 2; ++ks) {
        const bf16x8 ya = *(const LAS bf16x8*)(tA + fr * RC_TP + ks * 32 + fq * 8), yr = *(const LAS bf16x8*)(tR + fr * RC_TP + ks * 32 + fq * 8);
        const bf16x8 xb = *(const LAS bf16x8*)(tB + fr * RC_TP + ks * 32 + fq * 8), xk = *(const LAS bf16x8*)(tK + fr * RC_TP + ks * 32 + fq * 8);
        L1 = __builtin_amdgcn_mfma_f32_16x16x32_bf16(xb, ya, L1, 0, 0, 0); L2 = __builtin_amdgcn_mfma_f32_16x16x32_bf16(xk, ya, L2, 0, 0, 0);
        M1 = __builtin_amdgcn_mfma_f32_16x16x32_bf16(xb, yr, M1, 0, 0, 0); M2 = __builtin_amdgcn_mfma_f32_16x16x32_bf16(xk, yr, M2, 0, 0, 0);
    }
#pragma unroll
    for (int e = 0; e < 4; ++e) { const int s = 4 * fq + e, t = fr;
        if (!(s < t)) { L1[e] = 0.f; L2[e] = 0.f; } if (!(s <= t)) { M1[e] = 0.f; M2[e] = 0.f; }
        }
    {   const int cc = lane & 15; float Tc[16];
#pragma unroll
        for (int t = 0; t < 16; ++t) { float acc = (t == cc) ? 1.f : 0.f;
#pragma unroll
            for (int s = 0; s < t; ++s) { const float lts = __int_as_float(__builtin_amdgcn_readlane(__float_as_int(L1[s & 3]), 16 * (s >> 2) + t)); acc += lts * Tc[s]; }
            Tc[t] = acc; }
        if (lane < 16) {
#pragma unroll
            for (int t = 0; t < 16; ++t) Ts[t * 24 + cc] = (bf16)f2bf(Tc[t]); } }
    const bf16x8 Top = __builtin_bit_cast(bf16x8, (u32x4){((const LAS unsigned*)(Ts + fr * 24 + 4 * fq))[0], ((const LAS unsigned*)(Ts + fr * 24 + 4 * fq))[1], 0u, 0u});
    const bf16x8 L2op = pack_lo4(L2), M1op = pack_lo4(M1), M2op = pack_lo4(M2);
#pragma unroll
    for (int kt = 0; kt < 4; ++kt) { const LAS bf16* pa = tA + (4 * fq + q4) * RC_TP + kt * 16 + 4 * p4;
        const f32x4 ta = __builtin_amdgcn_mfma_f32_16x16x32_bf16(trfrag(pa, pa), Top, (f32x4){0.f, 0.f, 0.f, 0.f}, 0, 0, 0);
        uint2 pk; pk.x = pk2(ta[0], ta[1]); pk.y = pk2(ta[2], ta[3]);
        *(uint2*)(rec + fr * 64 + 32 * (kt >> 1) + 8 * fq + 4 * (kt & 1)) = pk;
        *(LAS u32x2*)(tB + fr * RC_TP + kt * 16 + 4 * fq) = (u32x2){pk.x, pk.y}; }
#pragma unroll
    for (int vt = 0; vt < 4; ++vt) { const LAS bf16* pa = tV + (4 * fq + q4) * RC_TP + vt * 16 + 4 * p4;
        const f32x4 x = __builtin_amdgcn_mfma_f32_16x16x32_bf16(trfrag(pa, pa), L2op, (f32x4){0.f, 0.f, 0.f, 0.f}, 0, 0, 0);
        *(LAS u32x2*)(tK + fr * RC_TP + vt * 16 + 4 * fq) = (u32x2){pk2(x[0], x[1]), pk2(x[2], x[3])}; }
#pragma unroll
    for (int kt = 0; kt < 4; ++kt) { const LAS bf16* pa = tB + (4 * fq + q4) * RC_TP + kt * 16 + 4 * p4;
        const u32x2 r2 = *(const LAS u32x2*)(tR + fr * RC_TP + kt * 16 + 4 * fq);
        f32x4 ra = (f32x4){__uint_as_float(r2.x << 16), __uint_as_float(r2.x & 0xffff0000u), __uint_as_float(r2.y << 16), __uint_as_float(r2.y & 0xffff0000u)};
        ra = __builtin_amdgcn_mfma_f32_16x16x32_bf16(trfrag(pa, pa), M1op, ra, 0, 0, 0);
        uint2 pk; pk.x = pk2(ra[0], ra[1]); pk.y = pk2(ra[2], ra[3]);
        *(uint2*)(rec + 1024 + fr * 64 + 32 * (kt >> 1) + 8 * fq + 4 * (kt & 1)) = pk; }
#pragma unroll
    for (int vt = 0; vt < 4; ++vt) { const LAS bf16* pa = tK + (4 * fq + q4) * RC_TP + vt * 16 + 4 * p4;
        const f32x4 x = __builtin_amdgcn_mfma_f32_16x16x32_bf16(trfrag(pa, pa), Top, (f32x4){0.f, 0.f, 0.f, 0.f}, 0, 0, 0);
        uint2 pk; pk.x = pk2(x[0], x[1]); pk.y = pk2(x[2], x[3]);
#pragma unroll
        for (int e = 0; e < 4; ++e) rec[2048 + (size_t)(vt * 16 + 4 * fq + e) * 16 + fr] = (bf16)f2bf(x[e]);
        *(LAS u32x2*)(tA + fr * RC_TP + vt * 16 + 4 * fq) = (u32x2){pk.x, pk.y}; }
#pragma unroll
    for (int vt = 0; vt < 4; ++vt) { const LAS bf16* pg = tA + (4 * fq + q4) * RC_TP + vt * 16 + 4 * p4; const LAS bf16* pv = tV + (4 * fq + q4) * RC_TP + vt * 16 + 4 * p4;
        f32x4 x = __builtin_amdgcn_mfma_f32_16x16x32_bf16(trfrag(pg, pg), M1op, (f32x4){0.f, 0.f, 0.f, 0.f}, 0, 0, 0);
        x = __builtin_amdgcn_mfma_f32_16x16x32_bf16(trfrag(pv, pv), M2op, x, 0, 0, 0);
#pragma unroll
        for (int e = 0; e < 4; ++e) Ycg[(size_t)(vt * 16 + 4 * fq + e) * 16 + fr] = (bf16)f2bf(x[e]); }
}

constexpr int R2_NV = 1, R2_WPC = 4 / R2_NV  , R2_CPW = 8 / R2_WPC  , R2_ITEMS = 128 / R2_CPW;
__device__ __forceinline__ void rwkv_r2(const Ctx& a, int l, int item) {
    unsigned char* ws = opqp(a.ws); const int tid = ((a.wv << 6) | lane_v()), lane = tid & 63, wid = tid >> 6, fr = lane & 15, fq = lane >> 4;
    const int chain = R2_CPW * item + (wid / R2_WPC), v0 = 16 * R2_NV * (wid % R2_WPC); const int dir = chain & 1, h = (chain >> 1) & 7, b = chain >> 4;
    bf16* Y = (bf16*)(ws + WS_YR) + (size_t)dir * MTOT * 512;
    f32x4 S[R2_NV][4];
#pragma unroll
    for (int vg = 0; vg < R2_NV; ++vg)
#pragma unroll
        for (int kt = 0; kt < 4; ++kt) S[vg][kt] = (f32x4){0.f, 0.f, 0.f, 0.f};
    struct Rec { bf16x8 taf[2], raf[2], bkf[4]; f32x4 pc[4]; uint2 g2[R2_NV], v2[R2_NV], yc[R2_NV]; int r0; };
    Rec ra, rb, rc;
#define R2_LOAD(R_, c_) do { const size_t unit_ = (size_t)chain * RC_NCH + (c_); \
        const bf16* rec_ = (const bf16*)(ws + WS_RC1) + unit_ * RC_REC; const bf16* Ycg_ = (const bf16*)(ws + WS_RC2) + unit_ * 1024; const float* PCg_ = (const float*)(ws + WS_RC2) + (size_t)RC_UNITS * 1024 + unit_ * 64; \
        _Pragma("unroll") for (int jj = 0; jj < 2; ++jj) { R_.taf[jj] = *(const bf16x8*)(rec_ + fr * 64 + jj * 32 + fq * 8); R_.raf[jj] = *(const bf16x8*)(rec_ + 1024 + fr * 64 + jj * 32 + fq * 8); } \
        _Pragma("unroll") for (int kt = 0; kt < 4; ++kt) { R_.bkf[kt] = *(const bf16x8*)(rec_ + 3072 + (size_t)(kt * 16 + fr) * 32 + fq * 8); R_.pc[kt] = *(const f32x4*)(PCg_ + kt * 16 + 4 * fq); } \
        _Pragma("unroll") for (int vg = 0; vg < R2_NV; ++vg) { const size_t vo_ = (size_t)(v0 + 16 * vg + fr) * 16 + 4 * fq; \
            R_.g2[vg] = *(const uint2*)(rec_ + 2048 + vo_); R_.v2[vg] = *(const uint2*)(rec_ + 5120 + vo_); R_.yc[vg] = *(const uint2*)(Ycg_ + vo_); } \
        const int s0_ = (c_) * 16; const int inc_ = s0_ < CTXL ? 1 : 0; const int t0_ = s0_ - (inc_ ? 0 : CTXL), L_ = inc_ ? CTXL : SEQ, base_ = inc_ ? MLAT + b * CTXL : b * SEQ; \
        R_.r0 = base_ + (dir ? L_ - 1 - t0_ : t0_); } while (0)
#define R2_STEP(R_, c_) do { _Pragma("unroll") for (int vg = 0; vg < R2_NV; ++vg) { \
        bf16x8 sb[2]; \
        _Pragma("unroll") for (int jj = 0; jj < 2; ++jj) { u32x4 w; w.x = pk2(S[vg][2 * jj][0], S[vg][2 * jj][1]); w.y = pk2(S[vg][2 * jj][2], S[vg][2 * jj][3]); w.z = pk2(S[vg][2 * jj + 1][0], S[vg][2 * jj + 1][1]); w.w = pk2(S[vg][2 * jj + 1][2], S[vg][2 * jj + 1][3]); sb[jj] = __builtin_bit_cast(bf16x8, w); } \
        f32x4 xt = (f32x4){0.f, 0.f, 0.f, 0.f}, yt = xt; \
        _Pragma("unroll") for (int jj = 0; jj < 2; ++jj) { xt = __builtin_amdgcn_mfma_f32_16x16x32_bf16(R_.taf[jj], sb[jj], xt, 0, 0, 0); yt = __builtin_amdgcn_mfma_f32_16x16x32_bf16(R_.raf[jj], sb[jj], yt, 0, 0, 0); }     \
        float yc4_[4]; unpack4(R_.yc[vg], yc4_); \
        _Pragma("unroll") for (int e = 0; e < 4; ++e) Y[(size_t)(R_.r0 + (dir ? -(4 * fq + e) : (4 * fq + e))) * 512 + h * 64 + v0 + 16 * vg + fr] = (bf16)f2bf(yt[e] + yc4_[e]); \
        float g4_[4]; unpack4(R_.g2[vg], g4_); \
        u32x4 w; w.x = pk2(xt[0] + g4_[0], xt[1] + g4_[1]); w.y = pk2(xt[2] + g4_[2], xt[3] + g4_[3]); w.z = R_.v2[vg].x; w.w = R_.v2[vg].y; \
        const bf16x8 yop = __builtin_bit_cast(bf16x8, w);                    \
        _Pragma("unroll") for (int kt = 0; kt < 4; ++kt) { S[vg][kt] = S[vg][kt] * R_.pc[kt]; S[vg][kt] = __builtin_amdgcn_mfma_f32_16x16x32_bf16(R_.bkf[kt], yop, S[vg][kt], 0, 0, 0); } } } while (0)
#define R2_CL(x_) ((x_) < RC_NCH ? (x_) : RC_NCH - 1)
    static_assert(RC_NCH % 3 == 0, "R2 unroll");
    R2_LOAD(ra, 0); R2_LOAD(rb, 1);
    for (int c = 0; c < RC_NCH; c += 3) {
        R2_LOAD(rc, R2_CL(c + 2)); R2_STEP(ra, c);
        R2_LOAD(ra, R2_CL(c + 3)); R2_STEP(rb, c + 1);
        R2_LOAD(rb, R2_CL(c + 4)); R2_STEP(rc, c + 2);
    }
#undef R2_STEP
#undef R2_CL
#undef R2_LOAD
}

constexpr int RW_LD = 384;
constexpr int RW_YOFF = 2 * CH_T * RW_LD;
__device__ __forceinline__ void rwkv_chain(const Ctx& a, LAS unsigned char* lds, int l, int item) {
    unsigned char* ws = opqp(a.ws); const int tid = ((a.wv << 6) | lane_v());
    const int dir = item & 1, h = (item >> 1) & 7, b = item >> 4;
    const int rp = tid >> 4, js = tid & 15, j0 = js * 4; const bool odd = js & 1;
    const bf16* R5 = (const bf16*)(ws + WS_RW5); const float* F = (const float*)(ws + WS_MIX); float* Y = (float*)(ws + WS_YR) + (size_t)dir * MTOT * 512;
    const size_t st = (size_t)MTOT * 512;
    LAS float* buf = (LAS float*)lds;
    const int ls = tid >> 4, lp = tid & 15;
    typedef float f32x2 __attribute__((ext_vector_type(2)));
    f32x2 S00 = {0.f, 0.f}, S01 = {0.f, 0.f}, S10 = {0.f, 0.f}, S11 = {0.f, 0.f};
    float4 wreg; uint2 kkr, br, kr, rr, vr;
    const float4 w0r = *(const float4*)(ldin(13) + l * 1024 + dir * 512 + h * 64 + lp * 4);
#define RW_LOAD(c) do { const int row_ = chain_row((c) * CH_T + ls, b, dir); const size_t o_ = (size_t)row_ * 512 + h * 64 + lp * 4; \
        wreg = *(const float4*)(F + (size_t)row_ * 2048 + dir * 512 + h * 64 + lp * 4); \
        rr = *(const uint2*)(R5 + o_); kr = *(const uint2*)(R5 + st + o_); vr = *(const uint2*)(R5 + 2 * st + o_); kkr = *(const uint2*)(R5 + 3 * st + o_); br = *(const uint2*)(R5 + 4 * st + o_); } while (0)
#define RW_STORE(c) do { LAS float* q_ = buf + (((c) & 1) * CH_T + ls) * RW_LD; float f_[4]; \
        unpack4(kkr, f_); *(LAS f32x4*)(q_ + lp * 4) = (f32x4){f_[0], f_[1], f_[2], f_[3]}; \
        unpack4(br, f_);  *(LAS f32x4*)(q_ + 64 + lp * 4) = (f32x4){f_[0], f_[1], f_[2], f_[3]}; \
        *(LAS f32x4*)(q_ + 128 + lp * 4) = (f32x4){__expf(-0.60653066f * fsigm(wreg.x + w0r.x)), __expf(-0.60653066f * fsigm(wreg.y + w0r.y)), __expf(-0.60653066f * fsigm(wreg.z + w0r.z)), __expf(-0.60653066f * fsigm(wreg.w + w0r.w))}; \
        unpack4(kr, f_);  *(LAS f32x4*)(q_ + 192 + lp * 4) = (f32x4){f_[0], f_[1], f_[2], f_[3]}; \
        unpack4(rr, f_);  *(LAS f32x4*)(q_ + 256 + lp * 4) = (f32x4){f_[0], f_[1], f_[2], f_[3]}; \
        unpack4(vr, f_);  *(LAS f32x4*)(q_ + 320 + lp * 4) = (f32x4){f_[0], f_[1], f_[2], f_[3]}; } while (0)
    __syncthreads();
    RW_LOAD(0); RW_STORE(0);
    __syncthreads();
    for (int c = 0; c < CH_NC; ++c) {
        if (c + 1 < CH_NC) RW_LOAD(c + 1);
        if (c > 0) {
            const int row = chain_row((c - 1) * CH_T + ls, b, dir);
            *(f32x4*)(Y + (size_t)row * 512 + h * 64 + lp * 4) = *(const LAS f32x4*)(buf + RW_YOFF + (((c - 1) & 1) * CH_T + ls) * 64 + lp * 4);
        }
        const LAS float* cb = buf + ((c & 1) * CH_T) * RW_LD; LAS float* yb = buf + RW_YOFF + ((c & 1) * CH_T) * 64;
#pragma unroll 2
        for (int s = 0; s < CH_T; ++s) {
            const LAS float* q = cb + s * RW_LD;
            const f32x4 kk4 = *(const LAS f32x4*)(q + j0), b4 = *(const LAS f32x4*)(q + 64 + j0), w4 = *(const LAS f32x4*)(q + 128 + j0), k4 = *(const LAS f32x4*)(q + 192 + j0), r4 = *(const LAS f32x4*)(q + 256 + j0);
            const f32x2 v2 = *(const LAS f32x2*)(q + 320 + 2 * rp);
            const f32x2 kkA = {kk4[0], kk4[1]}, kkB = {kk4[2], kk4[3]}, bA = {b4[0], b4[1]}, bB = {b4[2], b4[3]}, wA = {w4[0], w4[1]}, wB = {w4[2], w4[3]}, kA = {k4[0], k4[1]}, kB = {k4[2], k4[3]}, rA = {r4[0], r4[1]}, rB = {r4[2], r4[3]};
            f32x2 t0 = S00 * kkA + S01 * kkB, t1 = S10 * kkA + S11 * kkB;
            const float sa0 = -red16(t0[0] + t0[1]), sa1 = -red16(t1[0] + t1[1]);
            S00 = S00 * wA + (bA * sa0 + kA * v2[0]); S01 = S01 * wB + (bB * sa0 + kB * v2[0]);
            S10 = S10 * wA + (bA * sa1 + kA * v2[1]); S11 = S11 * wB + (bB * sa1 + kB * v2[1]);
            t0 = S00 * rA + S01 * rB; t1 = S10 * rA + S11 * rB;
            const float p0 = t0[0] + t0[1], p1 = t1[0] + t1[1];
            float ym = odd ? p1 : p0; const float yo = odd ? p0 : p1;
            ym += dppf<0xB1>(yo); ym += dppf<0x4E>(ym); ym += dppf<0x124>(ym); ym += dppf<0x128>(ym);
            if (js < 2) yb[s * 64 + 2 * rp + js] = ym;
        }
        if (c + 1 < CH_NC) RW_STORE(c + 1);
        __syncthreads();
    }
    { const int row = chain_row((CH_NC - 1) * CH_T + ls, b, dir);
      *(f32x4*)(Y + (size_t)row * 512 + h * 64 + lp * 4) = *(const LAS f32x4*)(buf + RW_YOFF + (((CH_NC - 1) & 1) * CH_T + ls) * 64 + lp * 4); }
#undef RW_LOAD
#undef RW_STORE
}

constexpr int AT_KP = 136, AT_VP = 144;
constexpr int AT_KB = 64 * AT_KP * 2, AT_VB = 64 * AT_VP * 2, AT_BUF = AT_KB + AT_VB;
__device__ __forceinline__ float xmax4(float v) {
    const unsigned u = __float_as_uint(v); const auto r = __builtin_amdgcn_permlane16_swap(u, u, false, false); const float m = fmaxf(__uint_as_float(r[0]), __uint_as_float(r[1]));
    const unsigned w = __float_as_uint(m); const auto q = __builtin_amdgcn_permlane32_swap(w, w, false, false); return fmaxf(__uint_as_float(q[0]), __uint_as_float(q[1])); }
__device__ __forceinline__ float xsum4(float v) {
    const unsigned u = __float_as_uint(v); const auto r = __builtin_amdgcn_permlane16_swap(u, u, false, false); const float m = __uint_as_float(r[0]) + __uint_as_float(r[1]);
    const unsigned w = __float_as_uint(m); const auto q = __builtin_amdgcn_permlane32_swap(w, w, false, false); return __uint_as_float(q[0]) + __uint_as_float(q[1]); }
__device__ __forceinline__ void attn_item(const Ctx& a, LAS unsigned char* lds, int l, int b, int h, int qt, bool ctxq, float lam, float post) {
    unsigned char* ws = opqp(a.ws); const int tid = ((a.wv << 6) | lane_v()), lane = tid & 63, wid = tid >> 6, fr = lane & 15, fq = lane >> 4, q4 = (lane & 15) >> 2, p4 = lane & 3;
    const bf16* QK = (const bf16*)(ws + WS_QK); const bf16* U = (const bf16*)(ws + WS_U); bf16* A2 = (bf16*)(ws + WS_HA);
    const int qrow = (ctxq ? MLAT + b * CTXL : b * SEQ) + qt * 128 + wid * 16 + fr;
    const int nkt = ctxq ? 4 : 36;
    bf16x8 qf[2][2];
#pragma unroll
    for (int c = 0; c < 2; ++c)
#pragma unroll
        for (int ks = 0; ks < 2; ++ks) qf[c][ks] = *(const bf16x8*)(QK + (size_t)qrow * 1024 + h * 128 + c * 64 + ks * 32 + fq * 8);
    f32x4 O[2][8];
#pragma unroll
    for (int c = 0; c < 2; ++c)
#pragma unroll
        for (int d = 0; d < 8; ++d) O[c][d] = (f32x4){0.f, 0.f, 0.f, 0.f};
    float mrun[2] = {-3.0e38f, -3.0e38f}, lrun[2] = {0.f, 0.f};
    uint4 kreg[2], vreg[2];
#define AT_ROW0(kt) ((kt) < 4 ? MLAT + b * CTXL + (kt) * 64 : b * SEQ + ((kt) - 4) * 64)
#define AT_LOADK(kt) do { const int kr0_ = AT_ROW0(kt); _Pragma("unroll") for (int j_ = 0; j_ < 2; ++j_) { const int id_ = tid + j_ * NT, key_ = id_ >> 4, part_ = id_ & 15; \
            kreg[j_] = *(const uint4*)(QK + (size_t)(kr0_ + key_) * 1024 + 512 + h * 128 + part_ * 8); } } while (0)
#define AT_LOADV(kt) do { const int kr0_ = AT_ROW0(kt); _Pragma("unroll") for (int j_ = 0; j_ < 2; ++j_) { const int id_ = tid + j_ * NT, key_ = id_ >> 4, part_ = id_ & 15; \
            vreg[j_] = *(const uint4*)(U + (size_t)(kr0_ + key_) * NINP + C_DA_V + h * 128 + part_ * 8); } } while (0)
#define AT_STOREK(kt) do { LAS bf16* Ks_ = (LAS bf16*)(lds + ((kt) & 1) * AT_KB); _Pragma("unroll") for (int j_ = 0; j_ < 2; ++j_) { const int id_ = tid + j_ * NT, key_ = id_ >> 4, part_ = id_ & 15; \
            *(LAS u32x4*)(Ks_ + key_ * AT_KP + part_ * 8) = (u32x4){kreg[j_].x, kreg[j_].y, kreg[j_].z, kreg[j_].w}; } } while (0)
#define AT_STOREV(kt) do { LAS bf16* Vs_ = (LAS bf16*)(lds + 2 * AT_KB + ((kt) & 1) * AT_VB); _Pragma("unroll") for (int j_ = 0; j_ < 2; ++j_) { const int id_ = tid + j_ * NT, key_ = id_ >> 4, part_ = id_ & 15; \
            *(LAS u32x4*)(Vs_ + key_ * AT_VP + part_ * 8) = (u32x4){vreg[j_].x, vreg[j_].y, vreg[j_].z, vreg[j_].w}; } } while (0)
    __syncthreads();
#define AT_QK(DST_, kt_) do { const LAS bf16* Ks_ = (const LAS bf16*)(lds + ((kt_) & 1) * AT_KB); \
        _Pragma("unroll") for (int c = 0; c < 2; ++c) _Pragma("unroll") for (int sb = 0; sb < 4; ++sb) { f32x4 acc = (f32x4){0.f, 0.f, 0.f, 0.f}; \
            _Pragma("unroll") for (int ks = 0; ks < 2; ++ks) { const bf16x8 kf = *(const LAS bf16x8*)(Ks_ + (sb * 16 + fr) * AT_KP + c * 64 + ks * 32 + fq * 8); \
                acc = __builtin_amdgcn_mfma_f32_16x16x32_bf16(kf, qf[c][ks], acc, 0, 0, 0); } \
            DST_[c][sb] = acc; if (sb == 3) __builtin_amdgcn_sched_barrier(0); } } while (0)
    AT_LOADK(0); AT_STOREK(0); AT_LOADK(1); AT_STOREK(1); AT_LOADV(0); AT_STOREV(0);
    __syncthreads();
    f32x4 S[2][4], Sn[2][4];
    AT_QK(S, 0);
    for (int kt = 0; kt < nkt; ++kt) {
        if (kt + 2 < nkt) AT_LOADK(kt + 2);
        if (kt + 1 < nkt) { AT_LOADV(kt + 1); AT_QK(Sn, kt + 1); }
        const LAS bf16* Vs = (const LAS bf16*)(lds + 2 * AT_KB + (kt & 1) * AT_VB);
        bf16x8 pf[2][2];
#pragma unroll
        for (int c = 0; c < 2; ++c) {
            float mx = S[c][0][0];
#pragma unroll
            for (int sb = 0; sb < 4; ++sb)
#pragma unroll
                for (int e = 0; e < 4; ++e) mx = fmaxf(mx, S[c][sb][e]);
            mx = xmax4(mx);
            const bool need = mx > mrun[c] + 8.0f;
            if (__builtin_amdgcn_ballot_w64(need) != 0ull) {
                const float mnew = need ? mx : mrun[c], alpha = __builtin_amdgcn_exp2f(mrun[c] - mnew); mrun[c] = mnew; lrun[c] *= alpha;
#pragma unroll
                for (int d = 0; d < 8; ++d) O[c][d] *= alpha; }
            const float mref = mrun[c];
            float ps = 0.f;
#pragma unroll
            for (int sb = 0; sb < 4; ++sb)
#pragma unroll
                for (int e = 0; e < 4; ++e) { const float pv = __builtin_amdgcn_exp2f(S[c][sb][e] - mref); S[c][sb][e] = pv; ps += pv; }
            lrun[c] += ps;
#pragma unroll
            for (int kc = 0; kc < 2; ++kc) { u32x4 w; w.x = pk2(S[c][2 * kc][0], S[c][2 * kc][1]); w.y = pk2(S[c][2 * kc][2], S[c][2 * kc][3]); w.z = pk2(S[c][2 * kc + 1][0], S[c][2 * kc + 1][1]); w.w = pk2(S[c][2 * kc + 1][2], S[c][2 * kc + 1][3]);
                pf[c][kc] = __builtin_bit_cast(bf16x8, w); }
        }
#pragma unroll
        for (int kc = 0; kc < 2; ++kc)
#pragma unroll
            for (int d = 0; d < 8; ++d) {
                const LAS bf16* pa = Vs + (kc * 32 + 4 * fq + q4) * AT_VP + d * 16 + 4 * p4;
                const bf16x8 vf = trfrag(pa, pa + 16 * AT_VP);
                O[0][d] = __builtin_amdgcn_mfma_f32_16x16x32_bf16(vf, pf[0][kc], O[0][d], 0, 0, 0);
                O[1][d] = __builtin_amdgcn_mfma_f32_16x16x32_bf16(vf, pf[1][kc], O[1][d], 0, 0, 0);
                if ((d & 3) == 3) __builtin_amdgcn_sched_barrier(0);
            }
        if (kt + 2 < nkt) AT_STOREK(kt + 2);
        if (kt + 1 < nkt) AT_STOREV(kt + 1);
        __syncthreads();
#pragma unroll
        for (int c = 0; c < 2; ++c)
#pragma unroll
            for (int sb = 0; sb < 4; ++sb) S[c][sb] = Sn[c][sb];
    }
#undef AT_QK
#undef AT_LOADK
#undef AT_LOADV
#undef AT_STOREK
#undef AT_STOREV
#undef AT_ROW0
    float l0 = lrun[0], l1 = lrun[1];
    l0 = xsum4(l0); l1 = xsum4(l1);
    const float i0 = 1.0f / l0, i1 = lam / l1;
    float ss = 0.f;
#pragma unroll
    for (int d = 0; d < 8; ++d)
#pragma unroll
        for (int e = 0; e < 4; ++e) { const float o = O[0][d][e] * i0 - O[1][d][e] * i1; O[0][d][e] = o; ss += o * o; }
    ss = xsum4(ss);
    const float rs = rsqrtf(ss * (1.0f / 128.0f) + 1e-5f) * post;
    const float* sw = ldin(30) + l * 128;
#pragma unroll
    for (int d = 0; d < 8; ++d) { const int dc = d * 16 + 4 * fq; const float4 w4 = *(const float4*)(sw + dc);
        uint2 pk; pk.x = pk2(O[0][d][0] * rs * w4.x, O[0][d][1] * rs * w4.y); pk.y = pk2(O[0][d][2] * rs * w4.z, O[0][d][3] * rs * w4.w);
        *(uint2*)(A2 + (size_t)qrow * DM + 1536 + h * 128 + dc) = pk; }
}

__device__ __forceinline__ int q_pull(unsigned* ctr, volatile LAS unsigned* slot, int tid) {
    __syncthreads();
    if (tid == 0) *slot = __hip_atomic_fetch_add(ctr, 1u, __ATOMIC_RELAXED, __HIP_MEMORY_SCOPE_AGENT);
    __syncthreads();
    return (int)*slot;
}
__device__ __forceinline__ void p6_mixers(const Ctx& a, LAS unsigned char* lds, int l, int bid, int G) {
    unsigned char* ws = opqp(a.ws); const int tid = ((a.wv << 6) | lane_v());
    volatile LAS unsigned* slot = (volatile LAS unsigned*)(lds + LDS_STAGE + 8);
    unsigned* qm = (unsigned*)(ws + WS_CTL) + CW_Q + (l * 2 + 0) * 64; unsigned* qa = (unsigned*)(ws + WS_CTL) + CW_Q + (l * 2 + 1) * 64;
    if (a.sub & 1) for (int it = bid; it < R2_ITEMS; it += G) rwkv_r2(a, l, it);
    if (a.sub & 4) {
    const float* lp = ldin(29) + l * 256; float s01 = 0.f, s23 = 0.f;
    for (int i = 0; i < 64; ++i) { s01 += lp[i] * lp[64 + i]; s23 += lp[128 + i] * lp[192 + i]; }
    const float lam_init = l == 0 ? 0.2f : (0.8f - 0.6f * 0.74081822068f);
    const float lam = expf(s01) - expf(s23) + lam_init, post = 1.0f - lam_init;
    const int nat = l == 0 ? 576 : 512;
    for (;;) { const int it = q_pull(qa, slot, tid); if (it >= nat) break;
        if (it < 512) { const int qt = it & 15, h = (it >> 4) & 3, b = it >> 6; attn_item(a, lds, l, b, h, qt, false, lam, post); }
        else { const int i2 = it - 512; const int qt = i2 & 1, h = (i2 >> 1) & 3, b = i2 >> 3; attn_item(a, lds, l, b, h, qt, true, lam, post); } }
    }
    if (a.sub & 2) { const int nit = l == 0 ? 8 * MB_NCH * 2 : 8 * 16 * 2;
        for (;;) { const int it = q_pull(qm, slot, tid); if (it >= nit) break;
            const int g = it & 1; int cc, b; if (l == 0) { cc = (it >> 1) % MB_NCH; b = (it >> 1) / MB_NCH; } else { cc = 2 + ((it >> 1) & 15); b = it >> 5; } mamba_m3(a, lds, b, cc, g); } }
}


constexpr int N_PHASES = 27;
#ifndef P6_CONV
#define P6_CONV 0
#endif
__global__ void __launch_bounds__(NT, 2) fwd(Args args) {
    extern __shared__ __attribute__((aligned(16))) unsigned char lds_dyn[];
    LAS unsigned char* lds = (LAS unsigned char*)lds_dyn;
    volatile LAS unsigned* MISC = (volatile LAS unsigned*)(lds + LDS_STAGE);
    const int wv = __builtin_amdgcn_readfirstlane((int)threadIdx.x >> 6);
    const int tid = (wv << 6) | lane_v(), bid = blockIdx.x, G = gridDim.x;
    unsigned char* ws = args.ws;
    const Ctx cx{ws, wv, args.sub};
    for (int u = tid; u < LDS_MISC / 4; u += NT) MISC[u] = 0u;
    __syncthreads();
    if (tid == 0) {
#pragma unroll
        for (int i = 0; i < 38; ++i) *(LAS unsigned long long*)(lds + LDS_PTRS + 8 * i) = (unsigned long long)args.in[i];
    }
    __syncthreads();
#if MK_PER_PHASE
#define GRID_BAR() do { } while (0)
#else
    XcdBarrier bar = xcd_barrier_post((unsigned*)(ws + WS_CTL) + CW_BAR, MISC);
#define GRID_BAR() do { XcdBarrier b_ = bar; b_.bar = opqp(b_.bar); b_.x = (unsigned)opqs((int)b_.x); xcd_barrier(b_); } while (0)
#endif
    const int lo = args.ph_lo, hi = args.ph_hi;
#define IN(k) (opqs(lo) <= (k) && (k) < opqs(hi))
#define SEAM(k) do { if (IN((k) + 1)) GRID_BAR(); } while (0)

#define XS (args.out)
#define XSB ((float*)(wsq + WS_XSB))
#define XC ((float*)(wsq + WS_XC))
#define HA ((bf16*)(wsq + WS_HA))
#define Ub ((bf16*)(wsq + WS_U))
#define MIX ((float*)(wsq + WS_MIX))
#define HID ((bf16*)(wsq + WS_BIG))
#define PH_LOCALS unsigned char* const wsq = opqp(ws); const int bidq = opqs(bid), Gq = opqs(G); (void)wsq; (void)bidq; (void)Gq

    if (IN(0)) { PH_LOCALS; if (args.sub & 64) bg_convert(cx, lds, nullptr, Gq); else p0_prologue(cx, lds,  bidq, Gq); SEAM(0); }
    if (IN(1)) { PH_LOCALS;
        thin_phase<0, 1>(cx, lds,  bidq, Gq, MTOT, ldin(0), ldin(2), nullptr, nullptr, nullptr, nullptr, 0, 0, ldin(6), 0, 1, 0);
        SEAM(1);
    }
    for (int l = 0; l < 2; ++l) {
        const int pb = 2 + 12 * l;
        const int Mo = l == 0 ? MTOT : MLAT;
        if (IN(pb + 0)) { PH_LOCALS;
            pg8::Gemm g{HA, (const bf16*)(wsq + WS_WIN) + (size_t)l * NINP * DM, MTOT, NINP, DM}; pg8::StaticOrder S; S.init(MTOT, NINP, Gq, bidq);
            pg8::EpiBf16P E{Ub, NINP, 0, 1.0f};
            pg8::gemm_phase<pg8::EpiBf16P, pg8::StaticOrder>(lds, g, S, E, nullptr, (wv << 6) | lane_v());
            bg_tail(cx, lds, l * 8 + 0, Gq);
            SEAM(pb + 0);
        }
        if (IN(pb + 1)) { PH_LOCALS; feat_a(cx, lds, l,  bidq, Gq); SEAM(pb + 1); }
        if (IN(pb + 2)) { PH_LOCALS;
            pg8::Gemm g{(const bf16*)(wsq + WS_ASM), (const bf16*)(wsq + WS_WSM) + (size_t)l * 2048 * 256, MTOT, 2048, 256}; pg8::StaticOrder S; S.init(MTOT, 2048, Gq, bidq);
            pg8::EpiF32 E{MIX, 2048, nullptr};
            pg8::gemm_phase<pg8::EpiF32, pg8::StaticOrder>(lds, g, S, E, nullptr, (wv << 6) | lane_v());
            for (int it = Gq - 1 - bidq; it < 8 * MB_NCH * 2; it += Gq) mamba_m1(cx, lds, it);
            bg_tail(cx, lds, l * 8 + 1, Gq);
            SEAM(pb + 2);
        }
        if (IN(pb + 4)) { PH_LOCALS; for (int it = bidq; it < 256; it += Gq) mamba_m2(cx, it);
            rc_consts(lds, l, (wv << 6) | lane_v());
            for (int u = bidq * NW + wv; u < RC_UNITS; u += Gq * NW) rwkv_r1(cx, lds, l, u); SEAM(pb + 4); }
        if (IN(pb + 5)) { PH_LOCALS; if (bidq < Gq - P6_CONV) p6_mixers(cx, lds, l,  bidq, Gq);
            if (!(args.sub & 32)) bg_tail(cx, lds, l * 8 + 5, Gq); SEAM(pb + 5); }
        if (IN(pb + 6)) { PH_LOCALS; mix_out(cx, lds, l, Mo,  bidq, Gq); SEAM(pb + 6); }
        if (IN(pb + 7)) { PH_LOCALS;
            pg8::Gemm g{HA, (const bf16*)(wsq + WS_WOUT) + (size_t)l * DM * DM, Mo, DM, DM}; pg8::StaticOrder S; S.init(Mo, DM, Gq, bidq);
            pg8::EpiBf16P E{(bf16*)MIX, DM, 0, 1.0f};
            pg8::gemm_phase<pg8::EpiBf16P, pg8::StaticOrder>(lds, g, S, E, nullptr, (wv << 6) | lane_v());
            bg_tail(cx, lds, l * 8 + 2, Gq);
            SEAM(pb + 7);
        }
        if (l == 0) {
            if (IN(pb + 8)) { PH_LOCALS;
                thin_phase<1, DENSE_GU8 ? 3 : 1, 0, 1>(cx, lds,  bidq, Gq, MTOT, ldin(0), ldin(2), XSB, XC, MIX, ldin(7), 0, 2, ldin(8), 0, 4, 3);
                SEAM(pb + 8);
            }
            if (IN(pb + 9)) { PH_LOCALS;
                pg8::StaticOrder S; S.init(MTOT, 2 * FF, Gq, bidq);
#if DENSE_GU8 && DENSE_D8
                pg8::Gemm g{HA, (const bf16*)(wsq + WS_WGU), MTOT, 2 * FF, DM / 2};
                pg8::EpiSwiGLU8 E{(unsigned char*)(wsq + WS_BIG), FF, 0, 1.0f / MOE_SGU, MOE_SH};
                pg8::gemm_phase<pg8::EpiSwiGLU8, pg8::StaticOrder, false, true>(lds, g, S, E, nullptr, (wv << 6) | lane_v());
#elif DENSE_GU8
                pg8::Gemm g{HA, (const bf16*)(wsq + WS_WGU), MTOT, 2 * FF, DM / 2};
                pg8::EpiSwiGLUS E{HID, FF, 0, 1.0f / MOE_SGU};
                pg8::gemm_phase<pg8::EpiSwiGLUS, pg8::StaticOrder, false, true>(lds, g, S, E, nullptr, (wv << 6) | lane_v());
#elif DENSE_D8
                pg8::Gemm g{HA, (const bf16*)(wsq + WS_WGU), MTOT, 2 * FF, DM};
                pg8::EpiSwiGLU8 E{(unsigned char*)(wsq + WS_BIG), FF, 0, 1.0f, MOE_SH};
                pg8::gemm_phase<pg8::EpiSwiGLU8, pg8::StaticOrder>(lds, g, S, E, nullptr, (wv << 6) | lane_v());
#else
                pg8::Gemm g{HA, (const bf16*)(wsq + WS_WGU), MTOT, 2 * FF, DM};
                pg8::EpiSwiGLU E{HID, FF, 0};
                pg8::gemm_phase<pg8::EpiSwiGLU, pg8::StaticOrder>(lds, g, S, E, nullptr, (wv << 6) | lane_v());
#endif
                bg_tail(cx, lds, 3, Gq);
                SEAM(pb + 9);
            }
            if (IN(pb + 10)) { PH_LOCALS;
                pg8::StaticOrder S; S.init(MTOT, DM, Gq, bidq);
#if DENSE_D8
                pg8::Gemm g{HID, (const bf16*)(wsq + WS_WD), MTOT, DM, FF / 2};
                pg8::EpiBf16P E{(bf16*)MIX, DM, 0, 1.0f / (MOE_SD * MOE_SH)};
                pg8::gemm_phase<pg8::EpiBf16P, pg8::StaticOrder, false, true>(lds, g, S, E, nullptr, (wv << 6) | lane_v());
#else
                pg8::Gemm g{HID, (const bf16*)(wsq + WS_WD), MTOT, DM, FF};
                pg8::EpiBf16P E{(bf16*)MIX, DM, 0, 1.0f};
                pg8::gemm_phase<pg8::EpiBf16P, pg8::StaticOrder>(lds, g, S, E, nullptr, (wv << 6) | lane_v());
#endif
                bg_tail(cx, lds, 4, Gq);
                SEAM(pb + 10);
            }
            if (IN(pb + 11)) { PH_LOCALS;
                thin_phase<1, 1, 1, 1>(cx, lds,  bidq, Gq, MTOT, XSB, XC, XSB, XC, MIX, ldin(9), 0, 5, ldin(6) + DM, 1, 1, 0);
                SEAM(pb + 11);
            }
        } else {
            if (IN(pb + 8)) { PH_LOCALS;
                thin_phase<1, 2, 1, 1>(cx, lds,  bidq, Gq, MLAT, XSB, XC, XSB, XC, MIX, ldin(7) + DM, 1, 2, ldin(8) + DM, 1, 4, 3);
                SEAM(pb + 8);
            }
            if (IN(pb + 9)) { PH_LOCALS; moe_gather(cx,  bidq, Gq); bg_convert(cx, lds, nullptr, Gq); SEAM(pb + 9); }
            if (IN(pb + 10) || IN(pb + 11)) { PH_LOCALS;
                if (((wv << 6) | lane_v()) == 0) { const unsigned* cnt = (const unsigned*)(wsq + WS_CTL) + CW_CNT; int run = 0;
                    for (int e = 0; e < 8; ++e) { const int t = (int)((cnt[e * 64] + 255u) >> 8); MISC[16 + e] = (unsigned)t; MISC[24 + e] = (unsigned)run; run += t; } }
                __syncthreads();
            }
            if (IN(pb + 10)) { PH_LOCALS;
                pg8::MoeOrder S{(const LAS int*)(lds + LDS_STAGE + 64), (2 * FE) / 256, Gq, bidq};
#if MOE_FP8
                pg8::Gemm g{(const bf16*)(wsq + WS_U), (const bf16*)(wsq + WS_MGU), MOE_ROWS, 2 * FE, DM / 2};
                pg8::EpiSwiGLU8 E{(unsigned char*)(wsq + WS_BIG), FE, (2 * FE) / 256, 1.0f / MOE_SGU, MOE_SH};
                pg8::gemm_phase<pg8::EpiSwiGLU8, pg8::MoeOrder, false, true>(lds, g, S, E, nullptr, (wv << 6) | lane_v());
#else
                pg8::Gemm g{(const bf16*)(wsq + WS_U), (const bf16*)(wsq + WS_MGU), MOE_ROWS, 2 * FE, DM};
                pg8::EpiSwiGLU E{HID, FE, (2 * FE) / 256};
                pg8::gemm_phase<pg8::EpiSwiGLU, pg8::MoeOrder>(lds, g, S, E, nullptr, (wv << 6) | lane_v());
#endif
                SEAM(pb + 10);
            }
            if (IN(pb + 11)) { PH_LOCALS;
                pg8::MoeOrder S{(const LAS int*)(lds + LDS_STAGE + 64), DM / 256, Gq, bidq};
#if MOE_FP8
                pg8::Gemm g{HID, (const bf16*)(wsq + WS_MD), MOE_ROWS, DM, FE / 2};
                pg8::EpiBf16P E{(bf16*)(wsq + WS_MIX), DM, DM / 256, 1.0f / (MOE_SD * MOE_SH)};
                pg8::gemm_phase<pg8::EpiBf16P, pg8::MoeOrder, false, true>(lds, g, S, E, nullptr, (wv << 6) | lane_v());
#else
                pg8::Gemm g{HID, (const bf16*)(wsq + WS_MD), MOE_ROWS, DM, FE};
                pg8::EpiBf16P E{(bf16*)(wsq + WS_MIX), DM, DM / 256, 1.0f};
                pg8::gemm_phase<pg8::EpiBf16P, pg8::MoeOrder>(lds, g, S, E, nullptr, (wv << 6) | lane_v());
#endif
                SEAM(pb + 11);
            }
            if (IN(pb + 12)) { PH_LOCALS;
                thin_phase<2, 0, 1, 0>(cx, lds,  bidq, Gq, MLAT, XSB, XC, XS, XC, nullptr, ldin(9) + DM, 1, 5, nullptr, 0, 0, 0);
            }
        }
    }
#undef IN
#undef SEAM
}

extern "C" void kernel_launch(void* const* d_in, const int* in_sizes, int n_in, void* d_out, int out_size, void* d_ws, size_t ws_size, hipStream_t stream) {
    static int grid = 0;
    if (grid == 0) {
        if (n_in != 38 || out_size != MLAT * DM || ws_size < WS_END) { fprintf(stderr, "kernel_launch: unexpected shapes (n_in %d out %d ws %zu need %zu)\n", n_in, out_size, ws_size, (size_t)WS_END); grid = -1; return; }
        int dev = 0, cus = 0, per_cu = 0;
        if (hipGetDevice(&dev) != hipSuccess || hipDeviceGetAttribute(&cus, hipDeviceAttributeMultiprocessorCount, dev) != hipSuccess) { grid = -1; return; }
        if (hipFuncSetAttribute((const void*)fwd, hipFuncAttributeMaxDynamicSharedMemorySize, LDS_BYTES) != hipSuccess) { fprintf(stderr, "kernel_launch: hipFuncSetAttribute failed\n"); grid = -1; return; }
        if (hipOccupancyMaxActiveBlocksPerMultiprocessor(&per_cu, (const void*)fwd, NT, LDS_BYTES) != hipSuccess || per_cu < 1) { fprintf(stderr, "kernel_launch: occupancy query says %d\n", per_cu); per_cu = 1; }
        (void)hipGetLastError();
        grid = cus;
    }
    if (grid < 0) return;
    if (hipMemsetAsync((char*)d_ws + WS_CTL, 0, CTL_BYTES, stream) != hipSuccess) return;
    Args a{};
    for (int i = 0; i < 38; ++i) a.in[i] = (const float*)d_in[i];
    a.out = (float*)d_out; a.ws = (unsigned char*)d_ws; a.sub = 7;
#if MK_PER_PHASE
#ifndef PROBE_SUB
#define PROBE_SUB 7
#endif
#ifndef PROBE_MASK
#define PROBE_MASK 0u
#endif
#ifndef PROBE_SPLIT
#define PROBE_SPLIT 0
#endif
#ifndef PROBE_REP
#define PROBE_REP 1
#endif
    for (int p = 0; p < N_PHASES; ++p) { a.ph_lo = p; a.ph_hi = p + 1;
        if (PROBE_SPLIT && (p == 7 || p == 19)) {
            a.sub = 1; hipLaunchKernelGGL(fwd, dim3(grid), dim3(NT), LDS_BYTES, stream, a);
            if (PROBE_SPLIT == 1) { a.sub = 2; hipLaunchKernelGGL(fwd, dim3(grid), dim3(NT), LDS_BYTES, stream, a); a.sub = 4; hipLaunchKernelGGL(fwd, dim3(grid), dim3(NT), LDS_BYTES, stream, a); }
            else if (PROBE_SPLIT == 2) { a.sub = 6; hipLaunchKernelGGL(fwd, dim3(grid), dim3(NT), LDS_BYTES, stream, a); }
            else { a.sub = 2; hipLaunchKernelGGL(fwd, dim3(grid), dim3(NT), LDS_BYTES, stream, a); a.sub = 5; hipLaunchKernelGGL(fwd, dim3(grid), dim3(NT), LDS_BYTES, stream, a); }
            a.sub = 7; continue; }
        if ((PROBE_MASK >> p) & 1u) { a.sub = PROBE_SUB;
            for (int rep = 0; rep < PROBE_REP; ++rep) { if (rep) (void)hipMemsetAsync((char*)d_ws + WS_CTL + CW_BG * 4, 0, 256, stream); hipLaunchKernelGGL(fwd, dim3(grid), dim3(NT), LDS_BYTES, stream, a); }
            a.sub = 7;
            (void)hipMemsetAsync((char*)d_ws + WS_CTL + CW_Q * 4, 0, 4 * 256, stream); }
        hipLaunchKernelGGL(fwd, dim3(grid), dim3(NT), LDS_BYTES, stream, a); }
#else
    a.ph_lo = 0; a.ph_hi = N_PHASES; hipLaunchKernelGGL(fwd, dim3(grid), dim3(NT), LDS_BYTES, stream, a);
#endif
}
```
